# Optimizing an MI355X kernel written in HIP

```python
import math
import jax
import jax.numpy as jnp
from jax import lax
import numpy as np

D_MODEL = 1024
BATCH = 16
SEQ = 4096
DEPTH = 1

ATT_HEADS = 16
ATT_KV_HEADS = 4
ATT_HEAD_DIM = 64
ATT_W = ATT_HEADS * ATT_HEAD_DIM
KV_W = ATT_KV_HEADS * ATT_HEAD_DIM
WINDOW = 128
BLOCK = 128
ROPE_THETA = 10000.0

SSD_HEADS = 8
SSD_HEAD_DIM = 64
SSD_W = SSD_HEADS * SSD_HEAD_DIM
SSD_GROUPS = 2
SSD_HPG = SSD_HEADS // SSD_GROUPS
SSD_STATE = 128
SSD_CONV = 5
CHUNK = 128
N_DIR = 2
XBC_W = SSD_W + 2 * SSD_GROUPS * SSD_STATE

MEM_LEN = 256
MEM_HEADS = 4
MEM_HEAD_DIM = 128
MEM_W = MEM_HEADS * MEM_HEAD_DIM

MIX_W = ATT_W + SSD_W + MEM_W
SPLIT_SIZES = (ATT_W, KV_W, KV_W, ATT_W, SSD_W, XBC_W, N_DIR * SSD_HEADS, MEM_W, MEM_W)
IN_W = ATT_W + 2 * KV_W + ATT_W + SSD_W + XBC_W + N_DIR * SSD_HEADS + 2 * MEM_W
EPS = 1e-6

kernel_name = "hymba_style_bidir_swa_ssd_memxattn_layer"


def _split_points():
    pts, acc = [], 0
    for s in SPLIT_SIZES[:-1]:
        acc += s
        pts.append(acc)
    return pts


def rms_norm(x, w):
    xf = x.astype(jnp.float32)
    y = xf * lax.rsqrt(jnp.mean(xf * xf, axis=-1, keepdims=True) + EPS)
    return (y * w.astype(jnp.float32)).astype(x.dtype)


def gated_group_rmsnorm(y, z, w):
    g = (y * jax.nn.silu(z)).astype(jnp.float32)
    b, l, c = g.shape
    g = g.reshape(b, l, SSD_GROUPS, c // SSD_GROUPS)
    g = g * lax.rsqrt(jnp.mean(g * g, axis=-1, keepdims=True) + EPS)
    return (g.reshape(b, l, c) * w.astype(jnp.float32)).astype(y.dtype)


def rotary(t, cos, sin):
    t1, t2 = jnp.split(t, 2, axis=-1)
    c = cos[None, :, None, :].astype(t.dtype)
    s = sin[None, :, None, :].astype(t.dtype)
    return jnp.concatenate([t1 * c - t2 * s, t1 * s + t2 * c], axis=-1)


def window_attention(q, k, v, sink):
    b, l, h, dh = q.shape
    kvh = k.shape[2]
    r = h // kvh
    nb = l // BLOCK
    span = BLOCK + 2 * WINDOW
    pad = ((0, 0), (WINDOW, WINDOW), (0, 0), (0, 0))
    kp = jnp.pad(k, pad)
    vp = jnp.pad(v, pad)
    qg = q.reshape(b, l, kvh, r, dh)
    scale = dh ** -0.5
    sink_f = sink.astype(jnp.float32).reshape(1, kvh, r, 1, 1)

    def one_block(i):
        start = i * BLOCK
        qb = lax.dynamic_slice_in_dim(qg, start, BLOCK, axis=1)
        kb = lax.dynamic_slice_in_dim(kp, start, span, axis=1)
        vb = lax.dynamic_slice_in_dim(vp, start, span, axis=1)
        s = jnp.einsum('bqkrd,bskd->bkrqs', qb, kb).astype(jnp.float32) * scale
        qpos = start + jnp.arange(BLOCK)
        kpos = start - WINDOW + jnp.arange(span)
        valid = ((jnp.abs(qpos[:, None] - kpos[None, :]) <= WINDOW)
                 & (kpos >= 0)[None, :] & (kpos < l)[None, :])
        s = jnp.where(valid, s, -jnp.inf)
        sink_col = jnp.broadcast_to(sink_f, s.shape[:-1] + (1,))
        p = jax.nn.softmax(jnp.concatenate([s, sink_col], axis=-1), axis=-1)[..., :-1]
        o = jnp.einsum('bkrqs,bskd->bqkrd', p.astype(vb.dtype), vb)
        return o.reshape(b, BLOCK, h, dh)

    out = lax.map(one_block, jnp.arange(nb))
    return out.transpose(1, 0, 2, 3, 4).reshape(b, l, h, dh)


def centred_depthwise_conv(u, w, bias):
    k = w.shape[0]
    y = lax.conv_general_dilated(
        u, w[:, None, :].astype(u.dtype), window_strides=(1,),
        padding=[((k - 1) // 2, k // 2)],
        dimension_numbers=('NWC', 'WIO', 'NWC'),
        feature_group_count=u.shape[-1])
    return y + bias.astype(u.dtype)


def ssd_scan(x, dt, a, bm, cm):
    bsz, l, g, r, p = x.shape
    n = bm.shape[-1]
    nc = l // CHUNK
    xdt = (x * dt[..., None]).reshape(bsz, nc, CHUNK, g, r, p)
    adt = (dt.astype(jnp.float32) * a.astype(jnp.float32)).reshape(bsz, nc, CHUNK, g, r)
    bc = bm.reshape(bsz, nc, CHUNK, g, n)
    cc = cm.reshape(bsz, nc, CHUNK, g, n)
    a_cs = jnp.cumsum(adt, axis=2).transpose(0, 1, 3, 4, 2)
    seg = a_cs[..., :, None] - a_cs[..., None, :]
    lower = jnp.tril(jnp.ones((CHUNK, CHUNK), dtype=bool))
    lmat = jnp.exp(jnp.where(lower, seg, -jnp.inf)).astype(x.dtype)
    cb = jnp.einsum('bclgn,bcsgn->bcgls', cc, bc)
    y_diag = jnp.einsum('bcgls,bcgrls,bcsgrp->bclgrp', cb, lmat, xdt)
    decay_in = jnp.exp(a_cs[..., -1:] - a_cs).astype(x.dtype)
    states = jnp.einsum('bcsgn,bcgrs,bcsgrp->bcgrpn', bc, decay_in, xdt)
    chunk_decay = jnp.exp(a_cs[..., -1]).astype(x.dtype)

    def step(hstate, inp):
        st, dec = inp
        return hstate * dec[..., None, None] + st, hstate

    h0 = jnp.zeros((bsz, g, r, p, n), dtype=states.dtype)
    _, prev = lax.scan(step, h0, (states.transpose(1, 0, 2, 3, 4, 5),
                                  chunk_decay.transpose(1, 0, 2, 3)))
    prev = prev.transpose(1, 0, 2, 3, 4, 5)
    y_off = jnp.einsum('bclgn,bcgrpn,bcgrl->bclgrp', cc, prev,
                       jnp.exp(a_cs).astype(x.dtype))
    return (y_diag + y_off).reshape(bsz, l, g, r, p)


def setup_inputs(seed: int = 0) -> dict:
    key = jax.random.key(seed)
    ks = jax.random.split(key, 20)
    f32 = jnp.float32
    x = jax.random.normal(ks[0], (BATCH, SEQ, D_MODEL), f32)
    mem = jax.random.normal(ks[1], (BATCH, MEM_LEN, D_MODEL), f32)
    norm_mem_w = 1.0 + 0.02 * jax.random.normal(ks[2], (D_MODEL,), f32)
    norm_in_w = 1.0 + 0.02 * jax.random.normal(ks[3], (DEPTH, D_MODEL), f32)
    w_in = jax.random.normal(ks[4], (DEPTH, D_MODEL, IN_W), f32) * D_MODEL ** -0.5
    attn_sink = 0.5 * jax.random.normal(ks[5], (DEPTH, ATT_HEADS), f32)
    conv_w = jax.random.normal(ks[6], (DEPTH, SSD_CONV, XBC_W), f32) * SSD_CONV ** -0.5
    conv_b = 0.01 * jax.random.normal(ks[7], (DEPTH, XBC_W), f32)
    u = jax.random.uniform(ks[8], (DEPTH, N_DIR, SSD_HEADS), f32)
    dt0 = jnp.exp(u * (math.log(0.1) - math.log(0.001)) + math.log(0.001))
    dt_bias = dt0 + jnp.log(-jnp.expm1(-dt0))
    a_log = jnp.log(jax.random.uniform(ks[9], (DEPTH, N_DIR, SSD_HEADS), f32,
                                       minval=1.0, maxval=16.0))
    d_skip = 1.0 + 0.1 * jax.random.normal(ks[10], (DEPTH, SSD_HEADS), f32)
    ssd_norm_w = 1.0 + 0.02 * jax.random.normal(ks[11], (DEPTH, SSD_W), f32)
    w_mem_kv = jax.random.normal(ks[12], (DEPTH, D_MODEL, 2 * MEM_W), f32) * D_MODEL ** -0.5
    w_out = jax.random.normal(ks[13], (DEPTH, MIX_W, D_MODEL), f32) * MIX_W ** -0.5
    norm_out_w = 1.0 + 0.02 * jax.random.normal(ks[14], (D_MODEL,), f32)
    return {"x": x, "mem": mem, "norm_mem_w": norm_mem_w, "norm_in_w": norm_in_w,
            "w_in": w_in, "attn_sink": attn_sink, "conv_w": conv_w, "conv_b": conv_b,
            "dt_bias": dt_bias, "a_log": a_log, "d_skip": d_skip, "ssd_norm_w": ssd_norm_w,
            "w_mem_kv": w_mem_kv, "w_out": w_out, "norm_out_w": norm_out_w}


def reference(x, mem, norm_mem_w, norm_in_w, w_in, attn_sink, conv_w, conv_b,
              dt_bias, a_log, d_skip, ssd_norm_w, w_mem_kv, w_out, norm_out_w):
    bsz, l, _ = x.shape
    pos = jnp.arange(l, dtype=jnp.float32)
    inv_freq = 1.0 / (ROPE_THETA ** (jnp.arange(0, ATT_HEAD_DIM, 2, dtype=jnp.float32) / ATT_HEAD_DIM))
    ang = pos[:, None] * inv_freq[None, :]
    cos, sin = jnp.cos(ang), jnp.sin(ang)
    memn = rms_norm(mem, norm_mem_w)
    splits = _split_points()

    h = x
    for layer in range(DEPTH):
        hn = rms_norm(h, norm_in_w[layer])
        proj = hn @ w_in[layer]
        q, k, v, g_attn, z, xbc, dt_raw, q_mem, g_mem = jnp.split(proj, splits, axis=-1)

        q = rotary(q.reshape(bsz, l, ATT_HEADS, ATT_HEAD_DIM), cos, sin)
        k = rotary(k.reshape(bsz, l, ATT_KV_HEADS, ATT_HEAD_DIM), cos, sin)
        v = v.reshape(bsz, l, ATT_KV_HEADS, ATT_HEAD_DIM)
        att = window_attention(q, k, v, attn_sink[layer]).reshape(bsz, l, ATT_W)
        att = att * jax.nn.silu(g_attn)

        xbc = jax.nn.silu(centred_depthwise_conv(xbc, conv_w[layer], conv_b[layer]))
        xs, bm, cm = jnp.split(xbc, [SSD_W, SSD_W + SSD_GROUPS * SSD_STATE], axis=-1)
        xs = xs.reshape(bsz, l, SSD_GROUPS, SSD_HPG, SSD_HEAD_DIM)
        bm = bm.reshape(bsz, l, SSD_GROUPS, SSD_STATE)
        cm = cm.reshape(bsz, l, SSD_GROUPS, SSD_STATE)
        dt = jax.nn.softplus(dt_raw.reshape(bsz, l, N_DIR, SSD_GROUPS, SSD_HPG)
                             + dt_bias[layer].reshape(N_DIR, SSD_GROUPS, SSD_HPG).astype(dt_raw.dtype))
        a = -jnp.exp(a_log[layer].astype(jnp.float32)).reshape(N_DIR, SSD_GROUPS, SSD_HPG)
        y_fwd = ssd_scan(xs, dt[:, :, 0], a[0], bm, cm)
        y_bwd = ssd_scan(xs[:, ::-1], dt[:, ::-1, 1], a[1], bm[:, ::-1], cm[:, ::-1])[:, ::-1]
        y = y_fwd + y_bwd + d_skip[layer].reshape(SSD_GROUPS, SSD_HPG, 1).astype(xs.dtype) * xs
        ssd = gated_group_rmsnorm(y.reshape(bsz, l, SSD_W).astype(x.dtype), z, ssd_norm_w[layer])

        mkv = memn @ w_mem_kv[layer]
        mk, mv = jnp.split(mkv, 2, axis=-1)
        mk = mk.reshape(bsz, MEM_LEN, MEM_HEADS, MEM_HEAD_DIM)
        mv = mv.reshape(bsz, MEM_LEN, MEM_HEADS, MEM_HEAD_DIM)
        qm = q_mem.reshape(bsz, l, MEM_HEADS, MEM_HEAD_DIM)
        sm = jnp.einsum('blhd,bmhd->bhlm', qm, mk).astype(jnp.float32) * MEM_HEAD_DIM ** -0.5
        pm = jax.nn.softmax(sm, axis=-1).astype(mv.dtype)
        xat = jnp.einsum('bhlm,bmhd->blhd', pm, mv).reshape(bsz, l, MEM_W)
        xat = xat * jax.nn.silu(g_mem)

        mixed = jnp.concatenate([att, ssd.astype(att.dtype), xat], axis=-1)
        h = h + mixed @ w_out[layer]

    return rms_norm(h, norm_out_w)
```

```cpp
#include <hip/hip_runtime.h>
#include <hip/hip_cooperative_groups.h>
#include <cstdio>
#include <cstdint>
namespace cg = cooperative_groups;

#ifndef DBG_STOP
#define DBG_STOP 0
#define DBG_SEL 2
#endif
#ifndef MK_ONE_LAUNCH
#define MK_ONE_LAUNCH 1
#endif

#define LAS __attribute__((address_space(3)))
typedef unsigned short bf16_t;
typedef short bf16x8 __attribute__((ext_vector_type(8)));
typedef short s16x4 __attribute__((ext_vector_type(4)));
typedef float f32x4 __attribute__((ext_vector_type(4)));
typedef float f32x2 __attribute__((ext_vector_type(2)));
typedef unsigned u32x4 __attribute__((ext_vector_type(4)));
typedef unsigned u32x2 __attribute__((ext_vector_type(2)));
typedef LAS unsigned char* ldsp;

constexpr int SEQ = 4096, NBATCH = 16, TOK = SEQ * NBATCH, DM = 1024;
constexpr int INW = 5136, NPHYS = 5376, PW = 5120;
constexpr int C_Q = 0, C_K = 1024, C_V = 1280, C_G = 1536, C_Z = 2560, C_X = 3072, C_QM = 4096, C_GM = 4608;
constexpr int MIXW = 2048;
constexpr float LOG2E = 1.4426950408889634f;
constexpr float EPS = 1e-6f;
constexpr int NPHASE = 7;

constexpr size_t MiB = (size_t)1 << 20;
constexpr size_t WS_ROWSS = 936 * MiB, WS_ROPE = 1 * MiB, WS_WIN = 2 * MiB, WS_WOUT = 13 * MiB, WS_WMEM = 17 * MiB, WS_MEMN = 19 * MiB,
                 WS_MKV = 27 * MiB, WS_DT = 35 * MiB, WS_DEC = 39 * MiB, WS_PROJ = 40 * MiB, WS_MIX = 680 * MiB, WS_END = 940 * MiB;

constexpr int LDS_BYTES = 155648;

__device__ __forceinline__ unsigned cvt_pk(float lo, float hi) { unsigned r; asm volatile("v_cvt_pk_bf16_f32 %0, %1, %2" : "=v"(r) : "v"(lo), "v"(hi)); return r; }
typedef __bf16 bf16x2_t __attribute__((ext_vector_type(2)));
__device__ __forceinline__ unsigned cvt_pk_c(float lo, float hi) { const f32x2 v = {lo, hi}; return __builtin_bit_cast(unsigned, __builtin_convertvector(v, bf16x2_t)); }
__device__ __forceinline__ float bf_lo(unsigned u) { return __uint_as_float(u << 16); }
__device__ __forceinline__ float bf_hi(unsigned u) { return __uint_as_float(u & 0xffff0000u); }
__device__ __forceinline__ f32x4 unpack4(u32x2 v) { return (f32x4){bf_lo(v.x), bf_hi(v.x), bf_lo(v.y), bf_hi(v.y)}; }
__device__ __forceinline__ u32x2 pack4(f32x4 v) { return (u32x2){cvt_pk_c(v.x, v.y), cvt_pk_c(v.z, v.w)}; }
__device__ __forceinline__ float silu_f(float x) { return x * __builtin_amdgcn_rcpf(1.f + __expf(-x)); }
__device__ __forceinline__ f32x4 silu4(f32x4 v) { return (f32x4){silu_f(v.x), silu_f(v.y), silu_f(v.z), silu_f(v.w)}; }
__device__ __forceinline__ float softplus_f(float x) { return x > 20.f ? x : log1pf(expf(x)); }
__device__ __forceinline__ float ex2(float x) { return __builtin_amdgcn_exp2f(x); }
typedef short v4i16_t __attribute__((ext_vector_type(4)));
__device__ __forceinline__ s16x4 vtr(ldsp p) { return __builtin_bit_cast(s16x4, __builtin_amdgcn_ds_read_tr16_b64_v4i16((LAS v4i16_t*)p)); }
__device__ __forceinline__ bf16x8 cat8(s16x4 a, s16x4 b) { return (bf16x8){a[0], a[1], a[2], a[3], b[0], b[1], b[2], b[3]}; }
__device__ __forceinline__ bf16x8 ld8(ldsp p) { return *(const LAS bf16x8*)p; }
__device__ __forceinline__ f32x4 mfma16(bf16x8 a, bf16x8 b, f32x4 c) { return __builtin_amdgcn_mfma_f32_16x16x32_bf16(a, b, c, 0, 0, 0); }
__device__ __forceinline__ bf16x8 packfrag(f32x4 a, f32x4 b) { u32x4 r = {cvt_pk_c(a.x, a.y), cvt_pk_c(a.z, a.w), cvt_pk_c(b.x, b.y), cvt_pk_c(b.z, b.w)}; return __builtin_bit_cast(bf16x8, r); }

__device__ __forceinline__ f32x4 zero4() { f32x4 z; asm volatile("v_mov_b32 %0, 0\n\tv_mov_b32 %1, 0\n\tv_mov_b32 %2, 0\n\tv_mov_b32 %3, 0" : "=v"(z.x), "=v"(z.y), "=v"(z.z), "=v"(z.w)); return z; }
__host__ __device__ __forceinline__ int perm_plain(int c) { const int bj = c >> 7, wc = (c >> 5) & 3, n = (c >> 4) & 1, fq = (c >> 2) & 3, i = c & 3; return 128 * bj + 32 * wc + 8 * fq + 4 * n + i; }
__host__ __device__ __forceinline__ int perm_rot(int c) { const int bj = c >> 7, wc = (c >> 5) & 3, n = (c >> 4) & 1, fq = (c >> 2) & 3, i = c & 3; return 64 * wc + 32 * bj + 8 * fq + 4 * n + i; }

namespace pg8 {
constexpr int BM = 256, BK = 64, HALF = 128, HTB = HALF * BK * 2, STAGE_BYTES = 8 * HTB, NXCD = 8, WGM = 8;
__host__ __device__ __forceinline__ int lds_byte(int r, int c) { const int st = (r >> 4) * 2 + (c >> 5), rr = r & 15, cc = c & 31, ob = rr * 64 + cc * 2; return st * 1024 + (ob ^ (((ob >> 9) & 1) << 5)); }
__host__ __device__ __forceinline__ void stage_rc(int b, int& R, int& C) { const int st = b / 1024, sb = b % 1024, swz = sb ^ (((sb >> 9) & 1) << 5); R = (st >> 1) * 16 + swz / 64; C = (st & 1) * 32 + (swz % 64) / 2; }
struct Unit { int pm, pn; };
struct Gemm { const bf16_t* A; const bf16_t* Bt; int M, N, K; };
struct StaticOrder {
    int nM, nN, nwg, G, c;
    __device__ void init(int M, int N, int G_, int c_) { nM = M / BM; nN = N / BM; nwg = nM * nN; G = G_; c = c_; }
    __device__ bool next(int i, Unit& u) const {
        const long L = (long)i * G + c; if (L >= nwg) return false;
        int wgid = (int)L; { const int q = nwg / NXCD, r = nwg % NXCD, xcd = wgid % NXCD, off = wgid / NXCD; wgid = (xcd < r ? xcd * (q + 1) : r * (q + 1) + (xcd - r) * q) + off; }
        const int nig = WGM * nN, gid = wgid / nig, fm = gid * WGM, gsz = (nM - fm) < WGM ? (nM - fm) : WGM;
        u.pm = fm + ((wgid % nig) % gsz); u.pn = (wgid % nig) / gsz; return true;
    }
};
struct PanelOrder {
    int nM, nN, G, c;
    __device__ void init(int M, int N, int G_, int c_) { nM = M / BM; nN = N / BM; G = G_; c = c_; }
    __device__ bool next(int i, Unit& u) const { const int pm = c + (i / nN) * G; if (pm >= nM) return false; u.pm = pm; u.pn = i % nN; return true; }
};

template <class Epi, class Sched>
__device__ __forceinline__ void gemm_phase(ldsp lds, const Gemm g, const Sched& S, const Epi& E) {
    const int tid = threadIdx.x, wid = __builtin_amdgcn_readfirstlane(tid >> 6), lane = tid & 63, wr = wid >> 2, wc = wid & 3, fr = lane & 15, fq = lane >> 4;
    const int K = g.K, nt = K / BK;
    unsigned voffA[2];
#pragma unroll
    for (int i = 0; i < 2; ++i) { int R, C; stage_rc(tid * 16 + i * 8192, R, C); voffA[i] = (unsigned)(R * K + C) * 2u; }
    const size_t kstep = (size_t)(BK * 2);
    const size_t hstep = (size_t)HALF * K * 2;
    const size_t tstep = 2 * hstep;
    const unsigned ldsw = (unsigned)wid * 1024u;
    const int aoff = lds_byte(wr * 64 + fr, fq * 8), boff = lds_byte(wc * 32 + fr, fq * 8);
#define PG8_SA(b, h) (((b) * 2 + (h)) * HTB)
#define PG8_SB(b, h) ((4 + (b) * 2 + (h)) * HTB)
#define PG8_STAGE(bufoff, gbase) do { _Pragma("unroll") for (int _i = 0; _i < 2; ++_i) \
        __builtin_amdgcn_global_load_lds((const unsigned*)((const char*)(gbase) + voffA[_i]), (LAS unsigned*)(lds + (bufoff) + ldsw + _i * 8192), 16, 0, 0); } while (0)
#define PG8_LDA(dst, b, h) do { _Pragma("unroll") for (int m = 0; m < 4; ++m) _Pragma("unroll") for (int k = 0; k < 2; ++k) dst[m][k] = *(const LAS bf16x8*)(lds + PG8_SA(b, h) + aoff + m * 2048 + k * 1024); } while (0)
#define PG8_LDB(dst, b, h) do { _Pragma("unroll") for (int n = 0; n < 2; ++n) _Pragma("unroll") for (int k = 0; k < 2; ++k) dst[n][k] = *(const LAS bf16x8*)(lds + PG8_SB(b, h) + boff + n * 2048 + k * 1024); } while (0)
#define PG8_MMA(ai, bj, At, Bt) do { __builtin_amdgcn_s_setprio(1); _Pragma("unroll") for (int m = 0; m < 4; ++m) _Pragma("unroll") for (int n = 0; n < 2; ++n) _Pragma("unroll") for (int k = 0; k < 2; ++k) \
        acc[ai][bj][m][n] = __builtin_amdgcn_mfma_f32_16x16x32_bf16(Bt[n][k], At[m][k], acc[ai][bj][m][n], 0, 0, 0); __builtin_amdgcn_s_setprio(0); } while (0)
#define PG8_WAIT_V(n) asm volatile("s_waitcnt vmcnt(" #n ")" ::: "memory")
#define PG8_WAIT_L(n) asm volatile("s_waitcnt lgkmcnt(" #n ")" ::: "memory")
#define PG8_BAR __builtin_amdgcn_s_barrier()
#define PG8_SCHED __builtin_amdgcn_sched_barrier(0)
    Unit cur, nxt; int ui = 0;
    if (!S.next(0, cur)) return;
    f32x4 acc[2][2][4][2];
#pragma unroll
    for (int a = 0; a < 2; ++a)
#pragma unroll
        for (int b = 0; b < 2; ++b)
#pragma unroll
            for (int m = 0; m < 4; ++m)
#pragma unroll
                for (int n = 0; n < 2; ++n) acc[a][b][m][n] = (f32x4){0.f, 0.f, 0.f, 0.f};
    bf16x8 At[4][2], B0[2][2], B1[2][2];
    const char* cA = (const char*)g.A + (size_t)cur.pm * tstep; const char* cB = (const char*)g.Bt + (size_t)cur.pn * tstep;
    PG8_STAGE(PG8_SB(0, 0), cB); PG8_STAGE(PG8_SA(0, 0), cA); PG8_STAGE(PG8_SB(0, 1), cB + hstep); PG8_STAGE(PG8_SA(0, 1), cA + hstep);
    if (wr == 1) PG8_BAR;
    PG8_WAIT_V(4); PG8_BAR;
    PG8_STAGE(PG8_SB(1, 0), cB + kstep); PG8_STAGE(PG8_SA(1, 0), cA + kstep); PG8_STAGE(PG8_SB(1, 1), cB + hstep + kstep);
    PG8_WAIT_V(6); PG8_BAR;
    for (;;) {
        const bool has_next = S.next(ui + 1, nxt);
        const char* nA = has_next ? (const char*)g.A + (size_t)nxt.pm * tstep : cA; const char* nB = has_next ? (const char*)g.Bt + (size_t)nxt.pn * tstep : cB;
        for (int t = 0; t < nt; t += 2) {
            const bool last = (t == nt - 2);
            const char* a1 = cA + (size_t)(t + 1) * kstep;
            const char* a2 = last ? nA : cA + (size_t)(t + 2) * kstep; const char* b2 = last ? nB : cB + (size_t)(t + 2) * kstep;
            const char* a3 = a2 + kstep; const char* b3 = b2 + kstep;
            PG8_LDB(B0, 0, 0); PG8_SCHED; PG8_LDA(At, 0, 0); PG8_STAGE(PG8_SA(1, 1), a1 + hstep);
            PG8_WAIT_L(8); PG8_BAR; PG8_WAIT_L(0); PG8_MMA(0, 0, At, B0); PG8_BAR; PG8_SCHED;
            PG8_LDB(B1, 0, 1); PG8_STAGE(PG8_SB(0, 0), b2);
            PG8_BAR; PG8_WAIT_L(0); PG8_MMA(0, 1, At, B1); PG8_BAR;
            PG8_LDA(At, 0, 1); PG8_STAGE(PG8_SA(0, 0), a2);
            PG8_BAR; PG8_WAIT_L(0); PG8_MMA(1, 0, At, B0); PG8_BAR; PG8_SCHED;
            PG8_STAGE(PG8_SB(0, 1), b2 + hstep);
            PG8_WAIT_V(6); PG8_BAR; PG8_MMA(1, 1, At, B1); PG8_BAR;
            PG8_LDB(B0, 1, 0); PG8_SCHED; PG8_LDA(At, 1, 0); PG8_STAGE(PG8_SA(0, 1), a2 + hstep);
            PG8_WAIT_L(8); PG8_BAR; PG8_WAIT_L(0); PG8_MMA(0, 0, At, B0); PG8_BAR; PG8_SCHED;
            PG8_LDB(B1, 1, 1); PG8_STAGE(PG8_SB(1, 0), b3);
            PG8_BAR; PG8_WAIT_L(0); PG8_MMA(0, 1, At, B1); PG8_BAR;
            PG8_LDA(At, 1, 1); PG8_STAGE(PG8_SA(1, 0), a3);
            PG8_BAR; PG8_WAIT_L(0); PG8_MMA(1, 0, At, B0); PG8_BAR; PG8_SCHED;
            PG8_STAGE(PG8_SB(1, 1), b3 + hstep);
            PG8_WAIT_V(6); PG8_BAR; PG8_MMA(1, 1, At, B1); PG8_BAR;
        }
        E(acc, cur, wr, wc, fr, fq);
        if (!has_next) break;
#pragma unroll
        for (int a = 0; a < 2; ++a)
#pragma unroll
            for (int b = 0; b < 2; ++b)
#pragma unroll
                for (int m = 0; m < 4; ++m)
#pragma unroll
                    for (int n = 0; n < 2; ++n) acc[a][b][m][n] = (f32x4){0.f, 0.f, 0.f, 0.f};
        cur = nxt; cA = nA; cB = nB; ++ui;
    }
    PG8_WAIT_V(0);
    if (wr == 0) PG8_BAR;
    PG8_BAR;
#undef PG8_SA
#undef PG8_SB
#undef PG8_STAGE
#undef PG8_LDA
#undef PG8_LDB
#undef PG8_MMA
#undef PG8_WAIT_V
#undef PG8_WAIT_L
#undef PG8_BAR
#undef PG8_SCHED
}
}

struct EpiProj {
    bf16_t* P; float* DT; const float* rope; const float* dt_bias;
    __device__ __forceinline__ void operator()(const f32x4 (&acc)[2][2][4][2], const pg8::Unit& u, int wr, int wc, int fr, int fq) const {
        const int row0 = u.pm * 256 + wr * 64 + fr, pn = u.pn;
        if (pn < 5) {
            const float sc = pn < 4 ? 0.125f * LOG2E : 1.f;
            const int col = pn * 256 + 64 * wc + 8 * fq;
#pragma unroll
            for (int ai = 0; ai < 2; ++ai)
#pragma unroll
                for (int m = 0; m < 4; ++m) {
                    const int row = row0 + ai * 128 + m * 16, pos = row & (SEQ - 1);
                    const f32x4* cp = (const f32x4*)(rope + pos * 32 + 8 * fq); const f32x4* sp = (const f32x4*)(rope + SEQ * 32 + pos * 32 + 8 * fq);
                    f32x4 o1[2], o2[2];
#pragma unroll
                    for (int n = 0; n < 2; ++n) { const f32x4 c = cp[n], s = sp[n], t1 = acc[ai][0][m][n], t2 = acc[ai][1][m][n]; o1[n] = (t1 * c - t2 * s) * sc; o2[n] = (t1 * s + t2 * c) * sc; }
                    bf16_t* dst = P + (size_t)row * PW + col;
                    *(u32x4*)dst = (u32x4){cvt_pk(o1[0].x, o1[0].y), cvt_pk(o1[0].z, o1[0].w), cvt_pk(o1[1].x, o1[1].y), cvt_pk(o1[1].z, o1[1].w)};
                    *(u32x4*)(dst + 32) = (u32x4){cvt_pk(o2[0].x, o2[0].y), cvt_pk(o2[0].z, o2[0].w), cvt_pk(o2[1].x, o2[1].y), cvt_pk(o2[1].z, o2[1].w)};
                }
        } else if (pn < 20) {
            const bool do_silu = (pn >= 6 && pn < 12) || pn >= 18;
            const float sc = (pn == 16 || pn == 17) ? 0.08838834764831845f * LOG2E : 1.f;
            const int col = pn * 256 + 32 * wc + 8 * fq;
#pragma unroll
            for (int ai = 0; ai < 2; ++ai)
#pragma unroll
                for (int m = 0; m < 4; ++m) {
                    const int row = row0 + ai * 128 + m * 16;
#pragma unroll
                    for (int bj = 0; bj < 2; ++bj) {
                        f32x4 v0 = acc[ai][bj][m][0], v1 = acc[ai][bj][m][1];
                        if (do_silu) { v0 = silu4(v0); v1 = silu4(v1); } else { v0 = v0 * sc; v1 = v1 * sc; }
                        *(u32x4*)(P + (size_t)row * PW + col + 128 * bj) = (u32x4){cvt_pk(v0.x, v0.y), cvt_pk(v0.z, v0.w), cvt_pk(v1.x, v1.y), cvt_pk(v1.z, v1.w)};
                    }
                }
        } else {
            if (wc == 0 && fq < 2) {
#pragma unroll
                for (int ai = 0; ai < 2; ++ai)
#pragma unroll
                    for (int m = 0; m < 4; ++m) {
                        const int row = row0 + ai * 128 + m * 16;
#pragma unroll
                        for (int n = 0; n < 2; ++n) {
                            const int j0 = 8 * fq + 4 * n; const f32x4 bb = *(const f32x4*)(dt_bias + j0); const f32x4 v = acc[ai][0][m][n] + bb;
                            *(f32x4*)(DT + (size_t)row * 16 + j0) = (f32x4){softplus_f(v.x), softplus_f(v.y), softplus_f(v.z), softplus_f(v.w)};
                        }
                    }
            }
        }
    }
};
struct EpiMkv {
    bf16_t* O;
    __device__ __forceinline__ void operator()(const f32x4 (&acc)[2][2][4][2], const pg8::Unit& u, int wr, int wc, int fr, int fq) const {
        const int row0 = u.pm * 256 + wr * 64 + fr, col = u.pn * 256 + 32 * wc + 8 * fq;
#pragma unroll
        for (int ai = 0; ai < 2; ++ai)
#pragma unroll
            for (int m = 0; m < 4; ++m) {
                const int row = row0 + ai * 128 + m * 16;
#pragma unroll
                for (int bj = 0; bj < 2; ++bj) { const f32x4 v0 = acc[ai][bj][m][0], v1 = acc[ai][bj][m][1];
                    *(u32x4*)(O + (size_t)row * 1024 + col + 128 * bj) = (u32x4){cvt_pk(v0.x, v0.y), cvt_pk(v0.z, v0.w), cvt_pk(v1.x, v1.y), cvt_pk(v1.z, v1.w)}; }
            }
    }
};
struct EpiOut {
    const float* x; float* out; float* rowss;
    __device__ __forceinline__ void operator()(const f32x4 (&acc)[2][2][4][2], const pg8::Unit& u, int wr, int wc, int fr, int fq) const {
        const int row0 = u.pm * 256 + wr * 64 + fr, col = u.pn * 256 + 32 * wc + 8 * fq;
#pragma unroll
        for (int ai = 0; ai < 2; ++ai)
#pragma unroll
            for (int m = 0; m < 4; ++m) {
                const int row = row0 + ai * 128 + m * 16; float ss = 0.f;
#pragma unroll
                for (int bj = 0; bj < 2; ++bj) {
                    const size_t o = (size_t)row * DM + col + 128 * bj;
                    const f32x4 h0 = *(const f32x4*)(x + o) + acc[ai][bj][m][0], h1 = *(const f32x4*)(x + o + 4) + acc[ai][bj][m][1];
                    *(f32x4*)(out + o) = h0; *(f32x4*)(out + o + 4) = h1;
                    ss += h0.x * h0.x + h0.y * h0.y + h0.z * h0.z + h0.w * h0.w + h1.x * h1.x + h1.y * h1.y + h1.z * h1.z + h1.w * h1.w;
                }
                ss += __shfl_xor(ss, 16); ss += __shfl_xor(ss, 32);
                if (fq == 0) rowss[(size_t)row * 16 + u.pn * 4 + wc] = ss;
            }
    }
};

struct Args { const float* in[15]; float* out; unsigned char* ws; int lo, hi; };
struct Ctx {
    const float *x, *mem, *norm_mem_w, *norm_in_w, *w_in, *attn_sink, *conv_w, *conv_b, *dt_bias, *a_log, *d_skip, *ssd_norm_w, *w_mem_kv, *w_out, *norm_out_w;
    float* out; float* rowss; float* rope; bf16_t* win_t; bf16_t* wout_t; bf16_t* wmem_t; bf16_t* memn; bf16_t* mkv; float* dt; float* dec; bf16_t* proj; bf16_t* mix; bf16_t* hn; bf16_t* st;
    ldsp lds; int tid, lane, wave, G, bid;
};

__device__ __forceinline__ void rms_row_bf16(const float* xr, const float* w, bf16_t* o, int lane) {
    f32x4 v[4]; float ss = 0.f;
#pragma unroll
    for (int j = 0; j < 4; ++j) { v[j] = *(const f32x4*)(xr + 4 * lane + 256 * j); ss += v[j].x * v[j].x + v[j].y * v[j].y + v[j].z * v[j].z + v[j].w * v[j].w; }
#pragma unroll
    for (int off = 1; off < 64; off <<= 1) ss += __shfl_xor(ss, off);
    const float r = rsqrtf(ss * (1.f / DM) + EPS);
#pragma unroll
    for (int j = 0; j < 4; ++j) { const f32x4 ww = *(const f32x4*)(w + 4 * lane + 256 * j); *(u32x2*)(o + 4 * lane + 256 * j) = pack4(v[j] * r * ww); }
}
template <int MODE>
__device__ __forceinline__ void transpose_w(const Ctx& F, const float* W, int K, int NS, bf16_t* Bt, int NP) {
    const int nitems = NP * (K / 8);
    for (int it = F.bid * 512 + F.tid; it < nitems; it += F.G * 512) {
        const int n = it % NP, kg = it / NP, tile = n >> 8, cph = n & 255; int src;
        if (MODE == 0) {
            if (tile < 5) src = tile * 256 + perm_rot(cph);
            else if (tile < 20) { src = tile * 256 + perm_plain(cph); if (src >= 4096) src += 16; }
            else { const int l = perm_plain(cph); src = l < 16 ? 4096 + l : -1; }
        } else src = tile * 256 + perm_plain(cph);
        float v[8];
#pragma unroll
        for (int j = 0; j < 8; ++j) v[j] = src >= 0 ? W[(size_t)(kg * 8 + j) * NS + src] : 0.f;
        *(u32x4*)(Bt + (size_t)n * K + kg * 8) = (u32x4){cvt_pk(v[0], v[1]), cvt_pk(v[2], v[3]), cvt_pk(v[4], v[5]), cvt_pk(v[6], v[7])};
    }
}
__device__ __forceinline__ void phase0(const Ctx& F) {
    const int gt = F.bid * 512 + F.tid, NT = F.G * 512;
    for (int i = gt; i < SEQ * 32; i += NT) {
        const int pos = i >> 5, f = i & 31;
        const float inv = 1.0f / exp2f((float)f * (13.287712379549449f / 32.f));
        const float ang = (float)pos * inv;
        const double rev = (double)ang * 0.15915494309189535; const double fr = rev - __builtin_rint(rev);
        const float r = (float)(fr * 6.283185307179586);
        F.rope[i] = __cosf(r); F.rope[SEQ * 32 + i] = __sinf(r);
    }
    transpose_w<0>(F, F.w_in, DM, INW, F.win_t, NPHYS);
    transpose_w<1>(F, F.w_out, MIXW, DM, F.wout_t, DM);
    transpose_w<1>(F, F.w_mem_kv, DM, DM, F.wmem_t, DM);
    const int gw = F.bid * 8 + F.wave, NGW = F.G * 8;
    for (int m = gw; m < NBATCH * 256; m += NGW) rms_row_bf16(F.mem + (size_t)m * DM, F.norm_mem_w, F.memn + (size_t)m * DM, F.lane);
    for (int m = gw; m < TOK; m += NGW) rms_row_bf16(F.x + (size_t)m * DM, F.norm_in_w, F.hn + (size_t)m * DM, F.lane);
}

template <int DH, int NQF>
__device__ __forceinline__ void attn_tile(ldsp Kt, int KS, ldsp Vt, int VS, const bf16x8 (&qf)[NQF][DH / 32], f32x4 (&o)[DH / 16][NQF], float (&m)[NQF], float (&lp)[NQF], int maskmode, int lane) {
    const int i16 = lane & 15, q4 = lane >> 4;
    f32x4 st[4][NQF];
#pragma unroll
    for (int kf = 0; kf < 4; ++kf)
#pragma unroll
        for (int q = 0; q < NQF; ++q) st[kf][q] = (f32x4){0.f, 0.f, 0.f, 0.f};
#pragma unroll
    for (int ks = 0; ks < DH / 32; ++ks)
#pragma unroll
        for (int kf = 0; kf < 4; ++kf) {
            const bf16x8 ka = ld8(Kt + (16 * kf + i16) * KS + (32 * ks + 8 * q4) * 2);
#pragma unroll
            for (int q = 0; q < NQF; ++q) st[kf][q] = mfma16(ka, qf[q][ks], st[kf][q]);
            if (DH > 64 && kf == 3) __builtin_amdgcn_sched_barrier(0);
        }
    if (maskmode) {
#pragma unroll
        for (int kf = 0; kf < 4; ++kf)
#pragma unroll
            for (int q = 0; q < NQF; ++q)
#pragma unroll
                for (int r = 0; r < 4; ++r) { const int ko = 16 * kf + 4 * q4 + r, qo = 16 * q + i16; const bool bad = maskmode == 1 ? (ko < qo) : (ko > qo); if (bad) st[kf][q][r] = -INFINITY; }
    }
#pragma unroll
    for (int q = 0; q < NQF; ++q) {
        float mx = st[0][q][0];
#pragma unroll
        for (int kf = 0; kf < 4; ++kf)
#pragma unroll
            for (int r = 0; r < 4; ++r) mx = fmaxf(mx, st[kf][q][r]);
        mx = fmaxf(mx, __shfl_xor(mx, 16)); mx = fmaxf(mx, __shfl_xor(mx, 32));
        const float mn = fmaxf(m[q], mx), alpha = ex2(m[q] - mn); m[q] = mn;
        float ps = 0.f;
#pragma unroll
        for (int kf = 0; kf < 4; ++kf)
#pragma unroll
            for (int r = 0; r < 4; ++r) { const float p = ex2(st[kf][q][r] - mn); st[kf][q][r] = p; ps += p; }
        lp[q] = lp[q] * alpha + ps;
#pragma unroll
        for (int d = 0; d < DH / 16; ++d) o[d][q] = o[d][q] * alpha;
    }
#pragma unroll
    for (int kp = 0; kp < 2; ++kp) {
        bf16x8 pk[NQF];
#pragma unroll
        for (int q = 0; q < NQF; ++q) pk[q] = packfrag(st[2 * kp][q], st[2 * kp + 1][q]);
#pragma unroll
        for (int d = 0; d < DH / 16; ++d) {
            ldsp va = Vt + (32 * kp + 4 * q4 + (i16 >> 2)) * VS + (16 * d + 4 * (i16 & 3)) * 2;
            const bf16x8 vf = cat8(vtr(va), vtr(va + 16 * VS));
#pragma unroll
            for (int q = 0; q < NQF; ++q) o[d][q] = mfma16(vf, pk[q], o[d][q]);
            if (DH > 64 && (d & 3) == 3) __builtin_amdgcn_sched_barrier(0);
        }
    }
}

__device__ __forceinline__ void attn_window_item(const Ctx& F, int item) {
    constexpr int KS = 144, VS = 160; const ldsp Ki = F.lds, Vi = F.lds + 384 * KS;
    const int kvh = item & 3, i = (item >> 2) & 31, b = item >> 7;
    __syncthreads();
    for (int c = F.tid; c < 3072; c += 512) {
        const int r = c >> 3, ch = c & 7, key = 128 * i - 128 + r;
        if (key >= 0 && key < SEQ) {
            const bf16_t* src = F.proj + (size_t)(b * SEQ + key) * PW + 64 * kvh + 8 * ch;
            *(LAS u32x4*)(Ki + r * KS + ch * 16) = *(const u32x4*)(src + C_K);
            *(LAS u32x4*)(Vi + r * VS + ch * 16) = *(const u32x4*)(src + C_V);
        }
    }
    __syncthreads();
    const int w = F.wave, lane = F.lane, i16 = lane & 15, q4 = lane >> 4, hq = 4 * kvh + (w >> 1), q0 = 128 * i + 64 * (w & 1);
    bf16x8 qf[4][2];
#pragma unroll
    for (int q = 0; q < 4; ++q)
#pragma unroll
        for (int ks = 0; ks < 2; ++ks) qf[q][ks] = *(const bf16x8*)(F.proj + (size_t)(b * SEQ + q0 + 16 * q + i16) * PW + C_Q + hq * 64 + 32 * ks + 8 * q4);
    f32x4 o[4][4]; float m[4], lp[4];
    const float sink = F.attn_sink[hq] * LOG2E;
#pragma unroll
    for (int q = 0; q < 4; ++q) { m[q] = sink; lp[q] = q4 == 0 ? 1.f : 0.f;
#pragma unroll
        for (int d = 0; d < 4; ++d) o[d][q] = (f32x4){0.f, 0.f, 0.f, 0.f}; }
#pragma unroll 1
    for (int j = 0; j < 5; ++j) {
        const int kstart = q0 - 128 + 64 * j; if (kstart < 0 || kstart >= SEQ) continue;
        const int ir = 64 * (w & 1) + 64 * j;
        attn_tile<64, 4>(Ki + ir * KS, KS, Vi + ir * VS, VS, qf, o, m, lp, j == 0 ? 1 : (j == 4 ? 2 : 0), lane);
    }
#pragma unroll
    for (int q = 0; q < 4; ++q) {
        float l = lp[q]; l += __shfl_xor(l, 16); l += __shfl_xor(l, 32); const float inv = 1.f / l;
        const size_t row = (size_t)(b * SEQ + q0 + 16 * q + i16);
#pragma unroll
        for (int d = 0; d < 4; ++d) {
            const int col = hq * 64 + 16 * d + 4 * q4;
            const f32x4 g = unpack4(*(const u32x2*)(F.proj + row * PW + C_G + col));
            *(u32x2*)(F.mix + row * MIXW + col) = pack4(o[d][q] * inv * g);
        }
    }
}
__device__ __forceinline__ void attn_mem_item(const Ctx& F, int item) {
    constexpr int KS = 272, VS = 288; const ldsp Ki = F.lds, Vi = F.lds + 256 * KS;
    const int hm = item & 3, qb = (item >> 2) & 15, b = item >> 6;
    __syncthreads();
    for (int c = F.tid; c < 4096; c += 512) {
        const int r = c >> 4, ch = c & 15;
        const bf16_t* src = F.mkv + (size_t)(b * 256 + r) * 1024 + hm * 128 + 8 * ch;
        *(LAS u32x4*)(Ki + r * KS + ch * 16) = *(const u32x4*)(src);
        *(LAS u32x4*)(Vi + r * VS + ch * 16) = *(const u32x4*)(src + 512);
    }
    __syncthreads();
    const int w = F.wave, lane = F.lane, i16 = lane & 15, q4 = lane >> 4, q0 = 256 * qb + 32 * w;
    bf16x8 qf[2][4];
#pragma unroll
    for (int q = 0; q < 2; ++q)
#pragma unroll
        for (int ks = 0; ks < 4; ++ks) qf[q][ks] = *(const bf16x8*)(F.proj + (size_t)(b * SEQ + q0 + 16 * q + i16) * PW + C_QM + hm * 128 + 32 * ks + 8 * q4);
    f32x4 o[8][2]; float m[2], lp[2];
#pragma unroll
    for (int q = 0; q < 2; ++q) { m[q] = -INFINITY; lp[q] = 0.f;
#pragma unroll
        for (int d = 0; d < 8; ++d) o[d][q] = (f32x4){0.f, 0.f, 0.f, 0.f}; }
#pragma unroll 1
    for (int j = 0; j < 4; ++j) attn_tile<128, 2>(Ki + 64 * j * KS, KS, Vi + 64 * j * VS, VS, qf, o, m, lp, 0, lane);
#pragma unroll
    for (int q = 0; q < 2; ++q) {
        float l = lp[q]; l += __shfl_xor(l, 16); l += __shfl_xor(l, 32); const float inv = 1.f / l;
        const size_t row = (size_t)(b * SEQ + q0 + 16 * q + i16);
#pragma unroll
        for (int d = 0; d < 8; ++d) {
            const int col = hm * 128 + 16 * d + 4 * q4;
            const f32x4 g = unpack4(*(const u32x2*)(F.proj + row * PW + C_GM + col));
            *(u32x2*)(F.mix + row * MIXW + 1536 + col) = pack4(o[d][q] * inv * g);
        }
    }
}

constexpr int XS = 544, BS = 288, XWS = 160, PS = 272;
constexpr int L_XI = 0, L_BI = 128 * XS, L_CI = L_BI + 128 * BS, L_XW = L_CI, L_F32 = L_XW + 2 * 128 * XWS;
static_assert(L_F32 + 8192 <= LDS_BYTES, "lds");
__device__ __forceinline__ void ssd_dtprep(const Ctx& F, int b, int c, int g, bool write_dec) {
    LAS float* DTs = (LAS float*)(F.lds + L_F32); LAS float* ACs = DTs + 1024;
    const int w = F.wave, lane = F.lane, dir = w >> 2, r = w & 3, h = 4 * g + r, j = dir * 8 + h;
    const size_t row0 = (size_t)b * SEQ + c * 128;
    const float d0 = F.dt[(row0 + 2 * lane) * 16 + j], d1 = F.dt[(row0 + 2 * lane + 1) * 16 + j];
    const float a = -expf(F.a_log[j]);
    const float x0 = d0 * a, x1 = d1 * a, ps = x0 + x1; float inc = ps;
#pragma unroll
    for (int off = 1; off < 64; off <<= 1) { const float t = __shfl_up(inc, off); if (lane >= off) inc += t; }
    const float total = __shfl(inc, 63);
    float a0, a1;
    if (dir == 0) { a0 = inc - x1; a1 = inc; } else { a0 = total - (inc - ps); a1 = total - (inc - x1); }
    *(LAS f32x2*)(DTs + w * 128 + 2 * lane) = (f32x2){d0, d1};
    *(LAS f32x2*)(ACs + w * 128 + 2 * lane) = (f32x2){a0, a1};
    if (write_dec && lane == 0) F.dec[(b * 32 + c) * 16 + j] = expf(total);
}
template <int NCOLS>
__device__ __forceinline__ void conv_img(const Ctx& F, int b, int c, int xcol, ldsp img, int stride) {
    constexpr int NCQ = NCOLS / 4, NRG = 512 / NCQ, R = 128 / NRG;
    const int cq = F.tid % NCQ, rg = F.tid / NCQ, col = xcol + 4 * cq;
    f32x4 w[5];
#pragma unroll
    for (int j = 0; j < 5; ++j) w[j] = *(const f32x4*)(F.conv_w + j * 1024 + col);
    const f32x4 bias = *(const f32x4*)(F.conv_b + col);
    const int t0 = c * 128 + rg * R - 2;
    const bf16_t* base = F.proj + (size_t)b * SEQ * PW + C_X + col;
    f32x4 win[R + 4];
#pragma unroll
    for (int k = 0; k < R + 4; ++k) { const int t = t0 + k; win[k] = (t >= 0 && t < SEQ) ? unpack4(*(const u32x2*)(base + (size_t)t * PW)) : (f32x4){0.f, 0.f, 0.f, 0.f}; }
#pragma unroll
    for (int r = 0; r < R; ++r) {
        f32x4 y = bias;
#pragma unroll
        for (int j = 0; j < 5; ++j) y = y + w[j] * win[r + j];
        *(LAS u32x2*)(img + (rg * R + r) * stride + cq * 8) = pack4(silu4(y));
    }
}
__device__ __forceinline__ void ssd_pass1_item(const Ctx& F, int item) {
    const int g = item & 1, c = (item >> 1) & 31, b = item >> 6;
    const ldsp XI = F.lds + L_XI, BI = F.lds + L_BI, XW = F.lds + L_XW;
    LAS float* DTs = (LAS float*)(F.lds + L_F32); LAS float* ACs = DTs + 1024;
    __syncthreads();
    ssd_dtprep(F, b, c, g, true);
    conv_img<256>(F, b, c, 256 * g, XI, XS);
    conv_img<128>(F, b, c, 512 + 128 * g, BI, BS);
    __syncthreads();
    const int lane = F.lane, i16 = lane & 15, q4 = lane >> 4, w = F.wave;
    for (int r = 0; r < 4; ++r) {
        if (r) __syncthreads();
        {
            const int dir = F.tid >> 8, row = (F.tid >> 1) & 127, half = F.tid & 1, seq = dir * 4 + r;
            const float wgt = DTs[seq * 128 + row] * expf(ACs[seq * 128 + (dir ? 0 : 127)] - ACs[seq * 128 + row]);
#pragma unroll
            for (int k = 0; k < 4; ++k) {
                const u32x4 v = *(const LAS u32x4*)(XI + row * XS + (64 * r + 32 * half + 8 * k) * 2);
                u32x4 o;
                o.x = cvt_pk(bf_lo(v.x) * wgt, bf_hi(v.x) * wgt); o.y = cvt_pk(bf_lo(v.y) * wgt, bf_hi(v.y) * wgt);
                o.z = cvt_pk(bf_lo(v.z) * wgt, bf_hi(v.z) * wgt); o.w = cvt_pk(bf_lo(v.w) * wgt, bf_hi(v.w) * wgt);
                *(LAS u32x4*)(XW + dir * (128 * XWS) + row * XWS + (32 * half + 8 * k) * 2) = o;
            }
        }
        __syncthreads();
        const int dir = w & 1, nq = w >> 1;
        f32x4 acc[2][4];
#pragma unroll
        for (int nf = 0; nf < 2; ++nf)
#pragma unroll
            for (int pf = 0; pf < 4; ++pf) acc[nf][pf] = (f32x4){0.f, 0.f, 0.f, 0.f};
#pragma unroll
        for (int ks = 0; ks < 4; ++ks) {
            const int trow = 32 * ks + 8 * q4 + (i16 >> 2);
            bf16x8 af[2], bfr[4];
#pragma unroll
            for (int nf = 0; nf < 2; ++nf) { ldsp p = BI + trow * BS + (32 * nq + 16 * nf + 4 * (i16 & 3)) * 2; af[nf] = cat8(vtr(p), vtr(p + 4 * BS)); }
#pragma unroll
            for (int pf = 0; pf < 4; ++pf) { ldsp p = XW + dir * (128 * XWS) + trow * XWS + (16 * pf + 4 * (i16 & 3)) * 2; bfr[pf] = cat8(vtr(p), vtr(p + 4 * XWS)); }
#pragma unroll
            for (int nf = 0; nf < 2; ++nf)
#pragma unroll
                for (int pf = 0; pf < 4; ++pf) acc[nf][pf] = mfma16(af[nf], bfr[pf], acc[nf][pf]);
        }
        bf16_t* S = F.st + ((((size_t)(b * 32 + c) * 2 + dir) * 8 + (4 * g + r)) << 13);
#pragma unroll
        for (int nf = 0; nf < 2; ++nf)
#pragma unroll
            for (int pf = 0; pf < 4; ++pf) *(u32x2*)(S + (16 * pf + i16) * 128 + 32 * nq + 16 * nf + 4 * q4) = pack4(acc[nf][pf]);
    }
}
__device__ __forceinline__ void ssd_scan(const Ctx& F) {
    for (int it = F.bid * 512 + F.tid; it < NBATCH * 2 * 8 * 1024; it += F.G * 512) {
        const int e8 = it & 1023, h = (it >> 10) & 7, dir = (it >> 13) & 1, b = it >> 14;
        float run[8];
#pragma unroll
        for (int k = 0; k < 8; ++k) run[k] = 0.f;
        for (int s0 = 0; s0 < 32; s0 += 4) {
            u32x4 v[4]; float dc[4]; bf16_t* ad[4];
#pragma unroll
            for (int u = 0; u < 4; ++u) { const int s = s0 + u, c = dir ? 31 - s : s; ad[u] = F.st + (((((size_t)(b * 32 + c) * 2 + dir) * 8 + h) << 13) + e8 * 8); v[u] = *(const u32x4*)ad[u]; dc[u] = F.dec[(b * 32 + c) * 16 + dir * 8 + h]; }
#pragma unroll
            for (int u = 0; u < 4; ++u) {
                *(u32x4*)ad[u] = (u32x4){cvt_pk(run[0], run[1]), cvt_pk(run[2], run[3]), cvt_pk(run[4], run[5]), cvt_pk(run[6], run[7])};
                run[0] = run[0] * dc[u] + bf_lo(v[u].x); run[1] = run[1] * dc[u] + bf_hi(v[u].x); run[2] = run[2] * dc[u] + bf_lo(v[u].y); run[3] = run[3] * dc[u] + bf_hi(v[u].y);
                run[4] = run[4] * dc[u] + bf_lo(v[u].z); run[5] = run[5] * dc[u] + bf_hi(v[u].z); run[6] = run[6] * dc[u] + bf_lo(v[u].w); run[7] = run[7] * dc[u] + bf_hi(v[u].w);
            }
        }
    }
}
__device__ __forceinline__ void ssd_pass2_item(const Ctx& F, int item) {
    const int g = item & 1, c = (item >> 1) & 31, b = item >> 6;
    const ldsp XI = F.lds + L_XI, BI = F.lds + L_BI, CI = F.lds + L_CI, PV = F.lds + L_BI;
    LAS float* DTs = (LAS float*)(F.lds + L_F32); LAS float* ACs = DTs + 1024;
    __syncthreads();
    ssd_dtprep(F, b, c, g, false);
    conv_img<256>(F, b, c, 256 * g, XI, XS);
    conv_img<128>(F, b, c, 512 + 128 * g, BI, BS);
    conv_img<128>(F, b, c, 768 + 128 * g, CI, BS);
    __syncthreads();
    const int lane = F.lane, i16 = lane & 15, q4 = lane >> 4, w = F.wave, tl = 16 * w + i16;
    bf16x8 cf[4];
#pragma unroll
    for (int ks = 0; ks < 4; ++ks) cf[ks] = ld8(CI + tl * BS + (32 * ks + 8 * q4) * 2);
    f32x4 cbt[8];
#pragma unroll
    for (int sf = 0; sf < 8; ++sf) {
        cbt[sf] = (f32x4){0.f, 0.f, 0.f, 0.f};
#pragma unroll
        for (int ks = 0; ks < 4; ++ks) cbt[sf] = mfma16(ld8(BI + (16 * sf + i16) * BS + (32 * ks + 8 * q4) * 2), cf[ks], cbt[sf]);
    }
    f32x4 gprev[4]; float ss = 0.f;
#pragma unroll
    for (int pf = 0; pf < 4; ++pf) gprev[pf] = (f32x4){0.f, 0.f, 0.f, 0.f};
    const size_t row = (size_t)b * SEQ + c * 128 + tl;
#pragma unroll 1
    for (int r = 0; r < 4; ++r) {
        const int h = 4 * g + r;
        __syncthreads();
        if (r > 0) {
#pragma unroll
            for (int pf = 0; pf < 4; ++pf) *(LAS u32x2*)(XI + tl * XS + (64 * (r - 1) + 16 * pf + 4 * q4) * 2) = pack4(gprev[pf]);
        }
        {
            const int dir = F.tid >> 8, p = (F.tid >> 2) & 63, qu = F.tid & 3;
            const bf16_t* src = F.st + (((((size_t)(b * 32 + c) * 2 + dir) * 8 + h) << 13) + p * 128 + 32 * qu);
#pragma unroll
            for (int k = 0; k < 4; ++k) *(LAS u32x4*)(PV + dir * (64 * PS) + p * PS + (32 * qu + 8 * k) * 2) = *(const u32x4*)(src + 8 * k);
        }
        __syncthreads();
        const float acf = ACs[r * 128 + tl], acb = ACs[(4 + r) * 128 + tl];
        f32x4 yt[4];
#pragma unroll
        for (int pf = 0; pf < 4; ++pf) yt[pf] = (f32x4){0.f, 0.f, 0.f, 0.f};
#pragma unroll
        for (int kp = 0; kp < 4; ++kp) {
            f32x4 gt[2];
#pragma unroll
            for (int u = 0; u < 2; ++u) {
                const int sf = 2 * kp + u, s0 = 16 * sf + 4 * q4;
                const f32x4 dtf = *(const LAS f32x4*)(DTs + r * 128 + s0), af = *(const LAS f32x4*)(ACs + r * 128 + s0);
                const f32x4 dtb = *(const LAS f32x4*)(DTs + (4 + r) * 128 + s0), ab = *(const LAS f32x4*)(ACs + (4 + r) * 128 + s0);
#pragma unroll
                for (int e = 0; e < 4; ++e) {
                    const int s = s0 + e;
                    const float mf = s <= tl ? dtf[e] * __expf(acf - af[e]) : 0.f;
                    const float mb = s >= tl ? dtb[e] * __expf(acb - ab[e]) : 0.f;
                    gt[u][e] = cbt[sf][e] * (mf + mb);
                }
            }
            const bf16x8 gk = packfrag(gt[0], gt[1]);
#pragma unroll
            for (int pf = 0; pf < 4; ++pf) {
                ldsp xa = XI + (32 * kp + 4 * q4 + (i16 >> 2)) * XS + (64 * r + 16 * pf + 4 * (i16 & 3)) * 2;
                yt[pf] = mfma16(cat8(vtr(xa), vtr(xa + 16 * XS)), gk, yt[pf]);
            }
        }
        f32x4 yf[4], yb[4];
#pragma unroll
        for (int pf = 0; pf < 4; ++pf) { yf[pf] = (f32x4){0.f, 0.f, 0.f, 0.f}; yb[pf] = (f32x4){0.f, 0.f, 0.f, 0.f}; }
#pragma unroll
        for (int ks = 0; ks < 4; ++ks)
#pragma unroll
            for (int pf = 0; pf < 4; ++pf) {
                yf[pf] = mfma16(ld8(PV + (16 * pf + i16) * PS + (32 * ks + 8 * q4) * 2), cf[ks], yf[pf]);
                yb[pf] = mfma16(ld8(PV + 64 * PS + (16 * pf + i16) * PS + (32 * ks + 8 * q4) * 2), cf[ks], yb[pf]);
            }
        const float ef = __expf(acf), eb = __expf(acb), dsk = F.d_skip[h];
#pragma unroll
        for (int pf = 0; pf < 4; ++pf) {
            const int pc = 64 * r + 16 * pf + 4 * q4;
            const f32x4 xv = unpack4(*(const LAS u32x2*)(XI + tl * XS + pc * 2));
            const f32x4 zv = unpack4(*(const u32x2*)(F.proj + row * PW + C_Z + 256 * g + pc));
            const f32x4 y = (yt[pf] + yf[pf] * ef + yb[pf] * eb + xv * dsk) * zv;
            gprev[pf] = y; ss += y.x * y.x + y.y * y.y + y.z * y.z + y.w * y.w;
        }
    }
    __syncthreads();
#pragma unroll
    for (int pf = 0; pf < 4; ++pf) *(LAS u32x2*)(XI + tl * XS + (64 * 3 + 16 * pf + 4 * q4) * 2) = pack4(gprev[pf]);
    ss += __shfl_xor(ss, 16); ss += __shfl_xor(ss, 32);
    const float rinv = rsqrtf(ss * (1.f / 256.f) + EPS);
#pragma unroll
    for (int r = 0; r < 4; ++r)
#pragma unroll
        for (int pf = 0; pf < 4; ++pf) {
            const int pl = 64 * r + 16 * pf + 4 * q4, pc = 256 * g + pl;
            const f32x4 nw = *(const f32x4*)(F.ssd_norm_w + pc);
            const f32x4 gv = unpack4(*(const LAS u32x2*)(XI + tl * XS + pl * 2));
            *(u32x2*)(F.mix + row * MIXW + 1024 + pc) = pack4(gv * rinv * nw);
        }
}

__device__ __forceinline__ void final_norm(const Ctx& F) {
    const int gw = F.bid * 8 + F.wave, NGW = F.G * 8, lane = F.lane;
    for (int m = gw; m < TOK; m += NGW) {
        const f32x4* rp = (const f32x4*)(F.rowss + (size_t)m * 16); const f32x4 s4 = (rp[0] + rp[1]) + (rp[2] + rp[3]);
        const float r = rsqrtf(((s4.x + s4.y) + (s4.z + s4.w)) * (1.f / DM) + EPS);
        float* o = F.out + (size_t)m * DM;
#pragma unroll
        for (int j = 0; j < 4; ++j) { const f32x4 v = *(const f32x4*)(o + 4 * lane + 256 * j), ww = *(const f32x4*)(F.norm_out_w + 4 * lane + 256 * j); *(f32x4*)(o + 4 * lane + 256 * j) = v * r * ww; }
    }
}

__global__ void __launch_bounds__(512, 2) hymba_fwd(Args args) {
    extern __shared__ __attribute__((aligned(16))) unsigned char lds_raw[];
    Ctx F;
    F.x = args.in[0]; F.mem = args.in[1]; F.norm_mem_w = args.in[2]; F.norm_in_w = args.in[3]; F.w_in = args.in[4]; F.attn_sink = args.in[5]; F.conv_w = args.in[6]; F.conv_b = args.in[7];
    F.dt_bias = args.in[8]; F.a_log = args.in[9]; F.d_skip = args.in[10]; F.ssd_norm_w = args.in[11]; F.w_mem_kv = args.in[12]; F.w_out = args.in[13]; F.norm_out_w = args.in[14];
    unsigned char* ws = args.ws;
    F.out = args.out; F.rowss = (float*)(ws + WS_ROWSS); F.rope = (float*)(ws + WS_ROPE); F.win_t = (bf16_t*)(ws + WS_WIN); F.wout_t = (bf16_t*)(ws + WS_WOUT); F.wmem_t = (bf16_t*)(ws + WS_WMEM);
    F.memn = (bf16_t*)(ws + WS_MEMN); F.mkv = (bf16_t*)(ws + WS_MKV); F.dt = (float*)(ws + WS_DT); F.dec = (float*)(ws + WS_DEC); F.proj = (bf16_t*)(ws + WS_PROJ); F.mix = (bf16_t*)(ws + WS_MIX);
    F.hn = (bf16_t*)args.out; F.st = (bf16_t*)args.out;
    F.lds = (ldsp)lds_raw; F.tid = threadIdx.x; F.lane = F.tid & 63; F.wave = __builtin_amdgcn_readfirstlane(F.tid >> 6); F.G = gridDim.x; F.bid = blockIdx.x;
    const int lo = args.lo, hi = args.hi;
    cg::grid_group grid = cg::this_grid();
#define IN(k) (lo <= (k) && (k) < hi)
#define SEAM(k) do { if (IN(k) && IN((k) + 1)) { __threadfence(); grid.sync(); } } while (0)
    if (IN(0)) phase0(F);
    SEAM(0);
    if (IN(1)) {
        { pg8::Gemm g{F.memn, F.wmem_t, NBATCH * 256, 1024, 1024}; pg8::StaticOrder S; S.init(g.M, g.N, F.G, F.bid); EpiMkv E{F.mkv}; pg8::gemm_phase(F.lds, g, S, E); }
        { pg8::Gemm g{F.hn, F.win_t, TOK, NPHYS, DM}; pg8::StaticOrder S; S.init(g.M, g.N, F.G, F.bid); EpiProj E{F.proj, F.dt, F.rope, F.dt_bias}; pg8::gemm_phase(F.lds, g, S, E); }
    }
    SEAM(1);
#if DBG_STOP == 1
    { grid.sync(); const int gw = F.bid * 8 + F.wave, NGW = F.G * 8;
      for (int m = gw; m < TOK; m += NGW) for (int j = 0; j < 16; ++j) { const int c = F.lane + 64 * j; float a = 0.f; for (int k = 0; k < 5; ++k) a += bf_lo(F.proj[(size_t)m * PW + c + 1024 * k]); a += F.dt[(size_t)m * 16 + (c & 15)] + bf_lo(F.mkv[(size_t)(m & 4095) * 1024 + c]); F.out[(size_t)m * DM + c] = a; }
      return; }
#endif
    if (IN(2)) {
        for (int it = F.bid; it < NBATCH * 32 * 2; it += F.G) ssd_pass1_item(F, it);
        for (int it = F.bid; it < NBATCH * 32 * 4; it += F.G) attn_window_item(F, it);
    }
    SEAM(2);
#if DBG_STOP == 2
    { grid.sync(); const int gw = F.bid * 8 + F.wave, NGW = F.G * 8;
      for (int m = gw; m < TOK; m += NGW) for (int j = 0; j < 16; ++j) { const int c = F.lane + 64 * j;
        const float a = (DBG_SEL & 1 ? bf_lo(F.mix[(size_t)m * MIXW + c]) : 0.f), bq = (DBG_SEL & 2 ? bf_lo(F.st[(size_t)m * 1024 + c]) : 0.f), d = (DBG_SEL & 4 ? F.dec[(m * 1024 + c) & 8191] : 0.f);
        ((float*)F.proj)[(size_t)m * DM + c] = a + bq + d; }
      __threadfence(); grid.sync();
      for (int m = gw; m < TOK; m += NGW) for (int j = 0; j < 16; ++j) { const int c = F.lane + 64 * j; F.out[(size_t)m * DM + c] = ((float*)F.proj)[(size_t)m * DM + c]; }
      return; }
#endif
    if (IN(3)) ssd_scan(F);
    SEAM(3);
    if (IN(4)) {
        for (int it = F.bid; it < NBATCH * 32 * 2; it += F.G) ssd_pass2_item(F, it);
        for (int it = F.bid; it < NBATCH * 16 * 4; it += F.G) attn_mem_item(F, it);
    }
    SEAM(4);
    if (IN(5)) { __syncthreads(); pg8::Gemm g{F.mix, F.wout_t, TOK, DM, MIXW}; pg8::PanelOrder S; S.init(g.M, g.N, F.G, F.bid); EpiOut E{F.x, F.out, F.rowss}; pg8::gemm_phase(F.lds, g, S, E); }
    SEAM(5);
    if (IN(6)) final_norm(F);
#undef IN
#undef SEAM
}

extern "C" void kernel_launch(void* const* d_in, const int* in_sizes, int n_in, void* d_out, int out_size, void* d_ws, size_t ws_size, hipStream_t stream) {
    static int grid = 0;
    if (grid == 0) {
        if (n_in != 15 || out_size != TOK * DM || ws_size < WS_END) { fprintf(stderr, "kernel_launch: unexpected shapes (n_in %d out %d ws %zu)\n", n_in, out_size, ws_size); grid = -1; return; }
        int dev = 0, cus = 0, per_cu = 0;
        (void)hipGetDevice(&dev); (void)hipDeviceGetAttribute(&cus, hipDeviceAttributeMultiprocessorCount, dev);
        if (hipFuncSetAttribute((const void*)hymba_fwd, hipFuncAttributeMaxDynamicSharedMemorySize, LDS_BYTES) != hipSuccess) { fprintf(stderr, "kernel_launch: hipFuncSetAttribute failed\n"); grid = -1; return; }
        if (hipOccupancyMaxActiveBlocksPerMultiprocessor(&per_cu, (const void*)hymba_fwd, 512, LDS_BYTES) != hipSuccess || per_cu < 1) { fprintf(stderr, "kernel_launch: occupancy query says %d\n", per_cu); per_cu = 1; }
        (void)hipGetLastError();
        grid = cus > 0 ? cus : 256;
    }
    if (grid < 0) return;
    Args a{};
    for (int i = 0; i < 15; ++i) a.in[i] = (const float*)d_in[i];
    a.out = (float*)d_out; a.ws = (unsigned char*)d_ws;
#if MK_ONE_LAUNCH
    a.lo = 0; a.hi = NPHASE;
    void* kargs[] = {&a};
    hipError_t e = hipLaunchCooperativeKernel((const void*)hymba_fwd, dim3(grid), dim3(512), kargs, LDS_BYTES, stream);
    if (e != hipSuccess) fprintf(stderr, "kernel_launch: cooperative launch failed: %s (grid %d)\n", hipGetErrorString(e), grid);
#else
    for (int k = 0; k < NPHASE; ++k) { a.lo = k; a.hi = k + 1; hipLaunchKernelGGL(hymba_fwd, dim3(grid), dim3(512), LDS_BYTES, stream, a); }
#endif
}
```

```cpp
#include <hip/hip_runtime.h>
#include <hip/hip_cooperative_groups.h>
#include <cstdio>
#include <cstdint>
namespace cg = cooperative_groups;

#ifndef DBG_STOP
#define DBG_STOP 0
#define DBG_SEL 2
#endif
#ifndef PROBE_PHASES
#define PROBE_PHASES 0
#define PROBE_SUB 3
#endif
#ifndef MK_ONE_LAUNCH
#define MK_ONE_LAUNCH 1
#endif

#define LAS __attribute__((address_space(3)))
typedef unsigned short bf16_t;
typedef short bf16x8 __attribute__((ext_vector_type(8)));
typedef short s16x4 __attribute__((ext_vector_type(4)));
typedef float f32x4 __attribute__((ext_vector_type(4)));
typedef float f32x2 __attribute__((ext_vector_type(2)));
typedef unsigned u32x4 __attribute__((ext_vector_type(4)));
typedef unsigned u32x2 __attribute__((ext_vector_type(2)));
typedef LAS unsigned char* ldsp;

constexpr int SEQ = 4096, NBATCH = 16, TOK = SEQ * NBATCH, DM = 1024;
constexpr int INW = 5136, NPHYS = 5376, PW = 5184;
constexpr int HNP = 1088, MIXP = 2112;
constexpr int C_Q = 0, C_K = 1024, C_V = 1280, C_G = 1536, C_Z = 2560, C_X = 3072, C_QM = 4096, C_GM = 4608;
constexpr int MIXW = 2048;
constexpr float LOG2E = 1.4426950408889634f;
constexpr float EPS = 1e-6f;
constexpr int NPHASE = 7;

constexpr size_t MiB = (size_t)1 << 20;
constexpr size_t WS_ROWSS = 956 * MiB, WS_ROPE = 1 * MiB, WS_WIN = 2 * MiB, WS_WOUT = 14 * MiB, WS_WMEM = 19 * MiB, WS_MEMN = 22 * MiB,
                 WS_MKV = 31 * MiB, WS_DT = 39 * MiB, WS_DEC = 43 * MiB, WS_PROJ = 44 * MiB, WS_MIX = 692 * MiB, WS_END = 960 * MiB;

constexpr int LDS_BYTES = 155648;

__device__ __forceinline__ unsigned cvt_pk(float lo, float hi) { unsigned r; asm volatile("v_cvt_pk_bf16_f32 %0, %1, %2" : "=v"(r) : "v"(lo), "v"(hi)); return r; }
typedef __bf16 bf16x2_t __attribute__((ext_vector_type(2)));
__device__ __forceinline__ unsigned cvt_pk_c(float lo, float hi) { const f32x2 v = {lo, hi}; return __builtin_bit_cast(unsigned, __builtin_convertvector(v, bf16x2_t)); }
__device__ __forceinline__ float bf_lo(unsigned u) { return __uint_as_float(u << 16); }
__device__ __forceinline__ float bf_hi(unsigned u) { return __uint_as_float(u & 0xffff0000u); }
__device__ __forceinline__ f32x4 unpack4(u32x2 v) { return (f32x4){bf_lo(v.x), bf_hi(v.x), bf_lo(v.y), bf_hi(v.y)}; }
__device__ __forceinline__ u32x2 pack4(f32x4 v) { return (u32x2){cvt_pk_c(v.x, v.y), cvt_pk_c(v.z, v.w)}; }
__device__ __forceinline__ float silu_f(float x) { return x * __builtin_amdgcn_rcpf(1.f + __expf(-x)); }
__device__ __forceinline__ f32x4 silu4(f32x4 v) { return (f32x4){silu_f(v.x), silu_f(v.y), silu_f(v.z), silu_f(v.w)}; }
__device__ __forceinline__ float softplus_f(float x) { return x > 20.f ? x : log1pf(expf(x)); }
__device__ __forceinline__ float ex2(float x) { return __builtin_amdgcn_exp2f(x); }
typedef short v4i16_t __attribute__((ext_vector_type(4)));
__device__ __forceinline__ s16x4 vtr(ldsp p) { return __builtin_bit_cast(s16x4, __builtin_amdgcn_ds_read_tr16_b64_v4i16((LAS v4i16_t*)p)); }
__device__ __forceinline__ bf16x8 cat8(s16x4 a, s16x4 b) { return (bf16x8){a[0], a[1], a[2], a[3], b[0], b[1], b[2], b[3]}; }
__device__ __forceinline__ bf16x8 ld8(ldsp p) { return *(const LAS bf16x8*)p; }
__device__ __forceinline__ f32x4 mfma16(bf16x8 a, bf16x8 b, f32x4 c) { return __builtin_amdgcn_mfma_f32_16x16x32_bf16(a, b, c, 0, 0, 0); }
__device__ __forceinline__ bf16x8 packfrag(f32x4 a, f32x4 b) { u32x4 r = {cvt_pk_c(a.x, a.y), cvt_pk_c(a.z, a.w), cvt_pk_c(b.x, b.y), cvt_pk_c(b.z, b.w)}; return __builtin_bit_cast(bf16x8, r); }

__device__ __forceinline__ f32x4 zero4() { f32x4 z; asm volatile("v_mov_b32 %0, 0\n\tv_mov_b32 %1, 0\n\tv_mov_b32 %2, 0\n\tv_mov_b32 %3, 0" : "=v"(z.x), "=v"(z.y), "=v"(z.z), "=v"(z.w)); return z; }
__host__ __device__ __forceinline__ int perm_plain(int c) { const int bj = c >> 7, wc = (c >> 5) & 3, n = (c >> 4) & 1, fq = (c >> 2) & 3, i = c & 3; return 128 * bj + 32 * wc + 8 * fq + 4 * n + i; }
__host__ __device__ __forceinline__ int perm_rot(int c) { const int bj = c >> 7, wc = (c >> 5) & 3, n = (c >> 4) & 1, fq = (c >> 2) & 3, i = c & 3; return 64 * wc + 32 * bj + 8 * fq + 4 * n + i; }

namespace pg8 {
constexpr int BM = 256, BK = 64, HALF = 128, HTB = HALF * BK * 2, STAGE_BYTES = 8 * HTB, NXCD = 8, WGM = 8;
__host__ __device__ __forceinline__ int lds_byte(int r, int c) { const int st = (r >> 4) * 2 + (c >> 5), rr = r & 15, cc = c & 31, ob = rr * 64 + cc * 2; return st * 1024 + (ob ^ (((ob >> 9) & 1) << 5)); }
__host__ __device__ __forceinline__ void stage_rc(int b, int& R, int& C) { const int st = b / 1024, sb = b % 1024, swz = sb ^ (((sb >> 9) & 1) << 5); R = (st >> 1) * 16 + swz / 64; C = (st & 1) * 32 + (swz % 64) / 2; }
struct Unit { int pm, pn; };
struct Gemm { const bf16_t* A; const bf16_t* Bt; int M, N, K, lda, ldb; };
struct StaticOrder {
    int nM, nN, nwg, G, c;
    __device__ void init(int M, int N, int G_, int c_) { nM = M / BM; nN = N / BM; nwg = nM * nN; G = G_; c = c_; }
    __device__ bool next(int i, Unit& u) const {
        const long L = (long)i * G + c; if (L >= nwg) return false;
        int wgid = (int)L; { const int q = nwg / NXCD, r = nwg % NXCD, xcd = wgid % NXCD, off = wgid / NXCD; wgid = (xcd < r ? xcd * (q + 1) : r * (q + 1) + (xcd - r) * q) + off; }
        const int nig = WGM * nN, gid = wgid / nig, fm = gid * WGM, gsz = (nM - fm) < WGM ? (nM - fm) : WGM;
        u.pm = fm + ((wgid % nig) % gsz); u.pn = (wgid % nig) / gsz; return true;
    }
};
struct PanelOrder {
    int nM, nN, G, c;
    __device__ void init(int M, int N, int G_, int c_) { nM = M / BM; nN = N / BM; G = G_; c = c_; }
    __device__ bool next(int i, Unit& u) const { const int pm = c + (i / nN) * G; if (pm >= nM) return false; u.pm = pm; u.pn = i % nN; return true; }
};

template <class Epi, class Sched>
__device__ __forceinline__ void gemm_phase(ldsp lds, const Gemm g, const Sched& S, const Epi& E) {
    const int tid = threadIdx.x, wid = __builtin_amdgcn_readfirstlane(tid >> 6), lane = tid & 63, wr = wid >> 2, wc = wid & 3, fr = lane & 15, fq = lane >> 4;
    const int K = g.K, nt = K / BK;
    unsigned voffA[2], voffB[2];
#pragma unroll
    for (int i = 0; i < 2; ++i) { int R, C; stage_rc(tid * 16 + i * 8192, R, C); voffA[i] = (unsigned)(R * g.lda + C) * 2u; voffB[i] = (unsigned)(R * g.ldb + C) * 2u; }
    const size_t kstep = (size_t)(BK * 2);
    const size_t hstep = (size_t)HALF * g.lda * 2, hstepB = (size_t)HALF * g.ldb * 2;
    const size_t tstep = 2 * hstep, tstepB = 2 * hstepB;
    const unsigned ldsw = (unsigned)wid * 1024u;
    const int aoff = lds_byte(wr * 64 + fr, fq * 8), boff = lds_byte(wc * 32 + fr, fq * 8);
#define PG8_SA(b, h) (((b) * 2 + (h)) * HTB)
#define PG8_SB(b, h) ((4 + (b) * 2 + (h)) * HTB)
#define PG8_STAGE(bufoff, gbase, voff) do { _Pragma("unroll") for (int _i = 0; _i < 2; ++_i) \
        __builtin_amdgcn_global_load_lds((const unsigned*)((const char*)(gbase) + (voff)[_i]), (LAS unsigned*)(lds + (bufoff) + ldsw + _i * 8192), 16, 0, 0); } while (0)
#define PG8_LDA(dst, b, h) do { _Pragma("unroll") for (int m = 0; m < 4; ++m) _Pragma("unroll") for (int k = 0; k < 2; ++k) dst[m][k] = *(const LAS bf16x8*)(lds + PG8_SA(b, h) + aoff + m * 2048 + k * 1024); } while (0)
#define PG8_LDB(dst, b, h) do { _Pragma("unroll") for (int n = 0; n < 2; ++n) _Pragma("unroll") for (int k = 0; k < 2; ++k) dst[n][k] = *(const LAS bf16x8*)(lds + PG8_SB(b, h) + boff + n * 2048 + k * 1024); } while (0)
#define PG8_MMA(ai, bj, At, Bt) do { __builtin_amdgcn_s_setprio(1); _Pragma("unroll") for (int m = 0; m < 4; ++m) _Pragma("unroll") for (int n = 0; n < 2; ++n) _Pragma("unroll") for (int k = 0; k < 2; ++k) \
        acc[ai][bj][m][n] = __builtin_amdgcn_mfma_f32_16x16x32_bf16(Bt[n][k], At[m][k], acc[ai][bj][m][n], 0, 0, 0); __builtin_amdgcn_s_setprio(0); } while (0)
#define PG8_WAIT_V(n) asm volatile("s_waitcnt vmcnt(" #n ")" ::: "memory")
#define PG8_WAIT_L(n) asm volatile("s_waitcnt lgkmcnt(" #n ")" ::: "memory")
#define PG8_BAR __builtin_amdgcn_s_barrier()
#define PG8_SCHED __builtin_amdgcn_sched_barrier(0)
    Unit cur, nxt; int ui = 0;
    if (!S.next(0, cur)) return;
    f32x4 acc[2][2][4][2];
#pragma unroll
    for (int a = 0; a < 2; ++a)
#pragma unroll
        for (int b = 0; b < 2; ++b)
#pragma unroll
            for (int m = 0; m < 4; ++m)
#pragma unroll
                for (int n = 0; n < 2; ++n) acc[a][b][m][n] = (f32x4){0.f, 0.f, 0.f, 0.f};
    bf16x8 At[4][2], B0[2][2], B1[2][2];
    const char* cA = (const char*)g.A + (size_t)cur.pm * tstep; const char* cB = (const char*)g.Bt + (size_t)cur.pn * tstepB;
    PG8_STAGE(PG8_SB(0, 0), cB, voffB); PG8_STAGE(PG8_SA(0, 0), cA, voffA); PG8_STAGE(PG8_SB(0, 1), cB + hstepB, voffB); PG8_STAGE(PG8_SA(0, 1), cA + hstep, voffA);
    if (wr == 1) PG8_BAR;
    PG8_WAIT_V(4); PG8_BAR;
    PG8_STAGE(PG8_SB(1, 0), cB + kstep, voffB); PG8_STAGE(PG8_SA(1, 0), cA + kstep, voffA); PG8_STAGE(PG8_SB(1, 1), cB + hstepB + kstep, voffB);
    PG8_WAIT_V(6); PG8_BAR;
    for (;;) {
        const bool has_next = S.next(ui + 1, nxt);
        const char* nA = has_next ? (const char*)g.A + (size_t)nxt.pm * tstep : cA; const char* nB = has_next ? (const char*)g.Bt + (size_t)nxt.pn * tstepB : cB;
        for (int t = 0; t < nt; t += 2) {
            const bool last = (t == nt - 2);
            const char* a1 = cA + (size_t)(t + 1) * kstep;
            const char* a2 = last ? nA : cA + (size_t)(t + 2) * kstep; const char* b2 = last ? nB : cB + (size_t)(t + 2) * kstep;
            const char* a3 = a2 + kstep; const char* b3 = b2 + kstep;
            PG8_LDB(B0, 0, 0); PG8_SCHED; PG8_LDA(At, 0, 0); PG8_STAGE(PG8_SA(1, 1), a1 + hstep, voffA);
            PG8_WAIT_L(8); PG8_BAR; PG8_WAIT_L(0); PG8_MMA(0, 0, At, B0); PG8_BAR; PG8_SCHED;
            PG8_LDB(B1, 0, 1); PG8_STAGE(PG8_SB(0, 0), b2, voffB);
            PG8_BAR; PG8_WAIT_L(0); PG8_MMA(0, 1, At, B1); PG8_BAR;
            PG8_LDA(At, 0, 1); PG8_STAGE(PG8_SA(0, 0), a2, voffA);
            PG8_BAR; PG8_WAIT_L(0); PG8_MMA(1, 0, At, B0); PG8_BAR; PG8_SCHED;
            PG8_STAGE(PG8_SB(0, 1), b2 + hstepB, voffB);
            PG8_WAIT_V(6); PG8_BAR; PG8_MMA(1, 1, At, B1); PG8_BAR;
            PG8_LDB(B0, 1, 0); PG8_SCHED; PG8_LDA(At, 1, 0); PG8_STAGE(PG8_SA(0, 1), a2 + hstep, voffA);
            PG8_WAIT_L(8); PG8_BAR; PG8_WAIT_L(0); PG8_MMA(0, 0, At, B0); PG8_BAR; PG8_SCHED;
            PG8_LDB(B1, 1, 1); PG8_STAGE(PG8_SB(1, 0), b3, voffB);
            PG8_BAR; PG8_WAIT_L(0); PG8_MMA(0, 1, At, B1); PG8_BAR;
            PG8_LDA(At, 1, 1); PG8_STAGE(PG8_SA(1, 0), a3, voffA);
            PG8_BAR; PG8_WAIT_L(0); PG8_MMA(1, 0, At, B0); PG8_BAR; PG8_SCHED;
            PG8_STAGE(PG8_SB(1, 1), b3 + hstepB, voffB);
            PG8_WAIT_V(6); PG8_BAR; PG8_MMA(1, 1, At, B1); PG8_BAR;
        }
        E(acc, cur, wr, wc, fr, fq);
        if (!has_next) break;
#pragma unroll
        for (int a = 0; a < 2; ++a)
#pragma unroll
            for (int b = 0; b < 2; ++b)
#pragma unroll
                for (int m = 0; m < 4; ++m)
#pragma unroll
                    for (int n = 0; n < 2; ++n) acc[a][b][m][n] = (f32x4){0.f, 0.f, 0.f, 0.f};
        cur = nxt; cA = nA; cB = nB; ++ui;
    }
    PG8_WAIT_V(0);
    if (wr == 0) PG8_BAR;
    PG8_BAR;
#undef PG8_SA
#undef PG8_SB
#undef PG8_STAGE
#undef PG8_LDA
#undef PG8_LDB
#undef PG8_MMA
#undef PG8_WAIT_V
#undef PG8_WAIT_L
#undef PG8_BAR
#undef PG8_SCHED
}
}

struct EpiProj {
    bf16_t* P; float* DT; const float* rope; const float* dt_bias;
    __device__ __forceinline__ void operator()(const f32x4 (&acc)[2][2][4][2], const pg8::Unit& u, int wr, int wc, int fr, int fq) const {
        const int row0 = u.pm * 256 + wr * 64 + fr, pn = u.pn;
        if (pn < 5) {
            const float sc = pn < 4 ? 0.125f * LOG2E : 1.f;
            const int col = pn * 256 + 64 * wc + 8 * fq;
#pragma unroll
            for (int ai = 0; ai < 2; ++ai)
#pragma unroll
                for (int m = 0; m < 4; ++m) {
                    const int row = row0 + ai * 128 + m * 16, pos = row & (SEQ - 1);
                    const f32x4* cp = (const f32x4*)(rope + pos * 32 + 8 * fq); const f32x4* sp = (const f32x4*)(rope + SEQ * 32 + pos * 32 + 8 * fq);
                    f32x4 o1[2], o2[2];
#pragma unroll
                    for (int n = 0; n < 2; ++n) { const f32x4 c = cp[n], s = sp[n], t1 = acc[ai][0][m][n], t2 = acc[ai][1][m][n]; o1[n] = (t1 * c - t2 * s) * sc; o2[n] = (t1 * s + t2 * c) * sc; }
                    bf16_t* dst = P + (size_t)row * PW + col;
                    *(u32x4*)dst = (u32x4){cvt_pk(o1[0].x, o1[0].y), cvt_pk(o1[0].z, o1[0].w), cvt_pk(o1[1].x, o1[1].y), cvt_pk(o1[1].z, o1[1].w)};
                    *(u32x4*)(dst + 32) = (u32x4){cvt_pk(o2[0].x, o2[0].y), cvt_pk(o2[0].z, o2[0].w), cvt_pk(o2[1].x, o2[1].y), cvt_pk(o2[1].z, o2[1].w)};
                }
        } else if (pn < 20) {
            const bool do_silu = (pn >= 6 && pn < 12) || pn >= 18;
            const float sc = (pn == 16 || pn == 17) ? 0.08838834764831845f * LOG2E : 1.f;
            const int col = pn * 256 + 32 * wc + 8 * fq;
#pragma unroll
            for (int ai = 0; ai < 2; ++ai)
#pragma unroll
                for (int m = 0; m < 4; ++m) {
                    const int row = row0 + ai * 128 + m * 16;
#pragma unroll
                    for (int bj = 0; bj < 2; ++bj) {
                        f32x4 v0 = acc[ai][bj][m][0], v1 = acc[ai][bj][m][1];
                        if (do_silu) { v0 = silu4(v0); v1 = silu4(v1); } else { v0 = v0 * sc; v1 = v1 * sc; }
                        *(u32x4*)(P + (size_t)row * PW + col + 128 * bj) = (u32x4){cvt_pk(v0.x, v0.y), cvt_pk(v0.z, v0.w), cvt_pk(v1.x, v1.y), cvt_pk(v1.z, v1.w)};
                    }
                }
        } else {
            if (wc == 0 && fq < 2) {
#pragma unroll
                for (int ai = 0; ai < 2; ++ai)
#pragma unroll
                    for (int m = 0; m < 4; ++m) {
                        const int row = row0 + ai * 128 + m * 16;
#pragma unroll
                        for (int n = 0; n < 2; ++n) {
                            const int j0 = 8 * fq + 4 * n; const f32x4 bb = *(const f32x4*)(dt_bias + j0); const f32x4 v = acc[ai][0][m][n] + bb;
                            *(f32x4*)(DT + (size_t)row * 16 + j0) = (f32x4){softplus_f(v.x), softplus_f(v.y), softplus_f(v.z), softplus_f(v.w)};
                        }
                    }
            }
        }
    }
};
struct EpiMkv {
    bf16_t* O;
    __device__ __forceinline__ void operator()(const f32x4 (&acc)[2][2][4][2], const pg8::Unit& u, int wr, int wc, int fr, int fq) const {
        const int row0 = u.pm * 256 + wr * 64 + fr, col = u.pn * 256 + 32 * wc + 8 * fq;
#pragma unroll
        for (int ai = 0; ai < 2; ++ai)
#pragma unroll
            for (int m = 0; m < 4; ++m) {
                const int row = row0 + ai * 128 + m * 16;
#pragma unroll
                for (int bj = 0; bj < 2; ++bj) { const f32x4 v0 = acc[ai][bj][m][0], v1 = acc[ai][bj][m][1];
                    *(u32x4*)(O + (size_t)row * 1024 + col + 128 * bj) = (u32x4){cvt_pk(v0.x, v0.y), cvt_pk(v0.z, v0.w), cvt_pk(v1.x, v1.y), cvt_pk(v1.z, v1.w)}; }
            }
    }
};
struct EpiOut {
    const float* x; float* out; float* rowss;
    __device__ __forceinline__ void operator()(const f32x4 (&acc)[2][2][4][2], const pg8::Unit& u, int wr, int wc, int fr, int fq) const {
        const int row0 = u.pm * 256 + wr * 64 + fr, col = u.pn * 256 + 32 * wc + 8 * fq;
#pragma unroll
        for (int ai = 0; ai < 2; ++ai)
#pragma unroll
            for (int m = 0; m < 4; ++m) {
                const int row = row0 + ai * 128 + m * 16; float ss = 0.f;
#pragma unroll
                for (int bj = 0; bj < 2; ++bj) {
                    const size_t o = (size_t)row * DM + col + 128 * bj;
                    const f32x4 h0 = *(const f32x4*)(x + o) + acc[ai][bj][m][0], h1 = *(const f32x4*)(x + o + 4) + acc[ai][bj][m][1];
                    *(f32x4*)(out + o) = h0; *(f32x4*)(out + o + 4) = h1;
                    ss += h0.x * h0.x + h0.y * h0.y + h0.z * h0.z + h0.w * h0.w + h1.x * h1.x + h1.y * h1.y + h1.z * h1.z + h1.w * h1.w;
                }
                ss += __shfl_xor(ss, 16); ss += __shfl_xor(ss, 32);
                if (fq == 0) rowss[(size_t)row * 16 + u.pn * 4 + wc] = ss;
            }
    }
};

struct Args { const float* in[15]; float* out; unsigned char* ws; int lo, hi, sub, pad; };
struct Ctx {
    const float *x, *mem, *norm_mem_w, *norm_in_w, *w_in, *attn_sink, *conv_w, *conv_b, *dt_bias, *a_log, *d_skip, *ssd_norm_w, *w_mem_kv, *w_out, *norm_out_w;
    float* out; float* rowss; float* rope; bf16_t* win_t; bf16_t* wout_t; bf16_t* wmem_t; bf16_t* memn; bf16_t* mkv; float* dt; float* dec; bf16_t* proj; bf16_t* mix; bf16_t* hn; bf16_t* st;
    ldsp lds; int tid, lane, wave, G, bid;
};

__device__ __forceinline__ void rms_row_bf16(const float* xr, const float* w, bf16_t* o, int lane) {
    f32x4 v[4]; float ss = 0.f;
#pragma unroll
    for (int j = 0; j < 4; ++j) { v[j] = *(const f32x4*)(xr + 4 * lane + 256 * j); ss += v[j].x * v[j].x + v[j].y * v[j].y + v[j].z * v[j].z + v[j].w * v[j].w; }
#pragma unroll
    for (int off = 1; off < 64; off <<= 1) ss += __shfl_xor(ss, off);
    const float r = rsqrtf(ss * (1.f / DM) + EPS);
#pragma unroll
    for (int j = 0; j < 4; ++j) { const f32x4 ww = *(const f32x4*)(w + 4 * lane + 256 * j); *(u32x2*)(o + 4 * lane + 256 * j) = pack4(v[j] * r * ww); }
}
template <int MODE>
__device__ __forceinline__ void transpose_w(const Ctx& F, const float* W, int K, int NS, bf16_t* Bt, int NP, int ldb) {
    const int nitems = NP * (K / 8);
    for (int it = F.bid * 512 + F.tid; it < nitems; it += F.G * 512) {
        const int n = it % NP, kg = it / NP, tile = n >> 8, cph = n & 255; int src;
        if (MODE == 0) {
            if (tile < 5) src = tile * 256 + perm_rot(cph);
            else if (tile < 20) { src = tile * 256 + perm_plain(cph); if (src >= 4096) src += 16; }
            else { const int l = perm_plain(cph); src = l < 16 ? 4096 + l : -1; }
        } else src = tile * 256 + perm_plain(cph);
        float v[8];
#pragma unroll
        for (int j = 0; j < 8; ++j) v[j] = src >= 0 ? W[(size_t)(kg * 8 + j) * NS + src] : 0.f;
        *(u32x4*)(Bt + (size_t)n * ldb + kg * 8) = (u32x4){cvt_pk(v[0], v[1]), cvt_pk(v[2], v[3]), cvt_pk(v[4], v[5]), cvt_pk(v[6], v[7])};
    }
}
__device__ __forceinline__ void phase0(const Ctx& F) {
    const int gt = F.bid * 512 + F.tid, NT = F.G * 512;
    for (int i = gt; i < SEQ * 32; i += NT) {
        const int pos = i >> 5, f = i & 31;
        const float inv = 1.0f / exp2f((float)f * (13.287712379549449f / 32.f));
        const float ang = (float)pos * inv;
        const double rev = (double)ang * 0.15915494309189535; const double fr = rev - __builtin_rint(rev);
        const float r = (float)(fr * 6.283185307179586);
        F.rope[i] = __cosf(r); F.rope[SEQ * 32 + i] = __sinf(r);
    }
    transpose_w<0>(F, F.w_in, DM, INW, F.win_t, NPHYS, HNP);
    transpose_w<1>(F, F.w_out, MIXW, DM, F.wout_t, DM, MIXP);
    transpose_w<1>(F, F.w_mem_kv, DM, DM, F.wmem_t, DM, HNP);
    const int gw = F.bid * 8 + F.wave, NGW = F.G * 8;
    for (int m = gw; m < NBATCH * 256; m += NGW) rms_row_bf16(F.mem + (size_t)m * DM, F.norm_mem_w, F.memn + (size_t)m * HNP, F.lane);
    for (int m = gw; m < TOK; m += NGW) rms_row_bf16(F.x + (size_t)m * DM, F.norm_in_w, F.hn + (size_t)m * HNP, F.lane);
}

template <int DH, int NQF>
__device__ __forceinline__ void attn_tile(ldsp Kt, int KS, ldsp Vt, int VS, const bf16x8 (&qf)[NQF][DH / 32], f32x4 (&o)[DH / 16][NQF], float (&m)[NQF], float (&lp)[NQF], int maskmode, int lane) {
    const int i16 = lane & 15, q4 = lane >> 4;
    f32x4 st[4][NQF];
#pragma unroll
    for (int kf = 0; kf < 4; ++kf)
#pragma unroll
        for (int q = 0; q < NQF; ++q) st[kf][q] = (f32x4){0.f, 0.f, 0.f, 0.f};
#pragma unroll
    for (int ks = 0; ks < DH / 32; ++ks)
#pragma unroll
        for (int kf = 0; kf < 4; ++kf) {
            const bf16x8 ka = ld8(Kt + (16 * kf + i16) * KS + (32 * ks + 8 * q4) * 2);
#pragma unroll
            for (int q = 0; q < NQF; ++q) st[kf][q] = mfma16(ka, qf[q][ks], st[kf][q]);
            if (DH > 64 && kf == 3) __builtin_amdgcn_sched_barrier(0);
        }
    if (maskmode) {
#pragma unroll
        for (int kf = 0; kf < 4; ++kf)
#pragma unroll
            for (int q = 0; q < NQF; ++q)
#pragma unroll
                for (int r = 0; r < 4; ++r) { const int ko = 16 * kf + 4 * q4 + r, qo = 16 * q + i16; const bool bad = maskmode == 1 ? (ko < qo) : (ko > qo); if (bad) st[kf][q][r] = -INFINITY; }
    }
#pragma unroll
    for (int q = 0; q < NQF; ++q) {
        float mx = st[0][q][0];
#pragma unroll
        for (int kf = 0; kf < 4; ++kf)
#pragma unroll
            for (int r = 0; r < 4; ++r) mx = fmaxf(mx, st[kf][q][r]);
        mx = fmaxf(mx, __shfl_xor(mx, 16)); mx = fmaxf(mx, __shfl_xor(mx, 32));
        const float mn = fmaxf(m[q], mx), alpha = ex2(m[q] - mn); m[q] = mn;
        float ps = 0.f;
#pragma unroll
        for (int kf = 0; kf < 4; ++kf)
#pragma unroll
            for (int r = 0; r < 4; ++r) { const float p = ex2(st[kf][q][r] - mn); st[kf][q][r] = p; ps += p; }
        lp[q] = lp[q] * alpha + ps;
#pragma unroll
        for (int d = 0; d < DH / 16; ++d) o[d][q] = o[d][q] * alpha;
    }
#pragma unroll
    for (int kp = 0; kp < 2; ++kp) {
        bf16x8 pk[NQF];
#pragma unroll
        for (int q = 0; q < NQF; ++q) pk[q] = packfrag(st[2 * kp][q], st[2 * kp + 1][q]);
#pragma unroll
        for (int d = 0; d < DH / 16; ++d) {
            ldsp va = Vt + (32 * kp + 4 * q4 + (i16 >> 2)) * VS + (16 * d + 4 * (i16 & 3)) * 2;
            const bf16x8 vf = cat8(vtr(va), vtr(va + 16 * VS));
#pragma unroll
            for (int q = 0; q < NQF; ++q) o[d][q] = mfma16(vf, pk[q], o[d][q]);
            if (DH > 64 && (d & 3) == 3) __builtin_amdgcn_sched_barrier(0);
        }
    }
}

__device__ __forceinline__ void attn_window_item(const Ctx& F, int item) {
    constexpr int KS = 144, VS = 160; const ldsp Ki = F.lds, Vi = F.lds + 384 * KS;
    const int kvh = item & 3, i = (item >> 2) & 31, b = item >> 7;
    __syncthreads();
    for (int c = F.tid; c < 3072; c += 512) {
        const int r = c >> 3, ch = c & 7, key = 128 * i - 128 + r;
        if (key >= 0 && key < SEQ) {
            const bf16_t* src = F.proj + (size_t)(b * SEQ + key) * PW + 64 * kvh + 8 * ch;
            *(LAS u32x4*)(Ki + r * KS + ch * 16) = *(const u32x4*)(src + C_K);
            *(LAS u32x4*)(Vi + r * VS + ch * 16) = *(const u32x4*)(src + C_V);
        }
    }
    __syncthreads();
    const int w = F.wave, lane = F.lane, i16 = lane & 15, q4 = lane >> 4, hq = 4 * kvh + (w >> 1), q0 = 128 * i + 64 * (w & 1);
    bf16x8 qf[4][2];
#pragma unroll
    for (int q = 0; q < 4; ++q)
#pragma unroll
        for (int ks = 0; ks < 2; ++ks) qf[q][ks] = *(const bf16x8*)(F.proj + (size_t)(b * SEQ + q0 + 16 * q + i16) * PW + C_Q + hq * 64 + 32 * ks + 8 * q4);
    f32x4 o[4][4]; float m[4], lp[4];
    const float sink = F.attn_sink[hq] * LOG2E;
#pragma unroll
    for (int q = 0; q < 4; ++q) { m[q] = sink; lp[q] = q4 == 0 ? 1.f : 0.f;
#pragma unroll
        for (int d = 0; d < 4; ++d) o[d][q] = (f32x4){0.f, 0.f, 0.f, 0.f}; }
#pragma unroll 1
    for (int j = 0; j < 5; ++j) {
        const int kstart = q0 - 128 + 64 * j; if (kstart < 0 || kstart >= SEQ) continue;
        const int ir = 64 * (w & 1) + 64 * j;
        attn_tile<64, 4>(Ki + ir * KS, KS, Vi + ir * VS, VS, qf, o, m, lp, j == 0 ? 1 : (j == 4 ? 2 : 0), lane);
    }
#pragma unroll
    for (int q = 0; q < 4; ++q) {
        float l = lp[q]; l += __shfl_xor(l, 16); l += __shfl_xor(l, 32); const float inv = 1.f / l;
        const size_t row = (size_t)(b * SEQ + q0 + 16 * q + i16);
#pragma unroll
        for (int d = 0; d < 4; ++d) {
            const int col = hq * 64 + 16 * d + 4 * q4;
            const f32x4 g = unpack4(*(const u32x2*)(F.proj + row * PW + C_G + col));
            *(u32x2*)(F.mix + row * MIXP + col) = pack4(o[d][q] * inv * g);
        }
    }
}
__device__ __forceinline__ void attn_mem_item(const Ctx& F, int item) {
    constexpr int KS = 272, VS = 288; const ldsp Ki = F.lds, Vi = F.lds + 256 * KS;
    const int hm = item & 3, qb = (item >> 2) & 15, b = item >> 6;
    __syncthreads();
    for (int c = F.tid; c < 4096; c += 512) {
        const int r = c >> 4, ch = c & 15;
        const bf16_t* src = F.mkv + (size_t)(b * 256 + r) * 1024 + hm * 128 + 8 * ch;
        *(LAS u32x4*)(Ki + r * KS + ch * 16) = *(const u32x4*)(src);
        *(LAS u32x4*)(Vi + r * VS + ch * 16) = *(const u32x4*)(src + 512);
    }
    __syncthreads();
    const int w = F.wave, lane = F.lane, i16 = lane & 15, q4 = lane >> 4, q0 = 256 * qb + 32 * w;
    bf16x8 qf[2][4];
#pragma unroll
    for (int q = 0; q < 2; ++q)
#pragma unroll
        for (int ks = 0; ks < 4; ++ks) qf[q][ks] = *(const bf16x8*)(F.proj + (size_t)(b * SEQ + q0 + 16 * q + i16) * PW + C_QM + hm * 128 + 32 * ks + 8 * q4);
    f32x4 o[8][2]; float m[2], lp[2];
#pragma unroll
    for (int q = 0; q < 2; ++q) { m[q] = -INFINITY; lp[q] = 0.f;
#pragma unroll
        for (int d = 0; d < 8; ++d) o[d][q] = (f32x4){0.f, 0.f, 0.f, 0.f}; }
#pragma unroll 1
    for (int j = 0; j < 4; ++j) attn_tile<128, 2>(Ki + 64 * j * KS, KS, Vi + 64 * j * VS, VS, qf, o, m, lp, 0, lane);
#pragma unroll
    for (int q = 0; q < 2; ++q) {
        float l = lp[q]; l += __shfl_xor(l, 16); l += __shfl_xor(l, 32); const float inv = 1.f / l;
        const size_t row = (size_t)(b * SEQ + q0 + 16 * q + i16);
#pragma unroll
        for (int d = 0; d < 8; ++d) {
            const int col = hm * 128 + 16 * d + 4 * q4;
            const f32x4 g = unpack4(*(const u32x2*)(F.proj + row * PW + C_GM + col));
            *(u32x2*)(F.mix + row * MIXP + 1536 + col) = pack4(o[d][q] * inv * g);
        }
    }
}

constexpr int XS = 544, BS = 288, XWS = 160, PS = 272;
constexpr int L_XI = 0, L_BI = 128 * XS, L_CI = L_BI + 128 * BS, L_XW = L_CI, L_F32 = L_XW + 2 * 128 * XWS;
static_assert(L_F32 + 8192 <= LDS_BYTES, "lds");
__device__ __forceinline__ void ssd_dtprep(const Ctx& F, int b, int c, int g, bool write_dec) {
    LAS float* DTs = (LAS float*)(F.lds + L_F32); LAS float* ACs = DTs + 1024;
    const int w = F.wave, lane = F.lane, dir = w >> 2, r = w & 3, h = 4 * g + r, j = dir * 8 + h;
    const size_t row0 = (size_t)b * SEQ + c * 128;
    const float d0 = F.dt[(row0 + 2 * lane) * 16 + j], d1 = F.dt[(row0 + 2 * lane + 1) * 16 + j];
    const float a = -expf(F.a_log[j]);
    const float x0 = d0 * a, x1 = d1 * a, ps = x0 + x1; float inc = ps;
#pragma unroll
    for (int off = 1; off < 64; off <<= 1) { const float t = __shfl_up(inc, off); if (lane >= off) inc += t; }
    const float total = __shfl(inc, 63);
    float a0, a1;
    if (dir == 0) { a0 = inc - x1; a1 = inc; } else { a0 = total - (inc - ps); a1 = total - (inc - x1); }
    *(LAS f32x2*)(DTs + w * 128 + 2 * lane) = (f32x2){d0, d1};
    *(LAS f32x2*)(ACs + w * 128 + 2 * lane) = (f32x2){a0, a1};
    if (write_dec && lane == 0) F.dec[(b * 32 + c) * 16 + j] = expf(total);
}
template <int NCOLS>
__device__ __forceinline__ void conv_img(const Ctx& F, int b, int c, int xcol, ldsp img, int stride) {
    constexpr int NCQ = NCOLS / 4, NRG = 512 / NCQ, R = 128 / NRG;
    const int cq = F.tid % NCQ, rg = F.tid / NCQ, col = xcol + 4 * cq;
    f32x4 w[5];
#pragma unroll
    for (int j = 0; j < 5; ++j) w[j] = *(const f32x4*)(F.conv_w + j * 1024 + col);
    const f32x4 bias = *(const f32x4*)(F.conv_b + col);
    const int t0 = c * 128 + rg * R - 2;
    const bf16_t* base = F.proj + (size_t)b * SEQ * PW + C_X + col;
    f32x4 win[R + 4];
#pragma unroll
    for (int k = 0; k < R + 4; ++k) { const int t = t0 + k; win[k] = (t >= 0 && t < SEQ) ? unpack4(*(const u32x2*)(base + (size_t)t * PW)) : (f32x4){0.f, 0.f, 0.f, 0.f}; }
#pragma unroll
    for (int r = 0; r < R; ++r) {
        f32x4 y = bias;
#pragma unroll
        for (int j = 0; j < 5; ++j) y = y + w[j] * win[r + j];
        *(LAS u32x2*)(img + (rg * R + r) * stride + cq * 8) = pack4(silu4(y));
    }
}
__device__ __forceinline__ void ssd_pass1_item(const Ctx& F, int item) {
    const int g = item & 1, c = (item >> 1) & 31, b = item >> 6;
    const ldsp XI = F.lds + L_XI, BI = F.lds + L_BI, XW = F.lds + L_XW;
    LAS float* DTs = (LAS float*)(F.lds + L_F32); LAS float* ACs = DTs + 1024;
    __syncthreads();
    ssd_dtprep(F, b, c, g, true);
    conv_img<256>(F, b, c, 256 * g, XI, XS);
    conv_img<128>(F, b, c, 512 + 128 * g, BI, BS);
    __syncthreads();
    const int lane = F.lane, i16 = lane & 15, q4 = lane >> 4, w = F.wave;
    for (int r = 0; r < 4; ++r) {
        if (r) __syncthreads();
        {
            const int dir = F.tid >> 8, row = (F.tid >> 1) & 127, half = F.tid & 1, seq = dir * 4 + r;
            const float wgt = DTs[seq * 128 + row] * expf(ACs[seq * 128 + (dir ? 0 : 127)] - ACs[seq * 128 + row]);
#pragma unroll
            for (int k = 0; k < 4; ++k) {
                const u32x4 v = *(const LAS u32x4*)(XI + row * XS + (64 * r + 32 * half + 8 * k) * 2);
                u32x4 o;
                o.x = cvt_pk(bf_lo(v.x) * wgt, bf_hi(v.x) * wgt); o.y = cvt_pk(bf_lo(v.y) * wgt, bf_hi(v.y) * wgt);
                o.z = cvt_pk(bf_lo(v.z) * wgt, bf_hi(v.z) * wgt); o.w = cvt_pk(bf_lo(v.w) * wgt, bf_hi(v.w) * wgt);
                *(LAS u32x4*)(XW + dir * (128 * XWS) + row * XWS + (32 * half + 8 * k) * 2) = o;
            }
        }
        __syncthreads();
        const int dir = w & 1, nq = w >> 1;
        f32x4 acc[2][4];
#pragma unroll
        for (int nf = 0; nf < 2; ++nf)
#pragma unroll
            for (int pf = 0; pf < 4; ++pf) acc[nf][pf] = (f32x4){0.f, 0.f, 0.f, 0.f};
#pragma unroll
        for (int ks = 0; ks < 4; ++ks) {
            const int trow = 32 * ks + 8 * q4 + (i16 >> 2);
            bf16x8 af[2], bfr[4];
#pragma unroll
            for (int nf = 0; nf < 2; ++nf) { ldsp p = BI + trow * BS + (32 * nq + 16 * nf + 4 * (i16 & 3)) * 2; af[nf] = cat8(vtr(p), vtr(p + 4 * BS)); }
#pragma unroll
            for (int pf = 0; pf < 4; ++pf) { ldsp p = XW + dir * (128 * XWS) + trow * XWS + (16 * pf + 4 * (i16 & 3)) * 2; bfr[pf] = cat8(vtr(p), vtr(p + 4 * XWS)); }
#pragma unroll
            for (int nf = 0; nf < 2; ++nf)
#pragma unroll
                for (int pf = 0; pf < 4; ++pf) acc[nf][pf] = mfma16(af[nf], bfr[pf], acc[nf][pf]);
        }
        bf16_t* S = F.st + ((((size_t)(b * 32 + c) * 2 + dir) * 8 + (4 * g + r)) << 13);
#pragma unroll
        for (int nf = 0; nf < 2; ++nf)
#pragma unroll
            for (int pf = 0; pf < 4; ++pf) *(u32x2*)(S + (16 * pf + i16) * 128 + 32 * nq + 16 * nf + 4 * q4) = pack4(acc[nf][pf]);
    }
}
__device__ __forceinline__ void ssd_scan(const Ctx& F) {
    for (int it = F.bid * 512 + F.tid; it < NBATCH * 2 * 8 * 1024; it += F.G * 512) {
        const int e8 = it & 1023, h = (it >> 10) & 7, dir = (it >> 13) & 1, b = it >> 14;
        float run[8];
#pragma unroll
        for (int k = 0; k < 8; ++k) run[k] = 0.f;
        for (int s0 = 0; s0 < 32; s0 += 4) {
            u32x4 v[4]; float dc[4]; bf16_t* ad[4];
#pragma unroll
            for (int u = 0; u < 4; ++u) { const int s = s0 + u, c = dir ? 31 - s : s; ad[u] = F.st + (((((size_t)(b * 32 + c) * 2 + dir) * 8 + h) << 13) + e8 * 8); v[u] = *(const u32x4*)ad[u]; dc[u] = F.dec[(b * 32 + c) * 16 + dir * 8 + h]; }
#pragma unroll
            for (int u = 0; u < 4; ++u) {
                *(u32x4*)ad[u] = (u32x4){cvt_pk(run[0], run[1]), cvt_pk(run[2], run[3]), cvt_pk(run[4], run[5]), cvt_pk(run[6], run[7])};
                run[0] = run[0] * dc[u] + bf_lo(v[u].x); run[1] = run[1] * dc[u] + bf_hi(v[u].x); run[2] = run[2] * dc[u] + bf_lo(v[u].y); run[3] = run[3] * dc[u] + bf_hi(v[u].y);
                run[4] = run[4] * dc[u] + bf_lo(v[u].z); run[5] = run[5] * dc[u] + bf_hi(v[u].z); run[6] = run[6] * dc[u] + bf_lo(v[u].w); run[7] = run[7] * dc[u] + bf_hi(v[u].w);
            }
        }
    }
}
__device__ __forceinline__ void ssd_pass2_item(const Ctx& F, int item) {
    const int g = item & 1, c = (item >> 1) & 31, b = item >> 6;
    const ldsp XI = F.lds + L_XI, BI = F.lds + L_BI, CI = F.lds + L_CI, PV = F.lds + L_BI;
    LAS float* DTs = (LAS float*)(F.lds + L_F32); LAS float* ACs = DTs + 1024;
    __syncthreads();
    ssd_dtprep(F, b, c, g, false);
    conv_img<256>(F, b, c, 256 * g, XI, XS);
    conv_img<128>(F, b, c, 512 + 128 * g, BI, BS);
    conv_img<128>(F, b, c, 768 + 128 * g, CI, BS);
    __syncthreads();
    const int lane = F.lane, i16 = lane & 15, q4 = lane >> 4, w = F.wave, tl = 16 * w + i16;
    bf16x8 cf[4];
#pragma unroll
    for (int ks = 0; ks < 4; ++ks) cf[ks] = ld8(CI + tl * BS + (32 * ks + 8 * q4) * 2);
    f32x4 cbt[8];
#pragma unroll
    for (int sf = 0; sf < 8; ++sf) {
        cbt[sf] = (f32x4){0.f, 0.f, 0.f, 0.f};
#pragma unroll
        for (int ks = 0; ks < 4; ++ks) cbt[sf] = mfma16(ld8(BI + (16 * sf + i16) * BS + (32 * ks + 8 * q4) * 2), cf[ks], cbt[sf]);
    }
    f32x4 gprev[4]; float ss = 0.f;
#pragma unroll
    for (int pf = 0; pf < 4; ++pf) gprev[pf] = (f32x4){0.f, 0.f, 0.f, 0.f};
    const size_t row = (size_t)b * SEQ + c * 128 + tl;
#pragma unroll 1
    for (int r = 0; r < 4; ++r) {
        const int h = 4 * g + r;
        __syncthreads();
        if (r > 0) {
#pragma unroll
            for (int pf = 0; pf < 4; ++pf) *(LAS u32x2*)(XI + tl * XS + (64 * (r - 1) + 16 * pf + 4 * q4) * 2) = pack4(gprev[pf]);
        }
        {
            const int dir = F.tid >> 8, p = (F.tid >> 2) & 63, qu = F.tid & 3;
            const bf16_t* src = F.st + (((((size_t)(b * 32 + c) * 2 + dir) * 8 + h) << 13) + p * 128 + 32 * qu);
#pragma unroll
            for (int k = 0; k < 4; ++k) *(LAS u32x4*)(PV + dir * (64 * PS) + p * PS + (32 * qu + 8 * k) * 2) = *(const u32x4*)(src + 8 * k);
        }
        __syncthreads();
        const float acf = ACs[r * 128 + tl], acb = ACs[(4 + r) * 128 + tl];
        f32x4 yt[4];
#pragma unroll
        for (int pf = 0; pf < 4; ++pf) yt[pf] = (f32x4){0.f, 0.f, 0.f, 0.f};
#pragma unroll
        for (int kp = 0; kp < 4; ++kp) {
            f32x4 gt[2];
#pragma unroll
            for (int u = 0; u < 2; ++u) {
                const int sf = 2 * kp + u, s0 = 16 * sf + 4 * q4;
                const f32x4 dtf = *(const LAS f32x4*)(DTs + r * 128 + s0), af = *(const LAS f32x4*)(ACs + r * 128 + s0);
                const f32x4 dtb = *(const LAS f32x4*)(DTs + (4 + r) * 128 + s0), ab = *(const LAS f32x4*)(ACs + (4 + r) * 128 + s0);
#pragma unroll
                for (int e = 0; e < 4; ++e) {
                    const int s = s0 + e;
                    const float mf = s <= tl ? dtf[e] * __expf(acf - af[e]) : 0.f;
                    const float mb = s >= tl ? dtb[e] * __expf(acb - ab[e]) : 0.f;
                    gt[u][e] = cbt[sf][e] * (mf + mb);
                }
            }
            const bf16x8 gk = packfrag(gt[0], gt[1]);
#pragma unroll
            for (int pf = 0; pf < 4; ++pf) {
                ldsp xa = XI + (32 * kp + 4 * q4 + (i16 >> 2)) * XS + (64 * r + 16 * pf + 4 * (i16 & 3)) * 2;
                yt[pf] = mfma16(cat8(vtr(xa), vtr(xa + 16 * XS)), gk, yt[pf]);
            }
        }
        f32x4 yf[4], yb[4];
#pragma unroll
        for (int pf = 0; pf < 4; ++pf) { yf[pf] = (f32x4){0.f, 0.f, 0.f, 0.f}; yb[pf] = (f32x4){0.f, 0.f, 0.f, 0.f}; }
#pragma unroll
        for (int ks = 0; ks < 4; ++ks)
#pragma unroll
            for (int pf = 0; pf < 4; ++pf) {
                yf[pf] = mfma16(ld8(PV + (16 * pf + i16) * PS + (32 * ks + 8 * q4) * 2), cf[ks], yf[pf]);
                yb[pf] = mfma16(ld8(PV + 64 * PS + (16 * pf + i16) * PS + (32 * ks + 8 * q4) * 2), cf[ks], yb[pf]);
            }
        const float ef = __expf(acf), eb = __expf(acb), dsk = F.d_skip[h];
#pragma unroll
        for (int pf = 0; pf < 4; ++pf) {
            const int pc = 64 * r + 16 * pf + 4 * q4;
            const f32x4 xv = unpack4(*(const LAS u32x2*)(XI + tl * XS + pc * 2));
            const f32x4 zv = unpack4(*(const u32x2*)(F.proj + row * PW + C_Z + 256 * g + pc));
            const f32x4 y = (yt[pf] + yf[pf] * ef + yb[pf] * eb + xv * dsk) * zv;
            gprev[pf] = y; ss += y.x * y.x + y.y * y.y + y.z * y.z + y.w * y.w;
        }
    }
    __syncthreads();
#pragma unroll
    for (int pf = 0; pf < 4; ++pf) *(LAS u32x2*)(XI + tl * XS + (64 * 3 + 16 * pf + 4 * q4) * 2) = pack4(gprev[pf]);
    ss += __shfl_xor(ss, 16); ss += __shfl_xor(ss, 32);
    const float rinv = rsqrtf(ss * (1.f / 256.f) + EPS);
#pragma unroll
    for (int r = 0; r < 4; ++r)
#pragma unroll
        for (int pf = 0; pf < 4; ++pf) {
            const int pl = 64 * r + 16 * pf + 4 * q4, pc = 256 * g + pl;
            const f32x4 nw = *(const f32x4*)(F.ssd_norm_w + pc);
            const f32x4 gv = unpack4(*(const LAS u32x2*)(XI + tl * XS + pl * 2));
            *(u32x2*)(F.mix + row * MIXP + 1024 + pc) = pack4(gv * rinv * nw);
        }
}

__device__ __forceinline__ void final_norm(const Ctx& F) {
    const int gw = F.bid * 8 + F.wave, NGW = F.G * 8, lane = F.lane;
    for (int m = gw; m < TOK; m += NGW) {
        const f32x4* rp = (const f32x4*)(F.rowss + (size_t)m * 16); const f32x4 s4 = (rp[0] + rp[1]) + (rp[2] + rp[3]);
        const float r = rsqrtf(((s4.x + s4.y) + (s4.z + s4.w)) * (1.f / DM) + EPS);
        float* o = F.out + (size_t)m * DM;
#pragma unroll
        for (int j = 0; j < 4; ++j) { const f32x4 v = *(const f32x4*)(o + 4 * lane + 256 * j), ww = *(const f32x4*)(F.norm_out_w + 4 * lane + 256 * j); *(f32x4*)(o + 4 * lane + 256 * j) = v * r * ww; }
    }
}

__device__ __forceinline__ void seam_barrier(unsigned* ctr, unsigned target, int tid) {
    asm volatile("s_waitcnt vmcnt(0) lgkmcnt(0)" ::: "memory");
    __syncthreads();
    if (tid == 0) {
        __builtin_amdgcn_fence(__ATOMIC_RELEASE, "agent");
        asm volatile("s_waitcnt vmcnt(0)" ::: "memory");
        __hip_atomic_fetch_add(ctr, 1u, __ATOMIC_RELAXED, __HIP_MEMORY_SCOPE_AGENT);
        while (__hip_atomic_load(ctr, __ATOMIC_RELAXED, __HIP_MEMORY_SCOPE_AGENT) < target) __builtin_amdgcn_s_sleep(1);
        __builtin_amdgcn_fence(__ATOMIC_ACQUIRE, "agent");
        asm volatile("s_waitcnt vmcnt(0)" ::: "memory");
    }
    __syncthreads();
}
__global__ void __launch_bounds__(512, 2) hymba_fwd(Args args) {
    extern __shared__ __attribute__((aligned(16))) unsigned char lds_raw[];
    Ctx F;
    F.x = args.in[0]; F.mem = args.in[1]; F.norm_mem_w = args.in[2]; F.norm_in_w = args.in[3]; F.w_in = args.in[4]; F.attn_sink = args.in[5]; F.conv_w = args.in[6]; F.conv_b = args.in[7];
    F.dt_bias = args.in[8]; F.a_log = args.in[9]; F.d_skip = args.in[10]; F.ssd_norm_w = args.in[11]; F.w_mem_kv = args.in[12]; F.w_out = args.in[13]; F.norm_out_w = args.in[14];
    unsigned char* ws = args.ws;
    F.out = args.out; F.rowss = (float*)(ws + WS_ROWSS); F.rope = (float*)(ws + WS_ROPE); F.win_t = (bf16_t*)(ws + WS_WIN); F.wout_t = (bf16_t*)(ws + WS_WOUT); F.wmem_t = (bf16_t*)(ws + WS_WMEM);
    F.memn = (bf16_t*)(ws + WS_MEMN); F.mkv = (bf16_t*)(ws + WS_MKV); F.dt = (float*)(ws + WS_DT); F.dec = (float*)(ws + WS_DEC); F.proj = (bf16_t*)(ws + WS_PROJ); F.mix = (bf16_t*)(ws + WS_MIX);
    F.hn = (bf16_t*)args.out; F.st = (bf16_t*)args.out;
    F.lds = (ldsp)lds_raw; F.tid = threadIdx.x; F.lane = F.tid & 63; F.wave = __builtin_amdgcn_readfirstlane(F.tid >> 6); F.G = gridDim.x; F.bid = blockIdx.x;
    const int lo = args.lo, hi = args.hi;
    cg::grid_group grid = cg::this_grid();
#define IN(k) (lo <= (k) && (k) < hi)
#define SEAM(k) do { if (IN(k) && IN((k) + 1)) { if ((k) == 0) grid.sync(); else seam_barrier((unsigned*)args.ws, (unsigned)(k) * (unsigned)F.G, F.tid); } } while (0)
    if (IN(0)) phase0(F);
    SEAM(0);
    if (IN(1)) {
        { pg8::Gemm g{F.memn, F.wmem_t, NBATCH * 256, 1024, 1024, HNP, HNP}; pg8::StaticOrder S; S.init(g.M, g.N, F.G, F.bid); EpiMkv E{F.mkv}; pg8::gemm_phase(F.lds, g, S, E); }
        { pg8::Gemm g{F.hn, F.win_t, TOK, NPHYS, DM, HNP, HNP}; pg8::StaticOrder S; S.init(g.M, g.N, F.G, F.bid); EpiProj E{F.proj, F.dt, F.rope, F.dt_bias}; pg8::gemm_phase(F.lds, g, S, E); }
    }
    SEAM(1);
#if DBG_STOP == 1
    { grid.sync(); const int gw = F.bid * 8 + F.wave, NGW = F.G * 8;
      for (int m = gw; m < TOK; m += NGW) for (int j = 0; j < 16; ++j) { const int c = F.lane + 64 * j; float a = 0.f; for (int k = 0; k < 5; ++k) a += bf_lo(F.proj[(size_t)m * PW + c + 1024 * k]); a += F.dt[(size_t)m * 16 + (c & 15)] + bf_lo(F.mkv[(size_t)(m & 4095) * 1024 + c]); F.out[(size_t)m * DM + c] = a; }
      return; }
#endif
    if (IN(2)) {
        if (args.sub & 1) for (int it = F.bid; it < NBATCH * 32 * 2; it += F.G) ssd_pass1_item(F, it);
        if (args.sub & 2) for (int it = F.bid; it < NBATCH * 32 * 4; it += F.G) attn_window_item(F, it);
    }
    SEAM(2);
#if DBG_STOP == 2
    { grid.sync(); const int gw = F.bid * 8 + F.wave, NGW = F.G * 8;
      for (int m = gw; m < TOK; m += NGW) for (int j = 0; j < 16; ++j) { const int c = F.lane + 64 * j;
        const float a = (DBG_SEL & 1 ? bf_lo(F.mix[(size_t)m * MIXW + c]) : 0.f), bq = (DBG_SEL & 2 ? bf_lo(F.st[(size_t)m * 1024 + c]) : 0.f), d = (DBG_SEL & 4 ? F.dec[(m * 1024 + c) & 8191] : 0.f);
        ((float*)F.proj)[(size_t)m * DM + c] = a + bq + d; }
      __threadfence(); grid.sync();
      for (int m = gw; m < TOK; m += NGW) for (int j = 0; j < 16; ++j) { const int c = F.lane + 64 * j; F.out[(size_t)m * DM + c] = ((float*)F.proj)[(size_t)m * DM + c]; }
      return; }
#endif
    if (IN(3)) ssd_scan(F);
    SEAM(3);
    if (IN(4)) {
        if (args.sub & 1) for (int it = F.bid; it < NBATCH * 32 * 2; it += F.G) ssd_pass2_item(F, it);
        if (args.sub & 2) for (int it = F.bid; it < NBATCH * 16 * 4; it += F.G) attn_mem_item(F, it);
    }
    SEAM(4);
    if (IN(5)) { __syncthreads(); pg8::Gemm g{F.mix, F.wout_t, TOK, DM, MIXW, MIXP, MIXP}; pg8::StaticOrder S; S.init(g.M, g.N, F.G, F.bid); EpiOut E{F.x, F.out, F.rowss}; pg8::gemm_phase(F.lds, g, S, E); }
    SEAM(5);
    if (IN(6)) final_norm(F);
#undef IN
#undef SEAM
}

extern "C" void kernel_launch(void* const* d_in, const int* in_sizes, int n_in, void* d_out, int out_size, void* d_ws, size_t ws_size, hipStream_t stream) {
    static int grid = 0;
    if (grid == 0) {
        if (n_in != 15 || out_size != TOK * DM || ws_size < WS_END) { fprintf(stderr, "kernel_launch: unexpected shapes (n_in %d out %d ws %zu)\n", n_in, out_size, ws_size); grid = -1; return; }
        int dev = 0, cus = 0, per_cu = 0;
        (void)hipGetDevice(&dev); (void)hipDeviceGetAttribute(&cus, hipDeviceAttributeMultiprocessorCount, dev);
        if (hipFuncSetAttribute((const void*)hymba_fwd, hipFuncAttributeMaxDynamicSharedMemorySize, LDS_BYTES) != hipSuccess) { fprintf(stderr, "kernel_launch: hipFuncSetAttribute failed\n"); grid = -1; return; }
        if (hipOccupancyMaxActiveBlocksPerMultiprocessor(&per_cu, (const void*)hymba_fwd, 512, LDS_BYTES) != hipSuccess || per_cu < 1) { fprintf(stderr, "kernel_launch: occupancy query says %d\n", per_cu); per_cu = 1; }
        (void)hipGetLastError();
        grid = cus > 0 ? cus : 256;
    }
    if (grid < 0) return;
    Args a{};
    for (int i = 0; i < 15; ++i) a.in[i] = (const float*)d_in[i];
    a.out = (float*)d_out; a.ws = (unsigned char*)d_ws; a.sub = 3;
    (void)hipMemsetAsync(d_ws, 0, 256, stream);
#if PROBE_PHASES
    for (int k = 0; k < NPHASE; ++k) if ((PROBE_PHASES >> k) & 1) { a.lo = k; a.hi = k + 1; a.sub = PROBE_SUB; hipLaunchKernelGGL(hymba_fwd, dim3(grid), dim3(512), LDS_BYTES, stream, a); }
#endif
#if MK_ONE_LAUNCH
    a.lo = 0; a.hi = NPHASE; a.sub = 3;
    void* kargs[] = {&a};
    hipError_t e = hipLaunchCooperativeKernel((const void*)hymba_fwd, dim3(grid), dim3(512), kargs, LDS_BYTES, stream);
    if (e != hipSuccess) fprintf(stderr, "kernel_launch: cooperative launch failed: %s (grid %d)\n", hipGetErrorString(e), grid);
#else
    for (int k = 0; k < NPHASE; ++k) { a.lo = k; a.hi = k + 1; hipLaunchKernelGGL(hymba_fwd, dim3(grid), dim3(512), LDS_BYTES, stream, a); }
#endif
}
```

```cpp
#include <hip/hip_runtime.h>
#include <hip/hip_cooperative_groups.h>
#include <cstdio>
#include <cstdint>
namespace cg = cooperative_groups;

#ifndef DBG_STOP
#define DBG_STOP 0
#define DBG_SEL 2
#endif
#ifndef PROBE_PHASES
#define PROBE_PHASES 0
#define PROBE_SUB 3
#endif
#ifndef MK_ONE_LAUNCH
#define MK_ONE_LAUNCH 1
#endif

#define LAS __attribute__((address_space(3)))
typedef unsigned short bf16_t;
typedef short bf16x8 __attribute__((ext_vector_type(8)));
typedef short s16x4 __attribute__((ext_vector_type(4)));
typedef float f32x4 __attribute__((ext_vector_type(4)));
typedef float f32x2 __attribute__((ext_vector_type(2)));
typedef unsigned u32x4 __attribute__((ext_vector_type(4)));
typedef unsigned u32x2 __attribute__((ext_vector_type(2)));
typedef LAS unsigned char* ldsp;

constexpr int SEQ = 4096, NBATCH = 16, TOK = SEQ * NBATCH, DM = 1024;
constexpr int INW = 5136, NPHYS = 5376, PW = 5184;
constexpr int HNP = 1088, MIXP = 2112;
constexpr int C_Q = 0, C_K = 1024, C_V = 1280, C_G = 1536, C_Z = 2560, C_X = 3072, C_QM = 4096, C_GM = 4608;
constexpr int MIXW = 2048;
constexpr float LOG2E = 1.4426950408889634f;
constexpr float EPS = 1e-6f;
constexpr int NPHASE = 7;

constexpr size_t MiB = (size_t)1 << 20;
constexpr size_t WS_ROWSS = 956 * MiB, WS_ROPE = 1 * MiB, WS_WIN = 2 * MiB, WS_WOUT = 14 * MiB, WS_WMEM = 19 * MiB, WS_MEMN = 22 * MiB,
                 WS_MKV = 31 * MiB, WS_DT = 39 * MiB, WS_DEC = 43 * MiB, WS_PROJ = 44 * MiB, WS_MIX = 692 * MiB, WS_END = 960 * MiB;

constexpr int LDS_BYTES = 155648;

__device__ __forceinline__ unsigned cvt_pk(float lo, float hi) { unsigned r; asm volatile("v_cvt_pk_bf16_f32 %0, %1, %2" : "=v"(r) : "v"(lo), "v"(hi)); return r; }
typedef __bf16 bf16x2_t __attribute__((ext_vector_type(2)));
__device__ __forceinline__ unsigned cvt_pk_c(float lo, float hi) { const f32x2 v = {lo, hi}; return __builtin_bit_cast(unsigned, __builtin_convertvector(v, bf16x2_t)); }
__device__ __forceinline__ float bf_lo(unsigned u) { return __uint_as_float(u << 16); }
__device__ __forceinline__ float bf_hi(unsigned u) { return __uint_as_float(u & 0xffff0000u); }
__device__ __forceinline__ f32x4 unpack4(u32x2 v) { return (f32x4){bf_lo(v.x), bf_hi(v.x), bf_lo(v.y), bf_hi(v.y)}; }
__device__ __forceinline__ u32x2 pack4(f32x4 v) { return (u32x2){cvt_pk_c(v.x, v.y), cvt_pk_c(v.z, v.w)}; }
__device__ __forceinline__ float silu_f(float x) { return x * __builtin_amdgcn_rcpf(1.f + __expf(-x)); }
__device__ __forceinline__ f32x4 silu4(f32x4 v) { return (f32x4){silu_f(v.x), silu_f(v.y), silu_f(v.z), silu_f(v.w)}; }
__device__ __forceinline__ float softplus_f(float x) { return x > 20.f ? x : log1pf(expf(x)); }
__device__ __forceinline__ float ex2(float x) { return __builtin_amdgcn_exp2f(x); }
typedef short v4i16_t __attribute__((ext_vector_type(4)));
__device__ __forceinline__ s16x4 vtr(ldsp p) { return __builtin_bit_cast(s16x4, __builtin_amdgcn_ds_read_tr16_b64_v4i16((LAS v4i16_t*)p)); }
__device__ __forceinline__ bf16x8 cat8(s16x4 a, s16x4 b) { return (bf16x8){a[0], a[1], a[2], a[3], b[0], b[1], b[2], b[3]}; }
__device__ __forceinline__ bf16x8 ld8(ldsp p) { return *(const LAS bf16x8*)p; }
__device__ __forceinline__ f32x4 mfma16(bf16x8 a, bf16x8 b, f32x4 c) { return __builtin_amdgcn_mfma_f32_16x16x32_bf16(a, b, c, 0, 0, 0); }
__device__ __forceinline__ bf16x8 packfrag(f32x4 a, f32x4 b) { u32x4 r = {cvt_pk_c(a.x, a.y), cvt_pk_c(a.z, a.w), cvt_pk_c(b.x, b.y), cvt_pk_c(b.z, b.w)}; return __builtin_bit_cast(bf16x8, r); }

__device__ __forceinline__ f32x4 zero4() { f32x4 z; asm volatile("v_mov_b32 %0, 0\n\tv_mov_b32 %1, 0\n\tv_mov_b32 %2, 0\n\tv_mov_b32 %3, 0" : "=v"(z.x), "=v"(z.y), "=v"(z.z), "=v"(z.w)); return z; }
__device__ __forceinline__ int lane_id_now() { int l; asm volatile("v_mbcnt_lo_u32_b32 %0, -1, 0\n\tv_mbcnt_hi_u32_b32 %0, -1, %0" : "=v"(l)); return l; }
__host__ __device__ __forceinline__ int perm_plain(int c) { const int bj = c >> 7, wc = (c >> 5) & 3, n = (c >> 4) & 1, fq = (c >> 2) & 3, i = c & 3; return 128 * bj + 32 * wc + 8 * fq + 4 * n + i; }
__host__ __device__ __forceinline__ int perm_rot(int c) { const int bj = c >> 7, wc = (c >> 5) & 3, n = (c >> 4) & 1, fq = (c >> 2) & 3, i = c & 3; return 64 * wc + 32 * bj + 8 * fq + 4 * n + i; }

namespace pg8 {
constexpr int BM = 256, BK = 64, HALF = 128, HTB = HALF * BK * 2, STAGE_BYTES = 8 * HTB, NXCD = 8, WGM = 8;
__host__ __device__ __forceinline__ int lds_byte(int r, int c) { const int st = (r >> 4) * 2 + (c >> 5), rr = r & 15, cc = c & 31, ob = rr * 64 + cc * 2; return st * 1024 + (ob ^ (((ob >> 9) & 1) << 5)); }
__host__ __device__ __forceinline__ void stage_rc(int b, int& R, int& C) { const int st = b / 1024, sb = b % 1024, swz = sb ^ (((sb >> 9) & 1) << 5); R = (st >> 1) * 16 + swz / 64; C = (st & 1) * 32 + (swz % 64) / 2; }
struct Unit { int pm, pn; };
struct Gemm { const bf16_t* A; const bf16_t* Bt; int M, N, K, lda, ldb; };
struct StaticOrder {
    int nM, nN, nwg, G, c;
    __device__ void init(int M, int N, int G_, int c_) { nM = M / BM; nN = N / BM; nwg = nM * nN; G = G_; c = c_; }
    __device__ bool next(int i, Unit& u) const {
        const long L = (long)i * G + c; if (L >= nwg) return false;
        int wgid = (int)L; { const int q = nwg / NXCD, r = nwg % NXCD, xcd = wgid % NXCD, off = wgid / NXCD; wgid = (xcd < r ? xcd * (q + 1) : r * (q + 1) + (xcd - r) * q) + off; }
        const int nig = WGM * nN, gid = wgid / nig, fm = gid * WGM, gsz = (nM - fm) < WGM ? (nM - fm) : WGM;
        u.pm = fm + ((wgid % nig) % gsz); u.pn = (wgid % nig) / gsz; return true;
    }
};
struct PanelOrder {
    int nM, nN, G, c;
    __device__ void init(int M, int N, int G_, int c_) { nM = M / BM; nN = N / BM; G = G_; c = c_; }
    __device__ bool next(int i, Unit& u) const { const int pm = c + (i / nN) * G; if (pm >= nM) return false; u.pm = pm; u.pn = i % nN; return true; }
};

template <class Epi, class Sched>
__device__ __forceinline__ void gemm_phase(ldsp lds, const Gemm g, const Sched& S, const Epi& E, int wave_id) {
    const int lane = lane_id_now(), wid = wave_id, tid = wid * 64 + lane, wr = wid >> 2, wc = wid & 3, fr = lane & 15, fq = lane >> 4;
    const int K = g.K, nt = K / BK;
    unsigned voffA[2], voffB[2];
#pragma unroll
    for (int i = 0; i < 2; ++i) { int R, C; stage_rc(tid * 16 + i * 8192, R, C); voffA[i] = (unsigned)(R * g.lda + C) * 2u; voffB[i] = (unsigned)(R * g.ldb + C) * 2u; }
    const size_t kstep = (size_t)(BK * 2);
    const size_t hstep = (size_t)HALF * g.lda * 2, hstepB = (size_t)HALF * g.ldb * 2;
    const size_t tstep = 2 * hstep, tstepB = 2 * hstepB;
    const unsigned ldsw = (unsigned)wid * 1024u;
    const int aoff = lds_byte(wr * 64 + fr, fq * 8), boff = lds_byte(wc * 32 + fr, fq * 8);
#define PG8_SA(b, h) (((b) * 2 + (h)) * HTB)
#define PG8_SB(b, h) ((4 + (b) * 2 + (h)) * HTB)
#define PG8_STAGE(bufoff, gbase, voff) do { _Pragma("unroll") for (int _i = 0; _i < 2; ++_i) \
        __builtin_amdgcn_global_load_lds((const unsigned*)((const char*)(gbase) + (voff)[_i]), (LAS unsigned*)(lds + (bufoff) + ldsw + _i * 8192), 16, 0, 0); } while (0)
#define PG8_LDA(dst, b, h) do { _Pragma("unroll") for (int m = 0; m < 4; ++m) _Pragma("unroll") for (int k = 0; k < 2; ++k) dst[m][k] = *(const LAS bf16x8*)(lds + PG8_SA(b, h) + aoff + m * 2048 + k * 1024); } while (0)
#define PG8_LDB(dst, b, h) do { _Pragma("unroll") for (int n = 0; n < 2; ++n) _Pragma("unroll") for (int k = 0; k < 2; ++k) dst[n][k] = *(const LAS bf16x8*)(lds + PG8_SB(b, h) + boff + n * 2048 + k * 1024); } while (0)
#define PG8_MMA(ai, bj, At, Bt) do { __builtin_amdgcn_s_setprio(1); _Pragma("unroll") for (int m = 0; m < 4; ++m) _Pragma("unroll") for (int n = 0; n < 2; ++n) _Pragma("unroll") for (int k = 0; k < 2; ++k) \
        acc[ai][bj][m][n] = __builtin_amdgcn_mfma_f32_16x16x32_bf16(Bt[n][k], At[m][k], acc[ai][bj][m][n], 0, 0, 0); __builtin_amdgcn_s_setprio(0); } while (0)
#define PG8_WAIT_V(n) asm volatile("s_waitcnt vmcnt(" #n ")" ::: "memory")
#define PG8_WAIT_L(n) asm volatile("s_waitcnt lgkmcnt(" #n ")" ::: "memory")
#define PG8_BAR __builtin_amdgcn_s_barrier()
#define PG8_SCHED __builtin_amdgcn_sched_barrier(0)
    Unit cur, nxt; int ui = 0;
    if (!S.next(0, cur)) return;
    f32x4 acc[2][2][4][2];
#pragma unroll
    for (int a = 0; a < 2; ++a)
#pragma unroll
        for (int b = 0; b < 2; ++b)
#pragma unroll
            for (int m = 0; m < 4; ++m)
#pragma unroll
                for (int n = 0; n < 2; ++n) acc[a][b][m][n] = (f32x4){0.f, 0.f, 0.f, 0.f};
    bf16x8 At[4][2], B0[2][2], B1[2][2];
    const char* cA = (const char*)g.A + (size_t)cur.pm * tstep; const char* cB = (const char*)g.Bt + (size_t)cur.pn * tstepB;
    PG8_STAGE(PG8_SB(0, 0), cB, voffB); PG8_STAGE(PG8_SA(0, 0), cA, voffA); PG8_STAGE(PG8_SB(0, 1), cB + hstepB, voffB); PG8_STAGE(PG8_SA(0, 1), cA + hstep, voffA);
    if (wr == 1) PG8_BAR;
    PG8_WAIT_V(4); PG8_BAR;
    PG8_STAGE(PG8_SB(1, 0), cB + kstep, voffB); PG8_STAGE(PG8_SA(1, 0), cA + kstep, voffA); PG8_STAGE(PG8_SB(1, 1), cB + hstepB + kstep, voffB);
    PG8_WAIT_V(6); PG8_BAR;
    for (;;) {
        const bool has_next = S.next(ui + 1, nxt);
        const char* nA = has_next ? (const char*)g.A + (size_t)nxt.pm * tstep : cA; const char* nB = has_next ? (const char*)g.Bt + (size_t)nxt.pn * tstepB : cB;
        for (int t = 0; t < nt; t += 2) {
            const bool last = (t == nt - 2);
            const char* a1 = cA + (size_t)(t + 1) * kstep;
            const char* a2 = last ? nA : cA + (size_t)(t + 2) * kstep; const char* b2 = last ? nB : cB + (size_t)(t + 2) * kstep;
            const char* a3 = a2 + kstep; const char* b3 = b2 + kstep;
            PG8_LDB(B0, 0, 0); PG8_SCHED; PG8_LDA(At, 0, 0); PG8_STAGE(PG8_SA(1, 1), a1 + hstep, voffA);
            PG8_WAIT_L(8); PG8_BAR; PG8_WAIT_L(0); PG8_MMA(0, 0, At, B0); PG8_BAR; PG8_SCHED;
            PG8_LDB(B1, 0, 1); PG8_STAGE(PG8_SB(0, 0), b2, voffB);
            PG8_BAR; PG8_WAIT_L(0); PG8_MMA(0, 1, At, B1); PG8_BAR;
            PG8_LDA(At, 0, 1); PG8_STAGE(PG8_SA(0, 0), a2, voffA);
            PG8_BAR; PG8_WAIT_L(0); PG8_MMA(1, 0, At, B0); PG8_BAR; PG8_SCHED;
            PG8_STAGE(PG8_SB(0, 1), b2 + hstepB, voffB);
            PG8_WAIT_V(6); PG8_BAR; PG8_MMA(1, 1, At, B1); PG8_BAR;
            PG8_LDB(B0, 1, 0); PG8_SCHED; PG8_LDA(At, 1, 0); PG8_STAGE(PG8_SA(0, 1), a2 + hstep, voffA);
            PG8_WAIT_L(8); PG8_BAR; PG8_WAIT_L(0); PG8_MMA(0, 0, At, B0); PG8_BAR; PG8_SCHED;
            PG8_LDB(B1, 1, 1); PG8_STAGE(PG8_SB(1, 0), b3, voffB);
            PG8_BAR; PG8_WAIT_L(0); PG8_MMA(0, 1, At, B1); PG8_BAR;
            PG8_LDA(At, 1, 1); PG8_STAGE(PG8_SA(1, 0), a3, voffA);
            PG8_BAR; PG8_WAIT_L(0); PG8_MMA(1, 0, At, B0); PG8_BAR; PG8_SCHED;
            PG8_STAGE(PG8_SB(1, 1), b3 + hstepB, voffB);
            PG8_WAIT_V(6); PG8_BAR; PG8_MMA(1, 1, At, B1); PG8_BAR;
        }
        E(acc, cur, wr, wc, fr, fq);
        if (!has_next) break;
#pragma unroll
        for (int a = 0; a < 2; ++a)
#pragma unroll
            for (int b = 0; b < 2; ++b)
#pragma unroll
                for (int m = 0; m < 4; ++m)
#pragma unroll
                    for (int n = 0; n < 2; ++n) acc[a][b][m][n] = (f32x4){0.f, 0.f, 0.f, 0.f};
        cur = nxt; cA = nA; cB = nB; ++ui;
    }
    PG8_WAIT_V(0);
    if (wr == 0) PG8_BAR;
    PG8_BAR;
#undef PG8_SA
#undef PG8_SB
#undef PG8_STAGE
#undef PG8_LDA
#undef PG8_LDB
#undef PG8_MMA
#undef PG8_WAIT_V
#undef PG8_WAIT_L
#undef PG8_BAR
#undef PG8_SCHED
}
}

struct EpiProj {
    bf16_t* P; float* DT; const float* rope; const float* dt_bias;
    __device__ __forceinline__ void operator()(const f32x4 (&acc)[2][2][4][2], const pg8::Unit& u, int wr, int wc, int fr, int fq) const {
        const int row0 = u.pm * 256 + wr * 64 + fr, pn = u.pn;
        if (pn < 5) {
            const float sc = pn < 4 ? 0.125f * LOG2E : 1.f;
            const int col = pn * 256 + 64 * wc + 8 * fq;
#pragma unroll
            for (int ai = 0; ai < 2; ++ai)
#pragma unroll
                for (int m = 0; m < 4; ++m) {
                    const int row = row0 + ai * 128 + m * 16, pos = row & (SEQ - 1);
                    const f32x4* cp = (const f32x4*)(rope + pos * 32 + 8 * fq); const f32x4* sp = (const f32x4*)(rope + SEQ * 32 + pos * 32 + 8 * fq);
                    f32x4 o1[2], o2[2];
#pragma unroll
                    for (int n = 0; n < 2; ++n) { const f32x4 c = cp[n], s = sp[n], t1 = acc[ai][0][m][n], t2 = acc[ai][1][m][n]; o1[n] = (t1 * c - t2 * s) * sc; o2[n] = (t1 * s + t2 * c) * sc; }
                    bf16_t* dst = P + (size_t)row * PW + col;
                    *(u32x4*)dst = (u32x4){cvt_pk(o1[0].x, o1[0].y), cvt_pk(o1[0].z, o1[0].w), cvt_pk(o1[1].x, o1[1].y), cvt_pk(o1[1].z, o1[1].w)};
                    *(u32x4*)(dst + 32) = (u32x4){cvt_pk(o2[0].x, o2[0].y), cvt_pk(o2[0].z, o2[0].w), cvt_pk(o2[1].x, o2[1].y), cvt_pk(o2[1].z, o2[1].w)};
                }
        } else if (pn < 20) {
            const bool do_silu = (pn >= 6 && pn < 12) || pn >= 18;
            const float sc = (pn == 16 || pn == 17) ? 0.08838834764831845f * LOG2E : 1.f;
            const int col = pn * 256 + 32 * wc + 8 * fq;
#pragma unroll
            for (int ai = 0; ai < 2; ++ai)
#pragma unroll
                for (int m = 0; m < 4; ++m) {
                    const int row = row0 + ai * 128 + m * 16;
#pragma unroll
                    for (int bj = 0; bj < 2; ++bj) {
                        f32x4 v0 = acc[ai][bj][m][0], v1 = acc[ai][bj][m][1];
                        if (do_silu) { v0 = silu4(v0); v1 = silu4(v1); } else { v0 = v0 * sc; v1 = v1 * sc; }
                        *(u32x4*)(P + (size_t)row * PW + col + 128 * bj) = (u32x4){cvt_pk(v0.x, v0.y), cvt_pk(v0.z, v0.w), cvt_pk(v1.x, v1.y), cvt_pk(v1.z, v1.w)};
                    }
                }
        } else {
            if (wc == 0 && fq < 2) {
#pragma unroll
                for (int ai = 0; ai < 2; ++ai)
#pragma unroll
                    for (int m = 0; m < 4; ++m) {
                        const int row = row0 + ai * 128 + m * 16;
#pragma unroll
                        for (int n = 0; n < 2; ++n) {
                            const int j0 = 8 * fq + 4 * n; const f32x4 bb = *(const f32x4*)(dt_bias + j0); const f32x4 v = acc[ai][0][m][n] + bb;
                            *(f32x4*)(DT + (size_t)row * 16 + j0) = (f32x4){softplus_f(v.x), softplus_f(v.y), softplus_f(v.z), softplus_f(v.w)};
                        }
                    }
            }
        }
    }
};
struct EpiMkv {
    bf16_t* O;
    __device__ __forceinline__ void operator()(const f32x4 (&acc)[2][2][4][2], const pg8::Unit& u, int wr, int wc, int fr, int fq) const {
        const int row0 = u.pm * 256 + wr * 64 + fr, col = u.pn * 256 + 32 * wc + 8 * fq;
#pragma unroll
        for (int ai = 0; ai < 2; ++ai)
#pragma unroll
            for (int m = 0; m < 4; ++m) {
                const int row = row0 + ai * 128 + m * 16;
#pragma unroll
                for (int bj = 0; bj < 2; ++bj) { const f32x4 v0 = acc[ai][bj][m][0], v1 = acc[ai][bj][m][1];
                    *(u32x4*)(O + (size_t)row * 1024 + col + 128 * bj) = (u32x4){cvt_pk(v0.x, v0.y), cvt_pk(v0.z, v0.w), cvt_pk(v1.x, v1.y), cvt_pk(v1.z, v1.w)}; }
            }
    }
};
struct EpiOut {
    const float* x; float* out; float* rowss;
    __device__ __forceinline__ void operator()(const f32x4 (&acc)[2][2][4][2], const pg8::Unit& u, int wr, int wc, int fr, int fq) const {
        const int row0 = u.pm * 256 + wr * 64 + fr, col = u.pn * 256 + 32 * wc + 8 * fq;
#pragma unroll
        for (int ai = 0; ai < 2; ++ai)
#pragma unroll
            for (int m = 0; m < 4; ++m) {
                const int row = row0 + ai * 128 + m * 16; float ss = 0.f;
#pragma unroll
                for (int bj = 0; bj < 2; ++bj) {
                    const size_t o = (size_t)row * DM + col + 128 * bj;
                    const f32x4 h0 = *(const f32x4*)(x + o) + acc[ai][bj][m][0], h1 = *(const f32x4*)(x + o + 4) + acc[ai][bj][m][1];
                    *(f32x4*)(out + o) = h0; *(f32x4*)(out + o + 4) = h1;
                    ss += h0.x * h0.x + h0.y * h0.y + h0.z * h0.z + h0.w * h0.w + h1.x * h1.x + h1.y * h1.y + h1.z * h1.z + h1.w * h1.w;
                }
                ss += __shfl_xor(ss, 16); ss += __shfl_xor(ss, 32);
                if (fq == 0) rowss[(size_t)row * 16 + u.pn * 4 + wc] = ss;
            }
    }
};

struct Args { const float* in[15]; float* out; unsigned char* ws; int lo, hi, sub, pad; };
struct Ctx {
    const float *x, *mem, *norm_mem_w, *norm_in_w, *w_in, *attn_sink, *conv_w, *conv_b, *dt_bias, *a_log, *d_skip, *ssd_norm_w, *w_mem_kv, *w_out, *norm_out_w;
    float* out; unsigned char* ws;
    __device__ __forceinline__ float* rowss() const { return (float*)(ws + WS_ROWSS); }
    __device__ __forceinline__ float* rope() const { return (float*)(ws + WS_ROPE); }
    __device__ __forceinline__ bf16_t* win_t() const { return (bf16_t*)(ws + WS_WIN); }
    __device__ __forceinline__ bf16_t* wout_t() const { return (bf16_t*)(ws + WS_WOUT); }
    __device__ __forceinline__ bf16_t* wmem_t() const { return (bf16_t*)(ws + WS_WMEM); }
    __device__ __forceinline__ bf16_t* memn() const { return (bf16_t*)(ws + WS_MEMN); }
    __device__ __forceinline__ bf16_t* mkv() const { return (bf16_t*)(ws + WS_MKV); }
    __device__ __forceinline__ float* dt() const { return (float*)(ws + WS_DT); }
    __device__ __forceinline__ float* dec() const { return (float*)(ws + WS_DEC); }
    __device__ __forceinline__ bf16_t* proj() const { return (bf16_t*)(ws + WS_PROJ); }
    __device__ __forceinline__ bf16_t* mix() const { return (bf16_t*)(ws + WS_MIX); }
    __device__ __forceinline__ bf16_t* hn() const { return (bf16_t*)((unsigned char*)out); }
    __device__ __forceinline__ bf16_t* st() const { return (bf16_t*)((unsigned char*)out); }
    ldsp lds; int tid, lane, wave, G, bid;
};

__device__ __forceinline__ void rms_row_bf16(const float* xr, const float* w, bf16_t* o, int lane) {
    f32x4 v[4]; float ss = 0.f;
#pragma unroll
    for (int j = 0; j < 4; ++j) { v[j] = *(const f32x4*)(xr + 4 * lane + 256 * j); ss += v[j].x * v[j].x + v[j].y * v[j].y + v[j].z * v[j].z + v[j].w * v[j].w; }
#pragma unroll
    for (int off = 1; off < 64; off <<= 1) ss += __shfl_xor(ss, off);
    const float r = rsqrtf(ss * (1.f / DM) + EPS);
#pragma unroll
    for (int j = 0; j < 4; ++j) { const f32x4 ww = *(const f32x4*)(w + 4 * lane + 256 * j); *(u32x2*)(o + 4 * lane + 256 * j) = pack4(v[j] * r * ww); }
}
template <int MODE>
__device__ __forceinline__ void transpose_w(const Ctx& F, const float* W, int K, int NS, bf16_t* Bt, int NP, int ldb) {
    const int nitems = NP * (K / 8);
    for (int it = F.bid * 512 + F.tid; it < nitems; it += F.G * 512) {
        const int n = it % NP, kg = it / NP, tile = n >> 8, cph = n & 255; int src;
        if (MODE == 0) {
            if (tile < 5) src = tile * 256 + perm_rot(cph);
            else if (tile < 20) { src = tile * 256 + perm_plain(cph); if (src >= 4096) src += 16; }
            else { const int l = perm_plain(cph); src = l < 16 ? 4096 + l : -1; }
        } else src = tile * 256 + perm_plain(cph);
        float v[8];
#pragma unroll
        for (int j = 0; j < 8; ++j) v[j] = src >= 0 ? W[(size_t)(kg * 8 + j) * NS + src] : 0.f;
        *(u32x4*)(Bt + (size_t)n * ldb + kg * 8) = (u32x4){cvt_pk(v[0], v[1]), cvt_pk(v[2], v[3]), cvt_pk(v[4], v[5]), cvt_pk(v[6], v[7])};
    }
}
__device__ __forceinline__ void phase0(const Ctx& F) {
    const int gt = F.bid * 512 + F.tid, NT = F.G * 512;
    for (int i = gt; i < SEQ * 32; i += NT) {
        const int pos = i >> 5, f = i & 31;
        const float inv = 1.0f / exp2f((float)f * (13.287712379549449f / 32.f));
        const float ang = (float)pos * inv;
        const double rev = (double)ang * 0.15915494309189535; const double fr = rev - __builtin_rint(rev);
        const float r = (float)(fr * 6.283185307179586);
        F.rope()[i] = __cosf(r); F.rope()[SEQ * 32 + i] = __sinf(r);
    }
    transpose_w<0>(F, F.w_in, DM, INW, F.win_t(), NPHYS, HNP);
    transpose_w<1>(F, F.w_out, MIXW, DM, F.wout_t(), DM, MIXP);
    transpose_w<1>(F, F.w_mem_kv, DM, DM, F.wmem_t(), DM, HNP);
    const int gw = F.bid * 8 + F.wave, NGW = F.G * 8;
    for (int m = gw; m < NBATCH * 256; m += NGW) rms_row_bf16(F.mem + (size_t)m * DM, F.norm_mem_w, F.memn() + (size_t)m * HNP, F.lane);
    for (int m = gw; m < TOK; m += NGW) rms_row_bf16(F.x + (size_t)m * DM, F.norm_in_w, F.hn() + (size_t)m * HNP, F.lane);
}

template <int DH, int NQF>
__device__ __forceinline__ void attn_tile(ldsp Kt, int KS, ldsp Vt, int VS, const bf16x8 (&qf)[NQF][DH / 32], f32x4 (&o)[DH / 16][NQF], float (&m)[NQF], float (&lp)[NQF], int maskmode, int lane, int qoff = 0) {
    const int i16 = lane & 15, q4 = lane >> 4;
    f32x4 st[4][NQF];
#pragma unroll
    for (int kf = 0; kf < 4; ++kf)
#pragma unroll
        for (int q = 0; q < NQF; ++q) st[kf][q] = (f32x4){0.f, 0.f, 0.f, 0.f};
#pragma unroll
    for (int ks = 0; ks < DH / 32; ++ks)
#pragma unroll
        for (int kf = 0; kf < 4; ++kf) {
            const bf16x8 ka = ld8(Kt + (16 * kf + i16) * KS + (32 * ks + 8 * q4) * 2);
#pragma unroll
            for (int q = 0; q < NQF; ++q) st[kf][q] = mfma16(ka, qf[q][ks], st[kf][q]);
            if (DH > 64 && kf == 3) __builtin_amdgcn_sched_barrier(0);
        }
    if (maskmode) {
        int zb; asm volatile("v_mov_b32 %0, 0" : "=v"(zb));
        const int base = (maskmode == 1 ? 4 * q4 - i16 - qoff : i16 + qoff - 4 * q4) + zb;
#pragma unroll
        for (int kf = 0; kf < 4; ++kf)
#pragma unroll
            for (int q = 0; q < NQF; ++q)
#pragma unroll
                for (int r = 0; r < 4; ++r) { const int off = 16 * (kf - q) + r; const bool bad = (maskmode == 1 ? base + off : base - off) < 0; if (bad) st[kf][q][r] = -INFINITY; }
    }
#pragma unroll
    for (int q = 0; q < NQF; ++q) {
        float mx = st[0][q][0];
#pragma unroll
        for (int kf = 0; kf < 4; ++kf)
#pragma unroll
            for (int r = 0; r < 4; ++r) mx = fmaxf(mx, st[kf][q][r]);
        mx = fmaxf(mx, __shfl_xor(mx, 16)); mx = fmaxf(mx, __shfl_xor(mx, 32));
        const float mn = fmaxf(m[q], mx), alpha = ex2(m[q] - mn); m[q] = mn;
        float ps = 0.f;
#pragma unroll
        for (int kf = 0; kf < 4; ++kf)
#pragma unroll
            for (int r = 0; r < 4; ++r) { const float p = ex2(st[kf][q][r] - mn); st[kf][q][r] = p; ps += p; }
        lp[q] = lp[q] * alpha + ps;
#pragma unroll
        for (int d = 0; d < DH / 16; ++d) o[d][q] = o[d][q] * alpha;
    }
#pragma unroll
    for (int kp = 0; kp < 2; ++kp) {
        bf16x8 pk[NQF];
#pragma unroll
        for (int q = 0; q < NQF; ++q) pk[q] = packfrag(st[2 * kp][q], st[2 * kp + 1][q]);
#pragma unroll
        for (int d = 0; d < DH / 16; ++d) {
            ldsp va = Vt + (32 * kp + 4 * q4 + (i16 >> 2)) * VS + (16 * d + 4 * (i16 & 3)) * 2;
            const bf16x8 vf = cat8(vtr(va), vtr(va + 16 * VS));
#pragma unroll
            for (int q = 0; q < NQF; ++q) o[d][q] = mfma16(vf, pk[q], o[d][q]);
            if (DH > 64 && (d & 3) == 3) __builtin_amdgcn_sched_barrier(0);
        }
    }
}

__device__ __forceinline__ void attn_window_item(const Ctx& F, int item) {
    constexpr int KS = 144, VS = 160; const ldsp Ki = F.lds, Vi = F.lds + 384 * KS;
    const int kvh = item & 3, i = (item >> 2) & 31, b = item >> 7;
    __syncthreads();
#pragma unroll
    for (int c = F.tid; c < 3072; c += 512) {
        const int r = c >> 3, ch = c & 7, key0 = 128 * i - 128 + r, key = key0 < 0 ? 0 : (key0 >= SEQ ? SEQ - 1 : key0);
        const bf16_t* src = F.proj() + (size_t)(b * SEQ + key) * PW + 64 * kvh + 8 * ch;
        *(LAS u32x4*)(Ki + r * KS + ch * 16) = *(const u32x4*)(src + C_K);
        *(LAS u32x4*)(Vi + r * VS + ch * 16) = *(const u32x4*)(src + C_V);
    }
    __syncthreads();
    const int w = F.wave, lane = F.lane, i16 = lane & 15, q4 = lane >> 4, hq = 4 * kvh + (w >> 1), q0 = 128 * i + 64 * (w & 1);
    bf16x8 qf[4][2];
#pragma unroll
    for (int q = 0; q < 4; ++q)
#pragma unroll
        for (int ks = 0; ks < 2; ++ks) qf[q][ks] = *(const bf16x8*)(F.proj() + (size_t)(b * SEQ + q0 + 16 * q + i16) * PW + C_Q + hq * 64 + 32 * ks + 8 * q4);
    f32x4 o[4][4]; float m[4], lp[4];
    const float sink = F.attn_sink[hq] * LOG2E;
#pragma unroll
    for (int q = 0; q < 4; ++q) { m[q] = sink; lp[q] = q4 == 0 ? 1.f : 0.f;
#pragma unroll
        for (int d = 0; d < 4; ++d) o[d][q] = (f32x4){0.f, 0.f, 0.f, 0.f}; }
#pragma unroll 1
    for (int j = 0; j < 5; ++j) {
        const int kstart = q0 - 128 + 64 * j; if (kstart < 0 || kstart >= SEQ) continue;
        const int ir = 64 * (w & 1) + 64 * j;
        attn_tile<64, 4>(Ki + ir * KS, KS, Vi + ir * VS, VS, qf, o, m, lp, j == 0 ? 1 : (j == 4 ? 2 : 0), lane);
    }
#pragma unroll
    for (int q = 0; q < 4; ++q) {
        float l = lp[q]; l += __shfl_xor(l, 16); l += __shfl_xor(l, 32); const float inv = 1.f / l;
        const size_t row = (size_t)(b * SEQ + q0 + 16 * q + i16);
#pragma unroll
        for (int d = 0; d < 4; ++d) {
            const int col = hq * 64 + 16 * d + 4 * q4;
            const f32x4 g = unpack4(*(const u32x2*)(F.proj() + row * PW + C_G + col));
            *(u32x2*)(F.mix() + row * MIXP + col) = pack4(o[d][q] * inv * g);
        }
    }
}

__device__ __forceinline__ void ring_stage_block(const Ctx& F, const bf16_t* kvbase, int keyblock) {
    constexpr int KS = 144, VS = 160; const ldsp Kb = F.lds + (keyblock & 511) * KS, Vb = F.lds + 512 * KS + (keyblock & 511) * VS;
    const bf16_t* src0 = kvbase + (size_t)keyblock * PW;
    for (int wi = F.wave; wi < 18; wi += 8) {
        const int slot = wi * 64 + F.lane, row = slot / 9, ch = slot - row * 9;
        __builtin_amdgcn_global_load_lds((const unsigned*)(src0 + (size_t)row * PW + C_K + 8 * (ch > 7 ? 7 : ch)), (LAS unsigned*)(Kb + wi * 1024), 16, 0, 0);
    }
    for (int wi = F.wave; wi < 20; wi += 8) {
        const int slot = wi * 64 + F.lane, row = slot / 10, ch = slot - row * 10;
        __builtin_amdgcn_global_load_lds((const unsigned*)(src0 + (size_t)row * PW + C_V + 8 * (ch > 7 ? 7 : ch)), (LAS unsigned*)(Vb + wi * 1024), 16, 0, 0);
    }
}
__device__ __forceinline__ void attn_window_seq(const Ctx& F, int sq) {
    constexpr int KS = 144, VS = 160; const ldsp Ki = F.lds, Vi = F.lds + 512 * KS;
    const int sidx = sq >> 2, b = sidx >> 2, kvh = sidx & 3, i0 = 8 * (sq & 3);
    const int w = F.wave, lane = F.lane, i16 = lane & 15, q4 = lane >> 4, hq = 4 * kvh + (w >> 1);
    const bf16_t* kvbase = F.proj() + (size_t)b * SEQ * PW + 64 * kvh;
    __syncthreads();
    for (int t = 0; t < 3; ++t) { const int kb = 128 * (i0 - 1 + t); if (kb >= 0 && kb < SEQ) ring_stage_block(F, kvbase, kb); }
    const float sink = F.attn_sink[hq] * LOG2E;
#pragma unroll 1
    for (int k = 0; k < 8; ++k) {
        const int i = i0 + k, q0 = 128 * i + 64 * (w & 1);
        __syncthreads();
        { const int nkey0 = 128 * i + 256; if (k < 7 && nkey0 < SEQ) ring_stage_block(F, kvbase, nkey0); }
#pragma unroll 1
        for (int half = 0; half < 2; ++half) {
            const int qh = q0 + 32 * half;
            bf16x8 qf[2][2];
#pragma unroll
            for (int q = 0; q < 2; ++q)
#pragma unroll
                for (int ks = 0; ks < 2; ++ks) qf[q][ks] = *(const bf16x8*)(F.proj() + (size_t)(b * SEQ + qh + 16 * q + i16) * PW + C_Q + hq * 64 + 32 * ks + 8 * q4);
            f32x4 o[4][2]; float m[2], lp[2];
#pragma unroll
            for (int q = 0; q < 2; ++q) { m[q] = sink; lp[q] = q4 == 0 ? 1.f : 0.f;
#pragma unroll
                for (int d = 0; d < 4; ++d) o[d][q] = (f32x4){0.f, 0.f, 0.f, 0.f}; }
#pragma unroll 1
            for (int j = 0; j < 5; ++j) {
                const int kstart = q0 - 128 + 64 * j; if (kstart < 0 || kstart >= SEQ) continue;
                const int ir = kstart & 511;
                attn_tile<64, 2>(Ki + ir * KS, KS, Vi + ir * VS, VS, qf, o, m, lp, j == 0 ? 1 : (j == 4 ? 2 : 0), lane, 32 * half);
            }
#pragma unroll
            for (int q = 0; q < 2; ++q) {
                float l = lp[q]; l += __shfl_xor(l, 16); l += __shfl_xor(l, 32); const float inv = 1.f / l;
                const size_t row = (size_t)(b * SEQ + qh + 16 * q + i16);
#pragma unroll
                for (int d = 0; d < 4; ++d) {
                    const int col = hq * 64 + 16 * d + 4 * q4;
                    const f32x4 g = unpack4(*(const u32x2*)(F.proj() + row * PW + C_G + col));
                    *(u32x2*)(F.mix() + row * MIXP + col) = pack4(o[d][q] * inv * g);
                }
            }
        }
    }
}
__device__ __forceinline__ void attn_mem_item(const Ctx& F, int item) {
    constexpr int KS = 272, VS = 288; const ldsp Ki = F.lds, Vi = F.lds + 256 * KS;
    const int hm = item & 3, qb = (item >> 2) & 15, b = item >> 6;
    __syncthreads();
#pragma unroll
    for (int c = F.tid; c < 4096; c += 512) {
        const int r = c >> 4, ch = c & 15;
        const bf16_t* src = F.mkv() + (size_t)(b * 256 + r) * 1024 + hm * 128 + 8 * ch;
        *(LAS u32x4*)(Ki + r * KS + ch * 16) = *(const u32x4*)(src);
        *(LAS u32x4*)(Vi + r * VS + ch * 16) = *(const u32x4*)(src + 512);
    }
    __syncthreads();
    const int w = F.wave, lane = F.lane, i16 = lane & 15, q4 = lane >> 4, q0 = 256 * qb + 32 * w;
    bf16x8 qf[2][4];
#pragma unroll
    for (int q = 0; q < 2; ++q)
#pragma unroll
        for (int ks = 0; ks < 4; ++ks) qf[q][ks] = *(const bf16x8*)(F.proj() + (size_t)(b * SEQ + q0 + 16 * q + i16) * PW + C_QM + hm * 128 + 32 * ks + 8 * q4);
    f32x4 o[8][2]; float m[2], lp[2];
#pragma unroll
    for (int q = 0; q < 2; ++q) { m[q] = -INFINITY; lp[q] = 0.f;
#pragma unroll
        for (int d = 0; d < 8; ++d) o[d][q] = (f32x4){0.f, 0.f, 0.f, 0.f}; }
#pragma unroll 1
    for (int j = 0; j < 4; ++j) attn_tile<128, 2>(Ki + 64 * j * KS, KS, Vi + 64 * j * VS, VS, qf, o, m, lp, 0, lane);
#pragma unroll
    for (int q = 0; q < 2; ++q) {
        float l = lp[q]; l += __shfl_xor(l, 16); l += __shfl_xor(l, 32); const float inv = 1.f / l;
        const size_t row = (size_t)(b * SEQ + q0 + 16 * q + i16);
#pragma unroll
        for (int d = 0; d < 8; ++d) {
            const int col = hm * 128 + 16 * d + 4 * q4;
            const f32x4 g = unpack4(*(const u32x2*)(F.proj() + row * PW + C_GM + col));
            *(u32x2*)(F.mix() + row * MIXP + 1536 + col) = pack4(o[d][q] * inv * g);
        }
    }
}

constexpr int XS = 544, BS = 288, XWS = 160, PS = 272;
constexpr int L_XI = 0, L_BI = 128 * XS, L_CI = L_BI + 128 * BS, L_XW = L_CI, L_F32 = L_XW + 2 * 128 * XWS;
static_assert(L_F32 + 8192 <= LDS_BYTES, "lds");
__device__ __forceinline__ void ssd_dtprep(const Ctx& F, int b, int c, int g, bool write_dec) {
    LAS float* DTs = (LAS float*)(F.lds + L_F32); LAS float* ACs = DTs + 1024;
    const int w = F.wave, lane = F.lane, dir = w >> 2, r = w & 3, h = 4 * g + r, j = dir * 8 + h;
    const size_t row0 = (size_t)b * SEQ + c * 128;
    const float d0 = F.dt()[(row0 + 2 * lane) * 16 + j], d1 = F.dt()[(row0 + 2 * lane + 1) * 16 + j];
    const float a = -expf(F.a_log[j]);
    const float x0 = d0 * a, x1 = d1 * a, ps = x0 + x1; float inc = ps;
#pragma unroll
    for (int off = 1; off < 64; off <<= 1) { const float t = __shfl_up(inc, off); if (lane >= off) inc += t; }
    const float total = __shfl(inc, 63);
    float a0, a1;
    if (dir == 0) { a0 = inc - x1; a1 = inc; } else { a0 = total - (inc - ps); a1 = total - (inc - x1); }
    *(LAS f32x2*)(DTs + w * 128 + 2 * lane) = (f32x2){d0, d1};
    *(LAS f32x2*)(ACs + w * 128 + 2 * lane) = (f32x2){a0, a1};
    if (write_dec && lane == 0) F.dec()[(b * 32 + c) * 16 + j] = expf(total);
}
template <int NCOLS>
__device__ __forceinline__ void conv_img(const Ctx& F, int b, int c, int xcol, ldsp img, int stride) {
    constexpr int NCQ = NCOLS / 4, NRG = 512 / NCQ, R = 128 / NRG;
    const int cq = F.tid % NCQ, rg = F.tid / NCQ, col = xcol + 4 * cq;
    f32x4 w[5];
#pragma unroll
    for (int j = 0; j < 5; ++j) w[j] = *(const f32x4*)(F.conv_w + j * 1024 + col);
    const f32x4 bias = *(const f32x4*)(F.conv_b + col);
    const int t0 = c * 128 + rg * R - 2;
    const bf16_t* base = F.proj() + (size_t)b * SEQ * PW + C_X + col;
    f32x4 win[R + 4];
#pragma unroll
    for (int k = 0; k < R + 4; ++k) { const int t = t0 + k, tc = t < 0 ? 0 : (t >= SEQ ? SEQ - 1 : t); const u32x2 raw = *(const u32x2*)(base + (size_t)tc * PW); const bool ok = (t == tc);
        win[k] = unpack4((u32x2){ok ? raw.x : 0u, ok ? raw.y : 0u}); }
#pragma unroll
    for (int r = 0; r < R; ++r) {
        f32x4 y = bias;
#pragma unroll
        for (int j = 0; j < 5; ++j) y = y + w[j] * win[r + j];
        *(LAS u32x2*)(img + (rg * R + r) * stride + cq * 8) = pack4(silu4(y));
    }
}
__device__ __forceinline__ void ssd_pass1_item(const Ctx& F, int item) {
    const int g = item & 1, c = (item >> 1) & 31, b = item >> 6;
    const ldsp XI = F.lds + L_XI, BI = F.lds + L_BI, XW = F.lds + L_XW;
    LAS float* DTs = (LAS float*)(F.lds + L_F32); LAS float* ACs = DTs + 1024;
    __syncthreads();
    ssd_dtprep(F, b, c, g, true);
    conv_img<256>(F, b, c, 256 * g, XI, XS);
    conv_img<128>(F, b, c, 512 + 128 * g, BI, BS);
    __syncthreads();
    const int lane = F.lane, i16 = lane & 15, q4 = lane >> 4, w = F.wave;
    for (int r = 0; r < 4; ++r) {
        if (r) __syncthreads();
        {
            const int dir = F.tid >> 8, row = (F.tid >> 1) & 127, half = F.tid & 1, seq = dir * 4 + r;
            const float wgt = DTs[seq * 128 + row] * expf(ACs[seq * 128 + (dir ? 0 : 127)] - ACs[seq * 128 + row]);
#pragma unroll
            for (int k = 0; k < 4; ++k) {
                const u32x4 v = *(const LAS u32x4*)(XI + row * XS + (64 * r + 32 * half + 8 * k) * 2);
                u32x4 o;
                o.x = cvt_pk(bf_lo(v.x) * wgt, bf_hi(v.x) * wgt); o.y = cvt_pk(bf_lo(v.y) * wgt, bf_hi(v.y) * wgt);
                o.z = cvt_pk(bf_lo(v.z) * wgt, bf_hi(v.z) * wgt); o.w = cvt_pk(bf_lo(v.w) * wgt, bf_hi(v.w) * wgt);
                *(LAS u32x4*)(XW + dir * (128 * XWS) + row * XWS + (32 * half + 8 * k) * 2) = o;
            }
        }
        __syncthreads();
        const int dir = w & 1, nq = w >> 1;
        f32x4 acc[2][4];
#pragma unroll
        for (int nf = 0; nf < 2; ++nf)
#pragma unroll
            for (int pf = 0; pf < 4; ++pf) acc[nf][pf] = (f32x4){0.f, 0.f, 0.f, 0.f};
#pragma unroll
        for (int ks = 0; ks < 4; ++ks) {
            const int trow = 32 * ks + 8 * q4 + (i16 >> 2);
            bf16x8 af[2], bfr[4];
#pragma unroll
            for (int nf = 0; nf < 2; ++nf) { ldsp p = BI + trow * BS + (32 * nq + 16 * nf + 4 * (i16 & 3)) * 2; af[nf] = cat8(vtr(p), vtr(p + 4 * BS)); }
#pragma unroll
            for (int pf = 0; pf < 4; ++pf) { ldsp p = XW + dir * (128 * XWS) + trow * XWS + (16 * pf + 4 * (i16 & 3)) * 2; bfr[pf] = cat8(vtr(p), vtr(p + 4 * XWS)); }
#pragma unroll
            for (int nf = 0; nf < 2; ++nf)
#pragma unroll
                for (int pf = 0; pf < 4; ++pf) acc[nf][pf] = mfma16(af[nf], bfr[pf], acc[nf][pf]);
        }
        bf16_t* S = F.st() + ((((size_t)(b * 32 + c) * 2 + dir) * 8 + (4 * g + r)) << 13);
#pragma unroll
        for (int nf = 0; nf < 2; ++nf)
#pragma unroll
            for (int pf = 0; pf < 4; ++pf) *(u32x2*)(S + (16 * pf + i16) * 128 + 32 * nq + 16 * nf + 4 * q4) = pack4(acc[nf][pf]);
    }
}
__device__ __forceinline__ void ssd_scan(const Ctx& F) {
    for (int it = F.bid * 512 + F.tid; it < NBATCH * 2 * 8 * 1024; it += F.G * 512) {
        const int e8 = it & 1023, h = (it >> 10) & 7, dir = (it >> 13) & 1, b = it >> 14;
        float run[8];
#pragma unroll
        for (int k = 0; k < 8; ++k) run[k] = 0.f;
        for (int s0 = 0; s0 < 32; s0 += 4) {
            u32x4 v[4]; float dc[4]; bf16_t* ad[4];
#pragma unroll
            for (int u = 0; u < 4; ++u) { const int s = s0 + u, c = dir ? 31 - s : s; ad[u] = F.st() + (((((size_t)(b * 32 + c) * 2 + dir) * 8 + h) << 13) + e8 * 8); v[u] = *(const u32x4*)ad[u]; dc[u] = F.dec()[(b * 32 + c) * 16 + dir * 8 + h]; }
#pragma unroll
            for (int u = 0; u < 4; ++u) {
                *(u32x4*)ad[u] = (u32x4){cvt_pk(run[0], run[1]), cvt_pk(run[2], run[3]), cvt_pk(run[4], run[5]), cvt_pk(run[6], run[7])};
                run[0] = run[0] * dc[u] + bf_lo(v[u].x); run[1] = run[1] * dc[u] + bf_hi(v[u].x); run[2] = run[2] * dc[u] + bf_lo(v[u].y); run[3] = run[3] * dc[u] + bf_hi(v[u].y);
                run[4] = run[4] * dc[u] + bf_lo(v[u].z); run[5] = run[5] * dc[u] + bf_hi(v[u].z); run[6] = run[6] * dc[u] + bf_lo(v[u].w); run[7] = run[7] * dc[u] + bf_hi(v[u].w);
            }
        }
    }
}
__device__ __forceinline__ void ssd_pass2_item(const Ctx& F, int item) {
    const int g = item & 1, c = (item >> 1) & 31, b = item >> 6;
    const ldsp XI = F.lds + L_XI, BI = F.lds + L_BI, CI = F.lds + L_CI, PV = F.lds + L_BI;
    LAS float* DTs = (LAS float*)(F.lds + L_F32); LAS float* ACs = DTs + 1024;
    __syncthreads();
    ssd_dtprep(F, b, c, g, false);
    conv_img<256>(F, b, c, 256 * g, XI, XS);
    conv_img<128>(F, b, c, 512 + 128 * g, BI, BS);
    conv_img<128>(F, b, c, 768 + 128 * g, CI, BS);
    __syncthreads();
    const int lane = F.lane, i16 = lane & 15, q4 = lane >> 4, w = F.wave, tl = 16 * w + i16;
    bf16x8 cf[4];
#pragma unroll
    for (int ks = 0; ks < 4; ++ks) cf[ks] = ld8(CI + tl * BS + (32 * ks + 8 * q4) * 2);
    f32x4 cbt[8];
#pragma unroll
    for (int sf = 0; sf < 8; ++sf) {
        cbt[sf] = (f32x4){0.f, 0.f, 0.f, 0.f};
#pragma unroll
        for (int ks = 0; ks < 4; ++ks) cbt[sf] = mfma16(ld8(BI + (16 * sf + i16) * BS + (32 * ks + 8 * q4) * 2), cf[ks], cbt[sf]);
    }
    f32x4 gprev[4]; float ss = 0.f;
#pragma unroll
    for (int pf = 0; pf < 4; ++pf) gprev[pf] = (f32x4){0.f, 0.f, 0.f, 0.f};
    const size_t row = (size_t)b * SEQ + c * 128 + tl;
#pragma unroll 1
    for (int r = 0; r < 4; ++r) {
        const int h = 4 * g + r;
        __syncthreads();
        if (r > 0) {
#pragma unroll
            for (int pf = 0; pf < 4; ++pf) *(LAS u32x2*)(XI + tl * XS + (64 * (r - 1) + 16 * pf + 4 * q4) * 2) = pack4(gprev[pf]);
        }
        {
            const int dir = F.tid >> 8, p = (F.tid >> 2) & 63, qu = F.tid & 3;
            const bf16_t* src = F.st() + (((((size_t)(b * 32 + c) * 2 + dir) * 8 + h) << 13) + p * 128 + 32 * qu);
#pragma unroll
            for (int k = 0; k < 4; ++k) *(LAS u32x4*)(PV + dir * (64 * PS) + p * PS + (32 * qu + 8 * k) * 2) = *(const u32x4*)(src + 8 * k);
        }
        __syncthreads();
        const float acf = ACs[r * 128 + tl], acb = ACs[(4 + r) * 128 + tl];
        f32x4 yt[4];
#pragma unroll
        for (int pf = 0; pf < 4; ++pf) yt[pf] = (f32x4){0.f, 0.f, 0.f, 0.f};
#pragma unroll
        for (int kp = 0; kp < 4; ++kp) {
            f32x4 gt[2];
#pragma unroll
            for (int u = 0; u < 2; ++u) {
                const int sf = 2 * kp + u, s0 = 16 * sf + 4 * q4;
                const f32x4 dtf = *(const LAS f32x4*)(DTs + r * 128 + s0), af = *(const LAS f32x4*)(ACs + r * 128 + s0);
                const f32x4 dtb = *(const LAS f32x4*)(DTs + (4 + r) * 128 + s0), ab = *(const LAS f32x4*)(ACs + (4 + r) * 128 + s0);
#pragma unroll
                for (int e = 0; e < 4; ++e) {
                    const int s = s0 + e;
                    const float mf = s <= tl ? dtf[e] * __expf(acf - af[e]) : 0.f;
                    const float mb = s >= tl ? dtb[e] * __expf(acb - ab[e]) : 0.f;
                    gt[u][e] = cbt[sf][e] * (mf + mb);
                }
            }
            const bf16x8 gk = packfrag(gt[0], gt[1]);
#pragma unroll
            for (int pf = 0; pf < 4; ++pf) {
                ldsp xa = XI + (32 * kp + 4 * q4 + (i16 >> 2)) * XS + (64 * r + 16 * pf + 4 * (i16 & 3)) * 2;
                yt[pf] = mfma16(cat8(vtr(xa), vtr(xa + 16 * XS)), gk, yt[pf]);
            }
        }
        f32x4 yf[4], yb[4];
#pragma unroll
        for (int pf = 0; pf < 4; ++pf) { yf[pf] = (f32x4){0.f, 0.f, 0.f, 0.f}; yb[pf] = (f32x4){0.f, 0.f, 0.f, 0.f}; }
#pragma unroll
        for (int ks = 0; ks < 4; ++ks)
#pragma unroll
            for (int pf = 0; pf < 4; ++pf) {
                yf[pf] = mfma16(ld8(PV + (16 * pf + i16) * PS + (32 * ks + 8 * q4) * 2), cf[ks], yf[pf]);
                yb[pf] = mfma16(ld8(PV + 64 * PS + (16 * pf + i16) * PS + (32 * ks + 8 * q4) * 2), cf[ks], yb[pf]);
            }
        const float ef = __expf(acf), eb = __expf(acb), dsk = F.d_skip[h];
#pragma unroll
        for (int pf = 0; pf < 4; ++pf) {
            const int pc = 64 * r + 16 * pf + 4 * q4;
            const f32x4 xv = unpack4(*(const LAS u32x2*)(XI + tl * XS + pc * 2));
            const f32x4 zv = unpack4(*(const u32x2*)(F.proj() + row * PW + C_Z + 256 * g + pc));
            const f32x4 y = (yt[pf] + yf[pf] * ef + yb[pf] * eb + xv * dsk) * zv;
            gprev[pf] = y; ss += y.x * y.x + y.y * y.y + y.z * y.z + y.w * y.w;
        }
    }
    __syncthreads();
#pragma unroll
    for (int pf = 0; pf < 4; ++pf) *(LAS u32x2*)(XI + tl * XS + (64 * 3 + 16 * pf + 4 * q4) * 2) = pack4(gprev[pf]);
    ss += __shfl_xor(ss, 16); ss += __shfl_xor(ss, 32);
    const float rinv = rsqrtf(ss * (1.f / 256.f) + EPS);
#pragma unroll
    for (int r = 0; r < 4; ++r)
#pragma unroll
        for (int pf = 0; pf < 4; ++pf) {
            const int pl = 64 * r + 16 * pf + 4 * q4, pc = 256 * g + pl;
            const f32x4 nw = *(const f32x4*)(F.ssd_norm_w + pc);
            const f32x4 gv = unpack4(*(const LAS u32x2*)(XI + tl * XS + pl * 2));
            *(u32x2*)(F.mix() + row * MIXP + 1024 + pc) = pack4(gv * rinv * nw);
        }
}

__device__ __forceinline__ void final_norm(const Ctx& F) {
    const int gw = F.bid * 8 + F.wave, NGW = F.G * 8, lane = F.lane;
    for (int m = gw; m < TOK; m += NGW) {
        const f32x4* rp = (const f32x4*)(F.rowss() + (size_t)m * 16); const f32x4 s4 = (rp[0] + rp[1]) + (rp[2] + rp[3]);
        const float r = rsqrtf(((s4.x + s4.y) + (s4.z + s4.w)) * (1.f / DM) + EPS);
        float* o = F.out + (size_t)m * DM;
#pragma unroll
        for (int j = 0; j < 4; ++j) { const f32x4 v = *(const f32x4*)(o + 4 * lane + 256 * j), ww = *(const f32x4*)(F.norm_out_w + 4 * lane + 256 * j); *(f32x4*)(o + 4 * lane + 256 * j) = v * r * ww; }
    }
}

__device__ __forceinline__ void seam_barrier(unsigned* ctr, unsigned target, int tid) {
    asm volatile("s_waitcnt vmcnt(0) lgkmcnt(0)" ::: "memory");
    __syncthreads();
    if (tid == 0) {
        __builtin_amdgcn_fence(__ATOMIC_RELEASE, "agent");
        asm volatile("s_waitcnt vmcnt(0)" ::: "memory");
        __hip_atomic_fetch_add(ctr, 1u, __ATOMIC_RELAXED, __HIP_MEMORY_SCOPE_AGENT);
        while (__hip_atomic_load(ctr, __ATOMIC_RELAXED, __HIP_MEMORY_SCOPE_AGENT) < target) __builtin_amdgcn_s_sleep(1);
        __builtin_amdgcn_fence(__ATOMIC_ACQUIRE, "agent");
        asm volatile("s_waitcnt vmcnt(0)" ::: "memory");
    }
    __syncthreads();
}
__global__ void __launch_bounds__(512, 2) hymba_fwd(Args args) {
    extern __shared__ __attribute__((aligned(16))) unsigned char lds_raw[];
    Ctx F;
    F.x = args.in[0]; F.mem = args.in[1]; F.norm_mem_w = args.in[2]; F.norm_in_w = args.in[3]; F.w_in = args.in[4]; F.attn_sink = args.in[5]; F.conv_w = args.in[6]; F.conv_b = args.in[7];
    F.dt_bias = args.in[8]; F.a_log = args.in[9]; F.d_skip = args.in[10]; F.ssd_norm_w = args.in[11]; F.w_mem_kv = args.in[12]; F.w_out = args.in[13]; F.norm_out_w = args.in[14];
    F.out = args.out; F.ws = args.ws;
    F.lds = (ldsp)lds_raw; F.tid = threadIdx.x; F.lane = F.tid & 63; F.wave = __builtin_amdgcn_readfirstlane(F.tid >> 6); F.G = gridDim.x; F.bid = blockIdx.x;
    const int lo = args.lo, hi = args.hi;
    cg::grid_group grid = cg::this_grid();
#define IN(k) (lo <= (k) && (k) < hi)
#define REFRESH() do { F.lane = lane_id_now(); F.tid = F.wave * 64 + F.lane; } while (0)
#define SEAM(k) do { if (IN(k) && IN((k) + 1)) { if ((k) == 0) grid.sync(); else seam_barrier((unsigned*)args.ws, (unsigned)(k) * (unsigned)F.G, F.tid); } } while (0)
    if (IN(0)) { REFRESH(); phase0(F); }
    SEAM(0);
    if (IN(1)) {
        REFRESH();
        { pg8::Gemm g{F.memn(), F.wmem_t(), NBATCH * 256, 1024, 1024, HNP, HNP}; pg8::StaticOrder S; S.init(g.M, g.N, F.G, F.bid); EpiMkv E{F.mkv()}; pg8::gemm_phase(F.lds, g, S, E, F.wave); }
        { pg8::Gemm g{F.hn(), F.win_t(), TOK, NPHYS, DM, HNP, HNP}; pg8::StaticOrder S; S.init(g.M, g.N, F.G, F.bid); EpiProj E{F.proj(), F.dt(), F.rope(), F.dt_bias}; pg8::gemm_phase(F.lds, g, S, E, F.wave); }
    }
    SEAM(1);
#if DBG_STOP == 1
    { grid.sync(); const int gw = F.bid * 8 + F.wave, NGW = F.G * 8;
      for (int m = gw; m < TOK; m += NGW) for (int j = 0; j < 16; ++j) { const int c = F.lane + 64 * j; float a = 0.f; for (int k = 0; k < 5; ++k) a += bf_lo(F.proj()[(size_t)m * PW + c + 1024 * k]); a += F.dt()[(size_t)m * 16 + (c & 15)] + bf_lo(F.mkv()[(size_t)(m & 4095) * 1024 + c]); F.out[(size_t)m * DM + c] = a; }
      return; }
#endif
    if (IN(2)) {
        REFRESH();
        if (args.sub & 1) for (int it = F.bid; it < NBATCH * 32 * 2; it += F.G) ssd_pass1_item(F, it);
        if (args.sub & 2) for (int sq = F.bid; sq < NBATCH * 4 * 4; sq += F.G) attn_window_seq(F, sq);
    }
    SEAM(2);
#if DBG_STOP == 2
    { grid.sync(); const int gw = F.bid * 8 + F.wave, NGW = F.G * 8;
      for (int m = gw; m < TOK; m += NGW) for (int j = 0; j < 16; ++j) { const int c = F.lane + 64 * j;
        const float a = (DBG_SEL & 1 ? bf_lo(F.mix()[(size_t)m * MIXW + c]) : 0.f), bq = (DBG_SEL & 2 ? bf_lo(F.st()[(size_t)m * 1024 + c]) : 0.f), d = (DBG_SEL & 4 ? F.dec()[(m * 1024 + c) & 8191] : 0.f);
        ((float*)F.proj())[(size_t)m * DM + c] = a + bq + d; }
      __threadfence(); grid.sync();
      for (int m = gw; m < TOK; m += NGW) for (int j = 0; j < 16; ++j) { const int c = F.lane + 64 * j; F.out[(size_t)m * DM + c] = ((float*)F.proj())[(size_t)m * DM + c]; }
      return; }
#endif
    if (IN(3)) { REFRESH(); ssd_scan(F); }
    SEAM(3);
    if (IN(4)) {
        REFRESH();
        if (args.sub & 1) for (int it = F.bid; it < NBATCH * 32 * 2; it += F.G) ssd_pass2_item(F, it);
        if (args.sub & 2) for (int it = F.bid; it < NBATCH * 16 * 4; it += F.G) attn_mem_item(F, it);
    }
    SEAM(4);
    if (IN(5)) { REFRESH(); __syncthreads(); pg8::Gemm g{F.mix(), F.wout_t(), TOK, DM, MIXW, MIXP, MIXP}; pg8::StaticOrder S; S.init(g.M, g.N, F.G, F.bid); EpiOut E{F.x, F.out, F.rowss()}; pg8::gemm_phase(F.lds, g, S, E, F.wave); }
    SEAM(5);
    if (IN(6)) { REFRESH(); final_norm(F); }
#undef IN
#undef SEAM
}

extern "C" void kernel_launch(void* const* d_in, const int* in_sizes, int n_in, void* d_out, int out_size, void* d_ws, size_t ws_size, hipStream_t stream) {
    static int grid = 0;
    if (grid == 0) {
        if (n_in != 15 || out_size != TOK * DM || ws_size < WS_END) { fprintf(stderr, "kernel_launch: unexpected shapes (n_in %d out %d ws %zu)\n", n_in, out_size, ws_size); grid = -1; return; }
        int dev = 0, cus = 0, per_cu = 0;
        (void)hipGetDevice(&dev); (void)hipDeviceGetAttribute(&cus, hipDeviceAttributeMultiprocessorCount, dev);
        if (hipFuncSetAttribute((const void*)hymba_fwd, hipFuncAttributeMaxDynamicSharedMemorySize, LDS_BYTES) != hipSuccess) { fprintf(stderr, "kernel_launch: hipFuncSetAttribute failed\n"); grid = -1; return; }
        if (hipOccupancyMaxActiveBlocksPerMultiprocessor(&per_cu, (const void*)hymba_fwd, 512, LDS_BYTES) != hipSuccess || per_cu < 1) { fprintf(stderr, "kernel_launch: occupancy query says %d\n", per_cu); per_cu = 1; }
        (void)hipGetLastError();
        grid = cus > 0 ? cus : 256;
    }
    if (grid < 0) return;
    Args a{};
    for (int i = 0; i < 15; ++i) a.in[i] = (const float*)d_in[i];
    a.out = (float*)d_out; a.ws = (unsigned char*)d_ws; a.sub = 3;
    (void)hipMemsetAsync(d_ws, 0, 256, stream);
#if PROBE_PHASES
    for (int k = 0; k < NPHASE; ++k) if ((PROBE_PHASES >> k) & 1) { a.lo = k; a.hi = k + 1; a.sub = PROBE_SUB; hipLaunchKernelGGL(hymba_fwd, dim3(grid), dim3(512), LDS_BYTES, stream, a); }
#endif
#if MK_ONE_LAUNCH
    a.lo = 0; a.hi = NPHASE; a.sub = 3;
    void* kargs[] = {&a};
    hipError_t e = hipLaunchCooperativeKernel((const void*)hymba_fwd, dim3(grid), dim3(512), kargs, LDS_BYTES, stream);
    if (e != hipSuccess) fprintf(stderr, "kernel_launch: cooperative launch failed: %s (grid %d)\n", hipGetErrorString(e), grid);
#else
    for (int k = 0; k < NPHASE; ++k) { a.lo = k; a.hi = k + 1; hipLaunchKernelGGL(hymba_fwd, dim3(grid), dim3(512), LDS_BYTES, stream, a); }
#endif
}
```

```cpp
#include <hip/hip_runtime.h>
#include <hip/hip_cooperative_groups.h>
#include <cstdio>
#include <cstdint>
namespace cg = cooperative_groups;

#ifndef DBG_STOP
#define DBG_STOP 0
#define DBG_SEL 2
#endif
#ifndef PROBE_PHASES
#define PROBE_PHASES 0
#define PROBE_SUB 3
#endif
#ifndef MK_ONE_LAUNCH
#define MK_ONE_LAUNCH 1
#endif

#define LAS __attribute__((address_space(3)))
typedef unsigned short bf16_t;
typedef short bf16x8 __attribute__((ext_vector_type(8)));
typedef short s16x4 __attribute__((ext_vector_type(4)));
typedef float f32x4 __attribute__((ext_vector_type(4)));
typedef float f32x2 __attribute__((ext_vector_type(2)));
typedef unsigned u32x4 __attribute__((ext_vector_type(4)));
typedef unsigned u32x2 __attribute__((ext_vector_type(2)));
typedef LAS unsigned char* ldsp;

constexpr int SEQ = 4096, NBATCH = 16, TOK = SEQ * NBATCH, DM = 1024;
constexpr int INW = 5136, NPHYS = 5376, PW = 5184;
constexpr int HNP = 1088, MIXP = 2112;
constexpr int C_Q = 0, C_K = 1024, C_V = 1280, C_G = 1536, C_Z = 2560, C_X = 3072, C_QM = 4096, C_GM = 4608;
constexpr int MIXW = 2048;
constexpr float LOG2E = 1.4426950408889634f;
constexpr float EPS = 1e-6f;
constexpr int NPHASE = 7;

constexpr size_t MiB = (size_t)1 << 20;
constexpr size_t WS_ROWSS = 956 * MiB, WS_ROPE = 1 * MiB, WS_WIN = 2 * MiB, WS_WOUT = 14 * MiB, WS_WMEM = 19 * MiB, WS_MEMN = 22 * MiB,
                 WS_MKV = 31 * MiB, WS_DT = 39 * MiB, WS_DEC = 43 * MiB, WS_PROJ = 44 * MiB, WS_MIX = 692 * MiB, WS_END = 960 * MiB;

constexpr int LDS_BYTES = 155648 + 16;
constexpr int LDS_XB = 155648;

__device__ __forceinline__ unsigned cvt_pk(float lo, float hi) { unsigned r; asm volatile("v_cvt_pk_bf16_f32 %0, %1, %2" : "=v"(r) : "v"(lo), "v"(hi)); return r; }
typedef __bf16 bf16x2_t __attribute__((ext_vector_type(2)));
__device__ __forceinline__ unsigned cvt_pk_c(float lo, float hi) { const f32x2 v = {lo, hi}; return __builtin_bit_cast(unsigned, __builtin_convertvector(v, bf16x2_t)); }
__device__ __forceinline__ float bf_lo(unsigned u) { return __uint_as_float(u << 16); }
__device__ __forceinline__ float bf_hi(unsigned u) { return __uint_as_float(u & 0xffff0000u); }
__device__ __forceinline__ f32x4 unpack4(u32x2 v) { return (f32x4){bf_lo(v.x), bf_hi(v.x), bf_lo(v.y), bf_hi(v.y)}; }
__device__ __forceinline__ u32x2 pack4(f32x4 v) { return (u32x2){cvt_pk_c(v.x, v.y), cvt_pk_c(v.z, v.w)}; }
__device__ __forceinline__ float silu_f(float x) { return x * __builtin_amdgcn_rcpf(1.f + __expf(-x)); }
__device__ __forceinline__ f32x4 silu4(f32x4 v) { return (f32x4){silu_f(v.x), silu_f(v.y), silu_f(v.z), silu_f(v.w)}; }
__device__ __forceinline__ float softplus_f(float x) { return x > 20.f ? x : log1pf(expf(x)); }
__device__ __forceinline__ float ex2(float x) { return __builtin_amdgcn_exp2f(x); }
typedef short v4i16_t __attribute__((ext_vector_type(4)));
__device__ __forceinline__ s16x4 vtr(ldsp p) { return __builtin_bit_cast(s16x4, __builtin_amdgcn_ds_read_tr16_b64_v4i16((LAS v4i16_t*)p)); }
__device__ __forceinline__ bf16x8 cat8(s16x4 a, s16x4 b) { return (bf16x8){a[0], a[1], a[2], a[3], b[0], b[1], b[2], b[3]}; }
__device__ __forceinline__ bf16x8 ld8(ldsp p) { return *(const LAS bf16x8*)p; }
__device__ __forceinline__ f32x4 mfma16(bf16x8 a, bf16x8 b, f32x4 c) { return __builtin_amdgcn_mfma_f32_16x16x32_bf16(a, b, c, 0, 0, 0); }
__device__ __forceinline__ bf16x8 packfrag(f32x4 a, f32x4 b) { u32x4 r = {cvt_pk_c(a.x, a.y), cvt_pk_c(a.z, a.w), cvt_pk_c(b.x, b.y), cvt_pk_c(b.z, b.w)}; return __builtin_bit_cast(bf16x8, r); }

__device__ __forceinline__ f32x4 zero4() { f32x4 z; asm volatile("v_mov_b32 %0, 0\n\tv_mov_b32 %1, 0\n\tv_mov_b32 %2, 0\n\tv_mov_b32 %3, 0" : "=v"(z.x), "=v"(z.y), "=v"(z.z), "=v"(z.w)); return z; }
__device__ __forceinline__ int lane_id_now() { int l; asm volatile("v_mbcnt_lo_u32_b32 %0, -1, 0\n\tv_mbcnt_hi_u32_b32 %0, -1, %0" : "=v"(l)); return l; }
__host__ __device__ __forceinline__ int perm_plain(int c) { const int bj = c >> 7, wc = (c >> 5) & 3, n = (c >> 4) & 1, fq = (c >> 2) & 3, i = c & 3; return 128 * bj + 32 * wc + 8 * fq + 4 * n + i; }
__host__ __device__ __forceinline__ int perm_rot(int c) { const int bj = c >> 7, wc = (c >> 5) & 3, n = (c >> 4) & 1, fq = (c >> 2) & 3, i = c & 3; return 64 * wc + 32 * bj + 8 * fq + 4 * n + i; }

namespace pg8 {
constexpr int BM = 256, BK = 64, HALF = 128, HTB = HALF * BK * 2, STAGE_BYTES = 8 * HTB, NXCD = 8, WGM = 8;
__host__ __device__ __forceinline__ int lds_byte(int r, int c) { const int st = (r >> 4) * 2 + (c >> 5), rr = r & 15, cc = c & 31, ob = rr * 64 + cc * 2; return st * 1024 + (ob ^ (((ob >> 9) & 1) << 5)); }
__host__ __device__ __forceinline__ void stage_rc(int b, int& R, int& C) { const int st = b / 1024, sb = b % 1024, swz = sb ^ (((sb >> 9) & 1) << 5); R = (st >> 1) * 16 + swz / 64; C = (st & 1) * 32 + (swz % 64) / 2; }
struct Unit { int pm, pn; };
struct Gemm { const bf16_t* A; const bf16_t* Bt; int M, N, K, lda, ldb; };
struct StaticOrder {
    int nM, nN, nwg, G, c;
    __device__ void init(int M, int N, int G_, int c_) { nM = M / BM; nN = N / BM; nwg = nM * nN; G = G_; c = c_; }
    __device__ bool next(int i, Unit& u) const {
        const long L = (long)i * G + c; if (L >= nwg) return false;
        int wgid = (int)L; { const int q = nwg / NXCD, r = nwg % NXCD, xcd = wgid % NXCD, off = wgid / NXCD; wgid = (xcd < r ? xcd * (q + 1) : r * (q + 1) + (xcd - r) * q) + off; }
        const int nig = WGM * nN, gid = wgid / nig, fm = gid * WGM, gsz = (nM - fm) < WGM ? (nM - fm) : WGM;
        u.pm = fm + ((wgid % nig) % gsz); u.pn = (wgid % nig) / gsz; return true;
    }
};
struct PanelOrder {
    int nM, nN, G, c;
    __device__ void init(int M, int N, int G_, int c_) { nM = M / BM; nN = N / BM; G = G_; c = c_; }
    __device__ bool next(int i, Unit& u) const { const int pm = c + (i / nN) * G; if (pm >= nM) return false; u.pm = pm; u.pn = i % nN; return true; }
};

template <class Epi, class Sched>
__device__ __forceinline__ void gemm_phase(ldsp lds, const Gemm g, const Sched& S, const Epi& E, int wave_id) {
    const int lane = lane_id_now(), wid = wave_id, tid = wid * 64 + lane, wr = wid >> 2, wc = wid & 3, fr = lane & 15, fq = lane >> 4;
    const int K = g.K, nt = K / BK;
    unsigned voffA[2], voffB[2];
#pragma unroll
    for (int i = 0; i < 2; ++i) { int R, C; stage_rc(tid * 16 + i * 8192, R, C); voffA[i] = (unsigned)(R * g.lda + C) * 2u; voffB[i] = (unsigned)(R * g.ldb + C) * 2u; }
    const size_t kstep = (size_t)(BK * 2);
    const size_t hstep = (size_t)HALF * g.lda * 2, hstepB = (size_t)HALF * g.ldb * 2;
    const size_t tstep = 2 * hstep, tstepB = 2 * hstepB;
    const unsigned ldsw = (unsigned)wid * 1024u;
    const int aoff = lds_byte(wr * 64 + fr, fq * 8), boff = lds_byte(wc * 32 + fr, fq * 8);
#define PG8_SA(b, h) (((b) * 2 + (h)) * HTB)
#define PG8_SB(b, h) ((4 + (b) * 2 + (h)) * HTB)
#define PG8_STAGE(bufoff, gbase, voff) do { _Pragma("unroll") for (int _i = 0; _i < 2; ++_i) \
        __builtin_amdgcn_global_load_lds((const unsigned*)((const char*)(gbase) + (voff)[_i]), (LAS unsigned*)(lds + (bufoff) + ldsw + _i * 8192), 16, 0, 0); } while (0)
#define PG8_LDA(dst, b, h) do { _Pragma("unroll") for (int m = 0; m < 4; ++m) _Pragma("unroll") for (int k = 0; k < 2; ++k) dst[m][k] = *(const LAS bf16x8*)(lds + PG8_SA(b, h) + aoff + m * 2048 + k * 1024); } while (0)
#define PG8_LDB(dst, b, h) do { _Pragma("unroll") for (int n = 0; n < 2; ++n) _Pragma("unroll") for (int k = 0; k < 2; ++k) dst[n][k] = *(const LAS bf16x8*)(lds + PG8_SB(b, h) + boff + n * 2048 + k * 1024); } while (0)
#define PG8_MMA(ai, bj, At, Bt) do { __builtin_amdgcn_s_setprio(1); _Pragma("unroll") for (int m = 0; m < 4; ++m) _Pragma("unroll") for (int n = 0; n < 2; ++n) _Pragma("unroll") for (int k = 0; k < 2; ++k) \
        acc[ai][bj][m][n] = __builtin_amdgcn_mfma_f32_16x16x32_bf16(Bt[n][k], At[m][k], acc[ai][bj][m][n], 0, 0, 0); __builtin_amdgcn_s_setprio(0); } while (0)
#define PG8_WAIT_V(n) asm volatile("s_waitcnt vmcnt(" #n ")" ::: "memory")
#define PG8_WAIT_L(n) asm volatile("s_waitcnt lgkmcnt(" #n ")" ::: "memory")
#define PG8_BAR __builtin_amdgcn_s_barrier()
#define PG8_SCHED __builtin_amdgcn_sched_barrier(0)
    Unit cur, nxt; int ui = 0;
    if (!S.next(0, cur)) return;
    f32x4 acc[2][2][4][2];
#pragma unroll
    for (int a = 0; a < 2; ++a)
#pragma unroll
        for (int b = 0; b < 2; ++b)
#pragma unroll
            for (int m = 0; m < 4; ++m)
#pragma unroll
                for (int n = 0; n < 2; ++n) acc[a][b][m][n] = (f32x4){0.f, 0.f, 0.f, 0.f};
    bf16x8 At[4][2], B0[2][2], B1[2][2];
    const char* cA = (const char*)g.A + (size_t)cur.pm * tstep; const char* cB = (const char*)g.Bt + (size_t)cur.pn * tstepB;
    PG8_STAGE(PG8_SB(0, 0), cB, voffB); PG8_STAGE(PG8_SA(0, 0), cA, voffA); PG8_STAGE(PG8_SB(0, 1), cB + hstepB, voffB); PG8_STAGE(PG8_SA(0, 1), cA + hstep, voffA);
    if (wr == 1) PG8_BAR;
    PG8_WAIT_V(4); PG8_BAR;
    PG8_STAGE(PG8_SB(1, 0), cB + kstep, voffB); PG8_STAGE(PG8_SA(1, 0), cA + kstep, voffA); PG8_STAGE(PG8_SB(1, 1), cB + hstepB + kstep, voffB);
    PG8_WAIT_V(6); PG8_BAR;
    for (;;) {
        const bool has_next = S.next(ui + 1, nxt);
        const char* nA = has_next ? (const char*)g.A + (size_t)nxt.pm * tstep : cA; const char* nB = has_next ? (const char*)g.Bt + (size_t)nxt.pn * tstepB : cB;
        for (int t = 0; t < nt; t += 2) {
            const bool last = (t == nt - 2);
            const char* a1 = cA + (size_t)(t + 1) * kstep;
            const char* a2 = last ? nA : cA + (size_t)(t + 2) * kstep; const char* b2 = last ? nB : cB + (size_t)(t + 2) * kstep;
            const char* a3 = a2 + kstep; const char* b3 = b2 + kstep;
            PG8_LDB(B0, 0, 0); PG8_SCHED; PG8_LDA(At, 0, 0); PG8_STAGE(PG8_SA(1, 1), a1 + hstep, voffA);
            PG8_WAIT_L(8); PG8_BAR; PG8_WAIT_L(0); PG8_MMA(0, 0, At, B0); PG8_BAR; PG8_SCHED;
            PG8_LDB(B1, 0, 1); PG8_STAGE(PG8_SB(0, 0), b2, voffB);
            PG8_BAR; PG8_WAIT_L(0); PG8_MMA(0, 1, At, B1); PG8_BAR;
            PG8_LDA(At, 0, 1); PG8_STAGE(PG8_SA(0, 0), a2, voffA);
            PG8_BAR; PG8_WAIT_L(0); PG8_MMA(1, 0, At, B0); PG8_BAR; PG8_SCHED;
            PG8_STAGE(PG8_SB(0, 1), b2 + hstepB, voffB);
            PG8_WAIT_V(6); PG8_BAR; PG8_MMA(1, 1, At, B1); PG8_BAR;
            PG8_LDB(B0, 1, 0); PG8_SCHED; PG8_LDA(At, 1, 0); PG8_STAGE(PG8_SA(0, 1), a2 + hstep, voffA);
            PG8_WAIT_L(8); PG8_BAR; PG8_WAIT_L(0); PG8_MMA(0, 0, At, B0); PG8_BAR; PG8_SCHED;
            PG8_LDB(B1, 1, 1); PG8_STAGE(PG8_SB(1, 0), b3, voffB);
            PG8_BAR; PG8_WAIT_L(0); PG8_MMA(0, 1, At, B1); PG8_BAR;
            PG8_LDA(At, 1, 1); PG8_STAGE(PG8_SA(1, 0), a3, voffA);
            PG8_BAR; PG8_WAIT_L(0); PG8_MMA(1, 0, At, B0); PG8_BAR; PG8_SCHED;
            PG8_STAGE(PG8_SB(1, 1), b3 + hstepB, voffB);
            PG8_WAIT_V(6); PG8_BAR; PG8_MMA(1, 1, At, B1); PG8_BAR;
        }
        E(acc, cur, wr, wc, fr, fq);
        if (!has_next) break;
#pragma unroll
        for (int a = 0; a < 2; ++a)
#pragma unroll
            for (int b = 0; b < 2; ++b)
#pragma unroll
                for (int m = 0; m < 4; ++m)
#pragma unroll
                    for (int n = 0; n < 2; ++n) acc[a][b][m][n] = (f32x4){0.f, 0.f, 0.f, 0.f};
        cur = nxt; cA = nA; cB = nB; ++ui;
    }
    PG8_WAIT_V(0);
    if (wr == 0) PG8_BAR;
    PG8_BAR;
#undef PG8_SA
#undef PG8_SB
#undef PG8_STAGE
#undef PG8_LDA
#undef PG8_LDB
#undef PG8_MMA
#undef PG8_WAIT_V
#undef PG8_WAIT_L
#undef PG8_BAR
#undef PG8_SCHED
}
}

struct EpiProj {
    bf16_t* P; float* DT; const float* rope; const float* dt_bias;
    __device__ __forceinline__ void operator()(const f32x4 (&acc)[2][2][4][2], const pg8::Unit& u, int wr, int wc, int fr, int fq) const {
        const int row0 = u.pm * 256 + wr * 64 + fr, pn = u.pn;
        if (pn < 5) {
            const float sc = pn < 4 ? 0.125f * LOG2E : 1.f;
            const int col = pn * 256 + 64 * wc + 8 * fq;
#pragma unroll
            for (int ai = 0; ai < 2; ++ai)
#pragma unroll
                for (int m = 0; m < 4; ++m) {
                    const int row = row0 + ai * 128 + m * 16, pos = row & (SEQ - 1);
                    const f32x4* cp = (const f32x4*)(rope + pos * 32 + 8 * fq); const f32x4* sp = (const f32x4*)(rope + SEQ * 32 + pos * 32 + 8 * fq);
                    f32x4 o1[2], o2[2];
#pragma unroll
                    for (int n = 0; n < 2; ++n) { const f32x4 c = cp[n], s = sp[n], t1 = acc[ai][0][m][n], t2 = acc[ai][1][m][n]; o1[n] = (t1 * c - t2 * s) * sc; o2[n] = (t1 * s + t2 * c) * sc; }
                    bf16_t* dst = P + (size_t)row * PW + col;
                    *(u32x4*)dst = (u32x4){cvt_pk(o1[0].x, o1[0].y), cvt_pk(o1[0].z, o1[0].w), cvt_pk(o1[1].x, o1[1].y), cvt_pk(o1[1].z, o1[1].w)};
                    *(u32x4*)(dst + 32) = (u32x4){cvt_pk(o2[0].x, o2[0].y), cvt_pk(o2[0].z, o2[0].w), cvt_pk(o2[1].x, o2[1].y), cvt_pk(o2[1].z, o2[1].w)};
                }
        } else if (pn < 20) {
            const bool do_silu = (pn >= 6 && pn < 12) || pn >= 18;
            const float sc = (pn == 16 || pn == 17) ? 0.08838834764831845f * LOG2E : 1.f;
            const int col = pn * 256 + 32 * wc + 8 * fq;
#pragma unroll
            for (int ai = 0; ai < 2; ++ai)
#pragma unroll
                for (int m = 0; m < 4; ++m) {
                    const int row = row0 + ai * 128 + m * 16;
#pragma unroll
                    for (int bj = 0; bj < 2; ++bj) {
                        f32x4 v0 = acc[ai][bj][m][0], v1 = acc[ai][bj][m][1];
                        if (do_silu) { v0 = silu4(v0); v1 = silu4(v1); } else { v0 = v0 * sc; v1 = v1 * sc; }
                        *(u32x4*)(P + (size_t)row * PW + col + 128 * bj) = (u32x4){cvt_pk(v0.x, v0.y), cvt_pk(v0.z, v0.w), cvt_pk(v1.x, v1.y), cvt_pk(v1.z, v1.w)};
                    }
                }
        } else {
            if (wc == 0 && fq < 2) {
#pragma unroll
                for (int ai = 0; ai < 2; ++ai)
#pragma unroll
                    for (int m = 0; m < 4; ++m) {
                        const int row = row0 + ai * 128 + m * 16;
#pragma unroll
                        for (int n = 0; n < 2; ++n) {
                            const int j0 = 8 * fq + 4 * n; const f32x4 bb = *(const f32x4*)(dt_bias + j0); const f32x4 v = acc[ai][0][m][n] + bb;
                            *(f32x4*)(DT + (size_t)row * 16 + j0) = (f32x4){softplus_f(v.x), softplus_f(v.y), softplus_f(v.z), softplus_f(v.w)};
                        }
                    }
            }
        }
    }
};
struct EpiMkv {
    bf16_t* O;
    __device__ __forceinline__ void operator()(const f32x4 (&acc)[2][2][4][2], const pg8::Unit& u, int wr, int wc, int fr, int fq) const {
        const int row0 = u.pm * 256 + wr * 64 + fr, col = u.pn * 256 + 32 * wc + 8 * fq;
#pragma unroll
        for (int ai = 0; ai < 2; ++ai)
#pragma unroll
            for (int m = 0; m < 4; ++m) {
                const int row = row0 + ai * 128 + m * 16;
#pragma unroll
                for (int bj = 0; bj < 2; ++bj) { const f32x4 v0 = acc[ai][bj][m][0], v1 = acc[ai][bj][m][1];
                    *(u32x4*)(O + (size_t)row * 1024 + col + 128 * bj) = (u32x4){cvt_pk(v0.x, v0.y), cvt_pk(v0.z, v0.w), cvt_pk(v1.x, v1.y), cvt_pk(v1.z, v1.w)}; }
            }
    }
};
struct EpiOut {
    const float* x; float* out; float* rowss;
    __device__ __forceinline__ void operator()(const f32x4 (&acc)[2][2][4][2], const pg8::Unit& u, int wr, int wc, int fr, int fq) const {
        const int row0 = u.pm * 256 + wr * 64 + fr, col = u.pn * 256 + 32 * wc + 8 * fq;
#pragma unroll
        for (int ai = 0; ai < 2; ++ai)
#pragma unroll
            for (int m = 0; m < 4; ++m) {
                const int row = row0 + ai * 128 + m * 16; float ss = 0.f;
#pragma unroll
                for (int bj = 0; bj < 2; ++bj) {
                    const size_t o = (size_t)row * DM + col + 128 * bj;
                    const f32x4 h0 = *(const f32x4*)(x + o) + acc[ai][bj][m][0], h1 = *(const f32x4*)(x + o + 4) + acc[ai][bj][m][1];
                    *(f32x4*)(out + o) = h0; *(f32x4*)(out + o + 4) = h1;
                    ss += h0.x * h0.x + h0.y * h0.y + h0.z * h0.z + h0.w * h0.w + h1.x * h1.x + h1.y * h1.y + h1.z * h1.z + h1.w * h1.w;
                }
                ss += __shfl_xor(ss, 16); ss += __shfl_xor(ss, 32);
                if (fq == 0) rowss[(size_t)row * 16 + u.pn * 4 + wc] = ss;
            }
    }
};

struct Args { const float* in[15]; float* out; unsigned char* ws; int lo, hi, sub, pad; };
struct Ctx {
    const float *x, *mem, *norm_mem_w, *norm_in_w, *w_in, *attn_sink, *conv_w, *conv_b, *dt_bias, *a_log, *d_skip, *ssd_norm_w, *w_mem_kv, *w_out, *norm_out_w;
    float* out; unsigned char* ws;
    __device__ __forceinline__ float* rowss() const { return (float*)(ws + WS_ROWSS); }
    __device__ __forceinline__ float* rope() const { return (float*)(ws + WS_ROPE); }
    __device__ __forceinline__ bf16_t* win_t() const { return (bf16_t*)(ws + WS_WIN); }
    __device__ __forceinline__ bf16_t* wout_t() const { return (bf16_t*)(ws + WS_WOUT); }
    __device__ __forceinline__ bf16_t* wmem_t() const { return (bf16_t*)(ws + WS_WMEM); }
    __device__ __forceinline__ bf16_t* memn() const { return (bf16_t*)(ws + WS_MEMN); }
    __device__ __forceinline__ bf16_t* mkv() const { return (bf16_t*)(ws + WS_MKV); }
    __device__ __forceinline__ float* dt() const { return (float*)(ws + WS_DT); }
    __device__ __forceinline__ float* dec() const { return (float*)(ws + WS_DEC); }
    __device__ __forceinline__ bf16_t* proj() const { return (bf16_t*)(ws + WS_PROJ); }
    __device__ __forceinline__ bf16_t* mix() const { return (bf16_t*)(ws + WS_MIX); }
    __device__ __forceinline__ bf16_t* hn() const { return (bf16_t*)((unsigned char*)out); }
    __device__ __forceinline__ bf16_t* st() const { return (bf16_t*)((unsigned char*)out); }
    ldsp lds; int tid, lane, wave, G, bid;
};

__device__ __forceinline__ void rms_row_bf16(const float* xr, const float* w, bf16_t* o, int lane) {
    f32x4 v[4]; float ss = 0.f;
#pragma unroll
    for (int j = 0; j < 4; ++j) { v[j] = *(const f32x4*)(xr + 4 * lane + 256 * j); ss += v[j].x * v[j].x + v[j].y * v[j].y + v[j].z * v[j].z + v[j].w * v[j].w; }
#pragma unroll
    for (int off = 1; off < 64; off <<= 1) ss += __shfl_xor(ss, off);
    const float r = rsqrtf(ss * (1.f / DM) + EPS);
#pragma unroll
    for (int j = 0; j < 4; ++j) { const f32x4 ww = *(const f32x4*)(w + 4 * lane + 256 * j); *(u32x2*)(o + 4 * lane + 256 * j) = pack4(v[j] * r * ww); }
}
template <int MODE>
__device__ __forceinline__ void transpose_w(const Ctx& F, const float* W, int K, int NS, bf16_t* Bt, int NP, int ldb) {
    const int nitems = NP * (K / 8);
    for (int it = F.bid * 512 + F.tid; it < nitems; it += F.G * 512) {
        const int n = it % NP, kg = it / NP, tile = n >> 8, cph = n & 255; int src;
        if (MODE == 0) {
            if (tile < 5) src = tile * 256 + perm_rot(cph);
            else if (tile < 20) { src = tile * 256 + perm_plain(cph); if (src >= 4096) src += 16; }
            else { const int l = perm_plain(cph); src = l < 16 ? 4096 + l : -1; }
        } else src = tile * 256 + perm_plain(cph);
        float v[8];
#pragma unroll
        for (int j = 0; j < 8; ++j) v[j] = src >= 0 ? W[(size_t)(kg * 8 + j) * NS + src] : 0.f;
        *(u32x4*)(Bt + (size_t)n * ldb + kg * 8) = (u32x4){cvt_pk(v[0], v[1]), cvt_pk(v[2], v[3]), cvt_pk(v[4], v[5]), cvt_pk(v[6], v[7])};
    }
}
__device__ __forceinline__ void phase0(const Ctx& F) {
    const int gt = F.bid * 512 + F.tid, NT = F.G * 512;
    for (int i = gt; i < SEQ * 32; i += NT) {
        const int pos = i >> 5, f = i & 31;
        const float inv = 1.0f / exp2f((float)f * (13.287712379549449f / 32.f));
        const float ang = (float)pos * inv;
        const double rev = (double)ang * 0.15915494309189535; const double fr = rev - __builtin_rint(rev);
        const float r = (float)(fr * 6.283185307179586);
        F.rope()[i] = __cosf(r); F.rope()[SEQ * 32 + i] = __sinf(r);
    }
    transpose_w<0>(F, F.w_in, DM, INW, F.win_t(), NPHYS, HNP);
    transpose_w<1>(F, F.w_out, MIXW, DM, F.wout_t(), DM, MIXP);
    transpose_w<1>(F, F.w_mem_kv, DM, DM, F.wmem_t(), DM, HNP);
    const int gw = F.bid * 8 + F.wave, NGW = F.G * 8;
    for (int m = gw; m < NBATCH * 256; m += NGW) rms_row_bf16(F.mem + (size_t)m * DM, F.norm_mem_w, F.memn() + (size_t)m * HNP, F.lane);
    for (int m = gw; m < TOK; m += NGW) rms_row_bf16(F.x + (size_t)m * DM, F.norm_in_w, F.hn() + (size_t)m * HNP, F.lane);
}

template <int DH, int NQF>
__device__ __forceinline__ void attn_tile(ldsp Kt, int KS, ldsp Vt, int VS, const bf16x8 (&qf)[NQF][DH / 32], f32x4 (&o)[DH / 16][NQF], float (&m)[NQF], float (&lp)[NQF], int maskmode, int lane, int qoff = 0) {
    const int i16 = lane & 15, q4 = lane >> 4;
    f32x4 st[4][NQF];
#pragma unroll
    for (int kf = 0; kf < 4; ++kf)
#pragma unroll
        for (int q = 0; q < NQF; ++q) st[kf][q] = (f32x4){0.f, 0.f, 0.f, 0.f};
#pragma unroll
    for (int ks = 0; ks < DH / 32; ++ks)
#pragma unroll
        for (int kf = 0; kf < 4; ++kf) {
            const bf16x8 ka = ld8(Kt + (16 * kf + i16) * KS + (32 * ks + 8 * q4) * 2);
#pragma unroll
            for (int q = 0; q < NQF; ++q) st[kf][q] = mfma16(ka, qf[q][ks], st[kf][q]);
            if (DH > 64 && kf == 3) __builtin_amdgcn_sched_barrier(0);
        }
    if (maskmode) {
        int zb; asm volatile("v_mov_b32 %0, 0" : "=v"(zb));
        const int base = (maskmode == 1 ? 4 * q4 - i16 - qoff : i16 + qoff - 4 * q4) + zb;
#pragma unroll
        for (int kf = 0; kf < 4; ++kf)
#pragma unroll
            for (int q = 0; q < NQF; ++q)
#pragma unroll
                for (int r = 0; r < 4; ++r) { const int off = 16 * (kf - q) + r; const bool bad = (maskmode == 1 ? base + off : base - off) < 0; if (bad) st[kf][q][r] = -INFINITY; }
    }
#pragma unroll
    for (int q = 0; q < NQF; ++q) {
        float mx = st[0][q][0];
#pragma unroll
        for (int kf = 0; kf < 4; ++kf)
#pragma unroll
            for (int r = 0; r < 4; ++r) mx = fmaxf(mx, st[kf][q][r]);
        mx = fmaxf(mx, __shfl_xor(mx, 16)); mx = fmaxf(mx, __shfl_xor(mx, 32));
        const float mn = fmaxf(m[q], mx), alpha = ex2(m[q] - mn); m[q] = mn;
        float ps = 0.f;
#pragma unroll
        for (int kf = 0; kf < 4; ++kf)
#pragma unroll
            for (int r = 0; r < 4; ++r) { const float p = ex2(st[kf][q][r] - mn); st[kf][q][r] = p; ps += p; }
        lp[q] = lp[q] * alpha + ps;
#pragma unroll
        for (int d = 0; d < DH / 16; ++d) o[d][q] = o[d][q] * alpha;
    }
#pragma unroll
    for (int kp = 0; kp < 2; ++kp) {
        bf16x8 pk[NQF];
#pragma unroll
        for (int q = 0; q < NQF; ++q) pk[q] = packfrag(st[2 * kp][q], st[2 * kp + 1][q]);
#pragma unroll
        for (int d = 0; d < DH / 16; ++d) {
            ldsp va = Vt + (32 * kp + 4 * q4 + (i16 >> 2)) * VS + (16 * d + 4 * (i16 & 3)) * 2;
            const bf16x8 vf = cat8(vtr(va), vtr(va + 16 * VS));
#pragma unroll
            for (int q = 0; q < NQF; ++q) o[d][q] = mfma16(vf, pk[q], o[d][q]);
            if (DH > 64 && (d & 3) == 3) __builtin_amdgcn_sched_barrier(0);
        }
    }
}

__device__ __forceinline__ void attn_window_item(const Ctx& F, int item) {
    constexpr int KS = 144, VS = 160; const ldsp Ki = F.lds, Vi = F.lds + 384 * KS;
    const int kvh = item & 3, i = (item >> 2) & 31, b = item >> 7;
    __syncthreads();
#pragma unroll
    for (int c = F.tid; c < 3072; c += 512) {
        const int r = c >> 3, ch = c & 7, key0 = 128 * i - 128 + r, key = key0 < 0 ? 0 : (key0 >= SEQ ? SEQ - 1 : key0);
        const bf16_t* src = F.proj() + (size_t)(b * SEQ + key) * PW + 64 * kvh + 8 * ch;
        *(LAS u32x4*)(Ki + r * KS + ch * 16) = *(const u32x4*)(src + C_K);
        *(LAS u32x4*)(Vi + r * VS + ch * 16) = *(const u32x4*)(src + C_V);
    }
    __syncthreads();
    const int w = F.wave, lane = F.lane, i16 = lane & 15, q4 = lane >> 4, hq = 4 * kvh + (w >> 1), q0 = 128 * i + 64 * (w & 1);
    bf16x8 qf[4][2];
#pragma unroll
    for (int q = 0; q < 4; ++q)
#pragma unroll
        for (int ks = 0; ks < 2; ++ks) qf[q][ks] = *(const bf16x8*)(F.proj() + (size_t)(b * SEQ + q0 + 16 * q + i16) * PW + C_Q + hq * 64 + 32 * ks + 8 * q4);
    f32x4 o[4][4]; float m[4], lp[4];
    const float sink = F.attn_sink[hq] * LOG2E;
#pragma unroll
    for (int q = 0; q < 4; ++q) { m[q] = sink; lp[q] = q4 == 0 ? 1.f : 0.f;
#pragma unroll
        for (int d = 0; d < 4; ++d) o[d][q] = (f32x4){0.f, 0.f, 0.f, 0.f}; }
#pragma unroll 1
    for (int j = 0; j < 5; ++j) {
        const int kstart = q0 - 128 + 64 * j; if (kstart < 0 || kstart >= SEQ) continue;
        const int ir = 64 * (w & 1) + 64 * j;
        attn_tile<64, 4>(Ki + ir * KS, KS, Vi + ir * VS, VS, qf, o, m, lp, j == 0 ? 1 : (j == 4 ? 2 : 0), lane);
    }
#pragma unroll
    for (int q = 0; q < 4; ++q) {
        float l = lp[q]; l += __shfl_xor(l, 16); l += __shfl_xor(l, 32); const float inv = 1.f / l;
        const size_t row = (size_t)(b * SEQ + q0 + 16 * q + i16);
#pragma unroll
        for (int d = 0; d < 4; ++d) {
            const int col = hq * 64 + 16 * d + 4 * q4;
            const f32x4 g = unpack4(*(const u32x2*)(F.proj() + row * PW + C_G + col));
            *(u32x2*)(F.mix() + row * MIXP + col) = pack4(o[d][q] * inv * g);
        }
    }
}

__device__ __forceinline__ void ring_stage_block(const Ctx& F, const bf16_t* kvbase, int keyblock) {
    constexpr int KS = 144, VS = 160; const ldsp Kb = F.lds + (keyblock & 511) * KS, Vb = F.lds + 512 * KS + (keyblock & 511) * VS;
    const bf16_t* src0 = kvbase + (size_t)keyblock * PW;
    for (int wi = F.wave; wi < 18; wi += 8) {
        const int slot = wi * 64 + F.lane, row = slot / 9, ch = slot - row * 9;
        __builtin_amdgcn_global_load_lds((const unsigned*)(src0 + (size_t)row * PW + C_K + 8 * (ch > 7 ? 7 : ch)), (LAS unsigned*)(Kb + wi * 1024), 16, 0, 0);
    }
    for (int wi = F.wave; wi < 20; wi += 8) {
        const int slot = wi * 64 + F.lane, row = slot / 10, ch = slot - row * 10;
        __builtin_amdgcn_global_load_lds((const unsigned*)(src0 + (size_t)row * PW + C_V + 8 * (ch > 7 ? 7 : ch)), (LAS unsigned*)(Vb + wi * 1024), 16, 0, 0);
    }
}
__device__ __forceinline__ void attn_window_seq(const Ctx& F, int sq) {
    constexpr int KS = 144, VS = 160; const ldsp Ki = F.lds, Vi = F.lds + 512 * KS;
    const int sidx = sq >> 2, b = sidx >> 2, kvh = sidx & 3, i0 = 8 * (sq & 3);
    const int w = F.wave, lane = F.lane, i16 = lane & 15, q4 = lane >> 4, hq = 4 * kvh + (w >> 1);
    const bf16_t* kvbase = F.proj() + (size_t)b * SEQ * PW + 64 * kvh;
    __syncthreads();
    for (int t = 0; t < 3; ++t) { const int kb = 128 * (i0 - 1 + t); if (kb >= 0 && kb < SEQ) ring_stage_block(F, kvbase, kb); }
    const float sink = F.attn_sink[hq] * LOG2E;
#pragma unroll 1
    for (int k = 0; k < 8; ++k) {
        const int i = i0 + k, q0 = 128 * i + 64 * (w & 1);
        __syncthreads();
        { const int nkey0 = 128 * i + 256; if (k < 7 && nkey0 < SEQ) ring_stage_block(F, kvbase, nkey0); }
#pragma unroll 1
        for (int half = 0; half < 2; ++half) {
            const int qh = q0 + 32 * half;
            bf16x8 qf[2][2];
#pragma unroll
            for (int q = 0; q < 2; ++q)
#pragma unroll
                for (int ks = 0; ks < 2; ++ks) qf[q][ks] = *(const bf16x8*)(F.proj() + (size_t)(b * SEQ + qh + 16 * q + i16) * PW + C_Q + hq * 64 + 32 * ks + 8 * q4);
            f32x4 o[4][2]; float m[2], lp[2];
#pragma unroll
            for (int q = 0; q < 2; ++q) { m[q] = sink; lp[q] = q4 == 0 ? 1.f : 0.f;
#pragma unroll
                for (int d = 0; d < 4; ++d) o[d][q] = (f32x4){0.f, 0.f, 0.f, 0.f}; }
#pragma unroll 1
            for (int j = 0; j < 5; ++j) {
                const int kstart = q0 - 128 + 64 * j; if (kstart < 0 || kstart >= SEQ) continue;
                const int ir = kstart & 511;
                attn_tile<64, 2>(Ki + ir * KS, KS, Vi + ir * VS, VS, qf, o, m, lp, j == 0 ? 1 : (j == 4 ? 2 : 0), lane, 32 * half);
            }
#pragma unroll
            for (int q = 0; q < 2; ++q) {
                float l = lp[q]; l += __shfl_xor(l, 16); l += __shfl_xor(l, 32); const float inv = 1.f / l;
                const size_t row = (size_t)(b * SEQ + qh + 16 * q + i16);
#pragma unroll
                for (int d = 0; d < 4; ++d) {
                    const int col = hq * 64 + 16 * d + 4 * q4;
                    const f32x4 g = unpack4(*(const u32x2*)(F.proj() + row * PW + C_G + col));
                    *(u32x2*)(F.mix() + row * MIXP + col) = pack4(o[d][q] * inv * g);
                }
            }
        }
    }
}
__device__ __forceinline__ void attn_mem_item(const Ctx& F, int item) {
    constexpr int KS = 272, VS = 288; const ldsp Ki = F.lds, Vi = F.lds + 256 * KS;
    const int hm = item & 3, qb = (item >> 2) & 15, b = item >> 6;
    __syncthreads();
#pragma unroll
    for (int c = F.tid; c < 4096; c += 512) {
        const int r = c >> 4, ch = c & 15;
        const bf16_t* src = F.mkv() + (size_t)(b * 256 + r) * 1024 + hm * 128 + 8 * ch;
        *(LAS u32x4*)(Ki + r * KS + ch * 16) = *(const u32x4*)(src);
        *(LAS u32x4*)(Vi + r * VS + ch * 16) = *(const u32x4*)(src + 512);
    }
    __syncthreads();
    const int w = F.wave, lane = F.lane, i16 = lane & 15, q4 = lane >> 4, q0 = 256 * qb + 32 * w;
    bf16x8 qf[2][4];
#pragma unroll
    for (int q = 0; q < 2; ++q)
#pragma unroll
        for (int ks = 0; ks < 4; ++ks) qf[q][ks] = *(const bf16x8*)(F.proj() + (size_t)(b * SEQ + q0 + 16 * q + i16) * PW + C_QM + hm * 128 + 32 * ks + 8 * q4);
    f32x4 o[8][2]; float m[2], lp[2];
#pragma unroll
    for (int q = 0; q < 2; ++q) { m[q] = -INFINITY; lp[q] = 0.f;
#pragma unroll
        for (int d = 0; d < 8; ++d) o[d][q] = (f32x4){0.f, 0.f, 0.f, 0.f}; }
#pragma unroll 1
    for (int j = 0; j < 4; ++j) attn_tile<128, 2>(Ki + 64 * j * KS, KS, Vi + 64 * j * VS, VS, qf, o, m, lp, 0, lane);
#pragma unroll
    for (int q = 0; q < 2; ++q) {
        float l = lp[q]; l += __shfl_xor(l, 16); l += __shfl_xor(l, 32); const float inv = 1.f / l;
        const size_t row = (size_t)(b * SEQ + q0 + 16 * q + i16);
#pragma unroll
        for (int d = 0; d < 8; ++d) {
            const int col = hm * 128 + 16 * d + 4 * q4;
            const f32x4 g = unpack4(*(const u32x2*)(F.proj() + row * PW + C_GM + col));
            *(u32x2*)(F.mix() + row * MIXP + 1536 + col) = pack4(o[d][q] * inv * g);
        }
    }
}

constexpr int XS = 544, BS = 288, XWS = 160, PS = 272;
constexpr int L_XI = 0, L_BI = 128 * XS, L_CI = L_BI + 128 * BS, L_XW = L_CI, L_F32 = L_XW + 2 * 128 * XWS;
static_assert(L_F32 + 8192 <= LDS_XB, "lds");
__device__ __forceinline__ void ssd_dtprep(const Ctx& F, int b, int c, int g, bool write_dec) {
    LAS float* DTs = (LAS float*)(F.lds + L_F32); LAS float* ACs = DTs + 1024;
    const int w = F.wave, lane = F.lane, dir = w >> 2, r = w & 3, h = 4 * g + r, j = dir * 8 + h;
    const size_t row0 = (size_t)b * SEQ + c * 128;
    const float d0 = F.dt()[(row0 + 2 * lane) * 16 + j], d1 = F.dt()[(row0 + 2 * lane + 1) * 16 + j];
    const float a = -expf(F.a_log[j]);
    const float x0 = d0 * a, x1 = d1 * a, ps = x0 + x1; float inc = ps;
#pragma unroll
    for (int off = 1; off < 64; off <<= 1) { const float t = __shfl_up(inc, off); if (lane >= off) inc += t; }
    const float total = __shfl(inc, 63);
    float a0, a1;
    if (dir == 0) { a0 = inc - x1; a1 = inc; } else { a0 = total - (inc - ps); a1 = total - (inc - x1); }
    *(LAS f32x2*)(DTs + w * 128 + 2 * lane) = (f32x2){d0, d1};
    *(LAS f32x2*)(ACs + w * 128 + 2 * lane) = (f32x2){a0, a1};
    if (write_dec && lane == 0) F.dec()[(b * 32 + c) * 16 + j] = expf(total);
}
template <int NCOLS>
__device__ __forceinline__ void conv_img(const Ctx& F, int b, int c, int xcol, ldsp img, int stride) {
    constexpr int NCQ = NCOLS / 4, NRG = 512 / NCQ, R = 128 / NRG;
    const int cq = F.tid % NCQ, rg = F.tid / NCQ, col = xcol + 4 * cq;
    f32x4 w[5];
#pragma unroll
    for (int j = 0; j < 5; ++j) w[j] = *(const f32x4*)(F.conv_w + j * 1024 + col);
    const f32x4 bias = *(const f32x4*)(F.conv_b + col);
    const int t0 = c * 128 + rg * R - 2;
    const bf16_t* base = F.proj() + (size_t)b * SEQ * PW + C_X + col;
    f32x4 win[R + 4];
#pragma unroll
    for (int k = 0; k < R + 4; ++k) { const int t = t0 + k, tc = t < 0 ? 0 : (t >= SEQ ? SEQ - 1 : t); const u32x2 raw = *(const u32x2*)(base + (size_t)tc * PW); const bool ok = (t == tc);
        win[k] = unpack4((u32x2){ok ? raw.x : 0u, ok ? raw.y : 0u}); }
#pragma unroll
    for (int r = 0; r < R; ++r) {
        f32x4 y = bias;
#pragma unroll
        for (int j = 0; j < 5; ++j) y = y + w[j] * win[r + j];
        *(LAS u32x2*)(img + (rg * R + r) * stride + cq * 8) = pack4(silu4(y));
    }
}
__device__ __forceinline__ void ssd_pass1_item(const Ctx& F, int item) {
    const int g = item & 1, c = (item >> 1) & 31, b = item >> 6;
    const ldsp XI = F.lds + L_XI, BI = F.lds + L_BI, XW = F.lds + L_XW;
    LAS float* DTs = (LAS float*)(F.lds + L_F32); LAS float* ACs = DTs + 1024;
    __syncthreads();
    ssd_dtprep(F, b, c, g, true);
    conv_img<256>(F, b, c, 256 * g, XI, XS);
    conv_img<128>(F, b, c, 512 + 128 * g, BI, BS);
    __syncthreads();
    const int lane = F.lane, i16 = lane & 15, q4 = lane >> 4, w = F.wave;
    for (int r = 0; r < 4; ++r) {
        if (r) __syncthreads();
        {
            const int dir = F.tid >> 8, row = (F.tid >> 1) & 127, half = F.tid & 1, seq = dir * 4 + r;
            const float wgt = DTs[seq * 128 + row] * expf(ACs[seq * 128 + (dir ? 0 : 127)] - ACs[seq * 128 + row]);
#pragma unroll
            for (int k = 0; k < 4; ++k) {
                const u32x4 v = *(const LAS u32x4*)(XI + row * XS + (64 * r + 32 * half + 8 * k) * 2);
                u32x4 o;
                o.x = cvt_pk(bf_lo(v.x) * wgt, bf_hi(v.x) * wgt); o.y = cvt_pk(bf_lo(v.y) * wgt, bf_hi(v.y) * wgt);
                o.z = cvt_pk(bf_lo(v.z) * wgt, bf_hi(v.z) * wgt); o.w = cvt_pk(bf_lo(v.w) * wgt, bf_hi(v.w) * wgt);
                *(LAS u32x4*)(XW + dir * (128 * XWS) + row * XWS + (32 * half + 8 * k) * 2) = o;
            }
        }
        __syncthreads();
        const int dir = w & 1, nq = w >> 1;
        f32x4 acc[2][4];
#pragma unroll
        for (int nf = 0; nf < 2; ++nf)
#pragma unroll
            for (int pf = 0; pf < 4; ++pf) acc[nf][pf] = (f32x4){0.f, 0.f, 0.f, 0.f};
#pragma unroll
        for (int ks = 0; ks < 4; ++ks) {
            const int trow = 32 * ks + 8 * q4 + (i16 >> 2);
            bf16x8 af[2], bfr[4];
#pragma unroll
            for (int nf = 0; nf < 2; ++nf) { ldsp p = BI + trow * BS + (32 * nq + 16 * nf + 4 * (i16 & 3)) * 2; af[nf] = cat8(vtr(p), vtr(p + 4 * BS)); }
#pragma unroll
            for (int pf = 0; pf < 4; ++pf) { ldsp p = XW + dir * (128 * XWS) + trow * XWS + (16 * pf + 4 * (i16 & 3)) * 2; bfr[pf] = cat8(vtr(p), vtr(p + 4 * XWS)); }
#pragma unroll
            for (int nf = 0; nf < 2; ++nf)
#pragma unroll
                for (int pf = 0; pf < 4; ++pf) acc[nf][pf] = mfma16(af[nf], bfr[pf], acc[nf][pf]);
        }
        bf16_t* S = F.st() + ((((size_t)(b * 32 + c) * 2 + dir) * 8 + (4 * g + r)) << 13);
#pragma unroll
        for (int nf = 0; nf < 2; ++nf)
#pragma unroll
            for (int pf = 0; pf < 4; ++pf) *(u32x2*)(S + (16 * pf + i16) * 128 + 32 * nq + 16 * nf + 4 * q4) = pack4(acc[nf][pf]);
    }
}
__device__ __forceinline__ void ssd_scan(const Ctx& F) {
    for (int it = F.bid * 512 + F.tid; it < NBATCH * 2 * 8 * 1024; it += F.G * 512) {
        const int e8 = it & 1023, h = (it >> 10) & 7, dir = (it >> 13) & 1, b = it >> 14;
        float run[8];
#pragma unroll
        for (int k = 0; k < 8; ++k) run[k] = 0.f;
        for (int s0 = 0; s0 < 32; s0 += 4) {
            u32x4 v[4]; float dc[4]; bf16_t* ad[4];
#pragma unroll
            for (int u = 0; u < 4; ++u) { const int s = s0 + u, c = dir ? 31 - s : s; ad[u] = F.st() + (((((size_t)(b * 32 + c) * 2 + dir) * 8 + h) << 13) + e8 * 8); v[u] = *(const u32x4*)ad[u]; dc[u] = F.dec()[(b * 32 + c) * 16 + dir * 8 + h]; }
#pragma unroll
            for (int u = 0; u < 4; ++u) {
                *(u32x4*)ad[u] = (u32x4){cvt_pk(run[0], run[1]), cvt_pk(run[2], run[3]), cvt_pk(run[4], run[5]), cvt_pk(run[6], run[7])};
                run[0] = run[0] * dc[u] + bf_lo(v[u].x); run[1] = run[1] * dc[u] + bf_hi(v[u].x); run[2] = run[2] * dc[u] + bf_lo(v[u].y); run[3] = run[3] * dc[u] + bf_hi(v[u].y);
                run[4] = run[4] * dc[u] + bf_lo(v[u].z); run[5] = run[5] * dc[u] + bf_hi(v[u].z); run[6] = run[6] * dc[u] + bf_lo(v[u].w); run[7] = run[7] * dc[u] + bf_hi(v[u].w);
            }
        }
    }
}
__device__ __forceinline__ void ssd_pass2_item(const Ctx& F, int item) {
    const int g = item & 1, c = (item >> 1) & 31, b = item >> 6;
    const ldsp XI = F.lds + L_XI, BI = F.lds + L_BI, CI = F.lds + L_CI, PV = F.lds + L_BI;
    LAS float* DTs = (LAS float*)(F.lds + L_F32); LAS float* ACs = DTs + 1024;
    __syncthreads();
    ssd_dtprep(F, b, c, g, false);
    conv_img<256>(F, b, c, 256 * g, XI, XS);
    conv_img<128>(F, b, c, 512 + 128 * g, BI, BS);
    conv_img<128>(F, b, c, 768 + 128 * g, CI, BS);
    __syncthreads();
    const int lane = F.lane, i16 = lane & 15, q4 = lane >> 4, w = F.wave, tl = 16 * w + i16;
    bf16x8 cf[4];
#pragma unroll
    for (int ks = 0; ks < 4; ++ks) cf[ks] = ld8(CI + tl * BS + (32 * ks + 8 * q4) * 2);
    f32x4 cbt[8];
#pragma unroll
    for (int sf = 0; sf < 8; ++sf) {
        cbt[sf] = (f32x4){0.f, 0.f, 0.f, 0.f};
#pragma unroll
        for (int ks = 0; ks < 4; ++ks) cbt[sf] = mfma16(ld8(BI + (16 * sf + i16) * BS + (32 * ks + 8 * q4) * 2), cf[ks], cbt[sf]);
    }
    f32x4 gprev[4]; float ss = 0.f;
#pragma unroll
    for (int pf = 0; pf < 4; ++pf) gprev[pf] = (f32x4){0.f, 0.f, 0.f, 0.f};
    const size_t row = (size_t)b * SEQ + c * 128 + tl;
#pragma unroll 1
    for (int r = 0; r < 4; ++r) {
        const int h = 4 * g + r;
        __syncthreads();
        if (r > 0) {
#pragma unroll
            for (int pf = 0; pf < 4; ++pf) *(LAS u32x2*)(XI + tl * XS + (64 * (r - 1) + 16 * pf + 4 * q4) * 2) = pack4(gprev[pf]);
        }
        {
            const int dir = F.tid >> 8, p = (F.tid >> 2) & 63, qu = F.tid & 3;
            const bf16_t* src = F.st() + (((((size_t)(b * 32 + c) * 2 + dir) * 8 + h) << 13) + p * 128 + 32 * qu);
#pragma unroll
            for (int k = 0; k < 4; ++k) *(LAS u32x4*)(PV + dir * (64 * PS) + p * PS + (32 * qu + 8 * k) * 2) = *(const u32x4*)(src + 8 * k);
        }
        __syncthreads();
        const float acf = ACs[r * 128 + tl], acb = ACs[(4 + r) * 128 + tl];
        f32x4 yt[4];
#pragma unroll
        for (int pf = 0; pf < 4; ++pf) yt[pf] = (f32x4){0.f, 0.f, 0.f, 0.f};
#pragma unroll
        for (int kp = 0; kp < 4; ++kp) {
            f32x4 gt[2];
#pragma unroll
            for (int u = 0; u < 2; ++u) {
                const int sf = 2 * kp + u, s0 = 16 * sf + 4 * q4;
                const f32x4 dtf = *(const LAS f32x4*)(DTs + r * 128 + s0), af = *(const LAS f32x4*)(ACs + r * 128 + s0);
                const f32x4 dtb = *(const LAS f32x4*)(DTs + (4 + r) * 128 + s0), ab = *(const LAS f32x4*)(ACs + (4 + r) * 128 + s0);
#pragma unroll
                for (int e = 0; e < 4; ++e) {
                    const int s = s0 + e;
                    const float mf = s <= tl ? dtf[e] * __expf(acf - af[e]) : 0.f;
                    const float mb = s >= tl ? dtb[e] * __expf(acb - ab[e]) : 0.f;
                    gt[u][e] = cbt[sf][e] * (mf + mb);
                }
            }
            const bf16x8 gk = packfrag(gt[0], gt[1]);
#pragma unroll
            for (int pf = 0; pf < 4; ++pf) {
                ldsp xa = XI + (32 * kp + 4 * q4 + (i16 >> 2)) * XS + (64 * r + 16 * pf + 4 * (i16 & 3)) * 2;
                yt[pf] = mfma16(cat8(vtr(xa), vtr(xa + 16 * XS)), gk, yt[pf]);
            }
        }
        f32x4 yf[4], yb[4];
#pragma unroll
        for (int pf = 0; pf < 4; ++pf) { yf[pf] = (f32x4){0.f, 0.f, 0.f, 0.f}; yb[pf] = (f32x4){0.f, 0.f, 0.f, 0.f}; }
#pragma unroll
        for (int ks = 0; ks < 4; ++ks)
#pragma unroll
            for (int pf = 0; pf < 4; ++pf) {
                yf[pf] = mfma16(ld8(PV + (16 * pf + i16) * PS + (32 * ks + 8 * q4) * 2), cf[ks], yf[pf]);
                yb[pf] = mfma16(ld8(PV + 64 * PS + (16 * pf + i16) * PS + (32 * ks + 8 * q4) * 2), cf[ks], yb[pf]);
            }
        const float ef = __expf(acf), eb = __expf(acb), dsk = F.d_skip[h];
#pragma unroll
        for (int pf = 0; pf < 4; ++pf) {
            const int pc = 64 * r + 16 * pf + 4 * q4;
            const f32x4 xv = unpack4(*(const LAS u32x2*)(XI + tl * XS + pc * 2));
            const f32x4 zv = unpack4(*(const u32x2*)(F.proj() + row * PW + C_Z + 256 * g + pc));
            const f32x4 y = (yt[pf] + yf[pf] * ef + yb[pf] * eb + xv * dsk) * zv;
            gprev[pf] = y; ss += y.x * y.x + y.y * y.y + y.z * y.z + y.w * y.w;
        }
    }
    __syncthreads();
#pragma unroll
    for (int pf = 0; pf < 4; ++pf) *(LAS u32x2*)(XI + tl * XS + (64 * 3 + 16 * pf + 4 * q4) * 2) = pack4(gprev[pf]);
    ss += __shfl_xor(ss, 16); ss += __shfl_xor(ss, 32);
    const float rinv = rsqrtf(ss * (1.f / 256.f) + EPS);
#pragma unroll
    for (int r = 0; r < 4; ++r)
#pragma unroll
        for (int pf = 0; pf < 4; ++pf) {
            const int pl = 64 * r + 16 * pf + 4 * q4, pc = 256 * g + pl;
            const f32x4 nw = *(const f32x4*)(F.ssd_norm_w + pc);
            const f32x4 gv = unpack4(*(const LAS u32x2*)(XI + tl * XS + pl * 2));
            *(u32x2*)(F.mix() + row * MIXP + 1024 + pc) = pack4(gv * rinv * nw);
        }
}

__device__ __forceinline__ void final_norm(const Ctx& F) {
    const int gw = F.bid * 8 + F.wave, NGW = F.G * 8, lane = F.lane;
    for (int m = gw; m < TOK; m += NGW) {
        const f32x4* rp = (const f32x4*)(F.rowss() + (size_t)m * 16); const f32x4 s4 = (rp[0] + rp[1]) + (rp[2] + rp[3]);
        const float r = rsqrtf(((s4.x + s4.y) + (s4.z + s4.w)) * (1.f / DM) + EPS);
        float* o = F.out + (size_t)m * DM;
#pragma unroll
        for (int j = 0; j < 4; ++j) { const f32x4 v = *(const f32x4*)(o + 4 * lane + 256 * j), ww = *(const f32x4*)(F.norm_out_w + 4 * lane + 256 * j); *(f32x4*)(o + 4 * lane + 256 * j) = v * r * ww; }
    }
}

#define XB_TMO      128
#define XB_XCNT(j)  (256  + 64 * (j))
#define XB_XSUB(j)  (1280 + 64 * (j))
#define XB_XGEN(j)  (2304 + 64 * (j))
#define XB_TOP      3328
#define XB_TOPGEN   3392
#define XCD_BAR_WORDS 3456
#define XB_SPIN_CAP (1u << 18)

__device__ __forceinline__ unsigned xb_ld(unsigned* p)              { return __hip_atomic_load(p, __ATOMIC_RELAXED, __HIP_MEMORY_SCOPE_AGENT); }
__device__ __forceinline__ unsigned xb_add(unsigned* p, unsigned v) { return __hip_atomic_fetch_add(p, v, __ATOMIC_RELAXED, __HIP_MEMORY_SCOPE_AGENT); }
__device__ __forceinline__ unsigned xb_xcc_id() { return (unsigned)__builtin_amdgcn_s_getreg((3 << 11) | 20) & 0xFu; }
#define XB_SPIN(cond, bar) do { unsigned _sp = 0; while (cond) { __builtin_amdgcn_s_sleep(1); \
    if ((++_sp & 255u) == 0u) { if (xb_ld(&(bar)[XB_TMO])) break; if (_sp > XB_SPIN_CAP) { atomicAdd(&(bar)[XB_TMO], 1u); break; } } } } while (0)

struct XcdBarrier {
    unsigned* bar; unsigned x;
    volatile LAS unsigned* st;
};

__device__ __forceinline__ XcdBarrier xcd_barrier_post(unsigned* bar, volatile LAS unsigned* st, int xb_tid) {
    XcdBarrier b; b.bar = bar; b.x = xb_xcc_id(); b.st = st;
    if (xb_tid == 0) (void)xb_add(&bar[XB_XCNT(b.x)], 1u);
    return b;
}
__device__ __forceinline__ void xcd_barrier_complete(unsigned* bar, unsigned x, unsigned& nloc, unsigned& nx) {
    const unsigned G = gridDim.x * gridDim.y * gridDim.z;
    unsigned sum, cnt, mine, sp = 0u;
    for (;;) {
        sum = 0u; cnt = 0u; mine = 0u;
#pragma unroll
        for (unsigned j = 0; j < 16; ++j) { const unsigned c = xb_ld(&bar[XB_XCNT(j)]); sum += c; cnt += (c > 0u) ? 1u : 0u; mine = (j == x) ? c : mine; }
        if (sum == G) break;
        __builtin_amdgcn_s_sleep(1);
        if ((++sp & 255u) == 0u) { if (xb_ld(&bar[XB_TMO])) break; if (sp > XB_SPIN_CAP) { atomicAdd(&bar[XB_TMO], 1u); break; } }
    }
    nloc = mine > 0u ? mine : 1u; nx = cnt > 0u ? cnt : 1u;
}

__device__ __forceinline__ void xcd_barrier(const XcdBarrier& b, int xb_tid) {
    asm volatile("s_waitcnt vmcnt(0)" ::: "memory");
    __syncthreads();
    if (xb_tid == 0) {
        unsigned* bar = b.bar;
        __builtin_amdgcn_s_waitcnt(0);
        unsigned nloc = b.st[0], nx = b.st[1];
        if (nloc == 0u) { xcd_barrier_complete(bar, b.x, nloc, nx); b.st[0] = nloc; b.st[1] = nx; }
        const unsigned old = xb_add(&bar[XB_XSUB(b.x)], 1u);
        const unsigned gen = old / nloc;
        if (old + 1u == (gen + 1u) * nloc) {
            __builtin_amdgcn_fence(__ATOMIC_RELEASE, "agent");
            asm volatile("s_waitcnt vmcnt(0)" ::: "memory");
            const unsigned og = xb_add(&bar[XB_TOP], 1u);
            const unsigned tg = og / nx;
            if (og + 1u == (tg + 1u) * nx) xb_add(&bar[XB_TOPGEN], 1u);
            else XB_SPIN(xb_ld(&bar[XB_TOPGEN]) == tg, bar);
            __builtin_amdgcn_fence(__ATOMIC_ACQUIRE, "agent");
            xb_add(&bar[XB_XGEN(b.x)], 1u);
            asm volatile("s_waitcnt vmcnt(0)" ::: "memory");
        } else {
            XB_SPIN(xb_ld(&bar[XB_XGEN(b.x)]) == gen, bar);
            __builtin_amdgcn_fence(__ATOMIC_ACQUIRE, "agent");
            asm volatile("s_waitcnt vmcnt(0)" ::: "memory");
        }
    }
    __syncthreads();
}

__global__ void __launch_bounds__(512, 2) hymba_fwd(Args args) {
    extern __shared__ __attribute__((aligned(16))) unsigned char lds_raw[];
    Ctx F;
    F.x = args.in[0]; F.mem = args.in[1]; F.norm_mem_w = args.in[2]; F.norm_in_w = args.in[3]; F.w_in = args.in[4]; F.attn_sink = args.in[5]; F.conv_w = args.in[6]; F.conv_b = args.in[7];
    F.dt_bias = args.in[8]; F.a_log = args.in[9]; F.d_skip = args.in[10]; F.ssd_norm_w = args.in[11]; F.w_mem_kv = args.in[12]; F.w_out = args.in[13]; F.norm_out_w = args.in[14];
    F.out = args.out; F.ws = args.ws;
    F.lds = (ldsp)lds_raw; F.tid = threadIdx.x; F.lane = F.tid & 63; F.wave = __builtin_amdgcn_readfirstlane(F.tid >> 6); F.G = gridDim.x; F.bid = blockIdx.x;
    const int lo = args.lo, hi = args.hi;
    cg::grid_group grid = cg::this_grid();
#define IN(k) (lo <= (k) && (k) < hi)
#define REFRESH() do { F.lane = lane_id_now(); F.tid = F.wave * 64 + F.lane; } while (0)
    if (F.tid == 0) { *(LAS u32x4*)(F.lds + LDS_XB) = (u32x4){0u, 0u, 0u, 0u}; }
    __syncthreads();
    XcdBarrier xbar; xbar.bar = (unsigned*)args.ws; xbar.x = 0; xbar.st = (volatile LAS unsigned*)(F.lds + LDS_XB);
    if (hi - lo > 1) xbar = xcd_barrier_post((unsigned*)args.ws, (volatile LAS unsigned*)(F.lds + LDS_XB), F.tid);
#define SEAM(k) do { if (IN(k) && IN((k) + 1)) { if ((k) == 0) grid.sync(); else xcd_barrier(xbar, F.tid); } } while (0)
    if (IN(0)) { REFRESH(); phase0(F); }
    SEAM(0);
    if (IN(1)) {
        REFRESH();
        { pg8::Gemm g{F.memn(), F.wmem_t(), NBATCH * 256, 1024, 1024, HNP, HNP}; pg8::StaticOrder S; S.init(g.M, g.N, F.G, F.bid); EpiMkv E{F.mkv()}; pg8::gemm_phase(F.lds, g, S, E, F.wave); }
        { pg8::Gemm g{F.hn(), F.win_t(), TOK, NPHYS, DM, HNP, HNP}; pg8::StaticOrder S; S.init(g.M, g.N, F.G, F.bid); EpiProj E{F.proj(), F.dt(), F.rope(), F.dt_bias}; pg8::gemm_phase(F.lds, g, S, E, F.wave); }
    }
    SEAM(1);
#if DBG_STOP == 1
    { grid.sync(); const int gw = F.bid * 8 + F.wave, NGW = F.G * 8;
      for (int m = gw; m < TOK; m += NGW) for (int j = 0; j < 16; ++j) { const int c = F.lane + 64 * j; float a = 0.f; for (int k = 0; k < 5; ++k) a += bf_lo(F.proj()[(size_t)m * PW + c + 1024 * k]); a += F.dt()[(size_t)m * 16 + (c & 15)] + bf_lo(F.mkv()[(size_t)(m & 4095) * 1024 + c]); F.out[(size_t)m * DM + c] = a; }
      return; }
#endif
    if (IN(2)) {
        REFRESH();
        if (args.sub & 1) for (int it = F.bid; it < NBATCH * 32 * 2; it += F.G) ssd_pass1_item(F, it);
        if (args.sub & 2) for (int sq = F.bid; sq < NBATCH * 4 * 4; sq += F.G) attn_window_seq(F, sq);
    }
    SEAM(2);
#if DBG_STOP == 2
    { grid.sync(); const int gw = F.bid * 8 + F.wave, NGW = F.G * 8;
      for (int m = gw; m < TOK; m += NGW) for (int j = 0; j < 16; ++j) { const int c = F.lane + 64 * j;
        const float a = (DBG_SEL & 1 ? bf_lo(F.mix()[(size_t)m * MIXW + c]) : 0.f), bq = (DBG_SEL & 2 ? bf_lo(F.st()[(size_t)m * 1024 + c]) : 0.f), d = (DBG_SEL & 4 ? F.dec()[(m * 1024 + c) & 8191] : 0.f);
        ((float*)F.proj())[(size_t)m * DM + c] = a + bq + d; }
      __threadfence(); grid.sync();
      for (int m = gw; m < TOK; m += NGW) for (int j = 0; j < 16; ++j) { const int c = F.lane + 64 * j; F.out[(size_t)m * DM + c] = ((float*)F.proj())[(size_t)m * DM + c]; }
      return; }
#endif
    if (IN(3)) { REFRESH(); ssd_scan(F); }
    SEAM(3);
    if (IN(4)) {
        REFRESH();
        if (args.sub & 1) for (int it = F.bid; it < NBATCH * 32 * 2; it += F.G) ssd_pass2_item(F, it);
        if (args.sub & 2) for (int it = F.bid; it < NBATCH * 16 * 4; it += F.G) attn_mem_item(F, it);
    }
    SEAM(4);
    if (IN(5)) { REFRESH(); __syncthreads(); pg8::Gemm g{F.mix(), F.wout_t(), TOK, DM, MIXW, MIXP, MIXP}; pg8::StaticOrder S; S.init(g.M, g.N, F.G, F.bid); EpiOut E{F.x, F.out, F.rowss()}; pg8::gemm_phase(F.lds, g, S, E, F.wave); }
    SEAM(5);
    if (IN(6)) { REFRESH(); final_norm(F); }
#undef IN
#undef SEAM
}

extern "C" void kernel_launch(void* const* d_in, const int* in_sizes, int n_in, void* d_out, int out_size, void* d_ws, size_t ws_size, hipStream_t stream) {
    static int grid = 0;
    if (grid == 0) {
        if (n_in != 15 || out_size != TOK * DM || ws_size < WS_END) { fprintf(stderr, "kernel_launch: unexpected shapes (n_in %d out %d ws %zu)\n", n_in, out_size, ws_size); grid = -1; return; }
        int dev = 0, cus = 0, per_cu = 0;
        (void)hipGetDevice(&dev); (void)hipDeviceGetAttribute(&cus, hipDeviceAttributeMultiprocessorCount, dev);
        if (hipFuncSetAttribute((const void*)hymba_fwd, hipFuncAttributeMaxDynamicSharedMemorySize, LDS_BYTES) != hipSuccess) { fprintf(stderr, "kernel_launch: hipFuncSetAttribute failed\n"); grid = -1; return; }
        if (hipOccupancyMaxActiveBlocksPerMultiprocessor(&per_cu, (const void*)hymba_fwd, 512, LDS_BYTES) != hipSuccess || per_cu < 1) { fprintf(stderr, "kernel_launch: occupancy query says %d\n", per_cu); per_cu = 1; }
        (void)hipGetLastError();
        grid = cus > 0 ? cus : 256;
    }
    if (grid < 0) return;
    Args a{};
    for (int i = 0; i < 15; ++i) a.in[i] = (const float*)d_in[i];
    a.out = (float*)d_out; a.ws = (unsigned char*)d_ws; a.sub = 3;
    (void)hipMemsetAsync(d_ws, 0, 16384, stream);
#if PROBE_PHASES
    for (int k = 0; k < NPHASE; ++k) if ((PROBE_PHASES >> k) & 1) { a.lo = k; a.hi = k + 1; a.sub = PROBE_SUB; hipLaunchKernelGGL(hymba_fwd, dim3(grid), dim3(512), LDS_BYTES, stream, a); }
#endif
#if MK_ONE_LAUNCH
    a.lo = 0; a.hi = NPHASE; a.sub = 3;
    void* kargs[] = {&a};
    hipError_t e = hipLaunchCooperativeKernel((const void*)hymba_fwd, dim3(grid), dim3(512), kargs, LDS_BYTES, stream);
    if (e != hipSuccess) fprintf(stderr, "kernel_launch: cooperative launch failed: %s (grid %d)\n", hipGetErrorString(e), grid);
#else
    for (int k = 0; k < NPHASE; ++k) { a.lo = k; a.hi = k + 1; hipLaunchKernelGGL(hymba_fwd, dim3(grid), dim3(512), LDS_BYTES, stream, a); }
#endif
}
```

```cpp
#include <hip/hip_runtime.h>
#include <hip/hip_cooperative_groups.h>
#include <cstdio>
#include <cstdint>
namespace cg = cooperative_groups;

#ifndef DBG_STOP
#define DBG_STOP 0
#define DBG_SEL 2
#endif
#ifndef PROBE_PHASES
#define PROBE_PHASES 0
#define PROBE_SUB 3
#endif
#ifndef MK_ONE_LAUNCH
#define MK_ONE_LAUNCH 1
#endif

#define LAS __attribute__((address_space(3)))
typedef unsigned short bf16_t;
typedef short bf16x8 __attribute__((ext_vector_type(8)));
typedef short s16x4 __attribute__((ext_vector_type(4)));
typedef float f32x4 __attribute__((ext_vector_type(4)));
typedef float f32x2 __attribute__((ext_vector_type(2)));
typedef unsigned u32x4 __attribute__((ext_vector_type(4)));
typedef unsigned u32x2 __attribute__((ext_vector_type(2)));
typedef LAS unsigned char* ldsp;

constexpr int SEQ = 4096, NBATCH = 16, TOK = SEQ * NBATCH, DM = 1024;
constexpr int INW = 5136, NPHYS = 5376, PW = 5184;
constexpr int HNP = 1088, MIXP = 2112;
constexpr int C_Q = 0, C_K = 1024, C_V = 1280, C_G = 1536, C_Z = 2560, C_X = 3072, C_QM = 4096, C_GM = 4608;
constexpr int MIXW = 2048;
constexpr float LOG2E = 1.4426950408889634f;
constexpr float EPS = 1e-6f;
constexpr int NPHASE = 7;

constexpr size_t MiB = (size_t)1 << 20;
constexpr size_t WS_ROWSS = 956 * MiB, WS_ROPE = 1 * MiB, WS_WIN = 2 * MiB, WS_WOUT = 14 * MiB, WS_WMEM = 19 * MiB, WS_MEMN = 22 * MiB,
                 WS_MKV = 31 * MiB, WS_DT = 39 * MiB, WS_DEC = 43 * MiB, WS_PROJ = 44 * MiB, WS_MIX = 692 * MiB, WS_END = 960 * MiB;

constexpr int LDS_BYTES = 155648 + 16;
constexpr int LDS_XB = 155648;

__device__ __forceinline__ unsigned cvt_pk(float lo, float hi) { unsigned r; asm volatile("v_cvt_pk_bf16_f32 %0, %1, %2" : "=v"(r) : "v"(lo), "v"(hi)); return r; }
typedef __bf16 bf16x2_t __attribute__((ext_vector_type(2)));
__device__ __forceinline__ unsigned cvt_pk_c(float lo, float hi) { const f32x2 v = {lo, hi}; return __builtin_bit_cast(unsigned, __builtin_convertvector(v, bf16x2_t)); }
__device__ __forceinline__ float bf_lo(unsigned u) { return __uint_as_float(u << 16); }
__device__ __forceinline__ float bf_hi(unsigned u) { return __uint_as_float(u & 0xffff0000u); }
__device__ __forceinline__ f32x4 unpack4(u32x2 v) { return (f32x4){bf_lo(v.x), bf_hi(v.x), bf_lo(v.y), bf_hi(v.y)}; }
__device__ __forceinline__ u32x2 pack4(f32x4 v) { return (u32x2){cvt_pk_c(v.x, v.y), cvt_pk_c(v.z, v.w)}; }
__device__ __forceinline__ float silu_f(float x) { return x * __builtin_amdgcn_rcpf(1.f + __expf(-x)); }
__device__ __forceinline__ f32x4 silu4(f32x4 v) { return (f32x4){silu_f(v.x), silu_f(v.y), silu_f(v.z), silu_f(v.w)}; }
__device__ __forceinline__ float softplus_f(float x) { return x > 20.f ? x : log1pf(expf(x)); }
__device__ __forceinline__ float ex2(float x) { return __builtin_amdgcn_exp2f(x); }
typedef short v4i16_t __attribute__((ext_vector_type(4)));
__device__ __forceinline__ s16x4 vtr(ldsp p) { return __builtin_bit_cast(s16x4, __builtin_amdgcn_ds_read_tr16_b64_v4i16((LAS v4i16_t*)p)); }
__device__ __forceinline__ bf16x8 cat8(s16x4 a, s16x4 b) { return (bf16x8){a[0], a[1], a[2], a[3], b[0], b[1], b[2], b[3]}; }
__device__ __forceinline__ bf16x8 ld8(ldsp p) { return *(const LAS bf16x8*)p; }
__device__ __forceinline__ f32x4 mfma16(bf16x8 a, bf16x8 b, f32x4 c) { return __builtin_amdgcn_mfma_f32_16x16x32_bf16(a, b, c, 0, 0, 0); }
__device__ __forceinline__ bf16x8 packfrag(f32x4 a, f32x4 b) { u32x4 r = {cvt_pk_c(a.x, a.y), cvt_pk_c(a.z, a.w), cvt_pk_c(b.x, b.y), cvt_pk_c(b.z, b.w)}; return __builtin_bit_cast(bf16x8, r); }

__device__ __forceinline__ f32x4 zero4() { f32x4 z; asm volatile("v_mov_b32 %0, 0\n\tv_mov_b32 %1, 0\n\tv_mov_b32 %2, 0\n\tv_mov_b32 %3, 0" : "=v"(z.x), "=v"(z.y), "=v"(z.z), "=v"(z.w)); return z; }
__device__ __forceinline__ int lane_id_now() { int l; asm volatile("v_mbcnt_lo_u32_b32 %0, -1, 0\n\tv_mbcnt_hi_u32_b32 %0, -1, %0" : "=v"(l)); return l; }
__host__ __device__ __forceinline__ int perm_plain(int c) { const int bj = c >> 7, wc = (c >> 5) & 3, n = (c >> 4) & 1, fq = (c >> 2) & 3, i = c & 3; return 128 * bj + 32 * wc + 8 * fq + 4 * n + i; }
__host__ __device__ __forceinline__ int perm_rot(int c) { const int bj = c >> 7, wc = (c >> 5) & 3, n = (c >> 4) & 1, fq = (c >> 2) & 3, i = c & 3; return 64 * wc + 32 * bj + 8 * fq + 4 * n + i; }

namespace pg8 {
constexpr int BM = 256, BK = 64, HALF = 128, HTB = HALF * BK * 2, STAGE_BYTES = 8 * HTB, NXCD = 8, WGM = 8;
__host__ __device__ __forceinline__ int lds_byte(int r, int c) { const int st = (r >> 4) * 2 + (c >> 5), rr = r & 15, cc = c & 31, ob = rr * 64 + cc * 2; return st * 1024 + (ob ^ (((ob >> 9) & 1) << 5)); }
__host__ __device__ __forceinline__ void stage_rc(int b, int& R, int& C) { const int st = b / 1024, sb = b % 1024, swz = sb ^ (((sb >> 9) & 1) << 5); R = (st >> 1) * 16 + swz / 64; C = (st & 1) * 32 + (swz % 64) / 2; }
struct Unit { int pm, pn; };
struct Gemm { const bf16_t* A; const bf16_t* Bt; int M, N, K, lda, ldb; };
struct StaticOrder {
    int nM, nN, nwg, G, c;
    __device__ void init(int M, int N, int G_, int c_) { nM = M / BM; nN = N / BM; nwg = nM * nN; G = G_; c = c_; }
    __device__ bool next(int i, Unit& u) const {
        const long L = (long)i * G + c; if (L >= nwg) return false;
        int wgid = (int)L; { const int q = nwg / NXCD, r = nwg % NXCD, xcd = wgid % NXCD, off = wgid / NXCD; wgid = (xcd < r ? xcd * (q + 1) : r * (q + 1) + (xcd - r) * q) + off; }
        const int nig = WGM * nN, gid = wgid / nig, fm = gid * WGM, gsz = (nM - fm) < WGM ? (nM - fm) : WGM;
        u.pm = fm + ((wgid % nig) % gsz); u.pn = (wgid % nig) / gsz; return true;
    }
};
struct PanelOrder {
    int nM, nN, G, c;
    __device__ void init(int M, int N, int G_, int c_) { nM = M / BM; nN = N / BM; G = G_; c = c_; }
    __device__ bool next(int i, Unit& u) const { const int pm = c + (i / nN) * G; if (pm >= nM) return false; u.pm = pm; u.pn = i % nN; return true; }
};

template <class Epi, class Sched>
__device__ __forceinline__ void gemm_phase(ldsp lds, const Gemm g, const Sched& S, const Epi& E, int wave_id) {
    const int lane = lane_id_now(), wid = wave_id, tid = wid * 64 + lane, wr = wid >> 2, wc = wid & 3, fr = lane & 15, fq = lane >> 4;
    const int K = g.K, nt = K / BK;
    unsigned voffA[2], voffB[2];
#pragma unroll
    for (int i = 0; i < 2; ++i) { int R, C; stage_rc(tid * 16 + i * 8192, R, C); voffA[i] = (unsigned)(R * g.lda + C) * 2u; voffB[i] = (unsigned)(R * g.ldb + C) * 2u; }
    const size_t kstep = (size_t)(BK * 2);
    const size_t hstep = (size_t)HALF * g.lda * 2, hstepB = (size_t)HALF * g.ldb * 2;
    const size_t tstep = 2 * hstep, tstepB = 2 * hstepB;
    const unsigned ldsw = (unsigned)wid * 1024u;
    const int aoff = lds_byte(wr * 64 + fr, fq * 8), boff = lds_byte(wc * 32 + fr, fq * 8);
#define PG8_SA(b, h) (((b) * 2 + (h)) * HTB)
#define PG8_SB(b, h) ((4 + (b) * 2 + (h)) * HTB)
#define PG8_STAGE(bufoff, gbase, voff) do { _Pragma("unroll") for (int _i = 0; _i < 2; ++_i) \
        __builtin_amdgcn_global_load_lds((const unsigned*)((const char*)(gbase) + (voff)[_i]), (LAS unsigned*)(lds + (bufoff) + ldsw + _i * 8192), 16, 0, 0); } while (0)
#define PG8_LDA(dst, b, h) do { _Pragma("unroll") for (int m = 0; m < 4; ++m) _Pragma("unroll") for (int k = 0; k < 2; ++k) dst[m][k] = *(const LAS bf16x8*)(lds + PG8_SA(b, h) + aoff + m * 2048 + k * 1024); } while (0)
#define PG8_LDB(dst, b, h) do { _Pragma("unroll") for (int n = 0; n < 2; ++n) _Pragma("unroll") for (int k = 0; k < 2; ++k) dst[n][k] = *(const LAS bf16x8*)(lds + PG8_SB(b, h) + boff + n * 2048 + k * 1024); } while (0)
#define PG8_MMA(ai, bj, At, Bt) do { __builtin_amdgcn_s_setprio(1); _Pragma("unroll") for (int m = 0; m < 4; ++m) _Pragma("unroll") for (int n = 0; n < 2; ++n) _Pragma("unroll") for (int k = 0; k < 2; ++k) \
        acc[ai][bj][m][n] = __builtin_amdgcn_mfma_f32_16x16x32_bf16(Bt[n][k], At[m][k], acc[ai][bj][m][n], 0, 0, 0); __builtin_amdgcn_s_setprio(0); } while (0)
#define PG8_WAIT_V(n) asm volatile("s_waitcnt vmcnt(" #n ")" ::: "memory")
#define PG8_WAIT_L(n) asm volatile("s_waitcnt lgkmcnt(" #n ")" ::: "memory")
#define PG8_BAR __builtin_amdgcn_s_barrier()
#define PG8_SCHED __builtin_amdgcn_sched_barrier(0)
    Unit cur, nxt; int ui = 0;
    if (!S.next(0, cur)) return;
    f32x4 acc[2][2][4][2];
#pragma unroll
    for (int a = 0; a < 2; ++a)
#pragma unroll
        for (int b = 0; b < 2; ++b)
#pragma unroll
            for (int m = 0; m < 4; ++m)
#pragma unroll
                for (int n = 0; n < 2; ++n) acc[a][b][m][n] = (f32x4){0.f, 0.f, 0.f, 0.f};
    bf16x8 At[4][2], B0[2][2], B1[2][2];
    const char* cA = (const char*)g.A + (size_t)cur.pm * tstep; const char* cB = (const char*)g.Bt + (size_t)cur.pn * tstepB;
    PG8_STAGE(PG8_SB(0, 0), cB, voffB); PG8_STAGE(PG8_SA(0, 0), cA, voffA); PG8_STAGE(PG8_SB(0, 1), cB + hstepB, voffB); PG8_STAGE(PG8_SA(0, 1), cA + hstep, voffA);
    if (wr == 1) PG8_BAR;
    PG8_WAIT_V(4); PG8_BAR;
    PG8_STAGE(PG8_SB(1, 0), cB + kstep, voffB); PG8_STAGE(PG8_SA(1, 0), cA + kstep, voffA); PG8_STAGE(PG8_SB(1, 1), cB + hstepB + kstep, voffB);
    PG8_WAIT_V(6); PG8_BAR;
    for (;;) {
        const bool has_next = S.next(ui + 1, nxt);
        const char* nA = has_next ? (const char*)g.A + (size_t)nxt.pm * tstep : cA; const char* nB = has_next ? (const char*)g.Bt + (size_t)nxt.pn * tstepB : cB;
        for (int t = 0; t < nt; t += 2) {
            const bool last = (t == nt - 2);
            const char* a1 = cA + (size_t)(t + 1) * kstep;
            const char* a2 = last ? nA : cA + (size_t)(t + 2) * kstep; const char* b2 = last ? nB : cB + (size_t)(t + 2) * kstep;
            const char* a3 = a2 + kstep; const char* b3 = b2 + kstep;
            PG8_LDB(B0, 0, 0); PG8_SCHED; PG8_LDA(At, 0, 0); PG8_STAGE(PG8_SA(1, 1), a1 + hstep, voffA);
            PG8_WAIT_L(8); PG8_BAR; PG8_WAIT_L(0); PG8_MMA(0, 0, At, B0); PG8_BAR; PG8_SCHED;
            PG8_LDB(B1, 0, 1); PG8_STAGE(PG8_SB(0, 0), b2, voffB);
            PG8_BAR; PG8_WAIT_L(0); PG8_MMA(0, 1, At, B1); PG8_BAR;
            PG8_LDA(At, 0, 1); PG8_STAGE(PG8_SA(0, 0), a2, voffA);
            PG8_BAR; PG8_WAIT_L(0); PG8_MMA(1, 0, At, B0); PG8_BAR; PG8_SCHED;
            PG8_STAGE(PG8_SB(0, 1), b2 + hstepB, voffB);
            PG8_WAIT_V(6); PG8_BAR; PG8_MMA(1, 1, At, B1); PG8_BAR;
            PG8_LDB(B0, 1, 0); PG8_SCHED; PG8_LDA(At, 1, 0); PG8_STAGE(PG8_SA(0, 1), a2 + hstep, voffA);
            PG8_WAIT_L(8); PG8_BAR; PG8_WAIT_L(0); PG8_MMA(0, 0, At, B0); PG8_BAR; PG8_SCHED;
            PG8_LDB(B1, 1, 1); PG8_STAGE(PG8_SB(1, 0), b3, voffB);
            PG8_BAR; PG8_WAIT_L(0); PG8_MMA(0, 1, At, B1); PG8_BAR;
            PG8_LDA(At, 1, 1); PG8_STAGE(PG8_SA(1, 0), a3, voffA);
            PG8_BAR; PG8_WAIT_L(0); PG8_MMA(1, 0, At, B0); PG8_BAR; PG8_SCHED;
            PG8_STAGE(PG8_SB(1, 1), b3 + hstepB, voffB);
            PG8_WAIT_V(6); PG8_BAR; PG8_MMA(1, 1, At, B1); PG8_BAR;
        }
        E(acc, cur, wr, wc, fr, fq);
        if (!has_next) break;
#pragma unroll
        for (int a = 0; a < 2; ++a)
#pragma unroll
            for (int b = 0; b < 2; ++b)
#pragma unroll
                for (int m = 0; m < 4; ++m)
#pragma unroll
                    for (int n = 0; n < 2; ++n) acc[a][b][m][n] = (f32x4){0.f, 0.f, 0.f, 0.f};
        cur = nxt; cA = nA; cB = nB; ++ui;
    }
    PG8_WAIT_V(0);
    if (wr == 0) PG8_BAR;
    PG8_BAR;
#undef PG8_SA
#undef PG8_SB
#undef PG8_STAGE
#undef PG8_LDA
#undef PG8_LDB
#undef PG8_MMA
#undef PG8_WAIT_V
#undef PG8_WAIT_L
#undef PG8_BAR
#undef PG8_SCHED
}
}

struct EpiProj {
    bf16_t* P; float* DT; const float* rope; const float* dt_bias;
    __device__ __forceinline__ void operator()(const f32x4 (&acc)[2][2][4][2], const pg8::Unit& u, int wr, int wc, int fr, int fq) const {
        const int row0 = u.pm * 256 + wr * 64 + fr, pn = u.pn;
        if (pn < 5) {
            const float sc = pn < 4 ? 0.125f * LOG2E : 1.f;
            const int col = pn * 256 + 64 * wc + 8 * fq;
#pragma unroll
            for (int ai = 0; ai < 2; ++ai)
#pragma unroll
                for (int m = 0; m < 4; ++m) {
                    const int row = row0 + ai * 128 + m * 16, pos = row & (SEQ - 1);
                    const f32x4* cp = (const f32x4*)(rope + pos * 32 + 8 * fq); const f32x4* sp = (const f32x4*)(rope + SEQ * 32 + pos * 32 + 8 * fq);
                    f32x4 o1[2], o2[2];
#pragma unroll
                    for (int n = 0; n < 2; ++n) { const f32x4 c = cp[n], s = sp[n], t1 = acc[ai][0][m][n], t2 = acc[ai][1][m][n]; o1[n] = (t1 * c - t2 * s) * sc; o2[n] = (t1 * s + t2 * c) * sc; }
                    bf16_t* dst = P + (size_t)row * PW + col;
                    *(u32x4*)dst = (u32x4){cvt_pk(o1[0].x, o1[0].y), cvt_pk(o1[0].z, o1[0].w), cvt_pk(o1[1].x, o1[1].y), cvt_pk(o1[1].z, o1[1].w)};
                    *(u32x4*)(dst + 32) = (u32x4){cvt_pk(o2[0].x, o2[0].y), cvt_pk(o2[0].z, o2[0].w), cvt_pk(o2[1].x, o2[1].y), cvt_pk(o2[1].z, o2[1].w)};
                }
        } else if (pn < 20) {
            const bool do_silu = (pn >= 6 && pn < 12) || pn >= 18;
            const float sc = (pn == 16 || pn == 17) ? 0.08838834764831845f * LOG2E : 1.f;
            const int col = pn * 256 + 32 * wc + 8 * fq;
#pragma unroll
            for (int ai = 0; ai < 2; ++ai)
#pragma unroll
                for (int m = 0; m < 4; ++m) {
                    const int row = row0 + ai * 128 + m * 16;
#pragma unroll
                    for (int bj = 0; bj < 2; ++bj) {
                        f32x4 v0 = acc[ai][bj][m][0], v1 = acc[ai][bj][m][1];
                        if (do_silu) { v0 = silu4(v0); v1 = silu4(v1); } else { v0 = v0 * sc; v1 = v1 * sc; }
                        *(u32x4*)(P + (size_t)row * PW + col + 128 * bj) = (u32x4){cvt_pk(v0.x, v0.y), cvt_pk(v0.z, v0.w), cvt_pk(v1.x, v1.y), cvt_pk(v1.z, v1.w)};
                    }
                }
        } else {
            if (wc == 0 && fq < 2) {
#pragma unroll
                for (int ai = 0; ai < 2; ++ai)
#pragma unroll
                    for (int m = 0; m < 4; ++m) {
                        const int row = row0 + ai * 128 + m * 16;
#pragma unroll
                        for (int n = 0; n < 2; ++n) {
                            const int j0 = 8 * fq + 4 * n; const f32x4 bb = *(const f32x4*)(dt_bias + j0); const f32x4 v = acc[ai][0][m][n] + bb;
                            *(f32x4*)(DT + (size_t)row * 16 + j0) = (f32x4){softplus_f(v.x), softplus_f(v.y), softplus_f(v.z), softplus_f(v.w)};
                        }
                    }
            }
        }
    }
};
struct EpiMkv {
    bf16_t* O;
    __device__ __forceinline__ void operator()(const f32x4 (&acc)[2][2][4][2], const pg8::Unit& u, int wr, int wc, int fr, int fq) const {
        const int row0 = u.pm * 256 + wr * 64 + fr, col = u.pn * 256 + 32 * wc + 8 * fq;
#pragma unroll
        for (int ai = 0; ai < 2; ++ai)
#pragma unroll
            for (int m = 0; m < 4; ++m) {
                const int row = row0 + ai * 128 + m * 16;
#pragma unroll
                for (int bj = 0; bj < 2; ++bj) { const f32x4 v0 = acc[ai][bj][m][0], v1 = acc[ai][bj][m][1];
                    *(u32x4*)(O + (size_t)row * 1024 + col + 128 * bj) = (u32x4){cvt_pk(v0.x, v0.y), cvt_pk(v0.z, v0.w), cvt_pk(v1.x, v1.y), cvt_pk(v1.z, v1.w)}; }
            }
    }
};
struct EpiOut {
    const float* x; float* out; float* rowss;
    __device__ __forceinline__ void operator()(const f32x4 (&acc)[2][2][4][2], const pg8::Unit& u, int wr, int wc, int fr, int fq) const {
        const int row0 = u.pm * 256 + wr * 64 + fr, col = u.pn * 256 + 32 * wc + 8 * fq;
#pragma unroll
        for (int ai = 0; ai < 2; ++ai)
#pragma unroll
            for (int m = 0; m < 4; ++m) {
                const int row = row0 + ai * 128 + m * 16; float ss = 0.f;
#pragma unroll
                for (int bj = 0; bj < 2; ++bj) {
                    const size_t o = (size_t)row * DM + col + 128 * bj;
                    const f32x4 h0 = *(const f32x4*)(x + o) + acc[ai][bj][m][0], h1 = *(const f32x4*)(x + o + 4) + acc[ai][bj][m][1];
                    *(f32x4*)(out + o) = h0; *(f32x4*)(out + o + 4) = h1;
                    ss += h0.x * h0.x + h0.y * h0.y + h0.z * h0.z + h0.w * h0.w + h1.x * h1.x + h1.y * h1.y + h1.z * h1.z + h1.w * h1.w;
                }
                ss += __shfl_xor(ss, 16); ss += __shfl_xor(ss, 32);
                if (fq == 0) rowss[(size_t)row * 16 + u.pn * 4 + wc] = ss;
            }
    }
};

struct Args { const float* in[15]; float* out; unsigned char* ws; int lo, hi, sub, pad; };
struct Ctx {
    const float *x, *mem, *norm_mem_w, *norm_in_w, *w_in, *attn_sink, *conv_w, *conv_b, *dt_bias, *a_log, *d_skip, *ssd_norm_w, *w_mem_kv, *w_out, *norm_out_w;
    float* out; unsigned char* ws;
    __device__ __forceinline__ float* rowss() const { return (float*)(ws + WS_ROWSS); }
    __device__ __forceinline__ float* rope() const { return (float*)(ws + WS_ROPE); }
    __device__ __forceinline__ bf16_t* win_t() const { return (bf16_t*)(ws + WS_WIN); }
    __device__ __forceinline__ bf16_t* wout_t() const { return (bf16_t*)(ws + WS_WOUT); }
    __device__ __forceinline__ bf16_t* wmem_t() const { return (bf16_t*)(ws + WS_WMEM); }
    __device__ __forceinline__ bf16_t* memn() const { return (bf16_t*)(ws + WS_MEMN); }
    __device__ __forceinline__ bf16_t* mkv() const { return (bf16_t*)(ws + WS_MKV); }
    __device__ __forceinline__ float* dt() const { return (float*)(ws + WS_DT); }
    __device__ __forceinline__ float* dec() const { return (float*)(ws + WS_DEC); }
    __device__ __forceinline__ bf16_t* proj() const { return (bf16_t*)(ws + WS_PROJ); }
    __device__ __forceinline__ bf16_t* mix() const { return (bf16_t*)(ws + WS_MIX); }
    __device__ __forceinline__ bf16_t* hn() const { return (bf16_t*)((unsigned char*)out); }
    __device__ __forceinline__ bf16_t* st() const { return (bf16_t*)((unsigned char*)out); }
    ldsp lds; int tid, lane, wave, G, bid;
};

__device__ __forceinline__ void rms_row_bf16(const float* xr, const float* w, bf16_t* o, int lane) {
    f32x4 v[4]; float ss = 0.f;
#pragma unroll
    for (int j = 0; j < 4; ++j) { v[j] = *(const f32x4*)(xr + 4 * lane + 256 * j); ss += v[j].x * v[j].x + v[j].y * v[j].y + v[j].z * v[j].z + v[j].w * v[j].w; }
#pragma unroll
    for (int off = 1; off < 64; off <<= 1) ss += __shfl_xor(ss, off);
    const float r = rsqrtf(ss * (1.f / DM) + EPS);
#pragma unroll
    for (int j = 0; j < 4; ++j) { const f32x4 ww = *(const f32x4*)(w + 4 * lane + 256 * j); *(u32x2*)(o + 4 * lane + 256 * j) = pack4(v[j] * r * ww); }
}
template <int MODE>
__device__ __forceinline__ void transpose_w(const Ctx& F, const float* W, int K, int NS, bf16_t* Bt, int NP, int ldb) {
    const int nitems = NP * (K / 8);
    for (int it = F.bid * 512 + F.tid; it < nitems; it += F.G * 512) {
        const int n = it % NP, kg = it / NP, tile = n >> 8, cph = n & 255; int src;
        if (MODE == 0) {
            if (tile < 5) src = tile * 256 + perm_rot(cph);
            else if (tile < 20) { src = tile * 256 + perm_plain(cph); if (src >= 4096) src += 16; }
            else { const int l = perm_plain(cph); src = l < 16 ? 4096 + l : -1; }
        } else src = tile * 256 + perm_plain(cph);
        float v[8];
#pragma unroll
        for (int j = 0; j < 8; ++j) v[j] = src >= 0 ? W[(size_t)(kg * 8 + j) * NS + src] : 0.f;
        *(u32x4*)(Bt + (size_t)n * ldb + kg * 8) = (u32x4){cvt_pk(v[0], v[1]), cvt_pk(v[2], v[3]), cvt_pk(v[4], v[5]), cvt_pk(v[6], v[7])};
    }
}
__device__ __forceinline__ void phase0(const Ctx& F) {
    const int gt = F.bid * 512 + F.tid, NT = F.G * 512;
    for (int i = gt; i < SEQ * 32; i += NT) {
        const int pos = i >> 5, f = i & 31;
        const float inv = 1.0f / exp2f((float)f * (13.287712379549449f / 32.f));
        const float ang = (float)pos * inv;
        const double rev = (double)ang * 0.15915494309189535; const double fr = rev - __builtin_rint(rev);
        const float r = (float)(fr * 6.283185307179586);
        F.rope()[i] = __cosf(r); F.rope()[SEQ * 32 + i] = __sinf(r);
    }
    transpose_w<0>(F, F.w_in, DM, INW, F.win_t(), NPHYS, HNP);
    transpose_w<1>(F, F.w_out, MIXW, DM, F.wout_t(), DM, MIXP);
    transpose_w<1>(F, F.w_mem_kv, DM, DM, F.wmem_t(), DM, HNP);
    const int gw = F.bid * 8 + F.wave, NGW = F.G * 8;
    for (int m = gw; m < NBATCH * 256; m += NGW) rms_row_bf16(F.mem + (size_t)m * DM, F.norm_mem_w, F.memn() + (size_t)m * HNP, F.lane);
    for (int m = gw; m < TOK; m += NGW) rms_row_bf16(F.x + (size_t)m * DM, F.norm_in_w, F.hn() + (size_t)m * HNP, F.lane);
}

template <int DH, int NQF>
__device__ __forceinline__ void attn_tile(ldsp Kt, int KS, ldsp Vt, int VS, const bf16x8 (&qf)[NQF][DH / 32], f32x4 (&o)[DH / 16][NQF], float (&m)[NQF], float (&lp)[NQF], int maskmode, int lane, int qoff = 0) {
    const int i16 = lane & 15, q4 = lane >> 4;
    f32x4 st[4][NQF];
#pragma unroll
    for (int kf = 0; kf < 4; ++kf)
#pragma unroll
        for (int q = 0; q < NQF; ++q) st[kf][q] = (f32x4){0.f, 0.f, 0.f, 0.f};
#pragma unroll
    for (int ks = 0; ks < DH / 32; ++ks)
#pragma unroll
        for (int kf = 0; kf < 4; ++kf) {
            const bf16x8 ka = ld8(Kt + (16 * kf + i16) * KS + (32 * ks + 8 * q4) * 2);
#pragma unroll
            for (int q = 0; q < NQF; ++q) st[kf][q] = mfma16(ka, qf[q][ks], st[kf][q]);
            if (DH > 64 && kf == 3) __builtin_amdgcn_sched_barrier(0);
        }
    if (maskmode) {
        int zb; asm volatile("v_mov_b32 %0, 0" : "=v"(zb));
        const int base = (maskmode == 1 ? 4 * q4 - i16 - qoff : i16 + qoff - 4 * q4) + zb;
#pragma unroll
        for (int kf = 0; kf < 4; ++kf)
#pragma unroll
            for (int q = 0; q < NQF; ++q)
#pragma unroll
                for (int r = 0; r < 4; ++r) { const int off = 16 * (kf - q) + r; const bool bad = (maskmode == 1 ? base + off : base - off) < 0; if (bad) st[kf][q][r] = -INFINITY; }
    }
#pragma unroll
    for (int q = 0; q < NQF; ++q) {
        float mx = st[0][q][0];
#pragma unroll
        for (int kf = 0; kf < 4; ++kf)
#pragma unroll
            for (int r = 0; r < 4; ++r) mx = fmaxf(mx, st[kf][q][r]);
        mx = fmaxf(mx, __shfl_xor(mx, 16)); mx = fmaxf(mx, __shfl_xor(mx, 32));
        const float mn = fmaxf(m[q], mx), alpha = ex2(m[q] - mn); m[q] = mn;
        float ps = 0.f;
#pragma unroll
        for (int kf = 0; kf < 4; ++kf)
#pragma unroll
            for (int r = 0; r < 4; ++r) { const float p = ex2(st[kf][q][r] - mn); st[kf][q][r] = p; ps += p; }
        lp[q] = lp[q] * alpha + ps;
#pragma unroll
        for (int d = 0; d < DH / 16; ++d) o[d][q] = o[d][q] * alpha;
    }
#pragma unroll
    for (int kp = 0; kp < 2; ++kp) {
        bf16x8 pk[NQF];
#pragma unroll
        for (int q = 0; q < NQF; ++q) pk[q] = packfrag(st[2 * kp][q], st[2 * kp + 1][q]);
#pragma unroll
        for (int d = 0; d < DH / 16; ++d) {
            ldsp va = Vt + (32 * kp + 4 * q4 + (i16 >> 2)) * VS + (16 * d + 4 * (i16 & 3)) * 2;
            const bf16x8 vf = cat8(vtr(va), vtr(va + 16 * VS));
#pragma unroll
            for (int q = 0; q < NQF; ++q) o[d][q] = mfma16(vf, pk[q], o[d][q]);
            if (DH > 64 && (d & 3) == 3) __builtin_amdgcn_sched_barrier(0);
        }
    }
}

__device__ __forceinline__ void attn_window_item(const Ctx& F, int item) {
    constexpr int KS = 144, VS = 160; const ldsp Ki = F.lds, Vi = F.lds + 384 * KS;
    const int kvh = item & 3, i = (item >> 2) & 31, b = item >> 7;
    __syncthreads();
#pragma unroll
    for (int c = F.tid; c < 3072; c += 512) {
        const int r = c >> 3, ch = c & 7, key0 = 128 * i - 128 + r, key = key0 < 0 ? 0 : (key0 >= SEQ ? SEQ - 1 : key0);
        const bf16_t* src = F.proj() + (size_t)(b * SEQ + key) * PW + 64 * kvh + 8 * ch;
        *(LAS u32x4*)(Ki + r * KS + ch * 16) = *(const u32x4*)(src + C_K);
        *(LAS u32x4*)(Vi + r * VS + ch * 16) = *(const u32x4*)(src + C_V);
    }
    __syncthreads();
    const int w = F.wave, lane = F.lane, i16 = lane & 15, q4 = lane >> 4, hq = 4 * kvh + (w >> 1), q0 = 128 * i + 64 * (w & 1);
    bf16x8 qf[4][2];
#pragma unroll
    for (int q = 0; q < 4; ++q)
#pragma unroll
        for (int ks = 0; ks < 2; ++ks) qf[q][ks] = *(const bf16x8*)(F.proj() + (size_t)(b * SEQ + q0 + 16 * q + i16) * PW + C_Q + hq * 64 + 32 * ks + 8 * q4);
    f32x4 o[4][4]; float m[4], lp[4];
    const float sink = F.attn_sink[hq] * LOG2E;
#pragma unroll
    for (int q = 0; q < 4; ++q) { m[q] = sink; lp[q] = q4 == 0 ? 1.f : 0.f;
#pragma unroll
        for (int d = 0; d < 4; ++d) o[d][q] = (f32x4){0.f, 0.f, 0.f, 0.f}; }
#pragma unroll 1
    for (int j = 0; j < 5; ++j) {
        const int kstart = q0 - 128 + 64 * j; if (kstart < 0 || kstart >= SEQ) continue;
        const int ir = 64 * (w & 1) + 64 * j;
        attn_tile<64, 4>(Ki + ir * KS, KS, Vi + ir * VS, VS, qf, o, m, lp, j == 0 ? 1 : (j == 4 ? 2 : 0), lane);
    }
#pragma unroll
    for (int q = 0; q < 4; ++q) {
        float l = lp[q]; l += __shfl_xor(l, 16); l += __shfl_xor(l, 32); const float inv = 1.f / l;
        const size_t row = (size_t)(b * SEQ + q0 + 16 * q + i16);
#pragma unroll
        for (int d = 0; d < 4; ++d) {
            const int col = hq * 64 + 16 * d + 4 * q4;
            const f32x4 g = unpack4(*(const u32x2*)(F.proj() + row * PW + C_G + col));
            *(u32x2*)(F.mix() + row * MIXP + col) = pack4(o[d][q] * inv * g);
        }
    }
}

__device__ __forceinline__ void ring_stage_block(const Ctx& F, const bf16_t* kvbase, int keyblock) {
    constexpr int KS = 144, VS = 160; const ldsp Kb = F.lds + (keyblock & 511) * KS, Vb = F.lds + 512 * KS + (keyblock & 511) * VS;
    const bf16_t* src0 = kvbase + (size_t)keyblock * PW;
    for (int wi = F.wave; wi < 18; wi += 8) {
        const int slot = wi * 64 + F.lane, row = slot / 9, ch = slot - row * 9;
        __builtin_amdgcn_global_load_lds((const unsigned*)(src0 + (size_t)row * PW + C_K + 8 * (ch > 7 ? 7 : ch)), (LAS unsigned*)(Kb + wi * 1024), 16, 0, 0);
    }
    for (int wi = F.wave; wi < 20; wi += 8) {
        const int slot = wi * 64 + F.lane, row = slot / 10, ch = slot - row * 10;
        __builtin_amdgcn_global_load_lds((const unsigned*)(src0 + (size_t)row * PW + C_V + 8 * (ch > 7 ? 7 : ch)), (LAS unsigned*)(Vb + wi * 1024), 16, 0, 0);
    }
}
__device__ __forceinline__ void attn_window_seq(const Ctx& F, int sq) {
    constexpr int KS = 144, VS = 160; const ldsp Ki = F.lds, Vi = F.lds + 512 * KS;
    const int sidx = sq >> 2, b = sidx >> 2, kvh = sidx & 3, i0 = 8 * (sq & 3);
    const int w = F.wave, lane = F.lane, i16 = lane & 15, q4 = lane >> 4, hq = 4 * kvh + (w >> 1);
    const bf16_t* kvbase = F.proj() + (size_t)b * SEQ * PW + 64 * kvh;
    __syncthreads();
    for (int t = 0; t < 3; ++t) { const int kb = 128 * (i0 - 1 + t); if (kb >= 0 && kb < SEQ) ring_stage_block(F, kvbase, kb); }
    const float sink = F.attn_sink[hq] * LOG2E;
#pragma unroll 1
    for (int k = 0; k < 8; ++k) {
        const int i = i0 + k, q0 = 128 * i + 64 * (w & 1);
        __syncthreads();
        { const int nkey0 = 128 * i + 256; if (k < 7 && nkey0 < SEQ) ring_stage_block(F, kvbase, nkey0); }
#pragma unroll 1
        for (int half = 0; half < 2; ++half) {
            const int qh = q0 + 32 * half;
            bf16x8 qf[2][2];
#pragma unroll
            for (int q = 0; q < 2; ++q)
#pragma unroll
                for (int ks = 0; ks < 2; ++ks) qf[q][ks] = *(const bf16x8*)(F.proj() + (size_t)(b * SEQ + qh + 16 * q + i16) * PW + C_Q + hq * 64 + 32 * ks + 8 * q4);
            u32x2 graw[2][4];
#pragma unroll
            for (int q = 0; q < 2; ++q)
#pragma unroll
                for (int d = 0; d < 4; ++d) graw[q][d] = *(const u32x2*)(F.proj() + (size_t)(b * SEQ + qh + 16 * q + i16) * PW + C_G + hq * 64 + 16 * d + 4 * q4);
            f32x4 o[4][2]; float m[2], lp[2];
#pragma unroll
            for (int q = 0; q < 2; ++q) { m[q] = sink; lp[q] = q4 == 0 ? 1.f : 0.f;
#pragma unroll
                for (int d = 0; d < 4; ++d) o[d][q] = (f32x4){0.f, 0.f, 0.f, 0.f}; }
#pragma unroll 1
            for (int j = 0; j < 5; ++j) {
                const int kstart = q0 - 128 + 64 * j; if (kstart < 0 || kstart >= SEQ) continue;
                const int ir = kstart & 511;
                attn_tile<64, 2>(Ki + ir * KS, KS, Vi + ir * VS, VS, qf, o, m, lp, j == 0 ? 1 : (j == 4 ? 2 : 0), lane, 32 * half);
            }
#pragma unroll
            for (int q = 0; q < 2; ++q) {
                float l = lp[q]; l += __shfl_xor(l, 16); l += __shfl_xor(l, 32); const float inv = 1.f / l;
                const size_t row = (size_t)(b * SEQ + qh + 16 * q + i16);
#pragma unroll
                for (int d = 0; d < 4; ++d) {
                    const int col = hq * 64 + 16 * d + 4 * q4;
                    const f32x4 g = unpack4(graw[q][d]);
                    *(u32x2*)(F.mix() + row * MIXP + col) = pack4(o[d][q] * inv * g);
                }
            }
        }
    }
}
__device__ __forceinline__ void attn_mem_item(const Ctx& F, int item, bool stage) {
    constexpr int KS = 272, VS = 288; const ldsp Ki = F.lds, Vi = F.lds + 256 * KS;
    const int qb = item & 15, hm = (item >> 4) & 3, b = item >> 6;
    if (stage) {
    __syncthreads();
#pragma unroll
    for (int c = F.tid; c < 4096; c += 512) {
        const int r = c >> 4, ch = c & 15;
        const bf16_t* src = F.mkv() + (size_t)(b * 256 + r) * 1024 + hm * 128 + 8 * ch;
        *(LAS u32x4*)(Ki + r * KS + ch * 16) = *(const u32x4*)(src);
        *(LAS u32x4*)(Vi + r * VS + ch * 16) = *(const u32x4*)(src + 512);
    }
    __syncthreads();
    }
    const int w = F.wave, lane = F.lane, i16 = lane & 15, q4 = lane >> 4, q0 = 256 * qb + 32 * w;
    bf16x8 qf[2][4];
#pragma unroll
    for (int q = 0; q < 2; ++q)
#pragma unroll
        for (int ks = 0; ks < 4; ++ks) qf[q][ks] = *(const bf16x8*)(F.proj() + (size_t)(b * SEQ + q0 + 16 * q + i16) * PW + C_QM + hm * 128 + 32 * ks + 8 * q4);
    f32x4 o[8][2]; float m[2], lp[2];
#pragma unroll
    for (int q = 0; q < 2; ++q) { m[q] = -INFINITY; lp[q] = 0.f;
#pragma unroll
        for (int d = 0; d < 8; ++d) o[d][q] = (f32x4){0.f, 0.f, 0.f, 0.f}; }
#pragma unroll 1
    for (int j = 0; j < 4; ++j) attn_tile<128, 2>(Ki + 64 * j * KS, KS, Vi + 64 * j * VS, VS, qf, o, m, lp, 0, lane);
#pragma unroll
    for (int q = 0; q < 2; ++q) {
        float l = lp[q]; l += __shfl_xor(l, 16); l += __shfl_xor(l, 32); const float inv = 1.f / l;
        const size_t row = (size_t)(b * SEQ + q0 + 16 * q + i16);
#pragma unroll
        for (int d = 0; d < 8; ++d) {
            const int col = hm * 128 + 16 * d + 4 * q4;
            const f32x4 g = unpack4(*(const u32x2*)(F.proj() + row * PW + C_GM + col));
            *(u32x2*)(F.mix() + row * MIXP + 1536 + col) = pack4(o[d][q] * inv * g);
        }
    }
}

constexpr int XS = 544, BS = 288, XWS = 160, PS = 272;
constexpr int L_XI = 0, L_BI = 128 * XS, L_CI = L_BI + 128 * BS, L_XW = L_CI, L_F32 = L_XW + 2 * 128 * XWS;
static_assert(L_F32 + 8192 <= LDS_XB, "lds");
__device__ __forceinline__ void ssd_dtprep(const Ctx& F, int b, int c, int g, bool write_dec) {
    LAS float* DTs = (LAS float*)(F.lds + L_F32); LAS float* ACs = DTs + 1024;
    const int w = F.wave, lane = F.lane, dir = w >> 2, r = w & 3, h = 4 * g + r, j = dir * 8 + h;
    const size_t row0 = (size_t)b * SEQ + c * 128;
    const float d0 = F.dt()[(row0 + 2 * lane) * 16 + j], d1 = F.dt()[(row0 + 2 * lane + 1) * 16 + j];
    const float a = -expf(F.a_log[j]);
    const float x0 = d0 * a, x1 = d1 * a, ps = x0 + x1; float inc = ps;
#pragma unroll
    for (int off = 1; off < 64; off <<= 1) { const float t = __shfl_up(inc, off); if (lane >= off) inc += t; }
    const float total = __shfl(inc, 63);
    float a0, a1;
    if (dir == 0) { a0 = inc - x1; a1 = inc; } else { a0 = total - (inc - ps); a1 = total - (inc - x1); }
    *(LAS f32x2*)(DTs + w * 128 + 2 * lane) = (f32x2){d0, d1};
    *(LAS f32x2*)(ACs + w * 128 + 2 * lane) = (f32x2){a0, a1};
    if (write_dec && lane == 0) F.dec()[(b * 32 + c) * 16 + j] = expf(total);
}
template <int NCOLS>
__device__ __forceinline__ void conv_img(const Ctx& F, int b, int c, int xcol, ldsp img, int stride) {
    constexpr int NCQ = NCOLS / 4, NRG = 512 / NCQ, R = 128 / NRG;
    const int cq = F.tid % NCQ, rg = F.tid / NCQ, col = xcol + 4 * cq;
    f32x4 w[5];
#pragma unroll
    for (int j = 0; j < 5; ++j) w[j] = *(const f32x4*)(F.conv_w + j * 1024 + col);
    const f32x4 bias = *(const f32x4*)(F.conv_b + col);
    const int t0 = c * 128 + rg * R - 2;
    const bf16_t* base = F.proj() + (size_t)b * SEQ * PW + C_X + col;
    f32x4 win[R + 4];
#pragma unroll
    for (int k = 0; k < R + 4; ++k) { const int t = t0 + k, tc = t < 0 ? 0 : (t >= SEQ ? SEQ - 1 : t); const u32x2 raw = *(const u32x2*)(base + (size_t)tc * PW); const bool ok = (t == tc);
        win[k] = unpack4((u32x2){ok ? raw.x : 0u, ok ? raw.y : 0u}); }
#pragma unroll
    for (int r = 0; r < R; ++r) {
        f32x4 y = bias;
#pragma unroll
        for (int j = 0; j < 5; ++j) y = y + w[j] * win[r + j];
        *(LAS u32x2*)(img + (rg * R + r) * stride + cq * 8) = pack4(silu4(y));
    }
}
__device__ __forceinline__ void ssd_pass1_item(const Ctx& F, int item) {
    const int g = item & 1, c = (item >> 1) & 31, b = item >> 6;
    const ldsp XI = F.lds + L_XI, BI = F.lds + L_BI, XW = F.lds + L_XW;
    LAS float* DTs = (LAS float*)(F.lds + L_F32); LAS float* ACs = DTs + 1024;
    __syncthreads();
    ssd_dtprep(F, b, c, g, true);
    conv_img<256>(F, b, c, 256 * g, XI, XS);
    conv_img<128>(F, b, c, 512 + 128 * g, BI, BS);
    __syncthreads();
    const int lane = F.lane, i16 = lane & 15, q4 = lane >> 4, w = F.wave;
    for (int r = 0; r < 4; ++r) {
        if (r) __syncthreads();
        {
            const int dir = F.tid >> 8, row = (F.tid >> 1) & 127, half = F.tid & 1, seq = dir * 4 + r;
            const float wgt = DTs[seq * 128 + row] * expf(ACs[seq * 128 + (dir ? 0 : 127)] - ACs[seq * 128 + row]);
#pragma unroll
            for (int k = 0; k < 4; ++k) {
                const u32x4 v = *(const LAS u32x4*)(XI + row * XS + (64 * r + 32 * half + 8 * k) * 2);
                u32x4 o;
                o.x = cvt_pk(bf_lo(v.x) * wgt, bf_hi(v.x) * wgt); o.y = cvt_pk(bf_lo(v.y) * wgt, bf_hi(v.y) * wgt);
                o.z = cvt_pk(bf_lo(v.z) * wgt, bf_hi(v.z) * wgt); o.w = cvt_pk(bf_lo(v.w) * wgt, bf_hi(v.w) * wgt);
                *(LAS u32x4*)(XW + dir * (128 * XWS) + row * XWS + (32 * half + 8 * k) * 2) = o;
            }
        }
        __syncthreads();
        const int dir = w & 1, nq = w >> 1;
        f32x4 acc[2][4];
#pragma unroll
        for (int nf = 0; nf < 2; ++nf)
#pragma unroll
            for (int pf = 0; pf < 4; ++pf) acc[nf][pf] = (f32x4){0.f, 0.f, 0.f, 0.f};
#pragma unroll
        for (int ks = 0; ks < 4; ++ks) {
            const int trow = 32 * ks + 8 * q4 + (i16 >> 2);
            bf16x8 af[2], bfr[4];
#pragma unroll
            for (int nf = 0; nf < 2; ++nf) { ldsp p = BI + trow * BS + (32 * nq + 16 * nf + 4 * (i16 & 3)) * 2; af[nf] = cat8(vtr(p), vtr(p + 4 * BS)); }
#pragma unroll
            for (int pf = 0; pf < 4; ++pf) { ldsp p = XW + dir * (128 * XWS) + trow * XWS + (16 * pf + 4 * (i16 & 3)) * 2; bfr[pf] = cat8(vtr(p), vtr(p + 4 * XWS)); }
#pragma unroll
            for (int nf = 0; nf < 2; ++nf)
#pragma unroll
                for (int pf = 0; pf < 4; ++pf) acc[nf][pf] = mfma16(af[nf], bfr[pf], acc[nf][pf]);
        }
        bf16_t* S = F.st() + ((((size_t)(b * 32 + c) * 2 + dir) * 8 + (4 * g + r)) << 13);
#pragma unroll
        for (int nf = 0; nf < 2; ++nf)
#pragma unroll
            for (int pf = 0; pf < 4; ++pf) *(u32x2*)(S + (16 * pf + i16) * 128 + 32 * nq + 16 * nf + 4 * q4) = pack4(acc[nf][pf]);
    }
}
__device__ __forceinline__ void ssd_scan(const Ctx& F) {
    for (int it = F.bid * 512 + F.tid; it < NBATCH * 2 * 8 * 1024; it += F.G * 512) {
        const int e8 = it & 1023, h = (it >> 10) & 7, dir = (it >> 13) & 1, b = it >> 14;
        float run[8];
#pragma unroll
        for (int k = 0; k < 8; ++k) run[k] = 0.f;
        for (int s0 = 0; s0 < 32; s0 += 4) {
            u32x4 v[4]; float dc[4]; bf16_t* ad[4];
#pragma unroll
            for (int u = 0; u < 4; ++u) { const int s = s0 + u, c = dir ? 31 - s : s; ad[u] = F.st() + (((((size_t)(b * 32 + c) * 2 + dir) * 8 + h) << 13) + e8 * 8); v[u] = *(const u32x4*)ad[u]; dc[u] = F.dec()[(b * 32 + c) * 16 + dir * 8 + h]; }
#pragma unroll
            for (int u = 0; u < 4; ++u) {
                *(u32x4*)ad[u] = (u32x4){cvt_pk(run[0], run[1]), cvt_pk(run[2], run[3]), cvt_pk(run[4], run[5]), cvt_pk(run[6], run[7])};
                run[0] = run[0] * dc[u] + bf_lo(v[u].x); run[1] = run[1] * dc[u] + bf_hi(v[u].x); run[2] = run[2] * dc[u] + bf_lo(v[u].y); run[3] = run[3] * dc[u] + bf_hi(v[u].y);
                run[4] = run[4] * dc[u] + bf_lo(v[u].z); run[5] = run[5] * dc[u] + bf_hi(v[u].z); run[6] = run[6] * dc[u] + bf_lo(v[u].w); run[7] = run[7] * dc[u] + bf_hi(v[u].w);
            }
        }
    }
}
__device__ __forceinline__ void ssd_pass2_item(const Ctx& F, int item) {
    const int g = item & 1, c = (item >> 1) & 31, b = item >> 6;
    const ldsp XI = F.lds + L_XI, BI = F.lds + L_BI, CI = F.lds + L_CI, PV = F.lds + L_BI;
    LAS float* DTs = (LAS float*)(F.lds + L_F32); LAS float* ACs = DTs + 1024;
    __syncthreads();
    ssd_dtprep(F, b, c, g, false);
    conv_img<256>(F, b, c, 256 * g, XI, XS);
    conv_img<128>(F, b, c, 512 + 128 * g, BI, BS);
    conv_img<128>(F, b, c, 768 + 128 * g, CI, BS);
    __syncthreads();
    const int lane = F.lane, i16 = lane & 15, q4 = lane >> 4, w = F.wave, tl = 16 * w + i16;
    bf16x8 cf[4];
#pragma unroll
    for (int ks = 0; ks < 4; ++ks) cf[ks] = ld8(CI + tl * BS + (32 * ks + 8 * q4) * 2);
    f32x4 cbt[8];
#pragma unroll
    for (int sf = 0; sf < 8; ++sf) {
        cbt[sf] = (f32x4){0.f, 0.f, 0.f, 0.f};
#pragma unroll
        for (int ks = 0; ks < 4; ++ks) cbt[sf] = mfma16(ld8(BI + (16 * sf + i16) * BS + (32 * ks + 8 * q4) * 2), cf[ks], cbt[sf]);
    }
    f32x4 gprev[4]; float ss = 0.f;
#pragma unroll
    for (int pf = 0; pf < 4; ++pf) gprev[pf] = (f32x4){0.f, 0.f, 0.f, 0.f};
    const size_t row = (size_t)b * SEQ + c * 128 + tl;
#pragma unroll 1
    for (int r = 0; r < 4; ++r) {
        const int h = 4 * g + r;
        __syncthreads();
        if (r > 0) {
#pragma unroll
            for (int pf = 0; pf < 4; ++pf) *(LAS u32x2*)(XI + tl * XS + (64 * (r - 1) + 16 * pf + 4 * q4) * 2) = pack4(gprev[pf]);
        }
        {
            const int dir = F.tid >> 8, p = (F.tid >> 2) & 63, qu = F.tid & 3;
            const bf16_t* src = F.st() + (((((size_t)(b * 32 + c) * 2 + dir) * 8 + h) << 13) + p * 128 + 32 * qu);
#pragma unroll
            for (int k = 0; k < 4; ++k) *(LAS u32x4*)(PV + dir * (64 * PS) + p * PS + (32 * qu + 8 * k) * 2) = *(const u32x4*)(src + 8 * k);
        }
        __syncthreads();
        const float acf = ACs[r * 128 + tl], acb = ACs[(4 + r) * 128 + tl];
        f32x4 yt[4];
#pragma unroll
        for (int pf = 0; pf < 4; ++pf) yt[pf] = (f32x4){0.f, 0.f, 0.f, 0.f};
#pragma unroll
        for (int kp = 0; kp < 4; ++kp) {
            f32x4 gt[2];
#pragma unroll
            for (int u = 0; u < 2; ++u) {
                const int sf = 2 * kp + u, s0 = 16 * sf + 4 * q4;
                const f32x4 dtf = *(const LAS f32x4*)(DTs + r * 128 + s0), af = *(const LAS f32x4*)(ACs + r * 128 + s0);
                const f32x4 dtb = *(const LAS f32x4*)(DTs + (4 + r) * 128 + s0), ab = *(const LAS f32x4*)(ACs + (4 + r) * 128 + s0);
#pragma unroll
                for (int e = 0; e < 4; ++e) {
                    const int s = s0 + e;
                    const float mf = s <= tl ? dtf[e] * __expf(acf - af[e]) : 0.f;
                    const float mb = s >= tl ? dtb[e] * __expf(acb - ab[e]) : 0.f;
                    gt[u][e] = cbt[sf][e] * (mf + mb);
                }
            }
            const bf16x8 gk = packfrag(gt[0], gt[1]);
#pragma unroll
            for (int pf = 0; pf < 4; ++pf) {
                ldsp xa = XI + (32 * kp + 4 * q4 + (i16 >> 2)) * XS + (64 * r + 16 * pf + 4 * (i16 & 3)) * 2;
                yt[pf] = mfma16(cat8(vtr(xa), vtr(xa + 16 * XS)), gk, yt[pf]);
            }
        }
        f32x4 yf[4], yb[4];
#pragma unroll
        for (int pf = 0; pf < 4; ++pf) { yf[pf] = (f32x4){0.f, 0.f, 0.f, 0.f}; yb[pf] = (f32x4){0.f, 0.f, 0.f, 0.f}; }
#pragma unroll
        for (int ks = 0; ks < 4; ++ks)
#pragma unroll
            for (int pf = 0; pf < 4; ++pf) {
                yf[pf] = mfma16(ld8(PV + (16 * pf + i16) * PS + (32 * ks + 8 * q4) * 2), cf[ks], yf[pf]);
                yb[pf] = mfma16(ld8(PV + 64 * PS + (16 * pf + i16) * PS + (32 * ks + 8 * q4) * 2), cf[ks], yb[pf]);
            }
        const float ef = __expf(acf), eb = __expf(acb), dsk = F.d_skip[h];
#pragma unroll
        for (int pf = 0; pf < 4; ++pf) {
            const int pc = 64 * r + 16 * pf + 4 * q4;
            const f32x4 xv = unpack4(*(const LAS u32x2*)(XI + tl * XS + pc * 2));
            const f32x4 zv = unpack4(*(const u32x2*)(F.proj() + row * PW + C_Z + 256 * g + pc));
            const f32x4 y = (yt[pf] + yf[pf] * ef + yb[pf] * eb + xv * dsk) * zv;
            gprev[pf] = y; ss += y.x * y.x + y.y * y.y + y.z * y.z + y.w * y.w;
        }
    }
    __syncthreads();
#pragma unroll
    for (int pf = 0; pf < 4; ++pf) *(LAS u32x2*)(XI + tl * XS + (64 * 3 + 16 * pf + 4 * q4) * 2) = pack4(gprev[pf]);
    ss += __shfl_xor(ss, 16); ss += __shfl_xor(ss, 32);
    const float rinv = rsqrtf(ss * (1.f / 256.f) + EPS);
#pragma unroll
    for (int r = 0; r < 4; ++r)
#pragma unroll
        for (int pf = 0; pf < 4; ++pf) {
            const int pl = 64 * r + 16 * pf + 4 * q4, pc = 256 * g + pl;
            const f32x4 nw = *(const f32x4*)(F.ssd_norm_w + pc);
            const f32x4 gv = unpack4(*(const LAS u32x2*)(XI + tl * XS + pl * 2));
            *(u32x2*)(F.mix() + row * MIXP + 1024 + pc) = pack4(gv * rinv * nw);
        }
}

__device__ __forceinline__ void final_norm(const Ctx& F) {
    const int gw = F.bid * 8 + F.wave, NGW = F.G * 8, lane = F.lane;
    for (int m = gw; m < TOK; m += NGW) {
        const f32x4* rp = (const f32x4*)(F.rowss() + (size_t)m * 16); const f32x4 s4 = (rp[0] + rp[1]) + (rp[2] + rp[3]);
        const float r = rsqrtf(((s4.x + s4.y) + (s4.z + s4.w)) * (1.f / DM) + EPS);
        float* o = F.out + (size_t)m * DM;
#pragma unroll
        for (int j = 0; j < 4; ++j) { const f32x4 v = *(const f32x4*)(o + 4 * lane + 256 * j), ww = *(const f32x4*)(F.norm_out_w + 4 * lane + 256 * j); *(f32x4*)(o + 4 * lane + 256 * j) = v * r * ww; }
    }
}

#define XB_TMO      128
#define XB_XCNT(j)  (256  + 64 * (j))
#define XB_XSUB(j)  (1280 + 64 * (j))
#define XB_XGEN(j)  (2304 + 64 * (j))
#define XB_TOP      3328
#define XB_TOPGEN   3392
#define XCD_BAR_WORDS 3456
#define XB_SPIN_CAP (1u << 18)

__device__ __forceinline__ unsigned xb_ld(unsigned* p)              { return __hip_atomic_load(p, __ATOMIC_RELAXED, __HIP_MEMORY_SCOPE_AGENT); }
__device__ __forceinline__ unsigned xb_add(unsigned* p, unsigned v) { return __hip_atomic_fetch_add(p, v, __ATOMIC_RELAXED, __HIP_MEMORY_SCOPE_AGENT); }
__device__ __forceinline__ unsigned xb_xcc_id() { return (unsigned)__builtin_amdgcn_s_getreg((3 << 11) | 20) & 0xFu; }
#define XB_SPIN(cond, bar) do { unsigned _sp = 0; while (cond) { __builtin_amdgcn_s_sleep(1); \
    if ((++_sp & 255u) == 0u) { if (xb_ld(&(bar)[XB_TMO])) break; if (_sp > XB_SPIN_CAP) { atomicAdd(&(bar)[XB_TMO], 1u); break; } } } } while (0)

struct XcdBarrier {
    unsigned* bar; unsigned x;
    volatile LAS unsigned* st;
};

__device__ __forceinline__ XcdBarrier xcd_barrier_post(unsigned* bar, volatile LAS unsigned* st, int xb_tid) {
    XcdBarrier b; b.bar = bar; b.x = xb_xcc_id(); b.st = st;
    if (xb_tid == 0) (void)xb_add(&bar[XB_XCNT(b.x)], 1u);
    return b;
}
__device__ __forceinline__ void xcd_barrier_complete(unsigned* bar, unsigned x, unsigned& nloc, unsigned& nx) {
    const unsigned G = gridDim.x * gridDim.y * gridDim.z;
    unsigned sum, cnt, mine, sp = 0u;
    for (;;) {
        sum = 0u; cnt = 0u; mine = 0u;
#pragma unroll
        for (unsigned j = 0; j < 16; ++j) { const unsigned c = xb_ld(&bar[XB_XCNT(j)]); sum += c; cnt += (c > 0u) ? 1u : 0u; mine = (j == x) ? c : mine; }
        if (sum == G) break;
        __builtin_amdgcn_s_sleep(1);
        if ((++sp & 255u) == 0u) { if (xb_ld(&bar[XB_TMO])) break; if (sp > XB_SPIN_CAP) { atomicAdd(&bar[XB_TMO], 1u); break; } }
    }
    nloc = mine > 0u ? mine : 1u; nx = cnt > 0u ? cnt : 1u;
}

__device__ __forceinline__ void xcd_barrier(const XcdBarrier& b, int xb_tid) {
    asm volatile("s_waitcnt vmcnt(0)" ::: "memory");
    __syncthreads();
    if (xb_tid == 0) {
        unsigned* bar = b.bar;
        __builtin_amdgcn_s_waitcnt(0);
        unsigned nloc = b.st[0], nx = b.st[1];
        if (nloc == 0u) { xcd_barrier_complete(bar, b.x, nloc, nx); b.st[0] = nloc; b.st[1] = nx; }
        const unsigned old = xb_add(&bar[XB_XSUB(b.x)], 1u);
        const unsigned gen = old / nloc;
        if (old + 1u == (gen + 1u) * nloc) {
            __builtin_amdgcn_fence(__ATOMIC_RELEASE, "agent");
            asm volatile("s_waitcnt vmcnt(0)" ::: "memory");
            const unsigned og = xb_add(&bar[XB_TOP], 1u);
            const unsigned tg = og / nx;
            if (og + 1u == (tg + 1u) * nx) xb_add(&bar[XB_TOPGEN], 1u);
            else XB_SPIN(xb_ld(&bar[XB_TOPGEN]) == tg, bar);
            __builtin_amdgcn_fence(__ATOMIC_ACQUIRE, "agent");
            xb_add(&bar[XB_XGEN(b.x)], 1u);
            asm volatile("s_waitcnt vmcnt(0)" ::: "memory");
        } else {
            XB_SPIN(xb_ld(&bar[XB_XGEN(b.x)]) == gen, bar);
            __builtin_amdgcn_fence(__ATOMIC_ACQUIRE, "agent");
            asm volatile("s_waitcnt vmcnt(0)" ::: "memory");
        }
    }
    __syncthreads();
}

__global__ void __launch_bounds__(512, 2) hymba_fwd(Args args) {
    extern __shared__ __attribute__((aligned(16))) unsigned char lds_raw[];
    Ctx F;
    F.x = args.in[0]; F.mem = args.in[1]; F.norm_mem_w = args.in[2]; F.norm_in_w = args.in[3]; F.w_in = args.in[4]; F.attn_sink = args.in[5]; F.conv_w = args.in[6]; F.conv_b = args.in[7];
    F.dt_bias = args.in[8]; F.a_log = args.in[9]; F.d_skip = args.in[10]; F.ssd_norm_w = args.in[11]; F.w_mem_kv = args.in[12]; F.w_out = args.in[13]; F.norm_out_w = args.in[14];
    F.out = args.out; F.ws = args.ws;
    F.lds = (ldsp)lds_raw; F.tid = threadIdx.x; F.lane = F.tid & 63; F.wave = __builtin_amdgcn_readfirstlane(F.tid >> 6); F.G = gridDim.x; F.bid = blockIdx.x;
    const int lo = args.lo, hi = args.hi;
    cg::grid_group grid = cg::this_grid();
#define IN(k) (lo <= (k) && (k) < hi)
#define REFRESH() do { F.lane = lane_id_now(); F.tid = F.wave * 64 + F.lane; } while (0)
    if (F.tid == 0) { *(LAS u32x4*)(F.lds + LDS_XB) = (u32x4){0u, 0u, 0u, 0u}; }
    __syncthreads();
    XcdBarrier xbar; xbar.bar = (unsigned*)args.ws; xbar.x = 0; xbar.st = (volatile LAS unsigned*)(F.lds + LDS_XB);
    if (hi - lo > 1) xbar = xcd_barrier_post((unsigned*)args.ws, (volatile LAS unsigned*)(F.lds + LDS_XB), F.tid);
    if (lo < 0) grid.sync();
#define SEAM(k) do { if (IN(k) && IN((k) + 1)) xcd_barrier(xbar, F.tid); } while (0)
    if (IN(0)) { REFRESH(); phase0(F); }
    SEAM(0);
    if (IN(1)) {
        REFRESH();
        { pg8::Gemm g{F.memn(), F.wmem_t(), NBATCH * 256, 1024, 1024, HNP, HNP}; pg8::StaticOrder S; S.init(g.M, g.N, F.G, F.bid); EpiMkv E{F.mkv()}; pg8::gemm_phase(F.lds, g, S, E, F.wave); }
        { pg8::Gemm g{F.hn(), F.win_t(), TOK, NPHYS, DM, HNP, HNP}; pg8::StaticOrder S; S.init(g.M, g.N, F.G, F.bid); EpiProj E{F.proj(), F.dt(), F.rope(), F.dt_bias}; pg8::gemm_phase(F.lds, g, S, E, F.wave); }
    }
    SEAM(1);
#if DBG_STOP == 1
    { grid.sync(); const int gw = F.bid * 8 + F.wave, NGW = F.G * 8;
      for (int m = gw; m < TOK; m += NGW) for (int j = 0; j < 16; ++j) { const int c = F.lane + 64 * j; float a = 0.f; for (int k = 0; k < 5; ++k) a += bf_lo(F.proj()[(size_t)m * PW + c + 1024 * k]); a += F.dt()[(size_t)m * 16 + (c & 15)] + bf_lo(F.mkv()[(size_t)(m & 4095) * 1024 + c]); F.out[(size_t)m * DM + c] = a; }
      return; }
#endif
    if (IN(2)) {
        REFRESH();
        if (args.sub & 1) for (int it = F.bid; it < NBATCH * 32 * 2; it += F.G) ssd_pass1_item(F, it);
        if (args.sub & 2) for (int sq = F.bid; sq < NBATCH * 4 * 4; sq += F.G) attn_window_seq(F, sq);
    }
    SEAM(2);
#if DBG_STOP == 2
    { grid.sync(); const int gw = F.bid * 8 + F.wave, NGW = F.G * 8;
      for (int m = gw; m < TOK; m += NGW) for (int j = 0; j < 16; ++j) { const int c = F.lane + 64 * j;
        const float a = (DBG_SEL & 1 ? bf_lo(F.mix()[(size_t)m * MIXW + c]) : 0.f), bq = (DBG_SEL & 2 ? bf_lo(F.st()[(size_t)m * 1024 + c]) : 0.f), d = (DBG_SEL & 4 ? F.dec()[(m * 1024 + c) & 8191] : 0.f);
        ((float*)F.proj())[(size_t)m * DM + c] = a + bq + d; }
      __threadfence(); grid.sync();
      for (int m = gw; m < TOK; m += NGW) for (int j = 0; j < 16; ++j) { const int c = F.lane + 64 * j; F.out[(size_t)m * DM + c] = ((float*)F.proj())[(size_t)m * DM + c]; }
      return; }
#endif
    if (IN(3)) { REFRESH(); ssd_scan(F); }
    SEAM(3);
    if (IN(4)) {
        REFRESH();
        if (args.sub & 1) for (int it = F.bid; it < NBATCH * 32 * 2; it += F.G) ssd_pass2_item(F, it);
        if (args.sub & 2) for (int grp = F.bid; grp < NBATCH * 16; grp += F.G) for (int k = 0; k < 4; ++k) attn_mem_item(F, 4 * grp + k, k == 0);
    }
    SEAM(4);
    if (IN(5)) { REFRESH(); __syncthreads(); pg8::Gemm g{F.mix(), F.wout_t(), TOK, DM, MIXW, MIXP, MIXP}; pg8::StaticOrder S; S.init(g.M, g.N, F.G, F.bid); EpiOut E{F.x, F.out, F.rowss()}; pg8::gemm_phase(F.lds, g, S, E, F.wave); }
    SEAM(5);
    if (IN(6)) { REFRESH(); final_norm(F); }
#undef IN
#undef SEAM
}

extern "C" void kernel_launch(void* const* d_in, const int* in_sizes, int n_in, void* d_out, int out_size, void* d_ws, size_t ws_size, hipStream_t stream) {
    static int grid = 0;
    if (grid == 0) {
        if (n_in != 15 || out_size != TOK * DM || ws_size < WS_END) { fprintf(stderr, "kernel_launch: unexpected shapes (n_in %d out %d ws %zu)\n", n_in, out_size, ws_size); grid = -1; return; }
        int dev = 0, cus = 0, per_cu = 0;
        (void)hipGetDevice(&dev); (void)hipDeviceGetAttribute(&cus, hipDeviceAttributeMultiprocessorCount, dev);
        if (hipFuncSetAttribute((const void*)hymba_fwd, hipFuncAttributeMaxDynamicSharedMemorySize, LDS_BYTES) != hipSuccess) { fprintf(stderr, "kernel_launch: hipFuncSetAttribute failed\n"); grid = -1; return; }
        if (hipOccupancyMaxActiveBlocksPerMultiprocessor(&per_cu, (const void*)hymba_fwd, 512, LDS_BYTES) != hipSuccess || per_cu < 1) { fprintf(stderr, "kernel_launch: occupancy query says %d\n", per_cu); per_cu = 1; }
        (void)hipGetLastError();
        grid = cus > 0 ? cus : 256;
    }
    if (grid < 0) return;
    Args a{};
    for (int i = 0; i < 15; ++i) a.in[i] = (const float*)d_in[i];
    a.out = (float*)d_out; a.ws = (unsigned char*)d_ws; a.sub = 3;
    (void)hipMemsetAsync(d_ws, 0, 16384, stream);
#if PROBE_PHASES
    for (int k = 0; k < NPHASE; ++k) if ((PROBE_PHASES >> k) & 1) { a.lo = k; a.hi = k + 1; a.sub = PROBE_SUB; hipLaunchKernelGGL(hymba_fwd, dim3(grid), dim3(512), LDS_BYTES, stream, a); }
#endif
#if MK_ONE_LAUNCH
    a.lo = 0; a.hi = NPHASE; a.sub = 3;
    void* kargs[] = {&a};
    hipError_t e = hipLaunchCooperativeKernel((const void*)hymba_fwd, dim3(grid), dim3(512), kargs, LDS_BYTES, stream);
    if (e != hipSuccess) fprintf(stderr, "kernel_launch: cooperative launch failed: %s (grid %d)\n", hipGetErrorString(e), grid);
#else
    for (int k = 0; k < NPHASE; ++k) { a.lo = k; a.hi = k + 1; hipLaunchKernelGGL(hymba_fwd, dim3(grid), dim3(512), LDS_BYTES, stream, a); }
#endif
}
```

```cpp
#include <hip/hip_runtime.h>
#include <hip/hip_cooperative_groups.h>
#include <cstdio>
#include <cstdint>
namespace cg = cooperative_groups;

#ifndef DBG_STOP
#define DBG_STOP 0
#define DBG_SEL 2
#endif
#ifndef PROBE_PHASES
#define PROBE_PHASES 0
#define PROBE_SUB 3
#endif
#ifndef MK_ONE_LAUNCH
#define MK_ONE_LAUNCH 1
#endif

#define LAS __attribute__((address_space(3)))
typedef unsigned short bf16_t;
typedef short bf16x8 __attribute__((ext_vector_type(8)));
typedef short s16x4 __attribute__((ext_vector_type(4)));
typedef float f32x4 __attribute__((ext_vector_type(4)));
typedef float f32x2 __attribute__((ext_vector_type(2)));
typedef unsigned u32x4 __attribute__((ext_vector_type(4)));
typedef unsigned u32x2 __attribute__((ext_vector_type(2)));
typedef LAS unsigned char* ldsp;

constexpr int SEQ = 4096, NBATCH = 16, TOK = SEQ * NBATCH, DM = 1024;
constexpr int INW = 5136, NPHYS = 5376, PW = 5184;
constexpr int HNP = 1088, MIXP = 2112;
constexpr int C_Q = 0, C_K = 1024, C_V = 1280, C_G = 1536, C_Z = 2560, C_X = 3072, C_QM = 4096, C_GM = 4608;
constexpr int MIXW = 2048;
constexpr float LOG2E = 1.4426950408889634f;
constexpr float EPS = 1e-6f;
constexpr int NPHASE = 7;

constexpr size_t MiB = (size_t)1 << 20;
constexpr size_t WS_ROWSS = 956 * MiB, WS_ROPE = 1 * MiB, WS_WIN = 2 * MiB, WS_WOUT = 14 * MiB, WS_WMEM = 19 * MiB, WS_MEMN = 22 * MiB,
                 WS_MKV = 31 * MiB, WS_DT = 39 * MiB, WS_DEC = 43 * MiB, WS_PROJ = 44 * MiB, WS_MIX = 692 * MiB, WS_END = 960 * MiB;

constexpr int LDS_BYTES = 155648 + 16;
constexpr int LDS_XB = 155648;

__device__ __forceinline__ unsigned cvt_pk(float lo, float hi) { unsigned r; asm volatile("v_cvt_pk_bf16_f32 %0, %1, %2" : "=v"(r) : "v"(lo), "v"(hi)); return r; }
typedef __bf16 bf16x2_t __attribute__((ext_vector_type(2)));
__device__ __forceinline__ unsigned cvt_pk_c(float lo, float hi) { const f32x2 v = {lo, hi}; return __builtin_bit_cast(unsigned, __builtin_convertvector(v, bf16x2_t)); }
__device__ __forceinline__ float bf_lo(unsigned u) { return __uint_as_float(u << 16); }
__device__ __forceinline__ float bf_hi(unsigned u) { return __uint_as_float(u & 0xffff0000u); }
__device__ __forceinline__ f32x4 unpack4(u32x2 v) { return (f32x4){bf_lo(v.x), bf_hi(v.x), bf_lo(v.y), bf_hi(v.y)}; }
__device__ __forceinline__ u32x2 pack4(f32x4 v) { return (u32x2){cvt_pk_c(v.x, v.y), cvt_pk_c(v.z, v.w)}; }
__device__ __forceinline__ float silu_f(float x) { return x * __builtin_amdgcn_rcpf(1.f + __expf(-x)); }
__device__ __forceinline__ f32x4 silu4(f32x4 v) { return (f32x4){silu_f(v.x), silu_f(v.y), silu_f(v.z), silu_f(v.w)}; }
__device__ __forceinline__ float softplus_f(float x) { return x > 20.f ? x : log1pf(expf(x)); }
__device__ __forceinline__ float ex2(float x) { return __builtin_amdgcn_exp2f(x); }
typedef short v4i16_t __attribute__((ext_vector_type(4)));
__device__ __forceinline__ s16x4 vtr(ldsp p) { return __builtin_bit_cast(s16x4, __builtin_amdgcn_ds_read_tr16_b64_v4i16((LAS v4i16_t*)p)); }
__device__ __forceinline__ bf16x8 cat8(s16x4 a, s16x4 b) { return (bf16x8){a[0], a[1], a[2], a[3], b[0], b[1], b[2], b[3]}; }
__device__ __forceinline__ bf16x8 ld8(ldsp p) { return *(const LAS bf16x8*)p; }
__device__ __forceinline__ f32x4 mfma16(bf16x8 a, bf16x8 b, f32x4 c) { return __builtin_amdgcn_mfma_f32_16x16x32_bf16(a, b, c, 0, 0, 0); }
__device__ __forceinline__ bf16x8 packfrag(f32x4 a, f32x4 b) { u32x4 r = {cvt_pk_c(a.x, a.y), cvt_pk_c(a.z, a.w), cvt_pk_c(b.x, b.y), cvt_pk_c(b.z, b.w)}; return __builtin_bit_cast(bf16x8, r); }

__device__ __forceinline__ f32x4 zero4() { f32x4 z; asm volatile("v_mov_b32 %0, 0\n\tv_mov_b32 %1, 0\n\tv_mov_b32 %2, 0\n\tv_mov_b32 %3, 0" : "=v"(z.x), "=v"(z.y), "=v"(z.z), "=v"(z.w)); return z; }
__device__ __forceinline__ int lane_id_now() { int l; asm volatile("v_mbcnt_lo_u32_b32 %0, -1, 0\n\tv_mbcnt_hi_u32_b32 %0, -1, %0" : "=v"(l)); return l; }
__host__ __device__ __forceinline__ int perm_plain(int c) { const int bj = c >> 7, wc = (c >> 5) & 3, n = (c >> 4) & 1, fq = (c >> 2) & 3, i = c & 3; return 128 * bj + 32 * wc + 8 * fq + 4 * n + i; }
__host__ __device__ __forceinline__ int perm_rot(int c) { const int bj = c >> 7, wc = (c >> 5) & 3, n = (c >> 4) & 1, fq = (c >> 2) & 3, i = c & 3; return 64 * wc + 32 * bj + 8 * fq + 4 * n + i; }

namespace pg8 {
constexpr int BM = 256, BK = 64, HALF = 128, HTB = HALF * BK * 2, STAGE_BYTES = 8 * HTB, NXCD = 8, WGM = 8;
__host__ __device__ __forceinline__ int lds_byte(int r, int c) { const int st = (r >> 4) * 2 + (c >> 5), rr = r & 15, cc = c & 31, ob = rr * 64 + cc * 2; return st * 1024 + (ob ^ (((ob >> 9) & 1) << 5)); }
__host__ __device__ __forceinline__ void stage_rc(int b, int& R, int& C) { const int st = b / 1024, sb = b % 1024, swz = sb ^ (((sb >> 9) & 1) << 5); R = (st >> 1) * 16 + swz / 64; C = (st & 1) * 32 + (swz % 64) / 2; }
struct Unit { int pm, pn; };
struct Gemm { const bf16_t* A; const bf16_t* Bt; int M, N, K, lda, ldb; };
struct StaticOrder {
    int nM, nN, nwg, G, c;
    __device__ void init(int M, int N, int G_, int c_) { nM = M / BM; nN = N / BM; nwg = nM * nN; G = G_; c = c_; }
    __device__ bool next(int i, Unit& u) const {
        const long L = (long)i * G + c; if (L >= nwg) return false;
        int wgid = (int)L; { const int q = nwg / NXCD, r = nwg % NXCD, xcd = wgid % NXCD, off = wgid / NXCD; wgid = (xcd < r ? xcd * (q + 1) : r * (q + 1) + (xcd - r) * q) + off; }
        const int nig = WGM * nN, gid = wgid / nig, fm = gid * WGM, gsz = (nM - fm) < WGM ? (nM - fm) : WGM;
        u.pm = fm + ((wgid % nig) % gsz); u.pn = (wgid % nig) / gsz; return true;
    }
};
struct PanelOrder {
    int nM, nN, G, c;
    __device__ void init(int M, int N, int G_, int c_) { nM = M / BM; nN = N / BM; G = G_; c = c_; }
    __device__ bool next(int i, Unit& u) const { const int pm = c + (i / nN) * G; if (pm >= nM) return false; u.pm = pm; u.pn = i % nN; return true; }
};

template <class Epi, class Sched>
__device__ __forceinline__ void gemm_phase(ldsp lds, const Gemm g, const Sched& S, const Epi& E, int wave_id) {
    const int lane = lane_id_now(), wid = wave_id, tid = wid * 64 + lane, wr = wid >> 2, wc = wid & 3, fr = lane & 15, fq = lane >> 4;
    const int K = g.K, nt = K / BK;
    unsigned voffA[2], voffB[2];
#pragma unroll
    for (int i = 0; i < 2; ++i) { int R, C; stage_rc(tid * 16 + i * 8192, R, C); voffA[i] = (unsigned)(R * g.lda + C) * 2u; voffB[i] = (unsigned)(R * g.ldb + C) * 2u; }
    const size_t kstep = (size_t)(BK * 2);
    const size_t hstep = (size_t)HALF * g.lda * 2, hstepB = (size_t)HALF * g.ldb * 2;
    const size_t tstep = 2 * hstep, tstepB = 2 * hstepB;
    const unsigned ldsw = (unsigned)wid * 1024u;
    const int aoff = lds_byte(wr * 64 + fr, fq * 8), boff = lds_byte(wc * 32 + fr, fq * 8);
#define PG8_SA(b, h) (((b) * 2 + (h)) * HTB)
#define PG8_SB(b, h) ((4 + (b) * 2 + (h)) * HTB)
#define PG8_STAGE(bufoff, gbase, voff) do { _Pragma("unroll") for (int _i = 0; _i < 2; ++_i) \
        __builtin_amdgcn_global_load_lds((const unsigned*)((const char*)(gbase) + (voff)[_i]), (LAS unsigned*)(lds + (bufoff) + ldsw + _i * 8192), 16, 0, 0); } while (0)
#define PG8_LDA(dst, b, h) do { _Pragma("unroll") for (int m = 0; m < 4; ++m) _Pragma("unroll") for (int k = 0; k < 2; ++k) dst[m][k] = *(const LAS bf16x8*)(lds + PG8_SA(b, h) + aoff + m * 2048 + k * 1024); } while (0)
#define PG8_LDB(dst, b, h) do { _Pragma("unroll") for (int n = 0; n < 2; ++n) _Pragma("unroll") for (int k = 0; k < 2; ++k) dst[n][k] = *(const LAS bf16x8*)(lds + PG8_SB(b, h) + boff + n * 2048 + k * 1024); } while (0)
#define PG8_MMA(ai, bj, At, Bt) do { __builtin_amdgcn_s_setprio(1); _Pragma("unroll") for (int m = 0; m < 4; ++m) _Pragma("unroll") for (int n = 0; n < 2; ++n) _Pragma("unroll") for (int k = 0; k < 2; ++k) \
        acc[ai][bj][m][n] = __builtin_amdgcn_mfma_f32_16x16x32_bf16(Bt[n][k], At[m][k], acc[ai][bj][m][n], 0, 0, 0); __builtin_amdgcn_s_setprio(0); } while (0)
#define PG8_WAIT_V(n) asm volatile("s_waitcnt vmcnt(" #n ")" ::: "memory")
#define PG8_WAIT_L(n) asm volatile("s_waitcnt lgkmcnt(" #n ")" ::: "memory")
#define PG8_BAR __builtin_amdgcn_s_barrier()
#define PG8_SCHED __builtin_amdgcn_sched_barrier(0)
    Unit cur, nxt; int ui = 0;
    if (!S.next(0, cur)) return;
    f32x4 acc[2][2][4][2];
#pragma unroll
    for (int a = 0; a < 2; ++a)
#pragma unroll
        for (int b = 0; b < 2; ++b)
#pragma unroll
            for (int m = 0; m < 4; ++m)
#pragma unroll
                for (int n = 0; n < 2; ++n) acc[a][b][m][n] = (f32x4){0.f, 0.f, 0.f, 0.f};
    bf16x8 At[4][2], B0[2][2], B1[2][2];
    const char* cA = (const char*)g.A + (size_t)cur.pm * tstep; const char* cB = (const char*)g.Bt + (size_t)cur.pn * tstepB;
    PG8_STAGE(PG8_SB(0, 0), cB, voffB); PG8_STAGE(PG8_SA(0, 0), cA, voffA); PG8_STAGE(PG8_SB(0, 1), cB + hstepB, voffB); PG8_STAGE(PG8_SA(0, 1), cA + hstep, voffA);
    if (wr == 1) PG8_BAR;
    PG8_WAIT_V(4); PG8_BAR;
    PG8_STAGE(PG8_SB(1, 0), cB + kstep, voffB); PG8_STAGE(PG8_SA(1, 0), cA + kstep, voffA); PG8_STAGE(PG8_SB(1, 1), cB + hstepB + kstep, voffB);
    PG8_WAIT_V(6); PG8_BAR;
    for (;;) {
        const bool has_next = S.next(ui + 1, nxt);
        const char* nA = has_next ? (const char*)g.A + (size_t)nxt.pm * tstep : cA; const char* nB = has_next ? (const char*)g.Bt + (size_t)nxt.pn * tstepB : cB;
        for (int t = 0; t < nt; t += 2) {
            const bool last = (t == nt - 2);
            const char* a1 = cA + (size_t)(t + 1) * kstep;
            const char* a2 = last ? nA : cA + (size_t)(t + 2) * kstep; const char* b2 = last ? nB : cB + (size_t)(t + 2) * kstep;
            const char* a3 = a2 + kstep; const char* b3 = b2 + kstep;
            PG8_LDB(B0, 0, 0); PG8_SCHED; PG8_LDA(At, 0, 0); PG8_STAGE(PG8_SA(1, 1), a1 + hstep, voffA);
            PG8_WAIT_L(8); PG8_BAR; PG8_WAIT_L(0); PG8_MMA(0, 0, At, B0); PG8_BAR; PG8_SCHED;
            PG8_LDB(B1, 0, 1); PG8_STAGE(PG8_SB(0, 0), b2, voffB);
            PG8_BAR; PG8_WAIT_L(0); PG8_MMA(0, 1, At, B1); PG8_BAR;
            PG8_LDA(At, 0, 1); PG8_STAGE(PG8_SA(0, 0), a2, voffA);
            PG8_BAR; PG8_WAIT_L(0); PG8_MMA(1, 0, At, B0); PG8_BAR; PG8_SCHED;
            PG8_STAGE(PG8_SB(0, 1), b2 + hstepB, voffB);
            PG8_WAIT_V(6); PG8_BAR; PG8_MMA(1, 1, At, B1); PG8_BAR;
            PG8_LDB(B0, 1, 0); PG8_SCHED; PG8_LDA(At, 1, 0); PG8_STAGE(PG8_SA(0, 1), a2 + hstep, voffA);
            PG8_WAIT_L(8); PG8_BAR; PG8_WAIT_L(0); PG8_MMA(0, 0, At, B0); PG8_BAR; PG8_SCHED;
            PG8_LDB(B1, 1, 1); PG8_STAGE(PG8_SB(1, 0), b3, voffB);
            PG8_BAR; PG8_WAIT_L(0); PG8_MMA(0, 1, At, B1); PG8_BAR;
            PG8_LDA(At, 1, 1); PG8_STAGE(PG8_SA(1, 0), a3, voffA);
            PG8_BAR; PG8_WAIT_L(0); PG8_MMA(1, 0, At, B0); PG8_BAR; PG8_SCHED;
            PG8_STAGE(PG8_SB(1, 1), b3 + hstepB, voffB);
            PG8_WAIT_V(6); PG8_BAR; PG8_MMA(1, 1, At, B1); PG8_BAR;
        }
        E(acc, cur, wr, wc, fr, fq);
        if (!has_next) break;
#pragma unroll
        for (int a = 0; a < 2; ++a)
#pragma unroll
            for (int b = 0; b < 2; ++b)
#pragma unroll
                for (int m = 0; m < 4; ++m)
#pragma unroll
                    for (int n = 0; n < 2; ++n) acc[a][b][m][n] = (f32x4){0.f, 0.f, 0.f, 0.f};
        cur = nxt; cA = nA; cB = nB; ++ui;
    }
    PG8_WAIT_V(0);
    if (wr == 0) PG8_BAR;
    PG8_BAR;
#undef PG8_SA
#undef PG8_SB
#undef PG8_STAGE
#undef PG8_LDA
#undef PG8_LDB
#undef PG8_MMA
#undef PG8_WAIT_V
#undef PG8_WAIT_L
#undef PG8_BAR
#undef PG8_SCHED
}
}

struct EpiProj {
    bf16_t* P; float* DT; const float* rope; const float* dt_bias;
    __device__ __forceinline__ void operator()(const f32x4 (&acc)[2][2][4][2], const pg8::Unit& u, int wr, int wc, int fr, int fq) const {
        const int row0 = u.pm * 256 + wr * 64 + fr, pn = u.pn;
        if (pn < 5) {
            const float sc = pn < 4 ? 0.125f * LOG2E : 1.f;
            const int col = pn * 256 + 64 * wc + 8 * fq;
#pragma unroll
            for (int ai = 0; ai < 2; ++ai)
#pragma unroll
                for (int m = 0; m < 4; ++m) {
                    const int row = row0 + ai * 128 + m * 16, pos = row & (SEQ - 1);
                    const f32x4* cp = (const f32x4*)(rope + pos * 32 + 8 * fq); const f32x4* sp = (const f32x4*)(rope + SEQ * 32 + pos * 32 + 8 * fq);
                    f32x4 o1[2], o2[2];
#pragma unroll
                    for (int n = 0; n < 2; ++n) { const f32x4 c = cp[n], s = sp[n], t1 = acc[ai][0][m][n], t2 = acc[ai][1][m][n]; o1[n] = (t1 * c - t2 * s) * sc; o2[n] = (t1 * s + t2 * c) * sc; }
                    bf16_t* dst = P + (size_t)row * PW + col;
                    *(u32x4*)dst = (u32x4){cvt_pk(o1[0].x, o1[0].y), cvt_pk(o1[0].z, o1[0].w), cvt_pk(o1[1].x, o1[1].y), cvt_pk(o1[1].z, o1[1].w)};
                    *(u32x4*)(dst + 32) = (u32x4){cvt_pk(o2[0].x, o2[0].y), cvt_pk(o2[0].z, o2[0].w), cvt_pk(o2[1].x, o2[1].y), cvt_pk(o2[1].z, o2[1].w)};
                }
        } else if (pn < 20) {
            const bool do_silu = (pn >= 6 && pn < 12) || pn >= 18;
            const float sc = (pn == 16 || pn == 17) ? 0.08838834764831845f * LOG2E : 1.f;
            const int col = pn * 256 + 32 * wc + 8 * fq;
#pragma unroll
            for (int ai = 0; ai < 2; ++ai)
#pragma unroll
                for (int m = 0; m < 4; ++m) {
                    const int row = row0 + ai * 128 + m * 16;
#pragma unroll
                    for (int bj = 0; bj < 2; ++bj) {
                        f32x4 v0 = acc[ai][bj][m][0], v1 = acc[ai][bj][m][1];
                        if (do_silu) { v0 = silu4(v0); v1 = silu4(v1); } else { v0 = v0 * sc; v1 = v1 * sc; }
                        *(u32x4*)(P + (size_t)row * PW + col + 128 * bj) = (u32x4){cvt_pk(v0.x, v0.y), cvt_pk(v0.z, v0.w), cvt_pk(v1.x, v1.y), cvt_pk(v1.z, v1.w)};
                    }
                }
        } else {
            if (wc == 0 && fq < 2) {
#pragma unroll
                for (int ai = 0; ai < 2; ++ai)
#pragma unroll
                    for (int m = 0; m < 4; ++m) {
                        const int row = row0 + ai * 128 + m * 16;
#pragma unroll
                        for (int n = 0; n < 2; ++n) {
                            const int j0 = 8 * fq + 4 * n; const f32x4 bb = *(const f32x4*)(dt_bias + j0); const f32x4 v = acc[ai][0][m][n] + bb;
                            *(f32x4*)(DT + (size_t)row * 16 + j0) = (f32x4){softplus_f(v.x), softplus_f(v.y), softplus_f(v.z), softplus_f(v.w)};
                        }
                    }
            }
        }
    }
};
struct EpiMkv {
    bf16_t* O;
    __device__ __forceinline__ void operator()(const f32x4 (&acc)[2][2][4][2], const pg8::Unit& u, int wr, int wc, int fr, int fq) const {
        const int row0 = u.pm * 256 + wr * 64 + fr, col = u.pn * 256 + 32 * wc + 8 * fq;
#pragma unroll
        for (int ai = 0; ai < 2; ++ai)
#pragma unroll
            for (int m = 0; m < 4; ++m) {
                const int row = row0 + ai * 128 + m * 16;
#pragma unroll
                for (int bj = 0; bj < 2; ++bj) { const f32x4 v0 = acc[ai][bj][m][0], v1 = acc[ai][bj][m][1];
                    *(u32x4*)(O + (size_t)row * 1024 + col + 128 * bj) = (u32x4){cvt_pk(v0.x, v0.y), cvt_pk(v0.z, v0.w), cvt_pk(v1.x, v1.y), cvt_pk(v1.z, v1.w)}; }
            }
    }
};
struct EpiOut {
    const float* x; float* out; float* rowss;
    __device__ __forceinline__ void operator()(const f32x4 (&acc)[2][2][4][2], const pg8::Unit& u, int wr, int wc, int fr, int fq) const {
        const int row0 = u.pm * 256 + wr * 64 + fr, col = u.pn * 256 + 32 * wc + 8 * fq;
#pragma unroll
        for (int ai = 0; ai < 2; ++ai)
#pragma unroll
            for (int m = 0; m < 4; ++m) {
                const int row = row0 + ai * 128 + m * 16; float ss = 0.f;
#pragma unroll
                for (int bj = 0; bj < 2; ++bj) {
                    const size_t o = (size_t)row * DM + col + 128 * bj;
                    const f32x4 h0 = *(const f32x4*)(x + o) + acc[ai][bj][m][0], h1 = *(const f32x4*)(x + o + 4) + acc[ai][bj][m][1];
                    *(f32x4*)(out + o) = h0; *(f32x4*)(out + o + 4) = h1;
                    ss += h0.x * h0.x + h0.y * h0.y + h0.z * h0.z + h0.w * h0.w + h1.x * h1.x + h1.y * h1.y + h1.z * h1.z + h1.w * h1.w;
                }
                ss += __shfl_xor(ss, 16); ss += __shfl_xor(ss, 32);
                if (fq == 0) rowss[(size_t)row * 16 + u.pn * 4 + wc] = ss;
            }
    }
};

struct Args { const float* in[15]; float* out; unsigned char* ws; int lo, hi, sub, pad; };
struct Ctx {
    const float *x, *mem, *norm_mem_w, *norm_in_w, *w_in, *attn_sink, *conv_w, *conv_b, *dt_bias, *a_log, *d_skip, *ssd_norm_w, *w_mem_kv, *w_out, *norm_out_w;
    float* out; unsigned char* ws;
    __device__ __forceinline__ float* rowss() const { return (float*)(ws + WS_ROWSS); }
    __device__ __forceinline__ float* rope() const { return (float*)(ws + WS_ROPE); }
    __device__ __forceinline__ bf16_t* win_t() const { return (bf16_t*)(ws + WS_WIN); }
    __device__ __forceinline__ bf16_t* wout_t() const { return (bf16_t*)(ws + WS_WOUT); }
    __device__ __forceinline__ bf16_t* wmem_t() const { return (bf16_t*)(ws + WS_WMEM); }
    __device__ __forceinline__ bf16_t* memn() const { return (bf16_t*)(ws + WS_MEMN); }
    __device__ __forceinline__ bf16_t* mkv() const { return (bf16_t*)(ws + WS_MKV); }
    __device__ __forceinline__ float* dt() const { return (float*)(ws + WS_DT); }
    __device__ __forceinline__ float* dec() const { return (float*)(ws + WS_DEC); }
    __device__ __forceinline__ bf16_t* proj() const { return (bf16_t*)(ws + WS_PROJ); }
    __device__ __forceinline__ bf16_t* mix() const { return (bf16_t*)(ws + WS_MIX); }
    __device__ __forceinline__ bf16_t* hn() const { return (bf16_t*)((unsigned char*)out); }
    __device__ __forceinline__ bf16_t* st() const { return (bf16_t*)((unsigned char*)out); }
    __device__ __forceinline__ bf16_t* yp() const { return (bf16_t*)((unsigned char*)out + 128 * MiB); }
    __device__ __forceinline__ bf16_t* cfb() const { return (bf16_t*)((unsigned char*)out + 192 * MiB); }
    __device__ __forceinline__ float* efb() const { return (float*)((unsigned char*)out + 224 * MiB); }
    ldsp lds; int tid, lane, wave, G, bid;
};

__device__ __forceinline__ void rms_row_bf16(const float* xr, const float* w, bf16_t* o, int lane) {
    f32x4 v[4]; float ss = 0.f;
#pragma unroll
    for (int j = 0; j < 4; ++j) { v[j] = *(const f32x4*)(xr + 4 * lane + 256 * j); ss += v[j].x * v[j].x + v[j].y * v[j].y + v[j].z * v[j].z + v[j].w * v[j].w; }
#pragma unroll
    for (int off = 1; off < 64; off <<= 1) ss += __shfl_xor(ss, off);
    const float r = rsqrtf(ss * (1.f / DM) + EPS);
#pragma unroll
    for (int j = 0; j < 4; ++j) { const f32x4 ww = *(const f32x4*)(w + 4 * lane + 256 * j); *(u32x2*)(o + 4 * lane + 256 * j) = pack4(v[j] * r * ww); }
}
template <int MODE>
__device__ __forceinline__ void transpose_w(const Ctx& F, const float* W, int K, int NS, bf16_t* Bt, int NP, int ldb) {
    const int nitems = NP * (K / 8);
    for (int it = F.bid * 512 + F.tid; it < nitems; it += F.G * 512) {
        const int n = it % NP, kg = it / NP, tile = n >> 8, cph = n & 255; int src;
        if (MODE == 0) {
            if (tile < 5) src = tile * 256 + perm_rot(cph);
            else if (tile < 20) { src = tile * 256 + perm_plain(cph); if (src >= 4096) src += 16; }
            else { const int l = perm_plain(cph); src = l < 16 ? 4096 + l : -1; }
        } else src = tile * 256 + perm_plain(cph);
        float v[8];
#pragma unroll
        for (int j = 0; j < 8; ++j) v[j] = src >= 0 ? W[(size_t)(kg * 8 + j) * NS + src] : 0.f;
        *(u32x4*)(Bt + (size_t)n * ldb + kg * 8) = (u32x4){cvt_pk(v[0], v[1]), cvt_pk(v[2], v[3]), cvt_pk(v[4], v[5]), cvt_pk(v[6], v[7])};
    }
}
__device__ __forceinline__ void phase0(const Ctx& F) {
    const int gt = F.bid * 512 + F.tid, NT = F.G * 512;
    for (int i = gt; i < SEQ * 32; i += NT) {
        const int pos = i >> 5, f = i & 31;
        const float inv = 1.0f / exp2f((float)f * (13.287712379549449f / 32.f));
        const float ang = (float)pos * inv;
        const double rev = (double)ang * 0.15915494309189535; const double fr = rev - __builtin_rint(rev);
        const float r = (float)(fr * 6.283185307179586);
        F.rope()[i] = __cosf(r); F.rope()[SEQ * 32 + i] = __sinf(r);
    }
    transpose_w<0>(F, F.w_in, DM, INW, F.win_t(), NPHYS, HNP);
    transpose_w<1>(F, F.w_out, MIXW, DM, F.wout_t(), DM, MIXP);
    transpose_w<1>(F, F.w_mem_kv, DM, DM, F.wmem_t(), DM, HNP);
    const int gw = F.bid * 8 + F.wave, NGW = F.G * 8;
    for (int m = gw; m < NBATCH * 256; m += NGW) rms_row_bf16(F.mem + (size_t)m * DM, F.norm_mem_w, F.memn() + (size_t)m * HNP, F.lane);
    for (int m = gw; m < TOK; m += NGW) rms_row_bf16(F.x + (size_t)m * DM, F.norm_in_w, F.hn() + (size_t)m * HNP, F.lane);
}

template <int DH, int NQF>
__device__ __forceinline__ void attn_tile(ldsp Kt, int KS, ldsp Vt, int VS, const bf16x8 (&qf)[NQF][DH / 32], f32x4 (&o)[DH / 16][NQF], float (&m)[NQF], float (&lp)[NQF], int maskmode, int lane, int qoff = 0) {
    const int i16 = lane & 15, q4 = lane >> 4;
    f32x4 st[4][NQF];
#pragma unroll
    for (int kf = 0; kf < 4; ++kf)
#pragma unroll
        for (int q = 0; q < NQF; ++q) st[kf][q] = (f32x4){0.f, 0.f, 0.f, 0.f};
#pragma unroll
    for (int ks = 0; ks < DH / 32; ++ks)
#pragma unroll
        for (int kf = 0; kf < 4; ++kf) {
            const bf16x8 ka = ld8(Kt + (16 * kf + i16) * KS + (32 * ks + 8 * q4) * 2);
#pragma unroll
            for (int q = 0; q < NQF; ++q) st[kf][q] = mfma16(ka, qf[q][ks], st[kf][q]);
            if (DH > 64 && kf == 3) __builtin_amdgcn_sched_barrier(0);
        }
    if (maskmode) {
        int zb; asm volatile("v_mov_b32 %0, 0" : "=v"(zb));
        const int base = (maskmode == 1 ? 4 * q4 - i16 - qoff : i16 + qoff - 4 * q4) + zb;
#pragma unroll
        for (int kf = 0; kf < 4; ++kf)
#pragma unroll
            for (int q = 0; q < NQF; ++q)
#pragma unroll
                for (int r = 0; r < 4; ++r) { const int off = 16 * (kf - q) + r; const bool bad = (maskmode == 1 ? base + off : base - off) < 0; if (bad) st[kf][q][r] = -INFINITY; }
    }
#pragma unroll
    for (int q = 0; q < NQF; ++q) {
        float mx = st[0][q][0];
#pragma unroll
        for (int kf = 0; kf < 4; ++kf)
#pragma unroll
            for (int r = 0; r < 4; ++r) mx = fmaxf(mx, st[kf][q][r]);
        mx = fmaxf(mx, __shfl_xor(mx, 16)); mx = fmaxf(mx, __shfl_xor(mx, 32));
        const float mn = fmaxf(m[q], mx), alpha = ex2(m[q] - mn); m[q] = mn;
        float ps = 0.f;
#pragma unroll
        for (int kf = 0; kf < 4; ++kf)
#pragma unroll
            for (int r = 0; r < 4; ++r) { const float p = ex2(st[kf][q][r] - mn); st[kf][q][r] = p; ps += p; }
        lp[q] = lp[q] * alpha + ps;
#pragma unroll
        for (int d = 0; d < DH / 16; ++d) o[d][q] = o[d][q] * alpha;
    }
#pragma unroll
    for (int kp = 0; kp < 2; ++kp) {
        bf16x8 pk[NQF];
#pragma unroll
        for (int q = 0; q < NQF; ++q) pk[q] = packfrag(st[2 * kp][q], st[2 * kp + 1][q]);
#pragma unroll
        for (int d = 0; d < DH / 16; ++d) {
            ldsp va = Vt + (32 * kp + 4 * q4 + (i16 >> 2)) * VS + (16 * d + 4 * (i16 & 3)) * 2;
            const bf16x8 vf = cat8(vtr(va), vtr(va + 16 * VS));
#pragma unroll
            for (int q = 0; q < NQF; ++q) o[d][q] = mfma16(vf, pk[q], o[d][q]);
            if (DH > 64 && (d & 3) == 3) __builtin_amdgcn_sched_barrier(0);
        }
    }
}

__device__ __forceinline__ void attn_window_item(const Ctx& F, int item) {
    constexpr int KS = 144, VS = 160; const ldsp Ki = F.lds, Vi = F.lds + 384 * KS;
    const int kvh = item & 3, i = (item >> 2) & 31, b = item >> 7;
    __syncthreads();
#pragma unroll
    for (int c = F.tid; c < 3072; c += 512) {
        const int r = c >> 3, ch = c & 7, key0 = 128 * i - 128 + r, key = key0 < 0 ? 0 : (key0 >= SEQ ? SEQ - 1 : key0);
        const bf16_t* src = F.proj() + (size_t)(b * SEQ + key) * PW + 64 * kvh + 8 * ch;
        *(LAS u32x4*)(Ki + r * KS + ch * 16) = *(const u32x4*)(src + C_K);
        *(LAS u32x4*)(Vi + r * VS + ch * 16) = *(const u32x4*)(src + C_V);
    }
    __syncthreads();
    const int w = F.wave, lane = F.lane, i16 = lane & 15, q4 = lane >> 4, hq = 4 * kvh + (w >> 1), q0 = 128 * i + 64 * (w & 1);
    bf16x8 qf[4][2];
#pragma unroll
    for (int q = 0; q < 4; ++q)
#pragma unroll
        for (int ks = 0; ks < 2; ++ks) qf[q][ks] = *(const bf16x8*)(F.proj() + (size_t)(b * SEQ + q0 + 16 * q + i16) * PW + C_Q + hq * 64 + 32 * ks + 8 * q4);
    f32x4 o[4][4]; float m[4], lp[4];
    const float sink = F.attn_sink[hq] * LOG2E;
#pragma unroll
    for (int q = 0; q < 4; ++q) { m[q] = sink; lp[q] = q4 == 0 ? 1.f : 0.f;
#pragma unroll
        for (int d = 0; d < 4; ++d) o[d][q] = (f32x4){0.f, 0.f, 0.f, 0.f}; }
#pragma unroll 1
    for (int j = 0; j < 5; ++j) {
        const int kstart = q0 - 128 + 64 * j; if (kstart < 0 || kstart >= SEQ) continue;
        const int ir = 64 * (w & 1) + 64 * j;
        attn_tile<64, 4>(Ki + ir * KS, KS, Vi + ir * VS, VS, qf, o, m, lp, j == 0 ? 1 : (j == 4 ? 2 : 0), lane);
    }
#pragma unroll
    for (int q = 0; q < 4; ++q) {
        float l = lp[q]; l += __shfl_xor(l, 16); l += __shfl_xor(l, 32); const float inv = 1.f / l;
        const size_t row = (size_t)(b * SEQ + q0 + 16 * q + i16);
#pragma unroll
        for (int d = 0; d < 4; ++d) {
            const int col = hq * 64 + 16 * d + 4 * q4;
            const f32x4 g = unpack4(*(const u32x2*)(F.proj() + row * PW + C_G + col));
            *(u32x2*)(F.mix() + row * MIXP + col) = pack4(o[d][q] * inv * g);
        }
    }
}

__device__ __forceinline__ void ring_stage_block(const Ctx& F, const bf16_t* kvbase, int keyblock) {
    constexpr int KS = 144, VS = 160; const ldsp Kb = F.lds + (keyblock & 511) * KS, Vb = F.lds + 512 * KS + (keyblock & 511) * VS;
    const bf16_t* src0 = kvbase + (size_t)keyblock * PW;
    for (int wi = F.wave; wi < 18; wi += 8) {
        const int slot = wi * 64 + F.lane, row = slot / 9, ch = slot - row * 9;
        __builtin_amdgcn_global_load_lds((const unsigned*)(src0 + (size_t)row * PW + C_K + 8 * (ch > 7 ? 7 : ch)), (LAS unsigned*)(Kb + wi * 1024), 16, 0, 0);
    }
    for (int wi = F.wave; wi < 20; wi += 8) {
        const int slot = wi * 64 + F.lane, row = slot / 10, ch = slot - row * 10;
        __builtin_amdgcn_global_load_lds((const unsigned*)(src0 + (size_t)row * PW + C_V + 8 * (ch > 7 ? 7 : ch)), (LAS unsigned*)(Vb + wi * 1024), 16, 0, 0);
    }
}
__device__ __forceinline__ void attn_window_seq(const Ctx& F, int sq) {
    constexpr int KS = 144, VS = 160; const ldsp Ki = F.lds, Vi = F.lds + 512 * KS;
    const int sidx = sq >> 2, b = sidx >> 2, kvh = sidx & 3, i0 = 8 * (sq & 3);
    const int w = F.wave, lane = F.lane, i16 = lane & 15, q4 = lane >> 4, hq = 4 * kvh + (w >> 1);
    const bf16_t* kvbase = F.proj() + (size_t)b * SEQ * PW + 64 * kvh;
    __syncthreads();
    for (int t = 0; t < 3; ++t) { const int kb = 128 * (i0 - 1 + t); if (kb >= 0 && kb < SEQ) ring_stage_block(F, kvbase, kb); }
    const float sink = F.attn_sink[hq] * LOG2E;
#pragma unroll 1
    for (int k = 0; k < 8; ++k) {
        const int i = i0 + k, q0 = 128 * i + 64 * (w & 1);
        __syncthreads();
        { const int nkey0 = 128 * i + 256; if (k < 7 && nkey0 < SEQ) ring_stage_block(F, kvbase, nkey0); }
#pragma unroll 1
        for (int half = 0; half < 2; ++half) {
            const int qh = q0 + 32 * half;
            bf16x8 qf[2][2];
#pragma unroll
            for (int q = 0; q < 2; ++q)
#pragma unroll
                for (int ks = 0; ks < 2; ++ks) qf[q][ks] = *(const bf16x8*)(F.proj() + (size_t)(b * SEQ + qh + 16 * q + i16) * PW + C_Q + hq * 64 + 32 * ks + 8 * q4);
            u32x2 graw[2][4];
#pragma unroll
            for (int q = 0; q < 2; ++q)
#pragma unroll
                for (int d = 0; d < 4; ++d) graw[q][d] = *(const u32x2*)(F.proj() + (size_t)(b * SEQ + qh + 16 * q + i16) * PW + C_G + hq * 64 + 16 * d + 4 * q4);
            f32x4 o[4][2]; float m[2], lp[2];
#pragma unroll
            for (int q = 0; q < 2; ++q) { m[q] = sink; lp[q] = q4 == 0 ? 1.f : 0.f;
#pragma unroll
                for (int d = 0; d < 4; ++d) o[d][q] = (f32x4){0.f, 0.f, 0.f, 0.f}; }
#pragma unroll 1
            for (int j = 0; j < 5; ++j) {
                const int kstart = q0 - 128 + 64 * j; if (kstart < 0 || kstart >= SEQ) continue;
                const int ir = kstart & 511;
                attn_tile<64, 2>(Ki + ir * KS, KS, Vi + ir * VS, VS, qf, o, m, lp, j == 0 ? 1 : (j == 4 ? 2 : 0), lane, 32 * half);
            }
#pragma unroll
            for (int q = 0; q < 2; ++q) {
                float l = lp[q]; l += __shfl_xor(l, 16); l += __shfl_xor(l, 32); const float inv = 1.f / l;
                const size_t row = (size_t)(b * SEQ + qh + 16 * q + i16);
#pragma unroll
                for (int d = 0; d < 4; ++d) {
                    const int col = hq * 64 + 16 * d + 4 * q4;
                    const f32x4 g = unpack4(graw[q][d]);
                    *(u32x2*)(F.mix() + row * MIXP + col) = pack4(o[d][q] * inv * g);
                }
            }
        }
    }
}
__device__ __forceinline__ void attn_mem_item(const Ctx& F, int item, bool stage) {
    constexpr int KS = 272, VS = 288; const ldsp Ki = F.lds, Vi = F.lds + 256 * KS;
    const int qb = item & 15, hm = (item >> 4) & 3, b = item >> 6;
    if (stage) {
    __syncthreads();
#pragma unroll
    for (int c = F.tid; c < 4096; c += 512) {
        const int r = c >> 4, ch = c & 15;
        const bf16_t* src = F.mkv() + (size_t)(b * 256 + r) * 1024 + hm * 128 + 8 * ch;
        *(LAS u32x4*)(Ki + r * KS + ch * 16) = *(const u32x4*)(src);
        *(LAS u32x4*)(Vi + r * VS + ch * 16) = *(const u32x4*)(src + 512);
    }
    __syncthreads();
    }
    const int w = F.wave, lane = F.lane, i16 = lane & 15, q4 = lane >> 4, q0 = 256 * qb + 32 * w;
    bf16x8 qf[2][4];
#pragma unroll
    for (int q = 0; q < 2; ++q)
#pragma unroll
        for (int ks = 0; ks < 4; ++ks) qf[q][ks] = *(const bf16x8*)(F.proj() + (size_t)(b * SEQ + q0 + 16 * q + i16) * PW + C_QM + hm * 128 + 32 * ks + 8 * q4);
    u32x2 graw[2][8];
#pragma unroll
    for (int q = 0; q < 2; ++q)
#pragma unroll
        for (int d = 0; d < 8; ++d) graw[q][d] = *(const u32x2*)(F.proj() + (size_t)(b * SEQ + q0 + 16 * q + i16) * PW + C_GM + hm * 128 + 16 * d + 4 * q4);
    f32x4 o[8][2]; float m[2], lp[2];
#pragma unroll
    for (int q = 0; q < 2; ++q) { m[q] = -INFINITY; lp[q] = 0.f;
#pragma unroll
        for (int d = 0; d < 8; ++d) o[d][q] = (f32x4){0.f, 0.f, 0.f, 0.f}; }
#pragma unroll 1
    for (int j = 0; j < 4; ++j) attn_tile<128, 2>(Ki + 64 * j * KS, KS, Vi + 64 * j * VS, VS, qf, o, m, lp, 0, lane);
#pragma unroll
    for (int q = 0; q < 2; ++q) {
        float l = lp[q]; l += __shfl_xor(l, 16); l += __shfl_xor(l, 32); const float inv = 1.f / l;
        const size_t row = (size_t)(b * SEQ + q0 + 16 * q + i16);
#pragma unroll
        for (int d = 0; d < 8; ++d) {
            const int col = hm * 128 + 16 * d + 4 * q4;
            const f32x4 g = unpack4(graw[q][d]);
            *(u32x2*)(F.mix() + row * MIXP + 1536 + col) = pack4(o[d][q] * inv * g);
        }
    }
}

constexpr int XS = 544, BS = 288, XWS = 160, PS = 272;
constexpr int L_XI = 0, L_BI = 128 * XS, L_CI = L_BI + 128 * BS, L_F32 = L_CI + 128 * BS;
static_assert(L_F32 + 12288 <= LDS_XB, "lds");
__device__ __forceinline__ void ssd_dtprep(const Ctx& F, int b, int c, int g, bool write_dec) {
    LAS float* DTs = (LAS float*)(F.lds + L_F32); LAS float* ACs = DTs + 1024;
    const int w = F.wave, lane = F.lane, dir = w >> 2, r = w & 3, h = 4 * g + r, j = dir * 8 + h;
    const size_t row0 = (size_t)b * SEQ + c * 128;
    const float d0 = F.dt()[(row0 + 2 * lane) * 16 + j], d1 = F.dt()[(row0 + 2 * lane + 1) * 16 + j];
    const float a = -expf(F.a_log[j]);
    const float x0 = d0 * a, x1 = d1 * a, ps = x0 + x1; float inc = ps;
#pragma unroll
    for (int off = 1; off < 64; off <<= 1) { const float t = __shfl_up(inc, off); if (lane >= off) inc += t; }
    const float total = __shfl(inc, 63);
    float a0, a1;
    if (dir == 0) { a0 = inc - x1; a1 = inc; } else { a0 = total - (inc - ps); a1 = total - (inc - x1); }
    *(LAS f32x2*)(DTs + w * 128 + 2 * lane) = (f32x2){d0, d1};
    *(LAS f32x2*)(ACs + w * 128 + 2 * lane) = (f32x2){a0, a1};
    *(LAS f32x2*)(ACs + 1024 + w * 128 + 2 * lane) = (f32x2){d0 * expf(total - a0), d1 * expf(total - a1)};
    if (write_dec && lane == 0) F.dec()[(b * 32 + c) * 16 + j] = expf(total);
}
template <int NCOLS>
__device__ __forceinline__ void conv_img(const Ctx& F, int b, int c, int xcol, ldsp img, int stride) {
    constexpr int NCQ = NCOLS / 4, NRG = 512 / NCQ, R = 128 / NRG;
    const int cq = F.tid % NCQ, rg = F.tid / NCQ, col = xcol + 4 * cq;
    f32x4 w[5];
#pragma unroll
    for (int j = 0; j < 5; ++j) w[j] = *(const f32x4*)(F.conv_w + j * 1024 + col);
    const f32x4 bias = *(const f32x4*)(F.conv_b + col);
    const int t0 = c * 128 + rg * R - 2;
    const bf16_t* base = F.proj() + (size_t)b * SEQ * PW + C_X + col;
    f32x4 win[R + 4];
#pragma unroll
    for (int k = 0; k < R + 4; ++k) { const int t = t0 + k, tc = t < 0 ? 0 : (t >= SEQ ? SEQ - 1 : t); const u32x2 raw = *(const u32x2*)(base + (size_t)tc * PW); const bool ok = (t == tc);
        win[k] = unpack4((u32x2){ok ? raw.x : 0u, ok ? raw.y : 0u}); }
#pragma unroll
    for (int r = 0; r < R; ++r) {
        f32x4 y = bias;
#pragma unroll
        for (int j = 0; j < 5; ++j) y = y + w[j] * win[r + j];
        *(LAS u32x2*)(img + (rg * R + r) * stride + cq * 8) = pack4(silu4(y));
    }
}
__device__ __forceinline__ void ssd_pass1_item(const Ctx& F, int item) {
    const int g = item & 1, c = (item >> 1) & 31, b = item >> 6;
    const ldsp XI = F.lds + L_XI, BI = F.lds + L_BI, CI = F.lds + L_CI;
    LAS float* DTs = (LAS float*)(F.lds + L_F32); LAS float* ACs = DTs + 1024;
    __syncthreads();
    ssd_dtprep(F, b, c, g, true);
    conv_img<256>(F, b, c, 256 * g, XI, XS);
    conv_img<128>(F, b, c, 512 + 128 * g, BI, BS);
    conv_img<128>(F, b, c, 768 + 128 * g, CI, BS);
    __syncthreads();
    const int lane = F.lane, i16 = lane & 15, q4 = lane >> 4, w = F.wave, tl = 16 * w + i16;
    const size_t row = (size_t)b * SEQ + c * 128 + tl;
    f32x4 cbt[8];
    {
        bf16x8 cf[4];
#pragma unroll
        for (int ks = 0; ks < 4; ++ks) cf[ks] = ld8(CI + tl * BS + (32 * ks + 8 * q4) * 2);
#pragma unroll
        for (int ks = 0; ks < 4; ++ks) *(bf16x8*)(F.cfb() + ((size_t)(item * 8 + w) * 64 + lane) * 32 + 8 * ks) = cf[ks];
#pragma unroll
        for (int sf = 0; sf < 8; ++sf) {
            cbt[sf] = (f32x4){0.f, 0.f, 0.f, 0.f};
#pragma unroll
            for (int ks = 0; ks < 4; ++ks) cbt[sf] = mfma16(ld8(BI + (16 * sf + i16) * BS + (32 * ks + 8 * q4) * 2), cf[ks], cbt[sf]);
        }
    }
#pragma unroll 1
    for (int r = 0; r < 4; ++r) {
        {
            const int dir = w & 1, nq = w >> 1;
            LAS const float* Wr = ACs + 1024 + (dir * 4 + r) * 128;
            f32x4 acc[2][4];
#pragma unroll
            for (int nf = 0; nf < 2; ++nf)
#pragma unroll
                for (int pf = 0; pf < 4; ++pf) acc[nf][pf] = (f32x4){0.f, 0.f, 0.f, 0.f};
#pragma unroll
            for (int ks = 0; ks < 4; ++ks) {
                const int t0 = 32 * ks + 8 * q4, trow = t0 + (i16 >> 2);
                const f32x4 wlo = *(const LAS f32x4*)(Wr + t0), whi = *(const LAS f32x4*)(Wr + t0 + 4);
                bf16x8 af[2], bfr[4];
#pragma unroll
                for (int nf = 0; nf < 2; ++nf) {
                    ldsp p = BI + trow * BS + (32 * nq + 16 * nf + 4 * (i16 & 3)) * 2;
                    const u32x2 lo = __builtin_bit_cast(u32x2, vtr(p)), hi = __builtin_bit_cast(u32x2, vtr(p + 4 * BS));
                    af[nf] = packfrag(unpack4(lo) * wlo, unpack4(hi) * whi);
                }
#pragma unroll
                for (int pf = 0; pf < 4; ++pf) { ldsp p = XI + trow * XS + (64 * r + 16 * pf + 4 * (i16 & 3)) * 2; bfr[pf] = cat8(vtr(p), vtr(p + 4 * XS)); }
#pragma unroll
                for (int nf = 0; nf < 2; ++nf)
#pragma unroll
                    for (int pf = 0; pf < 4; ++pf) acc[nf][pf] = mfma16(af[nf], bfr[pf], acc[nf][pf]);
            }
            bf16_t* S = F.st() + ((((size_t)(b * 32 + c) * 2 + dir) * 8 + (4 * g + r)) << 13);
#pragma unroll
            for (int nf = 0; nf < 2; ++nf)
#pragma unroll
                for (int pf = 0; pf < 4; ++pf) *(u32x2*)(S + (16 * pf + i16) * 128 + 32 * nq + 16 * nf + 4 * q4) = pack4(acc[nf][pf]);
        }
        {
            const float acf = ACs[r * 128 + tl], acb = ACs[(4 + r) * 128 + tl];
            f32x4 yt[4];
#pragma unroll
            for (int pf = 0; pf < 4; ++pf) yt[pf] = (f32x4){0.f, 0.f, 0.f, 0.f};
#pragma unroll
            for (int kp = 0; kp < 4; ++kp) {
                f32x4 gt[2];
#pragma unroll
                for (int u = 0; u < 2; ++u) {
                    const int sf = 2 * kp + u, s0 = 16 * sf + 4 * q4;
                    const f32x4 dtf = *(const LAS f32x4*)(DTs + r * 128 + s0), af = *(const LAS f32x4*)(ACs + r * 128 + s0);
                    const f32x4 dtb = *(const LAS f32x4*)(DTs + (4 + r) * 128 + s0), ab = *(const LAS f32x4*)(ACs + (4 + r) * 128 + s0);
#pragma unroll
                    for (int e = 0; e < 4; ++e) {
                        const int sx = s0 + e;
                        const float mf = sx <= tl ? dtf[e] * __expf(acf - af[e]) : 0.f;
                        const float mb = sx >= tl ? dtb[e] * __expf(acb - ab[e]) : 0.f;
                        gt[u][e] = cbt[sf][e] * (mf + mb);
                    }
                }
                const bf16x8 gk = packfrag(gt[0], gt[1]);
#pragma unroll
                for (int pf = 0; pf < 4; ++pf) {
                    ldsp xa = XI + (32 * kp + 4 * q4 + (i16 >> 2)) * XS + (64 * r + 16 * pf + 4 * (i16 & 3)) * 2;
                    yt[pf] = mfma16(cat8(vtr(xa), vtr(xa + 16 * XS)), gk, yt[pf]);
                }
            }
            const float dsk = F.d_skip[4 * g + r];
#pragma unroll
            for (int pf = 0; pf < 4; ++pf) {
                const int pc = 64 * r + 16 * pf + 4 * q4;
                const f32x4 xv = unpack4(*(const LAS u32x2*)(XI + tl * XS + pc * 2));
                *(u32x2*)(F.yp() + row * 512 + 256 * g + pc) = pack4(yt[pf] + xv * dsk);
            }
            if (q4 == 0) { F.efb()[row * 16 + 4 * g + r] = __expf(acf); F.efb()[row * 16 + 8 + 4 * g + r] = __expf(acb); }
        }
    }
}
__device__ __forceinline__ void ssd_scan(const Ctx& F) {
    for (int it = F.bid * 512 + F.tid; it < NBATCH * 2 * 8 * 1024; it += F.G * 512) {
        const int e8 = it & 1023, h = (it >> 10) & 7, dir = (it >> 13) & 1, b = it >> 14;
        float run[8];
#pragma unroll
        for (int k = 0; k < 8; ++k) run[k] = 0.f;
        for (int s0 = 0; s0 < 32; s0 += 4) {
            u32x4 v[4]; float dc[4]; bf16_t* ad[4];
#pragma unroll
            for (int u = 0; u < 4; ++u) { const int s = s0 + u, c = dir ? 31 - s : s; ad[u] = F.st() + (((((size_t)(b * 32 + c) * 2 + dir) * 8 + h) << 13) + e8 * 8); v[u] = *(const u32x4*)ad[u]; dc[u] = F.dec()[(b * 32 + c) * 16 + dir * 8 + h]; }
#pragma unroll
            for (int u = 0; u < 4; ++u) {
                *(u32x4*)ad[u] = (u32x4){cvt_pk(run[0], run[1]), cvt_pk(run[2], run[3]), cvt_pk(run[4], run[5]), cvt_pk(run[6], run[7])};
                run[0] = run[0] * dc[u] + bf_lo(v[u].x); run[1] = run[1] * dc[u] + bf_hi(v[u].x); run[2] = run[2] * dc[u] + bf_lo(v[u].y); run[3] = run[3] * dc[u] + bf_hi(v[u].y);
                run[4] = run[4] * dc[u] + bf_lo(v[u].z); run[5] = run[5] * dc[u] + bf_hi(v[u].z); run[6] = run[6] * dc[u] + bf_lo(v[u].w); run[7] = run[7] * dc[u] + bf_hi(v[u].w);
            }
        }
    }
}
__device__ __forceinline__ void ssd_pass2_item(const Ctx& F, int item) {
    const int g = item & 1, c = (item >> 1) & 31, b = item >> 6;
    const ldsp PV = F.lds;
    const int lane = F.lane, i16 = lane & 15, q4 = lane >> 4, w = F.wave, tl = 16 * w + i16;
    const size_t row = (size_t)b * SEQ + c * 128 + tl;
    bf16x8 cf[4];
#pragma unroll
    for (int ks = 0; ks < 4; ++ks) cf[ks] = *(const bf16x8*)(F.cfb() + ((size_t)(item * 8 + w) * 64 + lane) * 32 + 8 * ks);
    const int pdir = F.tid >> 8, pp = (F.tid >> 2) & 63, pqu = F.tid & 3;
    const bf16_t* psrc = F.st() + (((((size_t)(b * 32 + c) * 2 + pdir) * 8 + 4 * g) << 13) + pp * 128 + 32 * pqu);
    u32x4 pvn[4][4];
#pragma unroll
    for (int r = 0; r < 4; ++r)
#pragma unroll
        for (int k = 0; k < 4; ++k) pvn[r][k] = *(const u32x4*)(psrc + ((size_t)r << 13) + 8 * k);
    __syncthreads();
#pragma unroll
    for (int r = 0; r < 4; ++r)
#pragma unroll
        for (int k = 0; k < 4; ++k) *(LAS u32x4*)(PV + (2 * r + pdir) * (64 * PS) + pp * PS + (32 * pqu + 8 * k) * 2) = pvn[r][k];
    __syncthreads();
    f32x4 gy[4][4]; float ss = 0.f;
#pragma unroll
    for (int r = 0; r < 4; ++r) {
        u32x2 zraw[4], yraw[4];
#pragma unroll
        for (int pf = 0; pf < 4; ++pf) { const int pc = 256 * g + 64 * r + 16 * pf + 4 * q4; zraw[pf] = *(const u32x2*)(F.proj() + row * PW + C_Z + pc); yraw[pf] = *(const u32x2*)(F.yp() + row * 512 + pc); }
        const float ef = F.efb()[row * 16 + 4 * g + r], eb = F.efb()[row * 16 + 8 + 4 * g + r];
        const ldsp PVr = PV + 2 * r * (64 * PS);
        f32x4 yf[4], yb[4];
#pragma unroll
        for (int pf = 0; pf < 4; ++pf) { yf[pf] = (f32x4){0.f, 0.f, 0.f, 0.f}; yb[pf] = (f32x4){0.f, 0.f, 0.f, 0.f}; }
#pragma unroll
        for (int ks = 0; ks < 4; ++ks)
#pragma unroll
            for (int pf = 0; pf < 4; ++pf) {
                yf[pf] = mfma16(ld8(PVr + (16 * pf + i16) * PS + (32 * ks + 8 * q4) * 2), cf[ks], yf[pf]);
                yb[pf] = mfma16(ld8(PVr + 64 * PS + (16 * pf + i16) * PS + (32 * ks + 8 * q4) * 2), cf[ks], yb[pf]);
            }
#pragma unroll
        for (int pf = 0; pf < 4; ++pf) {
            const f32x4 y = (unpack4(yraw[pf]) + yf[pf] * ef + yb[pf] * eb) * unpack4(zraw[pf]);
            gy[r][pf] = y; ss += y.x * y.x + y.y * y.y + y.z * y.z + y.w * y.w;
        }
    }
    ss += __shfl_xor(ss, 16); ss += __shfl_xor(ss, 32);
    const float rinv = rsqrtf(ss * (1.f / 256.f) + EPS);
#pragma unroll
    for (int r = 0; r < 4; ++r)
#pragma unroll
        for (int pf = 0; pf < 4; ++pf) {
            const int pc = 256 * g + 64 * r + 16 * pf + 4 * q4;
            const f32x4 nw = *(const f32x4*)(F.ssd_norm_w + pc);
            *(u32x2*)(F.mix() + row * MIXP + 1024 + pc) = pack4(gy[r][pf] * rinv * nw);
        }
}

__device__ __forceinline__ void final_norm(const Ctx& F) {
    const int gw = F.bid * 8 + F.wave, NGW = F.G * 8, lane = F.lane;
    for (int m = gw; m < TOK; m += NGW) {
        const f32x4* rp = (const f32x4*)(F.rowss() + (size_t)m * 16); const f32x4 s4 = (rp[0] + rp[1]) + (rp[2] + rp[3]);
        const float r = rsqrtf(((s4.x + s4.y) + (s4.z + s4.w)) * (1.f / DM) + EPS);
        float* o = F.out + (size_t)m * DM;
#pragma unroll
        for (int j = 0; j < 4; ++j) { const f32x4 v = *(const f32x4*)(o + 4 * lane + 256 * j), ww = *(const f32x4*)(F.norm_out_w + 4 * lane + 256 * j); *(f32x4*)(o + 4 * lane + 256 * j) = v * r * ww; }
    }
}

#define XB_TMO      128
#define XB_XCNT(j)  (256  + 64 * (j))
#define XB_XSUB(j)  (1280 + 64 * (j))
#define XB_XGEN(j)  (2304 + 64 * (j))
#define XB_TOP      3328
#define XB_TOPGEN   3392
#define XCD_BAR_WORDS 3456
#define XB_SPIN_CAP (1u << 18)

__device__ __forceinline__ unsigned xb_ld(unsigned* p)              { return __hip_atomic_load(p, __ATOMIC_RELAXED, __HIP_MEMORY_SCOPE_AGENT); }
__device__ __forceinline__ unsigned xb_add(unsigned* p, unsigned v) { return __hip_atomic_fetch_add(p, v, __ATOMIC_RELAXED, __HIP_MEMORY_SCOPE_AGENT); }
__device__ __forceinline__ unsigned xb_xcc_id() { return (unsigned)__builtin_amdgcn_s_getreg((3 << 11) | 20) & 0xFu; }
#define XB_SPIN(cond, bar) do { unsigned _sp = 0; while (cond) { __builtin_amdgcn_s_sleep(1); \
    if ((++_sp & 255u) == 0u) { if (xb_ld(&(bar)[XB_TMO])) break; if (_sp > XB_SPIN_CAP) { atomicAdd(&(bar)[XB_TMO], 1u); break; } } } } while (0)

struct XcdBarrier {
    unsigned* bar; unsigned x;
    volatile LAS unsigned* st;
};

__device__ __forceinline__ XcdBarrier xcd_barrier_post(unsigned* bar, volatile LAS unsigned* st, int xb_tid) {
    XcdBarrier b; b.bar = bar; b.x = xb_xcc_id(); b.st = st;
    if (xb_tid == 0) (void)xb_add(&bar[XB_XCNT(b.x)], 1u);
    return b;
}
__device__ __forceinline__ void xcd_barrier_complete(unsigned* bar, unsigned x, unsigned& nloc, unsigned& nx) {
    const unsigned G = gridDim.x * gridDim.y * gridDim.z;
    unsigned sum, cnt, mine, sp = 0u;
    for (;;) {
        sum = 0u; cnt = 0u; mine = 0u;
#pragma unroll
        for (unsigned j = 0; j < 16; ++j) { const unsigned c = xb_ld(&bar[XB_XCNT(j)]); sum += c; cnt += (c > 0u) ? 1u : 0u; mine = (j == x) ? c : mine; }
        if (sum == G) break;
        __builtin_amdgcn_s_sleep(1);
        if ((++sp & 255u) == 0u) { if (xb_ld(&bar[XB_TMO])) break; if (sp > XB_SPIN_CAP) { atomicAdd(&bar[XB_TMO], 1u); break; } }
    }
    nloc = mine > 0u ? mine : 1u; nx = cnt > 0u ? cnt : 1u;
}

__device__ __forceinline__ void xcd_barrier(const XcdBarrier& b, int xb_tid) {
    asm volatile("s_waitcnt vmcnt(0)" ::: "memory");
    __syncthreads();
    if (xb_tid == 0) {
        unsigned* bar = b.bar;
        __builtin_amdgcn_s_waitcnt(0);
        unsigned nloc = b.st[0], nx = b.st[1];
        if (nloc == 0u) { xcd_barrier_complete(bar, b.x, nloc, nx); b.st[0] = nloc; b.st[1] = nx; }
        const unsigned old = xb_add(&bar[XB_XSUB(b.x)], 1u);
        const unsigned gen = old / nloc;
        if (old + 1u == (gen + 1u) * nloc) {
            __builtin_amdgcn_fence(__ATOMIC_RELEASE, "agent");
            asm volatile("s_waitcnt vmcnt(0)" ::: "memory");
            const unsigned og = xb_add(&bar[XB_TOP], 1u);
            const unsigned tg = og / nx;
            if (og + 1u == (tg + 1u) * nx) xb_add(&bar[XB_TOPGEN], 1u);
            else XB_SPIN(xb_ld(&bar[XB_TOPGEN]) == tg, bar);
            __builtin_amdgcn_fence(__ATOMIC_ACQUIRE, "agent");
            xb_add(&bar[XB_XGEN(b.x)], 1u);
            asm volatile("s_waitcnt vmcnt(0)" ::: "memory");
        } else {
            XB_SPIN(xb_ld(&bar[XB_XGEN(b.x)]) == gen, bar);
            __builtin_amdgcn_fence(__ATOMIC_ACQUIRE, "agent");
            asm volatile("s_waitcnt vmcnt(0)" ::: "memory");
        }
    }
    __syncthreads();
}

__global__ void __launch_bounds__(512, 2) hymba_fwd(Args args) {
    extern __shared__ __attribute__((aligned(16))) unsigned char lds_raw[];
    Ctx F;
    F.x = args.in[0]; F.mem = args.in[1]; F.norm_mem_w = args.in[2]; F.norm_in_w = args.in[3]; F.w_in = args.in[4]; F.attn_sink = args.in[5]; F.conv_w = args.in[6]; F.conv_b = args.in[7];
    F.dt_bias = args.in[8]; F.a_log = args.in[9]; F.d_skip = args.in[10]; F.ssd_norm_w = args.in[11]; F.w_mem_kv = args.in[12]; F.w_out = args.in[13]; F.norm_out_w = args.in[14];
    F.out = args.out; F.ws = args.ws;
    F.lds = (ldsp)lds_raw; F.tid = threadIdx.x; F.lane = F.tid & 63; F.wave = __builtin_amdgcn_readfirstlane(F.tid >> 6); F.G = gridDim.x; F.bid = blockIdx.x;
    const int lo = args.lo, hi = args.hi;
    cg::grid_group grid = cg::this_grid();
#define IN(k) (lo <= (k) && (k) < hi)
#define REFRESH() do { F.lane = lane_id_now(); F.tid = F.wave * 64 + F.lane; } while (0)
    if (F.tid == 0) { *(LAS u32x4*)(F.lds + LDS_XB) = (u32x4){0u, 0u, 0u, 0u}; }
    __syncthreads();
    XcdBarrier xbar; xbar.bar = (unsigned*)args.ws; xbar.x = 0; xbar.st = (volatile LAS unsigned*)(F.lds + LDS_XB);
    if (hi - lo > 1) xbar = xcd_barrier_post((unsigned*)args.ws, (volatile LAS unsigned*)(F.lds + LDS_XB), F.tid);
    if (lo < 0) grid.sync();
#define SEAM(k) do { if (IN(k) && IN((k) + 1)) xcd_barrier(xbar, F.tid); } while (0)
    if (IN(0)) { REFRESH(); phase0(F); }
    SEAM(0);
    if (IN(1)) {
        REFRESH();
        { pg8::Gemm g{F.memn(), F.wmem_t(), NBATCH * 256, 1024, 1024, HNP, HNP}; pg8::StaticOrder S; S.init(g.M, g.N, F.G, F.bid); EpiMkv E{F.mkv()}; pg8::gemm_phase(F.lds, g, S, E, F.wave); }
        { pg8::Gemm g{F.hn(), F.win_t(), TOK, NPHYS, DM, HNP, HNP}; pg8::StaticOrder S; S.init(g.M, g.N, F.G, F.bid); EpiProj E{F.proj(), F.dt(), F.rope(), F.dt_bias}; pg8::gemm_phase(F.lds, g, S, E, F.wave); }
    }
    SEAM(1);
#if DBG_STOP == 1
    { grid.sync(); const int gw = F.bid * 8 + F.wave, NGW = F.G * 8;
      for (int m = gw; m < TOK; m += NGW) for (int j = 0; j < 16; ++j) { const int c = F.lane + 64 * j; float a = 0.f; for (int k = 0; k < 5; ++k) a += bf_lo(F.proj()[(size_t)m * PW + c + 1024 * k]); a += F.dt()[(size_t)m * 16 + (c & 15)] + bf_lo(F.mkv()[(size_t)(m & 4095) * 1024 + c]); F.out[(size_t)m * DM + c] = a; }
      return; }
#endif
    if (IN(2)) {
        REFRESH();
        if (args.sub & 1) for (int it = F.bid; it < NBATCH * 32 * 2; it += F.G) ssd_pass1_item(F, it);
        if (args.sub & 2) for (int sq = F.bid; sq < NBATCH * 4 * 4; sq += F.G) attn_window_seq(F, sq);
    }
    SEAM(2);
#if DBG_STOP == 2
    { grid.sync(); const int gw = F.bid * 8 + F.wave, NGW = F.G * 8;
      for (int m = gw; m < TOK; m += NGW) for (int j = 0; j < 16; ++j) { const int c = F.lane + 64 * j;
        const float a = (DBG_SEL & 1 ? bf_lo(F.mix()[(size_t)m * MIXW + c]) : 0.f), bq = (DBG_SEL & 2 ? bf_lo(F.st()[(size_t)m * 1024 + c]) : 0.f), d = (DBG_SEL & 4 ? F.dec()[(m * 1024 + c) & 8191] : 0.f);
        ((float*)F.proj())[(size_t)m * DM + c] = a + bq + d; }
      __threadfence(); grid.sync();
      for (int m = gw; m < TOK; m += NGW) for (int j = 0; j < 16; ++j) { const int c = F.lane + 64 * j; F.out[(size_t)m * DM + c] = ((float*)F.proj())[(size_t)m * DM + c]; }
      return; }
#endif
    if (IN(3)) { REFRESH(); ssd_scan(F); }
    SEAM(3);
    if (IN(4)) {
        REFRESH();
        if (args.sub & 1) for (int it = F.bid; it < NBATCH * 32 * 2; it += F.G) ssd_pass2_item(F, it);
        if (args.sub & 2) for (int grp = F.bid; grp < NBATCH * 16; grp += F.G) for (int k = 0; k < 4; ++k) attn_mem_item(F, 4 * grp + k, k == 0);
    }
    SEAM(4);
    if (IN(5)) { REFRESH(); __syncthreads(); pg8::Gemm g{F.mix(), F.wout_t(), TOK, DM, MIXW, MIXP, MIXP}; pg8::StaticOrder S; S.init(g.M, g.N, F.G, F.bid); EpiOut E{F.x, F.out, F.rowss()}; pg8::gemm_phase(F.lds, g, S, E, F.wave); }
    SEAM(5);
    if (IN(6)) { REFRESH(); final_norm(F); }
#undef IN
#undef SEAM
}

extern "C" void kernel_launch(void* const* d_in, const int* in_sizes, int n_in, void* d_out, int out_size, void* d_ws, size_t ws_size, hipStream_t stream) {
    static int grid = 0;
    if (grid == 0) {
        if (n_in != 15 || out_size != TOK * DM || ws_size < WS_END) { fprintf(stderr, "kernel_launch: unexpected shapes (n_in %d out %d ws %zu)\n", n_in, out_size, ws_size); grid = -1; return; }
        int dev = 0, cus = 0, per_cu = 0;
        (void)hipGetDevice(&dev); (void)hipDeviceGetAttribute(&cus, hipDeviceAttributeMultiprocessorCount, dev);
        if (hipFuncSetAttribute((const void*)hymba_fwd, hipFuncAttributeMaxDynamicSharedMemorySize, LDS_BYTES) != hipSuccess) { fprintf(stderr, "kernel_launch: hipFuncSetAttribute failed\n"); grid = -1; return; }
        if (hipOccupancyMaxActiveBlocksPerMultiprocessor(&per_cu, (const void*)hymba_fwd, 512, LDS_BYTES) != hipSuccess || per_cu < 1) { fprintf(stderr, "kernel_launch: occupancy query says %d\n", per_cu); per_cu = 1; }
        (void)hipGetLastError();
        grid = cus > 0 ? cus : 256;
    }
    if (grid < 0) return;
    Args a{};
    for (int i = 0; i < 15; ++i) a.in[i] = (const float*)d_in[i];
    a.out = (float*)d_out; a.ws = (unsigned char*)d_ws; a.sub = 3;
    (void)hipMemsetAsync(d_ws, 0, 16384, stream);
#if PROBE_PHASES
    for (int k = 0; k < NPHASE; ++k) if ((PROBE_PHASES >> k) & 1) { a.lo = k; a.hi = k + 1; a.sub = PROBE_SUB; hipLaunchKernelGGL(hymba_fwd, dim3(grid), dim3(512), LDS_BYTES, stream, a); }
#endif
#if MK_ONE_LAUNCH
    a.lo = 0; a.hi = NPHASE; a.sub = 3;
    void* kargs[] = {&a};
    hipError_t e = hipLaunchCooperativeKernel((const void*)hymba_fwd, dim3(grid), dim3(512), kargs, LDS_BYTES, stream);
    if (e != hipSuccess) fprintf(stderr, "kernel_launch: cooperative launch failed: %s (grid %d)\n", hipGetErrorString(e), grid);
#else
    for (int k = 0; k < NPHASE; ++k) { a.lo = k; a.hi = k + 1; hipLaunchKernelGGL(hymba_fwd, dim3(grid), dim3(512), LDS_BYTES, stream, a); }
#endif
}
```

```cpp
#include <hip/hip_runtime.h>
#include <hip/hip_cooperative_groups.h>
#include <cstdio>
#include <cstdint>
namespace cg = cooperative_groups;

#ifndef DBG_STOP
#define DBG_STOP 0
#define DBG_SEL 2
#endif
#ifndef PROBE_PHASES
#define PROBE_PHASES 0
#define PROBE_SUB 3
#endif
#ifndef MK_ONE_LAUNCH
#define MK_ONE_LAUNCH 1
#endif

#define LAS __attribute__((address_space(3)))
typedef unsigned short bf16_t;
typedef short bf16x8 __attribute__((ext_vector_type(8)));
typedef short s16x4 __attribute__((ext_vector_type(4)));
typedef float f32x4 __attribute__((ext_vector_type(4)));
typedef float f32x2 __attribute__((ext_vector_type(2)));
typedef unsigned u32x4 __attribute__((ext_vector_type(4)));
typedef unsigned u32x2 __attribute__((ext_vector_type(2)));
typedef LAS unsigned char* ldsp;

constexpr int SEQ = 4096, NBATCH = 16, TOK = SEQ * NBATCH, DM = 1024;
constexpr int INW = 5136, NPHYS = 5376, PW = 5184;
constexpr int HNP = 1088, MIXP = 2112;
constexpr int C_Q = 0, C_K = 1024, C_V = 1280, C_G = 1536, C_Z = 2560, C_X = 3072, C_QM = 4096, C_GM = 4608;
constexpr int MIXW = 2048;
constexpr float LOG2E = 1.4426950408889634f;
constexpr float EPS = 1e-6f;
constexpr int NPHASE = 7;

constexpr size_t MiB = (size_t)1 << 20;
constexpr size_t WS_ROWSS = 956 * MiB, WS_ROPE = 1 * MiB, WS_WIN = 2 * MiB, WS_WOUT = 14 * MiB, WS_WMEM = 19 * MiB, WS_MEMN = 22 * MiB,
                 WS_MKV = 31 * MiB, WS_DT = 39 * MiB, WS_DEC = 43 * MiB, WS_PROJ = 44 * MiB, WS_MIX = 692 * MiB, WS_END = 960 * MiB;

constexpr int LDS_BYTES = 155648 + 16;
constexpr int LDS_XB = 155648;

__device__ __forceinline__ unsigned cvt_pk(float lo, float hi) { unsigned r; asm volatile("v_cvt_pk_bf16_f32 %0, %1, %2" : "=v"(r) : "v"(lo), "v"(hi)); return r; }
typedef __bf16 bf16x2_t __attribute__((ext_vector_type(2)));
__device__ __forceinline__ unsigned cvt_pk_c(float lo, float hi) { const f32x2 v = {lo, hi}; return __builtin_bit_cast(unsigned, __builtin_convertvector(v, bf16x2_t)); }
__device__ __forceinline__ float bf_lo(unsigned u) { return __uint_as_float(u << 16); }
__device__ __forceinline__ float bf_hi(unsigned u) { return __uint_as_float(u & 0xffff0000u); }
__device__ __forceinline__ f32x4 unpack4(u32x2 v) { return (f32x4){bf_lo(v.x), bf_hi(v.x), bf_lo(v.y), bf_hi(v.y)}; }
__device__ __forceinline__ u32x2 pack4(f32x4 v) { return (u32x2){cvt_pk_c(v.x, v.y), cvt_pk_c(v.z, v.w)}; }
__device__ __forceinline__ float silu_f(float x) { return x * __builtin_amdgcn_rcpf(1.f + __expf(-x)); }
__device__ __forceinline__ f32x4 silu4(f32x4 v) { return (f32x4){silu_f(v.x), silu_f(v.y), silu_f(v.z), silu_f(v.w)}; }
__device__ __forceinline__ float softplus_f(float x) { return x > 20.f ? x : log1pf(expf(x)); }
__device__ __forceinline__ float ex2(float x) { return __builtin_amdgcn_exp2f(x); }
typedef short v4i16_t __attribute__((ext_vector_type(4)));
__device__ __forceinline__ s16x4 vtr(ldsp p) { return __builtin_bit_cast(s16x4, __builtin_amdgcn_ds_read_tr16_b64_v4i16((LAS v4i16_t*)p)); }
__device__ __forceinline__ bf16x8 cat8(s16x4 a, s16x4 b) { return (bf16x8){a[0], a[1], a[2], a[3], b[0], b[1], b[2], b[3]}; }
__device__ __forceinline__ bf16x8 ld8(ldsp p) { return *(const LAS bf16x8*)p; }
__device__ __forceinline__ f32x4 mfma16(bf16x8 a, bf16x8 b, f32x4 c) { return __builtin_amdgcn_mfma_f32_16x16x32_bf16(a, b, c, 0, 0, 0); }
__device__ __forceinline__ bf16x8 packfrag(f32x4 a, f32x4 b) { u32x4 r = {cvt_pk_c(a.x, a.y), cvt_pk_c(a.z, a.w), cvt_pk_c(b.x, b.y), cvt_pk_c(b.z, b.w)}; return __builtin_bit_cast(bf16x8, r); }

__device__ __forceinline__ f32x4 zero4() { f32x4 z; asm volatile("v_mov_b32 %0, 0\n\tv_mov_b32 %1, 0\n\tv_mov_b32 %2, 0\n\tv_mov_b32 %3, 0" : "=v"(z.x), "=v"(z.y), "=v"(z.z), "=v"(z.w)); return z; }
__device__ __forceinline__ int lane_id_now() { int l; asm volatile("v_mbcnt_lo_u32_b32 %0, -1, 0\n\tv_mbcnt_hi_u32_b32 %0, -1, %0" : "=v"(l)); return l; }
__host__ __device__ __forceinline__ int perm_plain(int c) { const int bj = c >> 7, wc = (c >> 5) & 3, n = (c >> 4) & 1, fq = (c >> 2) & 3, i = c & 3; return 128 * bj + 32 * wc + 8 * fq + 4 * n + i; }
__host__ __device__ __forceinline__ int perm_rot(int c) { const int bj = c >> 7, wc = (c >> 5) & 3, n = (c >> 4) & 1, fq = (c >> 2) & 3, i = c & 3; return 64 * wc + 32 * bj + 8 * fq + 4 * n + i; }

namespace pg8 {
constexpr int BM = 256, BK = 64, HALF = 128, HTB = HALF * BK * 2, STAGE_BYTES = 8 * HTB, NXCD = 8, WGM = 8;
__host__ __device__ __forceinline__ int lds_byte(int r, int c) { const int st = (r >> 4) * 2 + (c >> 5), rr = r & 15, cc = c & 31, ob = rr * 64 + cc * 2; return st * 1024 + (ob ^ (((ob >> 9) & 1) << 5)); }
__host__ __device__ __forceinline__ void stage_rc(int b, int& R, int& C) { const int st = b / 1024, sb = b % 1024, swz = sb ^ (((sb >> 9) & 1) << 5); R = (st >> 1) * 16 + swz / 64; C = (st & 1) * 32 + (swz % 64) / 2; }
struct Unit { int pm, pn; };
struct Gemm { const bf16_t* A; const bf16_t* Bt; int M, N, K, lda, ldb; };
struct StaticOrder {
    int nM, nN, nwg, G, c;
    __device__ void init(int M, int N, int G_, int c_) { nM = M / BM; nN = N / BM; nwg = nM * nN; G = G_; c = c_; }
    __device__ bool next(int i, Unit& u) const {
        const long L = (long)i * G + c; if (L >= nwg) return false;
        int wgid = (int)L; { const int q = nwg / NXCD, r = nwg % NXCD, xcd = wgid % NXCD, off = wgid / NXCD; wgid = (xcd < r ? xcd * (q + 1) : r * (q + 1) + (xcd - r) * q) + off; }
        const int nig = WGM * nN, gid = wgid / nig, fm = gid * WGM, gsz = (nM - fm) < WGM ? (nM - fm) : WGM;
        u.pm = fm + ((wgid % nig) % gsz); u.pn = (wgid % nig) / gsz; return true;
    }
};
struct PanelOrder {
    int nM, nN, G, c;
    __device__ void init(int M, int N, int G_, int c_) { nM = M / BM; nN = N / BM; G = G_; c = c_; }
    __device__ bool next(int i, Unit& u) const { const int pm = c + (i / nN) * G; if (pm >= nM) return false; u.pm = pm; u.pn = i % nN; return true; }
};

template <class Epi, class Sched>
__device__ __forceinline__ void gemm_phase(ldsp lds, const Gemm g, const Sched& S, const Epi& E, int wave_id) {
    const int lane = lane_id_now(), wid = wave_id, tid = wid * 64 + lane, wr = wid >> 2, wc = wid & 3, fr = lane & 15, fq = lane >> 4;
    const int K = g.K, nt = K / BK;
    unsigned voffA[2], voffB[2];
#pragma unroll
    for (int i = 0; i < 2; ++i) { int R, C; stage_rc(tid * 16 + i * 8192, R, C); voffA[i] = (unsigned)(R * g.lda + C) * 2u; voffB[i] = (unsigned)(R * g.ldb + C) * 2u; }
    const size_t kstep = (size_t)(BK * 2);
    const size_t hstep = (size_t)HALF * g.lda * 2, hstepB = (size_t)HALF * g.ldb * 2;
    const size_t tstep = 2 * hstep, tstepB = 2 * hstepB;
    const unsigned ldsw = (unsigned)wid * 1024u;
    const int aoff = lds_byte(wr * 64 + fr, fq * 8), boff = lds_byte(wc * 32 + fr, fq * 8);
#define PG8_SA(b, h) (((b) * 2 + (h)) * HTB)
#define PG8_SB(b, h) ((4 + (b) * 2 + (h)) * HTB)
#define PG8_STAGE(bufoff, gbase, voff) do { _Pragma("unroll") for (int _i = 0; _i < 2; ++_i) \
        __builtin_amdgcn_global_load_lds((const unsigned*)((const char*)(gbase) + (voff)[_i]), (LAS unsigned*)(lds + (bufoff) + ldsw + _i * 8192), 16, 0, 0); } while (0)
#define PG8_LDA(dst, b, h) do { _Pragma("unroll") for (int m = 0; m < 4; ++m) _Pragma("unroll") for (int k = 0; k < 2; ++k) dst[m][k] = *(const LAS bf16x8*)(lds + PG8_SA(b, h) + aoff + m * 2048 + k * 1024); } while (0)
#define PG8_LDB(dst, b, h) do { _Pragma("unroll") for (int n = 0; n < 2; ++n) _Pragma("unroll") for (int k = 0; k < 2; ++k) dst[n][k] = *(const LAS bf16x8*)(lds + PG8_SB(b, h) + boff + n * 2048 + k * 1024); } while (0)
#define PG8_MMA(ai, bj, At, Bt) do { __builtin_amdgcn_s_setprio(1); _Pragma("unroll") for (int m = 0; m < 4; ++m) _Pragma("unroll") for (int n = 0; n < 2; ++n) _Pragma("unroll") for (int k = 0; k < 2; ++k) \
        acc[ai][bj][m][n] = __builtin_amdgcn_mfma_f32_16x16x32_bf16(Bt[n][k], At[m][k], acc[ai][bj][m][n], 0, 0, 0); __builtin_amdgcn_s_setprio(0); } while (0)
#define PG8_WAIT_V(n) asm volatile("s_waitcnt vmcnt(" #n ")" ::: "memory")
#define PG8_WAIT_L(n) asm volatile("s_waitcnt lgkmcnt(" #n ")" ::: "memory")
#define PG8_BAR __builtin_amdgcn_s_barrier()
#define PG8_SCHED __builtin_amdgcn_sched_barrier(0)
    Unit cur, nxt; int ui = 0;
    if (!S.next(0, cur)) return;
    f32x4 acc[2][2][4][2];
#pragma unroll
    for (int a = 0; a < 2; ++a)
#pragma unroll
        for (int b = 0; b < 2; ++b)
#pragma unroll
            for (int m = 0; m < 4; ++m)
#pragma unroll
                for (int n = 0; n < 2; ++n) acc[a][b][m][n] = (f32x4){0.f, 0.f, 0.f, 0.f};
    bf16x8 At[4][2], B0[2][2], B1[2][2];
    const char* cA = (const char*)g.A + (size_t)cur.pm * tstep; const char* cB = (const char*)g.Bt + (size_t)cur.pn * tstepB;
    PG8_STAGE(PG8_SB(0, 0), cB, voffB); PG8_STAGE(PG8_SA(0, 0), cA, voffA); PG8_STAGE(PG8_SB(0, 1), cB + hstepB, voffB); PG8_STAGE(PG8_SA(0, 1), cA + hstep, voffA);
    if (wr == 1) PG8_BAR;
    PG8_WAIT_V(4); PG8_BAR;
    PG8_STAGE(PG8_SB(1, 0), cB + kstep, voffB); PG8_STAGE(PG8_SA(1, 0), cA + kstep, voffA); PG8_STAGE(PG8_SB(1, 1), cB + hstepB + kstep, voffB);
    PG8_WAIT_V(6); PG8_BAR;
    for (;;) {
        const bool has_next = S.next(ui + 1, nxt);
        const char* nA = has_next ? (const char*)g.A + (size_t)nxt.pm * tstep : cA; const char* nB = has_next ? (const char*)g.Bt + (size_t)nxt.pn * tstepB : cB;
        for (int t = 0; t < nt; t += 2) {
            const bool last = (t == nt - 2);
            const char* a1 = cA + (size_t)(t + 1) * kstep;
            const char* a2 = last ? nA : cA + (size_t)(t + 2) * kstep; const char* b2 = last ? nB : cB + (size_t)(t + 2) * kstep;
            const char* a3 = a2 + kstep; const char* b3 = b2 + kstep;
            PG8_LDB(B0, 0, 0); PG8_SCHED; PG8_LDA(At, 0, 0); PG8_STAGE(PG8_SA(1, 1), a1 + hstep, voffA);
            PG8_WAIT_L(8); PG8_BAR; PG8_WAIT_L(0); PG8_MMA(0, 0, At, B0); PG8_BAR; PG8_SCHED;
            PG8_LDB(B1, 0, 1); PG8_STAGE(PG8_SB(0, 0), b2, voffB);
            PG8_BAR; PG8_WAIT_L(0); PG8_MMA(0, 1, At, B1); PG8_BAR;
            PG8_LDA(At, 0, 1); PG8_STAGE(PG8_SA(0, 0), a2, voffA);
            PG8_BAR; PG8_WAIT_L(0); PG8_MMA(1, 0, At, B0); PG8_BAR; PG8_SCHED;
            PG8_STAGE(PG8_SB(0, 1), b2 + hstepB, voffB);
            PG8_WAIT_V(6); PG8_BAR; PG8_MMA(1, 1, At, B1); PG8_BAR;
            PG8_LDB(B0, 1, 0); PG8_SCHED; PG8_LDA(At, 1, 0); PG8_STAGE(PG8_SA(0, 1), a2 + hstep, voffA);
            PG8_WAIT_L(8); PG8_BAR; PG8_WAIT_L(0); PG8_MMA(0, 0, At, B0); PG8_BAR; PG8_SCHED;
            PG8_LDB(B1, 1, 1); PG8_STAGE(PG8_SB(1, 0), b3, voffB);
            PG8_BAR; PG8_WAIT_L(0); PG8_MMA(0, 1, At, B1); PG8_BAR;
            PG8_LDA(At, 1, 1); PG8_STAGE(PG8_SA(1, 0), a3, voffA);
            PG8_BAR; PG8_WAIT_L(0); PG8_MMA(1, 0, At, B0); PG8_BAR; PG8_SCHED;
            PG8_STAGE(PG8_SB(1, 1), b3 + hstepB, voffB);
            PG8_WAIT_V(6); PG8_BAR; PG8_MMA(1, 1, At, B1); PG8_BAR;
        }
        E(acc, cur, wr, wc, fr, fq);
        if (!has_next) break;
#pragma unroll
        for (int a = 0; a < 2; ++a)
#pragma unroll
            for (int b = 0; b < 2; ++b)
#pragma unroll
                for (int m = 0; m < 4; ++m)
#pragma unroll
                    for (int n = 0; n < 2; ++n) acc[a][b][m][n] = (f32x4){0.f, 0.f, 0.f, 0.f};
        cur = nxt; cA = nA; cB = nB; ++ui;
    }
    PG8_WAIT_V(0);
    if (wr == 0) PG8_BAR;
    PG8_BAR;
#undef PG8_SA
#undef PG8_SB
#undef PG8_STAGE
#undef PG8_LDA
#undef PG8_LDB
#undef PG8_MMA
#undef PG8_WAIT_V
#undef PG8_WAIT_L
#undef PG8_BAR
#undef PG8_SCHED
}
}

struct EpiProj {
    bf16_t* P; float* DT; const float* rope; const float* dt_bias;
    __device__ __forceinline__ void operator()(const f32x4 (&acc)[2][2][4][2], const pg8::Unit& u, int wr, int wc, int fr, int fq) const {
        const int row0 = u.pm * 256 + wr * 64 + fr, pn = u.pn;
        if (pn < 5) {
            const float sc = pn < 4 ? 0.125f * LOG2E : 1.f;
            const int col = pn * 256 + 64 * wc + 8 * fq;
#pragma unroll
            for (int ai = 0; ai < 2; ++ai)
#pragma unroll
                for (int m = 0; m < 4; ++m) {
                    const int row = row0 + ai * 128 + m * 16, pos = row & (SEQ - 1);
                    const f32x4* cp = (const f32x4*)(rope + pos * 32 + 8 * fq); const f32x4* sp = (const f32x4*)(rope + SEQ * 32 + pos * 32 + 8 * fq);
                    f32x4 o1[2], o2[2];
#pragma unroll
                    for (int n = 0; n < 2; ++n) { const f32x4 c = cp[n], s = sp[n], t1 = acc[ai][0][m][n], t2 = acc[ai][1][m][n]; o1[n] = (t1 * c - t2 * s) * sc; o2[n] = (t1 * s + t2 * c) * sc; }
                    bf16_t* dst = P + (size_t)row * PW + col;
                    *(u32x4*)dst = (u32x4){cvt_pk(o1[0].x, o1[0].y), cvt_pk(o1[0].z, o1[0].w), cvt_pk(o1[1].x, o1[1].y), cvt_pk(o1[1].z, o1[1].w)};
                    *(u32x4*)(dst + 32) = (u32x4){cvt_pk(o2[0].x, o2[0].y), cvt_pk(o2[0].z, o2[0].w), cvt_pk(o2[1].x, o2[1].y), cvt_pk(o2[1].z, o2[1].w)};
                }
        } else if (pn < 20) {
            const bool do_silu = (pn >= 6 && pn < 12) || pn >= 18;
            const float sc = (pn == 16 || pn == 17) ? 0.08838834764831845f * LOG2E : 1.f;
            const int col = pn * 256 + 32 * wc + 8 * fq;
#pragma unroll
            for (int ai = 0; ai < 2; ++ai)
#pragma unroll
                for (int m = 0; m < 4; ++m) {
                    const int row = row0 + ai * 128 + m * 16;
#pragma unroll
                    for (int bj = 0; bj < 2; ++bj) {
                        f32x4 v0 = acc[ai][bj][m][0], v1 = acc[ai][bj][m][1];
                        if (do_silu) { v0 = silu4(v0); v1 = silu4(v1); } else { v0 = v0 * sc; v1 = v1 * sc; }
                        *(u32x4*)(P + (size_t)row * PW + col + 128 * bj) = (u32x4){cvt_pk(v0.x, v0.y), cvt_pk(v0.z, v0.w), cvt_pk(v1.x, v1.y), cvt_pk(v1.z, v1.w)};
                    }
                }
        } else {
            if (wc == 0 && fq < 2) {
#pragma unroll
                for (int ai = 0; ai < 2; ++ai)
#pragma unroll
                    for (int m = 0; m < 4; ++m) {
                        const int row = row0 + ai * 128 + m * 16;
#pragma unroll
                        for (int n = 0; n < 2; ++n) {
                            const int j0 = 8 * fq + 4 * n; const f32x4 bb = *(const f32x4*)(dt_bias + j0); const f32x4 v = acc[ai][0][m][n] + bb;
                            *(f32x4*)(DT + (size_t)row * 16 + j0) = (f32x4){softplus_f(v.x), softplus_f(v.y), softplus_f(v.z), softplus_f(v.w)};
                        }
                    }
            }
        }
    }
};
struct EpiMkv {
    bf16_t* O;
    __device__ __forceinline__ void operator()(const f32x4 (&acc)[2][2][4][2], const pg8::Unit& u, int wr, int wc, int fr, int fq) const {
        const int row0 = u.pm * 256 + wr * 64 + fr, col = u.pn * 256 + 32 * wc + 8 * fq;
#pragma unroll
        for (int ai = 0; ai < 2; ++ai)
#pragma unroll
            for (int m = 0; m < 4; ++m) {
                const int row = row0 + ai * 128 + m * 16;
#pragma unroll
                for (int bj = 0; bj < 2; ++bj) { const f32x4 v0 = acc[ai][bj][m][0], v1 = acc[ai][bj][m][1];
                    *(u32x4*)(O + (size_t)row * 1024 + col + 128 * bj) = (u32x4){cvt_pk(v0.x, v0.y), cvt_pk(v0.z, v0.w), cvt_pk(v1.x, v1.y), cvt_pk(v1.z, v1.w)}; }
            }
    }
};
struct EpiOut {
    const float* x; float* out; float* rowss;
    __device__ __forceinline__ void operator()(const f32x4 (&acc)[2][2][4][2], const pg8::Unit& u, int wr, int wc, int fr, int fq) const {
        const int row0 = u.pm * 256 + wr * 64 + fr, col = u.pn * 256 + 32 * wc + 8 * fq;
#pragma unroll
        for (int ai = 0; ai < 2; ++ai)
#pragma unroll
            for (int m = 0; m < 4; ++m) {
                const int row = row0 + ai * 128 + m * 16; float ss = 0.f;
#pragma unroll
                for (int bj = 0; bj < 2; ++bj) {
                    const size_t o = (size_t)row * DM + col + 128 * bj;
                    const f32x4 h0 = *(const f32x4*)(x + o) + acc[ai][bj][m][0], h1 = *(const f32x4*)(x + o + 4) + acc[ai][bj][m][1];
                    *(f32x4*)(out + o) = h0; *(f32x4*)(out + o + 4) = h1;
                    ss += h0.x * h0.x + h0.y * h0.y + h0.z * h0.z + h0.w * h0.w + h1.x * h1.x + h1.y * h1.y + h1.z * h1.z + h1.w * h1.w;
                }
                ss += __shfl_xor(ss, 16); ss += __shfl_xor(ss, 32);
                if (fq == 0) rowss[(size_t)row * 16 + u.pn * 4 + wc] = ss;
            }
    }
};

struct Args { const float* in[15]; float* out; unsigned char* ws; int lo, hi, sub, pad; };
struct Ctx {
    const float *x, *mem, *norm_mem_w, *norm_in_w, *w_in, *attn_sink, *conv_w, *conv_b, *dt_bias, *a_log, *d_skip, *ssd_norm_w, *w_mem_kv, *w_out, *norm_out_w;
    float* out; unsigned char* ws;
    __device__ __forceinline__ float* rowss() const { return (float*)(ws + WS_ROWSS); }
    __device__ __forceinline__ float* rope() const { return (float*)(ws + WS_ROPE); }
    __device__ __forceinline__ bf16_t* win_t() const { return (bf16_t*)(ws + WS_WIN); }
    __device__ __forceinline__ bf16_t* wout_t() const { return (bf16_t*)(ws + WS_WOUT); }
    __device__ __forceinline__ bf16_t* wmem_t() const { return (bf16_t*)(ws + WS_WMEM); }
    __device__ __forceinline__ bf16_t* memn() const { return (bf16_t*)(ws + WS_MEMN); }
    __device__ __forceinline__ bf16_t* mkv() const { return (bf16_t*)(ws + WS_MKV); }
    __device__ __forceinline__ float* dt() const { return (float*)(ws + WS_DT); }
    __device__ __forceinline__ float* dec() const { return (float*)(ws + WS_DEC); }
    __device__ __forceinline__ bf16_t* proj() const { return (bf16_t*)(ws + WS_PROJ); }
    __device__ __forceinline__ bf16_t* mix() const { return (bf16_t*)(ws + WS_MIX); }
    __device__ __forceinline__ bf16_t* hn() const { return (bf16_t*)((unsigned char*)out); }
    __device__ __forceinline__ bf16_t* st() const { return (bf16_t*)((unsigned char*)out); }
    __device__ __forceinline__ bf16_t* yp() const { return (bf16_t*)((unsigned char*)out + 128 * MiB); }
    __device__ __forceinline__ bf16_t* cfb() const { return (bf16_t*)((unsigned char*)out + 192 * MiB); }
    __device__ __forceinline__ float* efb() const { return (float*)((unsigned char*)out + 224 * MiB); }
    ldsp lds; int tid, lane, wave, G, bid;
};

__device__ __forceinline__ void rms_row_bf16(const float* xr, const float* w, bf16_t* o, int lane) {
    f32x4 v[4]; float ss = 0.f;
#pragma unroll
    for (int j = 0; j < 4; ++j) { v[j] = *(const f32x4*)(xr + 4 * lane + 256 * j); ss += v[j].x * v[j].x + v[j].y * v[j].y + v[j].z * v[j].z + v[j].w * v[j].w; }
#pragma unroll
    for (int off = 1; off < 64; off <<= 1) ss += __shfl_xor(ss, off);
    const float r = rsqrtf(ss * (1.f / DM) + EPS);
#pragma unroll
    for (int j = 0; j < 4; ++j) { const f32x4 ww = *(const f32x4*)(w + 4 * lane + 256 * j); *(u32x2*)(o + 4 * lane + 256 * j) = pack4(v[j] * r * ww); }
}
template <int MODE>
__device__ __forceinline__ void transpose_w(const Ctx& F, const float* W, int K, int NS, bf16_t* Bt, int NP, int ldb) {
    const int nitems = NP * (K / 8);
    for (int it = F.bid * 512 + F.tid; it < nitems; it += F.G * 512) {
        const int n = it % NP, kg = it / NP, tile = n >> 8, cph = n & 255; int src;
        if (MODE == 0) {
            if (tile < 5) src = tile * 256 + perm_rot(cph);
            else if (tile < 20) { src = tile * 256 + perm_plain(cph); if (src >= 4096) src += 16; }
            else { const int l = perm_plain(cph); src = l < 16 ? 4096 + l : -1; }
        } else src = tile * 256 + perm_plain(cph);
        float v[8];
#pragma unroll
        for (int j = 0; j < 8; ++j) v[j] = src >= 0 ? W[(size_t)(kg * 8 + j) * NS + src] : 0.f;
        *(u32x4*)(Bt + (size_t)n * ldb + kg * 8) = (u32x4){cvt_pk(v[0], v[1]), cvt_pk(v[2], v[3]), cvt_pk(v[4], v[5]), cvt_pk(v[6], v[7])};
    }
}
__device__ __forceinline__ void phase0(const Ctx& F) {
    const int gt = F.bid * 512 + F.tid, NT = F.G * 512;
    for (int i = gt; i < SEQ * 32; i += NT) {
        const int pos = i >> 5, f = i & 31;
        const float inv = 1.0f / exp2f((float)f * (13.287712379549449f / 32.f));
        const float ang = (float)pos * inv;
        const double rev = (double)ang * 0.15915494309189535; const double fr = rev - __builtin_rint(rev);
        const float r = (float)(fr * 6.283185307179586);
        F.rope()[i] = __cosf(r); F.rope()[SEQ * 32 + i] = __sinf(r);
    }
    transpose_w<0>(F, F.w_in, DM, INW, F.win_t(), NPHYS, HNP);
    transpose_w<1>(F, F.w_out, MIXW, DM, F.wout_t(), DM, MIXP);
    transpose_w<1>(F, F.w_mem_kv, DM, DM, F.wmem_t(), DM, HNP);
    const int gw = F.bid * 8 + F.wave, NGW = F.G * 8;
    for (int m = gw; m < NBATCH * 256; m += NGW) rms_row_bf16(F.mem + (size_t)m * DM, F.norm_mem_w, F.memn() + (size_t)m * HNP, F.lane);
    for (int m = gw; m < TOK; m += NGW) rms_row_bf16(F.x + (size_t)m * DM, F.norm_in_w, F.hn() + (size_t)m * HNP, F.lane);
}

template <int DH, int NQF>
__device__ __forceinline__ void attn_tile(ldsp Kt, int KS, ldsp Vt, int VS, const bf16x8 (&qf)[NQF][DH / 32], f32x4 (&o)[DH / 16][NQF], float (&m)[NQF], float (&lp)[NQF], int maskmode, int lane, int qoff = 0) {
    const int i16 = lane & 15, q4 = lane >> 4;
    f32x4 st[4][NQF];
#pragma unroll
    for (int kf = 0; kf < 4; ++kf)
#pragma unroll
        for (int q = 0; q < NQF; ++q) st[kf][q] = (f32x4){0.f, 0.f, 0.f, 0.f};
#pragma unroll
    for (int ks = 0; ks < DH / 32; ++ks)
#pragma unroll
        for (int kf = 0; kf < 4; ++kf) {
            const bf16x8 ka = ld8(Kt + (16 * kf + i16) * KS + (32 * ks + 8 * q4) * 2);
#pragma unroll
            for (int q = 0; q < NQF; ++q) st[kf][q] = mfma16(ka, qf[q][ks], st[kf][q]);
            if (DH > 64 && kf == 3) __builtin_amdgcn_sched_barrier(0);
        }
    if (maskmode) {
        int zb; asm volatile("v_mov_b32 %0, 0" : "=v"(zb));
        const int base = (maskmode == 1 ? 4 * q4 - i16 - qoff : i16 + qoff - 4 * q4) + zb;
#pragma unroll
        for (int kf = 0; kf < 4; ++kf)
#pragma unroll
            for (int q = 0; q < NQF; ++q)
#pragma unroll
                for (int r = 0; r < 4; ++r) { const int off = 16 * (kf - q) + r; const bool bad = (maskmode == 1 ? base + off : base - off) < 0; if (bad) st[kf][q][r] = -INFINITY; }
    }
#pragma unroll
    for (int q = 0; q < NQF; ++q) {
        float mx = st[0][q][0];
#pragma unroll
        for (int kf = 0; kf < 4; ++kf)
#pragma unroll
            for (int r = 0; r < 4; ++r) mx = fmaxf(mx, st[kf][q][r]);
        mx = fmaxf(mx, __shfl_xor(mx, 16)); mx = fmaxf(mx, __shfl_xor(mx, 32));
        const float mn = fmaxf(m[q], mx), alpha = ex2(m[q] - mn); m[q] = mn;
        float ps = 0.f;
#pragma unroll
        for (int kf = 0; kf < 4; ++kf)
#pragma unroll
            for (int r = 0; r < 4; ++r) { const float p = ex2(st[kf][q][r] - mn); st[kf][q][r] = p; ps += p; }
        lp[q] = lp[q] * alpha + ps;
#pragma unroll
        for (int d = 0; d < DH / 16; ++d) o[d][q] = o[d][q] * alpha;
    }
#pragma unroll
    for (int kp = 0; kp < 2; ++kp) {
        bf16x8 pk[NQF];
#pragma unroll
        for (int q = 0; q < NQF; ++q) pk[q] = packfrag(st[2 * kp][q], st[2 * kp + 1][q]);
#pragma unroll
        for (int d = 0; d < DH / 16; ++d) {
            ldsp va = Vt + (32 * kp + 4 * q4 + (i16 >> 2)) * VS + (16 * d + 4 * (i16 & 3)) * 2;
            const bf16x8 vf = cat8(vtr(va), vtr(va + 16 * VS));
#pragma unroll
            for (int q = 0; q < NQF; ++q) o[d][q] = mfma16(vf, pk[q], o[d][q]);
            if (DH > 64 && (d & 3) == 3) __builtin_amdgcn_sched_barrier(0);
        }
    }
}

__device__ __forceinline__ void attn_window_item(const Ctx& F, int item) {
    constexpr int KS = 144, VS = 160; const ldsp Ki = F.lds, Vi = F.lds + 384 * KS;
    const int kvh = item & 3, i = (item >> 2) & 31, b = item >> 7;
    __syncthreads();
#pragma unroll
    for (int c = F.tid; c < 3072; c += 512) {
        const int r = c >> 3, ch = c & 7, key0 = 128 * i - 128 + r, key = key0 < 0 ? 0 : (key0 >= SEQ ? SEQ - 1 : key0);
        const bf16_t* src = F.proj() + (size_t)(b * SEQ + key) * PW + 64 * kvh + 8 * ch;
        *(LAS u32x4*)(Ki + r * KS + ch * 16) = *(const u32x4*)(src + C_K);
        *(LAS u32x4*)(Vi + r * VS + ch * 16) = *(const u32x4*)(src + C_V);
    }
    __syncthreads();
    const int w = F.wave, lane = F.lane, i16 = lane & 15, q4 = lane >> 4, hq = 4 * kvh + (w >> 1), q0 = 128 * i + 64 * (w & 1);
    bf16x8 qf[4][2];
#pragma unroll
    for (int q = 0; q < 4; ++q)
#pragma unroll
        for (int ks = 0; ks < 2; ++ks) qf[q][ks] = *(const bf16x8*)(F.proj() + (size_t)(b * SEQ + q0 + 16 * q + i16) * PW + C_Q + hq * 64 + 32 * ks + 8 * q4);
    f32x4 o[4][4]; float m[4], lp[4];
    const float sink = F.attn_sink[hq] * LOG2E;
#pragma unroll
    for (int q = 0; q < 4; ++q) { m[q] = sink; lp[q] = q4 == 0 ? 1.f : 0.f;
#pragma unroll
        for (int d = 0; d < 4; ++d) o[d][q] = (f32x4){0.f, 0.f, 0.f, 0.f}; }
#pragma unroll 1
    for (int j = 0; j < 5; ++j) {
        const int kstart = q0 - 128 + 64 * j; if (kstart < 0 || kstart >= SEQ) continue;
        const int ir = 64 * (w & 1) + 64 * j;
        attn_tile<64, 4>(Ki + ir * KS, KS, Vi + ir * VS, VS, qf, o, m, lp, j == 0 ? 1 : (j == 4 ? 2 : 0), lane);
    }
#pragma unroll
    for (int q = 0; q < 4; ++q) {
        float l = lp[q]; l += __shfl_xor(l, 16); l += __shfl_xor(l, 32); const float inv = 1.f / l;
        const size_t row = (size_t)(b * SEQ + q0 + 16 * q + i16);
#pragma unroll
        for (int d = 0; d < 4; ++d) {
            const int col = hq * 64 + 16 * d + 4 * q4;
            const f32x4 g = unpack4(*(const u32x2*)(F.proj() + row * PW + C_G + col));
            *(u32x2*)(F.mix() + row * MIXP + col) = pack4(o[d][q] * inv * g);
        }
    }
}

__device__ __forceinline__ void ring_stage_block(const Ctx& F, const bf16_t* kvbase, int keyblock) {
    constexpr int KS = 144, VS = 160; const ldsp Kb = F.lds + (keyblock & 511) * KS, Vb = F.lds + 512 * KS + (keyblock & 511) * VS;
    const bf16_t* src0 = kvbase + (size_t)keyblock * PW;
    for (int wi = F.wave; wi < 18; wi += 8) {
        const int slot = wi * 64 + F.lane, row = slot / 9, ch = slot - row * 9;
        __builtin_amdgcn_global_load_lds((const unsigned*)(src0 + (size_t)row * PW + C_K + 8 * (ch > 7 ? 7 : ch)), (LAS unsigned*)(Kb + wi * 1024), 16, 0, 0);
    }
    for (int wi = F.wave; wi < 20; wi += 8) {
        const int slot = wi * 64 + F.lane, row = slot / 10, ch = slot - row * 10;
        __builtin_amdgcn_global_load_lds((const unsigned*)(src0 + (size_t)row * PW + C_V + 8 * (ch > 7 ? 7 : ch)), (LAS unsigned*)(Vb + wi * 1024), 16, 0, 0);
    }
}
__device__ __forceinline__ void attn_window_seq(const Ctx& F, int sq) {
    constexpr int KS = 144, VS = 160; const ldsp Ki = F.lds, Vi = F.lds + 512 * KS;
    const int sidx = sq >> 2, b = sidx >> 2, kvh = sidx & 3, i0 = 8 * (sq & 3);
    const int w = F.wave, lane = F.lane, i16 = lane & 15, q4 = lane >> 4, hq = 4 * kvh + (w >> 1);
    const bf16_t* kvbase = F.proj() + (size_t)b * SEQ * PW + 64 * kvh;
    __syncthreads();
    for (int t = 0; t < 3; ++t) { const int kb = 128 * (i0 - 1 + t); if (kb >= 0 && kb < SEQ) ring_stage_block(F, kvbase, kb); }
    const float sink = F.attn_sink[hq] * LOG2E;
#pragma unroll 1
    for (int k = 0; k < 8; ++k) {
        const int i = i0 + k, q0 = 128 * i + 64 * (w & 1);
        __syncthreads();
        { const int nkey0 = 128 * i + 256; if (k < 7 && nkey0 < SEQ) ring_stage_block(F, kvbase, nkey0); }
#pragma unroll 1
        for (int half = 0; half < 2; ++half) {
            const int qh = q0 + 32 * half;
            bf16x8 qf[2][2];
#pragma unroll
            for (int q = 0; q < 2; ++q)
#pragma unroll
                for (int ks = 0; ks < 2; ++ks) qf[q][ks] = *(const bf16x8*)(F.proj() + (size_t)(b * SEQ + qh + 16 * q + i16) * PW + C_Q + hq * 64 + 32 * ks + 8 * q4);
            u32x2 graw[2][4];
#pragma unroll
            for (int q = 0; q < 2; ++q)
#pragma unroll
                for (int d = 0; d < 4; ++d) graw[q][d] = *(const u32x2*)(F.proj() + (size_t)(b * SEQ + qh + 16 * q + i16) * PW + C_G + hq * 64 + 16 * d + 4 * q4);
            f32x4 o[4][2]; float m[2], lp[2];
#pragma unroll
            for (int q = 0; q < 2; ++q) { m[q] = sink; lp[q] = q4 == 0 ? 1.f : 0.f;
#pragma unroll
                for (int d = 0; d < 4; ++d) o[d][q] = (f32x4){0.f, 0.f, 0.f, 0.f}; }
#pragma unroll 1
            for (int j = 0; j < 5; ++j) {
                const int kstart = q0 - 128 + 64 * j; if (kstart < 0 || kstart >= SEQ) continue;
                const int ir = kstart & 511;
                attn_tile<64, 2>(Ki + ir * KS, KS, Vi + ir * VS, VS, qf, o, m, lp, j == 0 ? 1 : (j == 4 ? 2 : 0), lane, 32 * half);
            }
#pragma unroll
            for (int q = 0; q < 2; ++q) {
                float l = lp[q]; l += __shfl_xor(l, 16); l += __shfl_xor(l, 32); const float inv = 1.f / l;
                const size_t row = (size_t)(b * SEQ + qh + 16 * q + i16);
#pragma unroll
                for (int d = 0; d < 4; ++d) {
                    const int col = hq * 64 + 16 * d + 4 * q4;
                    const f32x4 g = unpack4(graw[q][d]);
                    *(u32x2*)(F.mix() + row * MIXP + col) = pack4(o[d][q] * inv * g);
                }
            }
        }
    }
}
__device__ __forceinline__ void attn_mem_item(const Ctx& F, int item, bool stage) {
    constexpr int KS = 272, VS = 288; const ldsp Ki = F.lds, Vi = F.lds + 256 * KS;
    const int qb = item & 15, hm = (item >> 4) & 3, b = item >> 6;
    if (stage) {
    __syncthreads();
#pragma unroll
    for (int c = F.tid; c < 4096; c += 512) {
        const int r = c >> 4, ch = c & 15;
        const bf16_t* src = F.mkv() + (size_t)(b * 256 + r) * 1024 + hm * 128 + 8 * ch;
        *(LAS u32x4*)(Ki + r * KS + ch * 16) = *(const u32x4*)(src);
        *(LAS u32x4*)(Vi + r * VS + ch * 16) = *(const u32x4*)(src + 512);
    }
    __syncthreads();
    }
    const int w = F.wave, lane = F.lane, i16 = lane & 15, q4 = lane >> 4, q0 = 256 * qb + 32 * w;
    bf16x8 qf[2][4];
#pragma unroll
    for (int q = 0; q < 2; ++q)
#pragma unroll
        for (int ks = 0; ks < 4; ++ks) qf[q][ks] = *(const bf16x8*)(F.proj() + (size_t)(b * SEQ + q0 + 16 * q + i16) * PW + C_QM + hm * 128 + 32 * ks + 8 * q4);
    u32x2 graw[2][8];
#pragma unroll
    for (int q = 0; q < 2; ++q)
#pragma unroll
        for (int d = 0; d < 8; ++d) graw[q][d] = *(const u32x2*)(F.proj() + (size_t)(b * SEQ + q0 + 16 * q + i16) * PW + C_GM + hm * 128 + 16 * d + 4 * q4);
    f32x4 o[8][2]; float m[2], lp[2];
#pragma unroll
    for (int q = 0; q < 2; ++q) { m[q] = -INFINITY; lp[q] = 0.f;
#pragma unroll
        for (int d = 0; d < 8; ++d) o[d][q] = (f32x4){0.f, 0.f, 0.f, 0.f}; }
#pragma unroll 1
    for (int j = 0; j < 4; ++j) attn_tile<128, 2>(Ki + 64 * j * KS, KS, Vi + 64 * j * VS, VS, qf, o, m, lp, 0, lane);
#pragma unroll
    for (int q = 0; q < 2; ++q) {
        float l = lp[q]; l += __shfl_xor(l, 16); l += __shfl_xor(l, 32); const float inv = 1.f / l;
        const size_t row = (size_t)(b * SEQ + q0 + 16 * q + i16);
#pragma unroll
        for (int d = 0; d < 8; ++d) {
            const int col = hm * 128 + 16 * d + 4 * q4;
            const f32x4 g = unpack4(graw[q][d]);
            *(u32x2*)(F.mix() + row * MIXP + 1536 + col) = pack4(o[d][q] * inv * g);
        }
    }
}

constexpr int XS = 544, BS = 288, XWS = 160, PS = 272;
constexpr int L_XI = 0, L_BI = 128 * XS, L_CI = L_BI + 128 * BS, L_F32 = L_CI + 128 * BS;
static_assert(L_F32 + 12288 <= LDS_XB, "lds");
__device__ __forceinline__ void ssd_dtprep(const Ctx& F, int b, int c, int g, bool write_dec) {
    LAS float* DTs = (LAS float*)(F.lds + L_F32); LAS float* ACs = DTs + 1024;
    const int w = F.wave, lane = F.lane, dir = w >> 2, r = w & 3, h = 4 * g + r, j = dir * 8 + h;
    const size_t row0 = (size_t)b * SEQ + c * 128;
    const float d0 = F.dt()[(row0 + 2 * lane) * 16 + j], d1 = F.dt()[(row0 + 2 * lane + 1) * 16 + j];
    const float a = -expf(F.a_log[j]);
    const float x0 = d0 * a, x1 = d1 * a, ps = x0 + x1; float inc = ps;
#pragma unroll
    for (int off = 1; off < 64; off <<= 1) { const float t = __shfl_up(inc, off); if (lane >= off) inc += t; }
    const float total = __shfl(inc, 63);
    float a0, a1;
    if (dir == 0) { a0 = inc - x1; a1 = inc; } else { a0 = total - (inc - ps); a1 = total - (inc - x1); }
    *(LAS f32x2*)(DTs + w * 128 + 2 * lane) = (f32x2){d0, d1};
    *(LAS f32x2*)(ACs + w * 128 + 2 * lane) = (f32x2){a0, a1};
    *(LAS f32x2*)(ACs + 1024 + w * 128 + 2 * lane) = (f32x2){d0 * expf(total - a0), d1 * expf(total - a1)};
    if (write_dec && lane == 0) F.dec()[(b * 32 + c) * 16 + j] = expf(total);
}
template <int NCOLS>
__device__ __forceinline__ void conv_img(const Ctx& F, int b, int c, int xcol, ldsp img, int stride) {
    constexpr int NCQ = NCOLS / 4, NRG = 512 / NCQ, R = 128 / NRG;
    const int cq = F.tid % NCQ, rg = F.tid / NCQ, col = xcol + 4 * cq;
    f32x4 w[5];
#pragma unroll
    for (int j = 0; j < 5; ++j) w[j] = *(const f32x4*)(F.conv_w + j * 1024 + col);
    const f32x4 bias = *(const f32x4*)(F.conv_b + col);
    const int t0 = c * 128 + rg * R - 2;
    const bf16_t* base = F.proj() + (size_t)b * SEQ * PW + C_X + col;
    f32x4 win[R + 4];
#pragma unroll
    for (int k = 0; k < R + 4; ++k) { const int t = t0 + k, tc = t < 0 ? 0 : (t >= SEQ ? SEQ - 1 : t); const u32x2 raw = *(const u32x2*)(base + (size_t)tc * PW); const bool ok = (t == tc);
        win[k] = unpack4((u32x2){ok ? raw.x : 0u, ok ? raw.y : 0u}); }
#pragma unroll
    for (int r = 0; r < R; ++r) {
        f32x4 y = bias;
#pragma unroll
        for (int j = 0; j < 5; ++j) y = y + w[j] * win[r + j];
        *(LAS u32x2*)(img + (rg * R + r) * stride + cq * 8) = pack4(silu4(y));
    }
}
__device__ __forceinline__ void ssd_pass1_item(const Ctx& F, int item) {
    const int g = item & 1, c = (item >> 1) & 31, b = item >> 6;
    const ldsp XI = F.lds + L_XI, BI = F.lds + L_BI, CI = F.lds + L_CI;
    LAS float* DTs = (LAS float*)(F.lds + L_F32); LAS float* ACs = DTs + 1024;
    __syncthreads();
    ssd_dtprep(F, b, c, g, true);
    conv_img<256>(F, b, c, 256 * g, XI, XS);
    conv_img<128>(F, b, c, 512 + 128 * g, BI, BS);
    conv_img<128>(F, b, c, 768 + 128 * g, CI, BS);
    __syncthreads();
    const int lane = F.lane, i16 = lane & 15, q4 = lane >> 4, w = F.wave, tl = 16 * w + i16;
    const size_t row = (size_t)b * SEQ + c * 128 + tl;
    f32x4 cbt[8];
    {
        bf16x8 cf[4];
#pragma unroll
        for (int ks = 0; ks < 4; ++ks) cf[ks] = ld8(CI + tl * BS + (32 * ks + 8 * q4) * 2);
#pragma unroll
        for (int ks = 0; ks < 4; ++ks) *(bf16x8*)(F.cfb() + ((size_t)(item * 8 + w) * 64 + lane) * 32 + 8 * ks) = cf[ks];
#pragma unroll
        for (int sf = 0; sf < 8; ++sf) {
            cbt[sf] = (f32x4){0.f, 0.f, 0.f, 0.f};
#pragma unroll
            for (int ks = 0; ks < 4; ++ks) cbt[sf] = mfma16(ld8(BI + (16 * sf + i16) * BS + (32 * ks + 8 * q4) * 2), cf[ks], cbt[sf]);
        }
    }
#pragma unroll 1
    for (int r = 0; r < 4; ++r) {
        {
            const int dir = w & 1, nq = w >> 1;
            LAS const float* Wr = ACs + 1024 + (dir * 4 + r) * 128;
            f32x4 acc[2][4];
#pragma unroll
            for (int nf = 0; nf < 2; ++nf)
#pragma unroll
                for (int pf = 0; pf < 4; ++pf) acc[nf][pf] = (f32x4){0.f, 0.f, 0.f, 0.f};
#pragma unroll
            for (int ks = 0; ks < 4; ++ks) {
                const int t0 = 32 * ks + 8 * q4, trow = t0 + (i16 >> 2);
                const f32x4 wlo = *(const LAS f32x4*)(Wr + t0), whi = *(const LAS f32x4*)(Wr + t0 + 4);
                bf16x8 af[2], bfr[4];
#pragma unroll
                for (int nf = 0; nf < 2; ++nf) {
                    ldsp p = BI + trow * BS + (32 * nq + 16 * nf + 4 * (i16 & 3)) * 2;
                    const u32x2 lo = __builtin_bit_cast(u32x2, vtr(p)), hi = __builtin_bit_cast(u32x2, vtr(p + 4 * BS));
                    af[nf] = packfrag(unpack4(lo) * wlo, unpack4(hi) * whi);
                }
#pragma unroll
                for (int pf = 0; pf < 4; ++pf) { ldsp p = XI + trow * XS + (64 * r + 16 * pf + 4 * (i16 & 3)) * 2; bfr[pf] = cat8(vtr(p), vtr(p + 4 * XS)); }
#pragma unroll
                for (int nf = 0; nf < 2; ++nf)
#pragma unroll
                    for (int pf = 0; pf < 4; ++pf) acc[nf][pf] = mfma16(af[nf], bfr[pf], acc[nf][pf]);
            }
            bf16_t* S = F.st() + ((((size_t)(b * 32 + c) * 2 + dir) * 8 + (4 * g + r)) << 13);
#pragma unroll
            for (int nf = 0; nf < 2; ++nf)
#pragma unroll
                for (int pf = 0; pf < 4; ++pf) *(u32x2*)(S + (16 * pf + i16) * 128 + 32 * nq + 16 * nf + 4 * q4) = pack4(acc[nf][pf]);
        }
        {
            const float acf = ACs[r * 128 + tl], acb = ACs[(4 + r) * 128 + tl];
            f32x4 yt[4];
#pragma unroll
            for (int pf = 0; pf < 4; ++pf) yt[pf] = (f32x4){0.f, 0.f, 0.f, 0.f};
#pragma unroll
            for (int kp = 0; kp < 4; ++kp) {
                f32x4 gt[2];
#pragma unroll
                for (int u = 0; u < 2; ++u) {
                    const int sf = 2 * kp + u, s0 = 16 * sf + 4 * q4;
                    const f32x4 dtf = *(const LAS f32x4*)(DTs + r * 128 + s0), af = *(const LAS f32x4*)(ACs + r * 128 + s0);
                    const f32x4 dtb = *(const LAS f32x4*)(DTs + (4 + r) * 128 + s0), ab = *(const LAS f32x4*)(ACs + (4 + r) * 128 + s0);
#pragma unroll
                    for (int e = 0; e < 4; ++e) {
                        const int sx = s0 + e;
                        const float mf = sx <= tl ? dtf[e] * __expf(acf - af[e]) : 0.f;
                        const float mb = sx >= tl ? dtb[e] * __expf(acb - ab[e]) : 0.f;
                        gt[u][e] = cbt[sf][e] * (mf + mb);
                    }
                }
                const bf16x8 gk = packfrag(gt[0], gt[1]);
#pragma unroll
                for (int pf = 0; pf < 4; ++pf) {
                    ldsp xa = XI + (32 * kp + 4 * q4 + (i16 >> 2)) * XS + (64 * r + 16 * pf + 4 * (i16 & 3)) * 2;
                    yt[pf] = mfma16(cat8(vtr(xa), vtr(xa + 16 * XS)), gk, yt[pf]);
                }
            }
            const float dsk = F.d_skip[4 * g + r];
#pragma unroll
            for (int pf = 0; pf < 4; ++pf) {
                const int pc = 64 * r + 16 * pf + 4 * q4;
                const f32x4 xv = unpack4(*(const LAS u32x2*)(XI + tl * XS + pc * 2));
                *(u32x2*)(F.yp() + row * 512 + 256 * g + pc) = pack4(yt[pf] + xv * dsk);
            }
            if (q4 == 0) { F.efb()[row * 16 + 4 * g + r] = __expf(acf); F.efb()[row * 16 + 8 + 4 * g + r] = __expf(acb); }
        }
    }
}
__device__ __forceinline__ void ssd_scan(const Ctx& F, int vb, int vg) {
    for (int it = vb * 512 + F.tid; it < NBATCH * 2 * 8 * 1024; it += vg * 512) {
        const int e8 = it & 1023, h = (it >> 10) & 7, dir = (it >> 13) & 1, b = it >> 14;
        float run[8];
#pragma unroll
        for (int k = 0; k < 8; ++k) run[k] = 0.f;
        for (int s0 = 0; s0 < 32; s0 += 4) {
            u32x4 v[4]; float dc[4]; bf16_t* ad[4];
#pragma unroll
            for (int u = 0; u < 4; ++u) { const int s = s0 + u, c = dir ? 31 - s : s; ad[u] = F.st() + (((((size_t)(b * 32 + c) * 2 + dir) * 8 + h) << 13) + e8 * 8); v[u] = *(const u32x4*)ad[u]; dc[u] = F.dec()[(b * 32 + c) * 16 + dir * 8 + h]; }
#pragma unroll
            for (int u = 0; u < 4; ++u) {
                *(u32x4*)ad[u] = (u32x4){cvt_pk(run[0], run[1]), cvt_pk(run[2], run[3]), cvt_pk(run[4], run[5]), cvt_pk(run[6], run[7])};
                run[0] = run[0] * dc[u] + bf_lo(v[u].x); run[1] = run[1] * dc[u] + bf_hi(v[u].x); run[2] = run[2] * dc[u] + bf_lo(v[u].y); run[3] = run[3] * dc[u] + bf_hi(v[u].y);
                run[4] = run[4] * dc[u] + bf_lo(v[u].z); run[5] = run[5] * dc[u] + bf_hi(v[u].z); run[6] = run[6] * dc[u] + bf_lo(v[u].w); run[7] = run[7] * dc[u] + bf_hi(v[u].w);
            }
        }
    }
}
__device__ __forceinline__ void ssd_pass2_item(const Ctx& F, int item) {
    const int g = item & 1, c = (item >> 1) & 31, b = item >> 6;
    const ldsp PV = F.lds;
    const int lane = F.lane, i16 = lane & 15, q4 = lane >> 4, w = F.wave, tl = 16 * w + i16;
    const size_t row = (size_t)b * SEQ + c * 128 + tl;
    bf16x8 cf[4];
#pragma unroll
    for (int ks = 0; ks < 4; ++ks) cf[ks] = *(const bf16x8*)(F.cfb() + ((size_t)(item * 8 + w) * 64 + lane) * 32 + 8 * ks);
    const int pdir = F.tid >> 8, pp = (F.tid >> 2) & 63, pqu = F.tid & 3;
    const bf16_t* psrc = F.st() + (((((size_t)(b * 32 + c) * 2 + pdir) * 8 + 4 * g) << 13) + pp * 128 + 32 * pqu);
    u32x4 pvn[4][4];
#pragma unroll
    for (int r = 0; r < 4; ++r)
#pragma unroll
        for (int k = 0; k < 4; ++k) pvn[r][k] = *(const u32x4*)(psrc + ((size_t)r << 13) + 8 * k);
    __syncthreads();
#pragma unroll
    for (int r = 0; r < 4; ++r)
#pragma unroll
        for (int k = 0; k < 4; ++k) *(LAS u32x4*)(PV + (2 * r + pdir) * (64 * PS) + pp * PS + (32 * pqu + 8 * k) * 2) = pvn[r][k];
    __syncthreads();
    f32x4 gy[4][4]; float ss = 0.f;
#pragma unroll
    for (int r = 0; r < 4; ++r) {
        u32x2 zraw[4], yraw[4];
#pragma unroll
        for (int pf = 0; pf < 4; ++pf) { const int pc = 256 * g + 64 * r + 16 * pf + 4 * q4; zraw[pf] = *(const u32x2*)(F.proj() + row * PW + C_Z + pc); yraw[pf] = *(const u32x2*)(F.yp() + row * 512 + pc); }
        const float ef = F.efb()[row * 16 + 4 * g + r], eb = F.efb()[row * 16 + 8 + 4 * g + r];
        const ldsp PVr = PV + 2 * r * (64 * PS);
        f32x4 yf[4], yb[4];
#pragma unroll
        for (int pf = 0; pf < 4; ++pf) { yf[pf] = (f32x4){0.f, 0.f, 0.f, 0.f}; yb[pf] = (f32x4){0.f, 0.f, 0.f, 0.f}; }
#pragma unroll
        for (int ks = 0; ks < 4; ++ks)
#pragma unroll
            for (int pf = 0; pf < 4; ++pf) {
                yf[pf] = mfma16(ld8(PVr + (16 * pf + i16) * PS + (32 * ks + 8 * q4) * 2), cf[ks], yf[pf]);
                yb[pf] = mfma16(ld8(PVr + 64 * PS + (16 * pf + i16) * PS + (32 * ks + 8 * q4) * 2), cf[ks], yb[pf]);
            }
#pragma unroll
        for (int pf = 0; pf < 4; ++pf) {
            const f32x4 y = (unpack4(yraw[pf]) + yf[pf] * ef + yb[pf] * eb) * unpack4(zraw[pf]);
            gy[r][pf] = y; ss += y.x * y.x + y.y * y.y + y.z * y.z + y.w * y.w;
        }
    }
    ss += __shfl_xor(ss, 16); ss += __shfl_xor(ss, 32);
    const float rinv = rsqrtf(ss * (1.f / 256.f) + EPS);
#pragma unroll
    for (int r = 0; r < 4; ++r)
#pragma unroll
        for (int pf = 0; pf < 4; ++pf) {
            const int pc = 256 * g + 64 * r + 16 * pf + 4 * q4;
            const f32x4 nw = *(const f32x4*)(F.ssd_norm_w + pc);
            *(u32x2*)(F.mix() + row * MIXP + 1024 + pc) = pack4(gy[r][pf] * rinv * nw);
        }
}

__device__ __forceinline__ void final_norm(const Ctx& F) {
    const int gw = F.bid * 8 + F.wave, NGW = F.G * 8, lane = F.lane;
    for (int m = gw; m < TOK; m += NGW) {
        const f32x4* rp = (const f32x4*)(F.rowss() + (size_t)m * 16); const f32x4 s4 = (rp[0] + rp[1]) + (rp[2] + rp[3]);
        const float r = rsqrtf(((s4.x + s4.y) + (s4.z + s4.w)) * (1.f / DM) + EPS);
        float* o = F.out + (size_t)m * DM;
#pragma unroll
        for (int j = 0; j < 4; ++j) { const f32x4 v = *(const f32x4*)(o + 4 * lane + 256 * j), ww = *(const f32x4*)(F.norm_out_w + 4 * lane + 256 * j); *(f32x4*)(o + 4 * lane + 256 * j) = v * r * ww; }
    }
}

#define XB_TMO      128
#define XB_XCNT(j)  (256  + 64 * (j))
#define XB_XSUB(j)  (1280 + 64 * (j))
#define XB_XGEN(j)  (2304 + 64 * (j))
#define XB_TOP      3328
#define XB_TOPGEN   3392
#define XCD_BAR_WORDS 3456
#define XB_SPIN_CAP (1u << 18)

__device__ __forceinline__ unsigned xb_ld(unsigned* p)              { return __hip_atomic_load(p, __ATOMIC_RELAXED, __HIP_MEMORY_SCOPE_AGENT); }
__device__ __forceinline__ unsigned xb_add(unsigned* p, unsigned v) { return __hip_atomic_fetch_add(p, v, __ATOMIC_RELAXED, __HIP_MEMORY_SCOPE_AGENT); }
__device__ __forceinline__ unsigned xb_xcc_id() { return (unsigned)__builtin_amdgcn_s_getreg((3 << 11) | 20) & 0xFu; }
#define XB_SPIN(cond, bar) do { unsigned _sp = 0; while (cond) { __builtin_amdgcn_s_sleep(1); \
    if ((++_sp & 255u) == 0u) { if (xb_ld(&(bar)[XB_TMO])) break; if (_sp > XB_SPIN_CAP) { atomicAdd(&(bar)[XB_TMO], 1u); break; } } } } while (0)

struct XcdBarrier {
    unsigned* bar; unsigned x;
    volatile LAS unsigned* st;
};

__device__ __forceinline__ XcdBarrier xcd_barrier_post(unsigned* bar, volatile LAS unsigned* st, int xb_tid) {
    XcdBarrier b; b.bar = bar; b.x = xb_xcc_id(); b.st = st;
    if (xb_tid == 0) (void)xb_add(&bar[XB_XCNT(b.x)], 1u);
    return b;
}
__device__ __forceinline__ void xcd_barrier_complete(unsigned* bar, unsigned x, unsigned& nloc, unsigned& nx) {
    const unsigned G = gridDim.x * gridDim.y * gridDim.z;
    unsigned sum, cnt, mine, sp = 0u;
    for (;;) {
        sum = 0u; cnt = 0u; mine = 0u;
#pragma unroll
        for (unsigned j = 0; j < 16; ++j) { const unsigned c = xb_ld(&bar[XB_XCNT(j)]); sum += c; cnt += (c > 0u) ? 1u : 0u; mine = (j == x) ? c : mine; }
        if (sum == G) break;
        __builtin_amdgcn_s_sleep(1);
        if ((++sp & 255u) == 0u) { if (xb_ld(&bar[XB_TMO])) break; if (sp > XB_SPIN_CAP) { atomicAdd(&bar[XB_TMO], 1u); break; } }
    }
    nloc = mine > 0u ? mine : 1u; nx = cnt > 0u ? cnt : 1u;
}

__device__ __forceinline__ void xcd_barrier(const XcdBarrier& b, int xb_tid) {
    asm volatile("s_waitcnt vmcnt(0)" ::: "memory");
    __syncthreads();
    if (xb_tid == 0) {
        unsigned* bar = b.bar;
        __builtin_amdgcn_s_waitcnt(0);
        unsigned nloc = b.st[0], nx = b.st[1];
        if (nloc == 0u) { xcd_barrier_complete(bar, b.x, nloc, nx); b.st[0] = nloc; b.st[1] = nx; }
        const unsigned old = xb_add(&bar[XB_XSUB(b.x)], 1u);
        const unsigned gen = old / nloc;
        if (old + 1u == (gen + 1u) * nloc) {
            __builtin_amdgcn_fence(__ATOMIC_RELEASE, "agent");
            asm volatile("s_waitcnt vmcnt(0)" ::: "memory");
            const unsigned og = xb_add(&bar[XB_TOP], 1u);
            const unsigned tg = og / nx;
            if (og + 1u == (tg + 1u) * nx) xb_add(&bar[XB_TOPGEN], 1u);
            else XB_SPIN(xb_ld(&bar[XB_TOPGEN]) == tg, bar);
            __builtin_amdgcn_fence(__ATOMIC_ACQUIRE, "agent");
            xb_add(&bar[XB_XGEN(b.x)], 1u);
            asm volatile("s_waitcnt vmcnt(0)" ::: "memory");
        } else {
            XB_SPIN(xb_ld(&bar[XB_XGEN(b.x)]) == gen, bar);
            __builtin_amdgcn_fence(__ATOMIC_ACQUIRE, "agent");
            asm volatile("s_waitcnt vmcnt(0)" ::: "memory");
        }
    }
    __syncthreads();
}

__global__ void __launch_bounds__(512, 2) hymba_fwd(Args args) {
    extern __shared__ __attribute__((aligned(16))) unsigned char lds_raw[];
    Ctx F;
    F.x = args.in[0]; F.mem = args.in[1]; F.norm_mem_w = args.in[2]; F.norm_in_w = args.in[3]; F.w_in = args.in[4]; F.attn_sink = args.in[5]; F.conv_w = args.in[6]; F.conv_b = args.in[7];
    F.dt_bias = args.in[8]; F.a_log = args.in[9]; F.d_skip = args.in[10]; F.ssd_norm_w = args.in[11]; F.w_mem_kv = args.in[12]; F.w_out = args.in[13]; F.norm_out_w = args.in[14];
    F.out = args.out; F.ws = args.ws;
    F.lds = (ldsp)lds_raw; F.tid = threadIdx.x; F.lane = F.tid & 63; F.wave = __builtin_amdgcn_readfirstlane(F.tid >> 6); F.G = gridDim.x; F.bid = blockIdx.x;
    const int lo = args.lo, hi = args.hi;
    cg::grid_group grid = cg::this_grid();
#define IN(k) (lo <= (k) && (k) < hi)
#define REFRESH() do { F.lane = lane_id_now(); F.tid = F.wave * 64 + F.lane; } while (0)
    if (F.tid == 0) { *(LAS u32x4*)(F.lds + LDS_XB) = (u32x4){0u, 0u, 0u, 0u}; }
    __syncthreads();
    XcdBarrier xbar; xbar.bar = (unsigned*)args.ws; xbar.x = 0; xbar.st = (volatile LAS unsigned*)(F.lds + LDS_XB);
    if (hi - lo > 1) xbar = xcd_barrier_post((unsigned*)args.ws, (volatile LAS unsigned*)(F.lds + LDS_XB), F.tid);
    if (lo < 0) grid.sync();
#define SEAM(k) do { if (IN(k) && IN((k) + 1)) xcd_barrier(xbar, F.tid); } while (0)
    if (IN(0)) { REFRESH(); phase0(F); }
    SEAM(0);
    if (IN(1)) {
        REFRESH();
        { pg8::Gemm g{F.hn(), F.win_t(), TOK, NPHYS, DM, HNP, HNP}; pg8::StaticOrder S; S.init(g.M, g.N, F.G, F.bid); EpiProj E{F.proj(), F.dt(), F.rope(), F.dt_bias}; pg8::gemm_phase(F.lds, g, S, E, F.wave); }
    }
    SEAM(1);
#if DBG_STOP == 1
    { grid.sync(); const int gw = F.bid * 8 + F.wave, NGW = F.G * 8;
      for (int m = gw; m < TOK; m += NGW) for (int j = 0; j < 16; ++j) { const int c = F.lane + 64 * j; float a = 0.f; for (int k = 0; k < 5; ++k) a += bf_lo(F.proj()[(size_t)m * PW + c + 1024 * k]); a += F.dt()[(size_t)m * 16 + (c & 15)] + bf_lo(F.mkv()[(size_t)(m & 4095) * 1024 + c]); F.out[(size_t)m * DM + c] = a; }
      return; }
#endif
    if (IN(2)) {
        REFRESH();
        if (args.sub & 1) for (int it = F.bid; it < NBATCH * 32 * 2; it += F.G) ssd_pass1_item(F, it);
        if (args.sub & 2) for (int sq = F.bid; sq < NBATCH * 4 * 4; sq += F.G) attn_window_seq(F, sq);
    }
    SEAM(2);
#if DBG_STOP == 2
    { grid.sync(); const int gw = F.bid * 8 + F.wave, NGW = F.G * 8;
      for (int m = gw; m < TOK; m += NGW) for (int j = 0; j < 16; ++j) { const int c = F.lane + 64 * j;
        const float a = (DBG_SEL & 1 ? bf_lo(F.mix()[(size_t)m * MIXW + c]) : 0.f), bq = (DBG_SEL & 2 ? bf_lo(F.st()[(size_t)m * 1024 + c]) : 0.f), d = (DBG_SEL & 4 ? F.dec()[(m * 1024 + c) & 8191] : 0.f);
        ((float*)F.proj())[(size_t)m * DM + c] = a + bq + d; }
      __threadfence(); grid.sync();
      for (int m = gw; m < TOK; m += NGW) for (int j = 0; j < 16; ++j) { const int c = F.lane + 64 * j; F.out[(size_t)m * DM + c] = ((float*)F.proj())[(size_t)m * DM + c]; }
      return; }
#endif
    if (IN(3)) {
        REFRESH();
        if (F.G >= 128) {
            if (F.bid < 64) { pg8::Gemm g{F.memn(), F.wmem_t(), NBATCH * 256, 1024, 1024, HNP, HNP}; pg8::StaticOrder S; S.init(g.M, g.N, 64, F.bid); EpiMkv E{F.mkv()}; pg8::gemm_phase(F.lds, g, S, E, F.wave); }
            else ssd_scan(F, F.bid - 64, F.G - 64);
        } else {
            { pg8::Gemm g{F.memn(), F.wmem_t(), NBATCH * 256, 1024, 1024, HNP, HNP}; pg8::StaticOrder S; S.init(g.M, g.N, F.G, F.bid); EpiMkv E{F.mkv()}; pg8::gemm_phase(F.lds, g, S, E, F.wave); }
            ssd_scan(F, F.bid, F.G);
        }
    }
    SEAM(3);
    if (IN(4)) {
        REFRESH();
        if (args.sub & 1) for (int it = F.bid; it < NBATCH * 32 * 2; it += F.G) ssd_pass2_item(F, it);
        if (args.sub & 2) for (int grp = F.bid; grp < NBATCH * 16; grp += F.G) for (int k = 0; k < 4; ++k) attn_mem_item(F, 4 * grp + k, k == 0);
    }
    SEAM(4);
    if (IN(5)) { REFRESH(); __syncthreads(); pg8::Gemm g{F.mix(), F.wout_t(), TOK, DM, MIXW, MIXP, MIXP}; pg8::StaticOrder S; S.init(g.M, g.N, F.G, F.bid); EpiOut E{F.x, F.out, F.rowss()}; pg8::gemm_phase(F.lds, g, S, E, F.wave); }
    SEAM(5);
    if (IN(6)) { REFRESH(); final_norm(F); }
#undef IN
#undef SEAM
}

extern "C" void kernel_launch(void* const* d_in, const int* in_sizes, int n_in, void* d_out, int out_size, void* d_ws, size_t ws_size, hipStream_t stream) {
    static int grid = 0;
    if (grid == 0) {
        if (n_in != 15 || out_size != TOK * DM || ws_size < WS_END) { fprintf(stderr, "kernel_launch: unexpected shapes (n_in %d out %d ws %zu)\n", n_in, out_size, ws_size); grid = -1; return; }
        int dev = 0, cus = 0, per_cu = 0;
        (void)hipGetDevice(&dev); (void)hipDeviceGetAttribute(&cus, hipDeviceAttributeMultiprocessorCount, dev);
        if (hipFuncSetAttribute((const void*)hymba_fwd, hipFuncAttributeMaxDynamicSharedMemorySize, LDS_BYTES) != hipSuccess) { fprintf(stderr, "kernel_launch: hipFuncSetAttribute failed\n"); grid = -1; return; }
        if (hipOccupancyMaxActiveBlocksPerMultiprocessor(&per_cu, (const void*)hymba_fwd, 512, LDS_BYTES) != hipSuccess || per_cu < 1) { fprintf(stderr, "kernel_launch: occupancy query says %d\n", per_cu); per_cu = 1; }
        (void)hipGetLastError();
        grid = cus > 0 ? cus : 256;
    }
    if (grid < 0) return;
    Args a{};
    for (int i = 0; i < 15; ++i) a.in[i] = (const float*)d_in[i];
    a.out = (float*)d_out; a.ws = (unsigned char*)d_ws; a.sub = 3;
    (void)hipMemsetAsync(d_ws, 0, 16384, stream);
#if PROBE_PHASES
    for (int k = 0; k < NPHASE; ++k) if ((PROBE_PHASES >> k) & 1) { a.lo = k; a.hi = k + 1; a.sub = PROBE_SUB; hipLaunchKernelGGL(hymba_fwd, dim3(grid), dim3(512), LDS_BYTES, stream, a); }
#endif
#if MK_ONE_LAUNCH
    a.lo = 0; a.hi = NPHASE; a.sub = 3;
    void* kargs[] = {&a};
    hipError_t e = hipLaunchCooperativeKernel((const void*)hymba_fwd, dim3(grid), dim3(512), kargs, LDS_BYTES, stream);
    if (e != hipSuccess) fprintf(stderr, "kernel_launch: cooperative launch failed: %s (grid %d)\n", hipGetErrorString(e), grid);
#else
    for (int k = 0; k < NPHASE; ++k) { a.lo = k; a.hi = k + 1; hipLaunchKernelGGL(hymba_fwd, dim3(grid), dim3(512), LDS_BYTES, stream, a); }
#endif
}
```

```cpp
#include <hip/hip_runtime.h>
#include <hip/hip_cooperative_groups.h>
#include <cstdio>
#include <cstdint>
namespace cg = cooperative_groups;

#ifndef DBG_STOP
#define DBG_STOP 0
#define DBG_SEL 2
#endif
#ifndef PROBE_PHASES
#define PROBE_PHASES 0
#define PROBE_SUB 3
#endif
#ifndef MK_ONE_LAUNCH
#define MK_ONE_LAUNCH 1
#endif

#define LAS __attribute__((address_space(3)))
typedef unsigned short bf16_t;
typedef short bf16x8 __attribute__((ext_vector_type(8)));
typedef short s16x4 __attribute__((ext_vector_type(4)));
typedef float f32x4 __attribute__((ext_vector_type(4)));
typedef float f32x2 __attribute__((ext_vector_type(2)));
typedef unsigned u32x4 __attribute__((ext_vector_type(4)));
typedef unsigned u32x2 __attribute__((ext_vector_type(2)));
typedef LAS unsigned char* ldsp;

constexpr int SEQ = 4096, NBATCH = 16, TOK = SEQ * NBATCH, DM = 1024;
constexpr int INW = 5136, NPHYS = 5376, PW = 5184;
constexpr int HNP = 1088, MIXP = 2112;
constexpr int C_Q = 0, C_K = 1024, C_V = 1280, C_G = 1536, C_Z = 2560, C_X = 3072, C_QM = 4096, C_GM = 4608;
constexpr int MIXW = 2048;
constexpr float LOG2E = 1.4426950408889634f;
constexpr float EPS = 1e-6f;
constexpr int NPHASE = 7;

constexpr size_t MiB = (size_t)1 << 20;
constexpr size_t WS_ROWSS = 956 * MiB, WS_ROPE = 1 * MiB, WS_WIN = 2 * MiB, WS_WOUT = 14 * MiB, WS_WMEM = 19 * MiB, WS_MEMN = 22 * MiB,
                 WS_MKV = 31 * MiB, WS_DT = 39 * MiB, WS_DEC = 43 * MiB, WS_PROJ = 44 * MiB, WS_MIX = 692 * MiB, WS_END = 960 * MiB;

constexpr int LDS_BYTES = 155648 + 16;
constexpr int LDS_XB = 155648;

__device__ __forceinline__ unsigned cvt_pk(float lo, float hi) { unsigned r; asm volatile("v_cvt_pk_bf16_f32 %0, %1, %2" : "=v"(r) : "v"(lo), "v"(hi)); return r; }
typedef __bf16 bf16x2_t __attribute__((ext_vector_type(2)));
__device__ __forceinline__ unsigned cvt_pk_c(float lo, float hi) { const f32x2 v = {lo, hi}; return __builtin_bit_cast(unsigned, __builtin_convertvector(v, bf16x2_t)); }
__device__ __forceinline__ float bf_lo(unsigned u) { return __uint_as_float(u << 16); }
__device__ __forceinline__ float bf_hi(unsigned u) { return __uint_as_float(u & 0xffff0000u); }
__device__ __forceinline__ f32x4 unpack4(u32x2 v) { return (f32x4){bf_lo(v.x), bf_hi(v.x), bf_lo(v.y), bf_hi(v.y)}; }
__device__ __forceinline__ u32x2 pack4(f32x4 v) { return (u32x2){cvt_pk_c(v.x, v.y), cvt_pk_c(v.z, v.w)}; }
__device__ __forceinline__ float silu_f(float x) { return x * __builtin_amdgcn_rcpf(1.f + __expf(-x)); }
__device__ __forceinline__ f32x4 silu4(f32x4 v) { return (f32x4){silu_f(v.x), silu_f(v.y), silu_f(v.z), silu_f(v.w)}; }
__device__ __forceinline__ float softplus_f(float x) { return x > 20.f ? x : log1pf(expf(x)); }
__device__ __forceinline__ float ex2(float x) { return __builtin_amdgcn_exp2f(x); }
typedef short v4i16_t __attribute__((ext_vector_type(4)));
__device__ __forceinline__ s16x4 vtr(ldsp p) { return __builtin_bit_cast(s16x4, __builtin_amdgcn_ds_read_tr16_b64_v4i16((LAS v4i16_t*)p)); }
__device__ __forceinline__ bf16x8 cat8(s16x4 a, s16x4 b) { return (bf16x8){a[0], a[1], a[2], a[3], b[0], b[1], b[2], b[3]}; }
__device__ __forceinline__ bf16x8 ld8(ldsp p) { return *(const LAS bf16x8*)p; }
__device__ __forceinline__ f32x4 mfma16(bf16x8 a, bf16x8 b, f32x4 c) { return __builtin_amdgcn_mfma_f32_16x16x32_bf16(a, b, c, 0, 0, 0); }
__device__ __forceinline__ bf16x8 packfrag(f32x4 a, f32x4 b) { u32x4 r = {cvt_pk_c(a.x, a.y), cvt_pk_c(a.z, a.w), cvt_pk_c(b.x, b.y), cvt_pk_c(b.z, b.w)}; return __builtin_bit_cast(bf16x8, r); }

__device__ __forceinline__ f32x4 zero4() { f32x4 z; asm volatile("v_mov_b32 %0, 0\n\tv_mov_b32 %1, 0\n\tv_mov_b32 %2, 0\n\tv_mov_b32 %3, 0" : "=v"(z.x), "=v"(z.y), "=v"(z.z), "=v"(z.w)); return z; }
__device__ __forceinline__ int lane_id_now() { int l; asm volatile("v_mbcnt_lo_u32_b32 %0, -1, 0\n\tv_mbcnt_hi_u32_b32 %0, -1, %0" : "=v"(l)); return l; }
__host__ __device__ __forceinline__ int perm_plain(int c) { const int bj = c >> 7, wc = (c >> 5) & 3, n = (c >> 4) & 1, fq = (c >> 2) & 3, i = c & 3; return 128 * bj + 32 * wc + 8 * fq + 4 * n + i; }
__host__ __device__ __forceinline__ int perm_rot(int c) { const int bj = c >> 7, wc = (c >> 5) & 3, n = (c >> 4) & 1, fq = (c >> 2) & 3, i = c & 3; return 64 * wc + 32 * bj + 8 * fq + 4 * n + i; }

namespace pg8 {
constexpr int BM = 256, BK = 64, HALF = 128, HTB = HALF * BK * 2, STAGE_BYTES = 8 * HTB, NXCD = 8, WGM = 8;
__host__ __device__ __forceinline__ int lds_byte(int r, int c) { const int st = (r >> 4) * 2 + (c >> 5), rr = r & 15, cc = c & 31, ob = rr * 64 + cc * 2; return st * 1024 + (ob ^ (((ob >> 9) & 1) << 5)); }
__host__ __device__ __forceinline__ void stage_rc(int b, int& R, int& C) { const int st = b / 1024, sb = b % 1024, swz = sb ^ (((sb >> 9) & 1) << 5); R = (st >> 1) * 16 + swz / 64; C = (st & 1) * 32 + (swz % 64) / 2; }
struct Unit { int pm, pn; };
struct Gemm { const bf16_t* A; const bf16_t* Bt; int M, N, K, lda, ldb; };
struct StaticOrder {
    int nM, nN, nwg, G, c;
    __device__ void init(int M, int N, int G_, int c_) { nM = M / BM; nN = N / BM; nwg = nM * nN; G = G_; c = c_; }
    __device__ bool next(int i, Unit& u) const {
        const long L = (long)i * G + c; if (L >= nwg) return false;
        int wgid = (int)L; { const int q = nwg / NXCD, r = nwg % NXCD, xcd = wgid % NXCD, off = wgid / NXCD; wgid = (xcd < r ? xcd * (q + 1) : r * (q + 1) + (xcd - r) * q) + off; }
        const int nig = WGM * nN, gid = wgid / nig, fm = gid * WGM, gsz = (nM - fm) < WGM ? (nM - fm) : WGM;
        u.pm = fm + ((wgid % nig) % gsz); u.pn = (wgid % nig) / gsz; return true;
    }
};
struct PanelOrder {
    int nM, nN, G, c;
    __device__ void init(int M, int N, int G_, int c_) { nM = M / BM; nN = N / BM; G = G_; c = c_; }
    __device__ bool next(int i, Unit& u) const { const int pm = c + (i / nN) * G; if (pm >= nM) return false; u.pm = pm; u.pn = i % nN; return true; }
};

template <class Epi, class Sched>
__device__ __forceinline__ void gemm_phase(ldsp lds, const Gemm g, const Sched& S, const Epi& E, int wave_id) {
    const int lane = lane_id_now(), wid = wave_id, tid = wid * 64 + lane, wr = wid >> 2, wc = wid & 3, fr = lane & 15, fq = lane >> 4;
    const int K = g.K, nt = K / BK;
    unsigned voffA[2], voffB[2];
#pragma unroll
    for (int i = 0; i < 2; ++i) { int R, C; stage_rc(tid * 16 + i * 8192, R, C); voffA[i] = (unsigned)(R * g.lda + C) * 2u; voffB[i] = (unsigned)(R * g.ldb + C) * 2u; }
    const size_t kstep = (size_t)(BK * 2);
    const size_t hstep = (size_t)HALF * g.lda * 2, hstepB = (size_t)HALF * g.ldb * 2;
    const size_t tstep = 2 * hstep, tstepB = 2 * hstepB;
    const unsigned ldsw = (unsigned)wid * 1024u;
    const int aoff = lds_byte(wr * 64 + fr, fq * 8), boff = lds_byte(wc * 32 + fr, fq * 8);
#define PG8_SA(b, h) (((b) * 2 + (h)) * HTB)
#define PG8_SB(b, h) ((4 + (b) * 2 + (h)) * HTB)
#define PG8_STAGE(bufoff, gbase, voff) do { _Pragma("unroll") for (int _i = 0; _i < 2; ++_i) \
        __builtin_amdgcn_global_load_lds((const unsigned*)((const char*)(gbase) + (voff)[_i]), (LAS unsigned*)(lds + (bufoff) + ldsw + _i * 8192), 16, 0, 0); } while (0)
#define PG8_LDA(dst, b, h) do { _Pragma("unroll") for (int m = 0; m < 4; ++m) _Pragma("unroll") for (int k = 0; k < 2; ++k) dst[m][k] = *(const LAS bf16x8*)(lds + PG8_SA(b, h) + aoff + m * 2048 + k * 1024); } while (0)
#define PG8_LDB(dst, b, h) do { _Pragma("unroll") for (int n = 0; n < 2; ++n) _Pragma("unroll") for (int k = 0; k < 2; ++k) dst[n][k] = *(const LAS bf16x8*)(lds + PG8_SB(b, h) + boff + n * 2048 + k * 1024); } while (0)
#define PG8_MMA(ai, bj, At, Bt) do { __builtin_amdgcn_s_setprio(1); _Pragma("unroll") for (int m = 0; m < 4; ++m) _Pragma("unroll") for (int n = 0; n < 2; ++n) _Pragma("unroll") for (int k = 0; k < 2; ++k) \
        acc[ai][bj][m][n] = __builtin_amdgcn_mfma_f32_16x16x32_bf16(Bt[n][k], At[m][k], acc[ai][bj][m][n], 0, 0, 0); __builtin_amdgcn_s_setprio(0); } while (0)
#define PG8_WAIT_V(n) asm volatile("s_waitcnt vmcnt(" #n ")" ::: "memory")
#define PG8_WAIT_L(n) asm volatile("s_waitcnt lgkmcnt(" #n ")" ::: "memory")
#define PG8_BAR __builtin_amdgcn_s_barrier()
#define PG8_SCHED __builtin_amdgcn_sched_barrier(0)
    Unit cur, nxt; int ui = 0;
    if (!S.next(0, cur)) return;
    f32x4 acc[2][2][4][2];
#pragma unroll
    for (int a = 0; a < 2; ++a)
#pragma unroll
        for (int b = 0; b < 2; ++b)
#pragma unroll
            for (int m = 0; m < 4; ++m)
#pragma unroll
                for (int n = 0; n < 2; ++n) acc[a][b][m][n] = (f32x4){0.f, 0.f, 0.f, 0.f};
    bf16x8 At[4][2], B0[2][2], B1[2][2];
    const char* cA = (const char*)g.A + (size_t)cur.pm * tstep; const char* cB = (const char*)g.Bt + (size_t)cur.pn * tstepB;
    PG8_STAGE(PG8_SB(0, 0), cB, voffB); PG8_STAGE(PG8_SA(0, 0), cA, voffA); PG8_STAGE(PG8_SB(0, 1), cB + hstepB, voffB); PG8_STAGE(PG8_SA(0, 1), cA + hstep, voffA);
    if (wr == 1) PG8_BAR;
    PG8_WAIT_V(4); PG8_BAR;
    PG8_STAGE(PG8_SB(1, 0), cB + kstep, voffB); PG8_STAGE(PG8_SA(1, 0), cA + kstep, voffA); PG8_STAGE(PG8_SB(1, 1), cB + hstepB + kstep, voffB);
    PG8_WAIT_V(6); PG8_BAR;
    for (;;) {
        const bool has_next = S.next(ui + 1, nxt);
        const char* nA = has_next ? (const char*)g.A + (size_t)nxt.pm * tstep : cA; const char* nB = has_next ? (const char*)g.Bt + (size_t)nxt.pn * tstepB : cB;
        for (int t = 0; t < nt; t += 2) {
            const bool last = (t == nt - 2);
            const char* a1 = cA + (size_t)(t + 1) * kstep;
            const char* a2 = last ? nA : cA + (size_t)(t + 2) * kstep; const char* b2 = last ? nB : cB + (size_t)(t + 2) * kstep;
            const char* a3 = a2 + kstep; const char* b3 = b2 + kstep;
            PG8_LDB(B0, 0, 0); PG8_SCHED; PG8_LDA(At, 0, 0); PG8_STAGE(PG8_SA(1, 1), a1 + hstep, voffA);
            PG8_WAIT_L(8); PG8_BAR; PG8_WAIT_L(0); PG8_MMA(0, 0, At, B0); PG8_BAR; PG8_SCHED;
            PG8_LDB(B1, 0, 1); PG8_STAGE(PG8_SB(0, 0), b2, voffB);
            PG8_BAR; PG8_WAIT_L(0); PG8_MMA(0, 1, At, B1); PG8_BAR;
            PG8_LDA(At, 0, 1); PG8_STAGE(PG8_SA(0, 0), a2, voffA);
            PG8_BAR; PG8_WAIT_L(0); PG8_MMA(1, 0, At, B0); PG8_BAR; PG8_SCHED;
            PG8_STAGE(PG8_SB(0, 1), b2 + hstepB, voffB);
            PG8_WAIT_V(6); PG8_BAR; PG8_MMA(1, 1, At, B1); PG8_BAR;
            PG8_LDB(B0, 1, 0); PG8_SCHED; PG8_LDA(At, 1, 0); PG8_STAGE(PG8_SA(0, 1), a2 + hstep, voffA);
            PG8_WAIT_L(8); PG8_BAR; PG8_WAIT_L(0); PG8_MMA(0, 0, At, B0); PG8_BAR; PG8_SCHED;
            PG8_LDB(B1, 1, 1); PG8_STAGE(PG8_SB(1, 0), b3, voffB);
            PG8_BAR; PG8_WAIT_L(0); PG8_MMA(0, 1, At, B1); PG8_BAR;
            PG8_LDA(At, 1, 1); PG8_STAGE(PG8_SA(1, 0), a3, voffA);
            PG8_BAR; PG8_WAIT_L(0); PG8_MMA(1, 0, At, B0); PG8_BAR; PG8_SCHED;
            PG8_STAGE(PG8_SB(1, 1), b3 + hstepB, voffB);
            PG8_WAIT_V(6); PG8_BAR; PG8_MMA(1, 1, At, B1); PG8_BAR;
        }
        E(acc, cur, wr, wc, fr, fq);
        if (!has_next) break;
#pragma unroll
        for (int a = 0; a < 2; ++a)
#pragma unroll
            for (int b = 0; b < 2; ++b)
#pragma unroll
                for (int m = 0; m < 4; ++m)
#pragma unroll
                    for (int n = 0; n < 2; ++n) acc[a][b][m][n] = (f32x4){0.f, 0.f, 0.f, 0.f};
        cur = nxt; cA = nA; cB = nB; ++ui;
    }
    PG8_WAIT_V(0);
    if (wr == 0) PG8_BAR;
    PG8_BAR;
#undef PG8_SA
#undef PG8_SB
#undef PG8_STAGE
#undef PG8_LDA
#undef PG8_LDB
#undef PG8_MMA
#undef PG8_WAIT_V
#undef PG8_WAIT_L
#undef PG8_BAR
#undef PG8_SCHED
}
}

struct EpiProj {
    bf16_t* P; float* DT; const float* rope; const float* dt_bias;
    __device__ __forceinline__ void operator()(const f32x4 (&acc)[2][2][4][2], const pg8::Unit& u, int wr, int wc, int fr, int fq) const {
        const int row0 = u.pm * 256 + wr * 64 + fr, pn = u.pn;
        if (pn < 5) {
            const float sc = pn < 4 ? 0.125f * LOG2E : 1.f;
            const int col = pn * 256 + 64 * wc + 8 * fq;
#pragma unroll
            for (int ai = 0; ai < 2; ++ai)
#pragma unroll
                for (int m = 0; m < 4; ++m) {
                    const int row = row0 + ai * 128 + m * 16, pos = row & (SEQ - 1);
                    const f32x4* cp = (const f32x4*)(rope + pos * 32 + 8 * fq); const f32x4* sp = (const f32x4*)(rope + SEQ * 32 + pos * 32 + 8 * fq);
                    f32x4 o1[2], o2[2];
#pragma unroll
                    for (int n = 0; n < 2; ++n) { const f32x4 c = cp[n], s = sp[n], t1 = acc[ai][0][m][n], t2 = acc[ai][1][m][n]; o1[n] = (t1 * c - t2 * s) * sc; o2[n] = (t1 * s + t2 * c) * sc; }
                    bf16_t* dst = P + (size_t)row * PW + col;
                    __builtin_nontemporal_store((u32x4){cvt_pk(o1[0].x, o1[0].y), cvt_pk(o1[0].z, o1[0].w), cvt_pk(o1[1].x, o1[1].y), cvt_pk(o1[1].z, o1[1].w)}, (u32x4*)dst);
                    __builtin_nontemporal_store((u32x4){cvt_pk(o2[0].x, o2[0].y), cvt_pk(o2[0].z, o2[0].w), cvt_pk(o2[1].x, o2[1].y), cvt_pk(o2[1].z, o2[1].w)}, (u32x4*)(dst + 32));
                }
        } else if (pn < 20) {
            const bool do_silu = (pn >= 6 && pn < 12) || pn >= 18;
            const float sc = (pn == 16 || pn == 17) ? 0.08838834764831845f * LOG2E : 1.f;
            const int col = pn * 256 + 32 * wc + 8 * fq;
#pragma unroll
            for (int ai = 0; ai < 2; ++ai)
#pragma unroll
                for (int m = 0; m < 4; ++m) {
                    const int row = row0 + ai * 128 + m * 16;
#pragma unroll
                    for (int bj = 0; bj < 2; ++bj) {
                        f32x4 v0 = acc[ai][bj][m][0], v1 = acc[ai][bj][m][1];
                        if (do_silu) { v0 = silu4(v0); v1 = silu4(v1); } else { v0 = v0 * sc; v1 = v1 * sc; }
                        __builtin_nontemporal_store((u32x4){cvt_pk(v0.x, v0.y), cvt_pk(v0.z, v0.w), cvt_pk(v1.x, v1.y), cvt_pk(v1.z, v1.w)}, (u32x4*)(P + (size_t)row * PW + col + 128 * bj));
                    }
                }
        } else {
            if (wc == 0 && fq < 2) {
#pragma unroll
                for (int ai = 0; ai < 2; ++ai)
#pragma unroll
                    for (int m = 0; m < 4; ++m) {
                        const int row = row0 + ai * 128 + m * 16;
#pragma unroll
                        for (int n = 0; n < 2; ++n) {
                            const int j0 = 8 * fq + 4 * n; const f32x4 bb = *(const f32x4*)(dt_bias + j0); const f32x4 v = acc[ai][0][m][n] + bb;
                            *(f32x4*)(DT + (size_t)row * 16 + j0) = (f32x4){softplus_f(v.x), softplus_f(v.y), softplus_f(v.z), softplus_f(v.w)};
                        }
                    }
            }
        }
    }
};
struct EpiMkv {
    bf16_t* O;
    __device__ __forceinline__ void operator()(const f32x4 (&acc)[2][2][4][2], const pg8::Unit& u, int wr, int wc, int fr, int fq) const {
        const int row0 = u.pm * 256 + wr * 64 + fr, col = u.pn * 256 + 32 * wc + 8 * fq;
#pragma unroll
        for (int ai = 0; ai < 2; ++ai)
#pragma unroll
            for (int m = 0; m < 4; ++m) {
                const int row = row0 + ai * 128 + m * 16;
#pragma unroll
                for (int bj = 0; bj < 2; ++bj) { const f32x4 v0 = acc[ai][bj][m][0], v1 = acc[ai][bj][m][1];
                    *(u32x4*)(O + (size_t)row * 1024 + col + 128 * bj) = (u32x4){cvt_pk(v0.x, v0.y), cvt_pk(v0.z, v0.w), cvt_pk(v1.x, v1.y), cvt_pk(v1.z, v1.w)}; }
            }
    }
};
struct EpiOut {
    const float* x; float* out; float* rowss;
    __device__ __forceinline__ void operator()(const f32x4 (&acc)[2][2][4][2], const pg8::Unit& u, int wr, int wc, int fr, int fq) const {
        const int row0 = u.pm * 256 + wr * 64 + fr, col = u.pn * 256 + 32 * wc + 8 * fq;
#pragma unroll
        for (int ai = 0; ai < 2; ++ai)
#pragma unroll
            for (int m = 0; m < 4; ++m) {
                const int row = row0 + ai * 128 + m * 16; float ss = 0.f;
#pragma unroll
                for (int bj = 0; bj < 2; ++bj) {
                    const size_t o = (size_t)row * DM + col + 128 * bj;
                    const f32x4 h0 = __builtin_nontemporal_load((const f32x4*)(x + o)) + acc[ai][bj][m][0], h1 = __builtin_nontemporal_load((const f32x4*)(x + o + 4)) + acc[ai][bj][m][1];
                    *(f32x4*)(out + o) = h0; *(f32x4*)(out + o + 4) = h1;
                    ss += h0.x * h0.x + h0.y * h0.y + h0.z * h0.z + h0.w * h0.w + h1.x * h1.x + h1.y * h1.y + h1.z * h1.z + h1.w * h1.w;
                }
                ss += __shfl_xor(ss, 16); ss += __shfl_xor(ss, 32);
                if (fq == 0) rowss[(size_t)row * 16 + u.pn * 4 + wc] = ss;
            }
    }
};

struct Args { const float* in[15]; float* out; unsigned char* ws; int lo, hi, sub, pad; };
struct Ctx {
    const float *x, *mem, *norm_mem_w, *norm_in_w, *w_in, *attn_sink, *conv_w, *conv_b, *dt_bias, *a_log, *d_skip, *ssd_norm_w, *w_mem_kv, *w_out, *norm_out_w;
    float* out; unsigned char* ws;
    __device__ __forceinline__ float* rowss() const { return (float*)(ws + WS_ROWSS); }
    __device__ __forceinline__ float* rope() const { return (float*)(ws + WS_ROPE); }
    __device__ __forceinline__ bf16_t* win_t() const { return (bf16_t*)(ws + WS_WIN); }
    __device__ __forceinline__ bf16_t* wout_t() const { return (bf16_t*)(ws + WS_WOUT); }
    __device__ __forceinline__ bf16_t* wmem_t() const { return (bf16_t*)(ws + WS_WMEM); }
    __device__ __forceinline__ bf16_t* memn() const { return (bf16_t*)(ws + WS_MEMN); }
    __device__ __forceinline__ bf16_t* mkv() const { return (bf16_t*)(ws + WS_MKV); }
    __device__ __forceinline__ float* dt() const { return (float*)(ws + WS_DT); }
    __device__ __forceinline__ float* dec() const { return (float*)(ws + WS_DEC); }
    __device__ __forceinline__ bf16_t* proj() const { return (bf16_t*)(ws + WS_PROJ); }
    __device__ __forceinline__ bf16_t* mix() const { return (bf16_t*)(ws + WS_MIX); }
    __device__ __forceinline__ bf16_t* hn() const { return (bf16_t*)((unsigned char*)out); }
    __device__ __forceinline__ bf16_t* st() const { return (bf16_t*)((unsigned char*)out); }
    __device__ __forceinline__ bf16_t* yp() const { return (bf16_t*)((unsigned char*)out + 128 * MiB); }
    __device__ __forceinline__ bf16_t* cfb() const { return (bf16_t*)((unsigned char*)out + 192 * MiB); }
    __device__ __forceinline__ float* efb() const { return (float*)((unsigned char*)out + 224 * MiB); }
    ldsp lds; int tid, lane, wave, G, bid;
};

__device__ __forceinline__ void rms_row_bf16(const float* xr, const float* w, bf16_t* o, int lane) {
    f32x4 v[4]; float ss = 0.f;
#pragma unroll
    for (int j = 0; j < 4; ++j) { v[j] = __builtin_nontemporal_load((const f32x4*)(xr + 4 * lane + 256 * j)); ss += v[j].x * v[j].x + v[j].y * v[j].y + v[j].z * v[j].z + v[j].w * v[j].w; }
#pragma unroll
    for (int off = 1; off < 64; off <<= 1) ss += __shfl_xor(ss, off);
    const float r = rsqrtf(ss * (1.f / DM) + EPS);
#pragma unroll
    for (int j = 0; j < 4; ++j) { const f32x4 ww = *(const f32x4*)(w + 4 * lane + 256 * j); *(u32x2*)(o + 4 * lane + 256 * j) = pack4(v[j] * r * ww); }
}
template <int MODE>
__device__ __forceinline__ void transpose_w(const Ctx& F, const float* W, int K, int NS, bf16_t* Bt, int NP, int ldb) {
    const int nitems = NP * (K / 8);
    for (int it = F.bid * 512 + F.tid; it < nitems; it += F.G * 512) {
        const int n = it % NP, kg = it / NP, tile = n >> 8, cph = n & 255; int src;
        if (MODE == 0) {
            if (tile < 5) src = tile * 256 + perm_rot(cph);
            else if (tile < 20) { src = tile * 256 + perm_plain(cph); if (src >= 4096) src += 16; }
            else { const int l = perm_plain(cph); src = l < 16 ? 4096 + l : -1; }
        } else src = tile * 256 + perm_plain(cph);
        float v[8];
#pragma unroll
        for (int j = 0; j < 8; ++j) v[j] = src >= 0 ? W[(size_t)(kg * 8 + j) * NS + src] : 0.f;
        *(u32x4*)(Bt + (size_t)n * ldb + kg * 8) = (u32x4){cvt_pk(v[0], v[1]), cvt_pk(v[2], v[3]), cvt_pk(v[4], v[5]), cvt_pk(v[6], v[7])};
    }
}
__device__ __forceinline__ void phase0(const Ctx& F) {
    const int gt = F.bid * 512 + F.tid, NT = F.G * 512;
    for (int i = gt; i < SEQ * 32; i += NT) {
        const int pos = i >> 5, f = i & 31;
        const float inv = 1.0f / exp2f((float)f * (13.287712379549449f / 32.f));
        const float ang = (float)pos * inv;
        const double rev = (double)ang * 0.15915494309189535; const double fr = rev - __builtin_rint(rev);
        const float r = (float)(fr * 6.283185307179586);
        F.rope()[i] = __cosf(r); F.rope()[SEQ * 32 + i] = __sinf(r);
    }
    transpose_w<0>(F, F.w_in, DM, INW, F.win_t(), NPHYS, HNP);
    transpose_w<1>(F, F.w_out, MIXW, DM, F.wout_t(), DM, MIXP);
    transpose_w<1>(F, F.w_mem_kv, DM, DM, F.wmem_t(), DM, HNP);
    const int gw = F.bid * 8 + F.wave, NGW = F.G * 8;
    for (int m = gw; m < NBATCH * 256; m += NGW) rms_row_bf16(F.mem + (size_t)m * DM, F.norm_mem_w, F.memn() + (size_t)m * HNP, F.lane);
    for (int m = gw; m < TOK; m += NGW) rms_row_bf16(F.x + (size_t)m * DM, F.norm_in_w, F.hn() + (size_t)m * HNP, F.lane);
}

template <int DH, int NQF>
__device__ __forceinline__ void attn_tile(ldsp Kt, int KS, ldsp Vt, int VS, const bf16x8 (&qf)[NQF][DH / 32], f32x4 (&o)[DH / 16][NQF], float (&m)[NQF], float (&lp)[NQF], int maskmode, int lane, int qoff = 0) {
    const int i16 = lane & 15, q4 = lane >> 4;
    f32x4 st[4][NQF];
#pragma unroll
    for (int kf = 0; kf < 4; ++kf)
#pragma unroll
        for (int q = 0; q < NQF; ++q) st[kf][q] = (f32x4){0.f, 0.f, 0.f, 0.f};
#pragma unroll
    for (int ks = 0; ks < DH / 32; ++ks)
#pragma unroll
        for (int kf = 0; kf < 4; ++kf) {
            const bf16x8 ka = ld8(Kt + (16 * kf + i16) * KS + (32 * ks + 8 * q4) * 2);
#pragma unroll
            for (int q = 0; q < NQF; ++q) st[kf][q] = mfma16(ka, qf[q][ks], st[kf][q]);
            if (DH > 64 && kf == 3) __builtin_amdgcn_sched_barrier(0);
        }
    if (maskmode) {
        int zb; asm volatile("v_mov_b32 %0, 0" : "=v"(zb));
        const int base = (maskmode == 1 ? 4 * q4 - i16 - qoff : i16 + qoff - 4 * q4) + zb;
#pragma unroll
        for (int kf = 0; kf < 4; ++kf)
#pragma unroll
            for (int q = 0; q < NQF; ++q)
#pragma unroll
                for (int r = 0; r < 4; ++r) { const int off = 16 * (kf - q) + r; const bool bad = (maskmode == 1 ? base + off : base - off) < 0; if (bad) st[kf][q][r] = -INFINITY; }
    }
#pragma unroll
    for (int q = 0; q < NQF; ++q) {
        float mx = st[0][q][0];
#pragma unroll
        for (int kf = 0; kf < 4; ++kf)
#pragma unroll
            for (int r = 0; r < 4; ++r) mx = fmaxf(mx, st[kf][q][r]);
        mx = fmaxf(mx, __shfl_xor(mx, 16)); mx = fmaxf(mx, __shfl_xor(mx, 32));
        const float mn = fmaxf(m[q], mx), alpha = ex2(m[q] - mn); m[q] = mn;
        float ps = 0.f;
#pragma unroll
        for (int kf = 0; kf < 4; ++kf)
#pragma unroll
            for (int r = 0; r < 4; ++r) { const float p = ex2(st[kf][q][r] - mn); st[kf][q][r] = p; ps += p; }
        lp[q] = lp[q] * alpha + ps;
#pragma unroll
        for (int d = 0; d < DH / 16; ++d) o[d][q] = o[d][q] * alpha;
    }
#pragma unroll
    for (int kp = 0; kp < 2; ++kp) {
        bf16x8 pk[NQF];
#pragma unroll
        for (int q = 0; q < NQF; ++q) pk[q] = packfrag(st[2 * kp][q], st[2 * kp + 1][q]);
#pragma unroll
        for (int d = 0; d < DH / 16; ++d) {
            ldsp va = Vt + (32 * kp + 4 * q4 + (i16 >> 2)) * VS + (16 * d + 4 * (i16 & 3)) * 2;
            const bf16x8 vf = cat8(vtr(va), vtr(va + 16 * VS));
#pragma unroll
            for (int q = 0; q < NQF; ++q) o[d][q] = mfma16(vf, pk[q], o[d][q]);
            if (DH > 64 && (d & 3) == 3) __builtin_amdgcn_sched_barrier(0);
        }
    }
}

__device__ __forceinline__ void attn_window_item(const Ctx& F, int item) {
    constexpr int KS = 144, VS = 160; const ldsp Ki = F.lds, Vi = F.lds + 384 * KS;
    const int kvh = item & 3, i = (item >> 2) & 31, b = item >> 7;
    __syncthreads();
#pragma unroll
    for (int c = F.tid; c < 3072; c += 512) {
        const int r = c >> 3, ch = c & 7, key0 = 128 * i - 128 + r, key = key0 < 0 ? 0 : (key0 >= SEQ ? SEQ - 1 : key0);
        const bf16_t* src = F.proj() + (size_t)(b * SEQ + key) * PW + 64 * kvh + 8 * ch;
        *(LAS u32x4*)(Ki + r * KS + ch * 16) = *(const u32x4*)(src + C_K);
        *(LAS u32x4*)(Vi + r * VS + ch * 16) = *(const u32x4*)(src + C_V);
    }
    __syncthreads();
    const int w = F.wave, lane = F.lane, i16 = lane & 15, q4 = lane >> 4, hq = 4 * kvh + (w >> 1), q0 = 128 * i + 64 * (w & 1);
    bf16x8 qf[4][2];
#pragma unroll
    for (int q = 0; q < 4; ++q)
#pragma unroll
        for (int ks = 0; ks < 2; ++ks) qf[q][ks] = *(const bf16x8*)(F.proj() + (size_t)(b * SEQ + q0 + 16 * q + i16) * PW + C_Q + hq * 64 + 32 * ks + 8 * q4);
    f32x4 o[4][4]; float m[4], lp[4];
    const float sink = F.attn_sink[hq] * LOG2E;
#pragma unroll
    for (int q = 0; q < 4; ++q) { m[q] = sink; lp[q] = q4 == 0 ? 1.f : 0.f;
#pragma unroll
        for (int d = 0; d < 4; ++d) o[d][q] = (f32x4){0.f, 0.f, 0.f, 0.f}; }
#pragma unroll 1
    for (int j = 0; j < 5; ++j) {
        const int kstart = q0 - 128 + 64 * j; if (kstart < 0 || kstart >= SEQ) continue;
        const int ir = 64 * (w & 1) + 64 * j;
        attn_tile<64, 4>(Ki + ir * KS, KS, Vi + ir * VS, VS, qf, o, m, lp, j == 0 ? 1 : (j == 4 ? 2 : 0), lane);
    }
#pragma unroll
    for (int q = 0; q < 4; ++q) {
        float l = lp[q]; l += __shfl_xor(l, 16); l += __shfl_xor(l, 32); const float inv = 1.f / l;
        const size_t row = (size_t)(b * SEQ + q0 + 16 * q + i16);
#pragma unroll
        for (int d = 0; d < 4; ++d) {
            const int col = hq * 64 + 16 * d + 4 * q4;
            const f32x4 g = unpack4(*(const u32x2*)(F.proj() + row * PW + C_G + col));
            *(u32x2*)(F.mix() + row * MIXP + col) = pack4(o[d][q] * inv * g);
        }
    }
}

__device__ __forceinline__ void ring_stage_block(const Ctx& F, const bf16_t* kvbase, int keyblock) {
    constexpr int KS = 144, VS = 160; const ldsp Kb = F.lds + (keyblock & 511) * KS, Vb = F.lds + 512 * KS + (keyblock & 511) * VS;
    const bf16_t* src0 = kvbase + (size_t)keyblock * PW;
    for (int wi = F.wave; wi < 18; wi += 8) {
        const int slot = wi * 64 + F.lane, row = slot / 9, ch = slot - row * 9;
        __builtin_amdgcn_global_load_lds((const unsigned*)(src0 + (size_t)row * PW + C_K + 8 * (ch > 7 ? 7 : ch)), (LAS unsigned*)(Kb + wi * 1024), 16, 0, 0);
    }
    for (int wi = F.wave; wi < 20; wi += 8) {
        const int slot = wi * 64 + F.lane, row = slot / 10, ch = slot - row * 10;
        __builtin_amdgcn_global_load_lds((const unsigned*)(src0 + (size_t)row * PW + C_V + 8 * (ch > 7 ? 7 : ch)), (LAS unsigned*)(Vb + wi * 1024), 16, 0, 0);
    }
}
__device__ __forceinline__ void attn_window_seq(const Ctx& F, int sq) {
    constexpr int KS = 144, VS = 160; const ldsp Ki = F.lds, Vi = F.lds + 512 * KS;
    const int sidx = sq >> 2, b = sidx >> 2, kvh = sidx & 3, i0 = 8 * (sq & 3);
    const int w = F.wave, lane = F.lane, i16 = lane & 15, q4 = lane >> 4, hq = 4 * kvh + (w >> 1);
    const bf16_t* kvbase = F.proj() + (size_t)b * SEQ * PW + 64 * kvh;
    __syncthreads();
    for (int t = 0; t < 3; ++t) { const int kb = 128 * (i0 - 1 + t); if (kb >= 0 && kb < SEQ) ring_stage_block(F, kvbase, kb); }
    const float sink = F.attn_sink[hq] * LOG2E;
#pragma unroll 1
    for (int k = 0; k < 8; ++k) {
        const int i = i0 + k, q0 = 128 * i + 64 * (w & 1);
        __syncthreads();
        { const int nkey0 = 128 * i + 256; if (k < 7 && nkey0 < SEQ) ring_stage_block(F, kvbase, nkey0); }
#pragma unroll 1
        for (int half = 0; half < 2; ++half) {
            const int qh = q0 + 32 * half;
            bf16x8 qf[2][2];
#pragma unroll
            for (int q = 0; q < 2; ++q)
#pragma unroll
                for (int ks = 0; ks < 2; ++ks) qf[q][ks] = *(const bf16x8*)(F.proj() + (size_t)(b * SEQ + qh + 16 * q + i16) * PW + C_Q + hq * 64 + 32 * ks + 8 * q4);
            u32x2 graw[2][4];
#pragma unroll
            for (int q = 0; q < 2; ++q)
#pragma unroll
                for (int d = 0; d < 4; ++d) graw[q][d] = *(const u32x2*)(F.proj() + (size_t)(b * SEQ + qh + 16 * q + i16) * PW + C_G + hq * 64 + 16 * d + 4 * q4);
            f32x4 o[4][2]; float m[2], lp[2];
#pragma unroll
            for (int q = 0; q < 2; ++q) { m[q] = sink; lp[q] = q4 == 0 ? 1.f : 0.f;
#pragma unroll
                for (int d = 0; d < 4; ++d) o[d][q] = (f32x4){0.f, 0.f, 0.f, 0.f}; }
#pragma unroll 1
            for (int j = 0; j < 5; ++j) {
                const int kstart = q0 - 128 + 64 * j; if (kstart < 0 || kstart >= SEQ) continue;
                const int ir = kstart & 511;
                attn_tile<64, 2>(Ki + ir * KS, KS, Vi + ir * VS, VS, qf, o, m, lp, j == 0 ? 1 : (j == 4 ? 2 : 0), lane, 32 * half);
            }
#pragma unroll
            for (int q = 0; q < 2; ++q) {
                float l = lp[q]; l += __shfl_xor(l, 16); l += __shfl_xor(l, 32); const float inv = 1.f / l;
                const size_t row = (size_t)(b * SEQ + qh + 16 * q + i16);
#pragma unroll
                for (int d = 0; d < 4; ++d) {
                    const int col = hq * 64 + 16 * d + 4 * q4;
                    const f32x4 g = unpack4(graw[q][d]);
                    *(u32x2*)(F.mix() + row * MIXP + col) = pack4(o[d][q] * inv * g);
                }
            }
        }
    }
}
__device__ __forceinline__ void attn_mem_item(const Ctx& F, int item, bool stage) {
    constexpr int KS = 272, VS = 288; const ldsp Ki = F.lds, Vi = F.lds + 256 * KS;
    const int qb = item & 15, hm = (item >> 4) & 3, b = item >> 6;
    if (stage) {
    __syncthreads();
#pragma unroll
    for (int c = F.tid; c < 4096; c += 512) {
        const int r = c >> 4, ch = c & 15;
        const bf16_t* src = F.mkv() + (size_t)(b * 256 + r) * 1024 + hm * 128 + 8 * ch;
        *(LAS u32x4*)(Ki + r * KS + ch * 16) = *(const u32x4*)(src);
        *(LAS u32x4*)(Vi + r * VS + ch * 16) = *(const u32x4*)(src + 512);
    }
    __syncthreads();
    }
    const int w = F.wave, lane = F.lane, i16 = lane & 15, q4 = lane >> 4, q0 = 256 * qb + 32 * w;
    bf16x8 qf[2][4];
#pragma unroll
    for (int q = 0; q < 2; ++q)
#pragma unroll
        for (int ks = 0; ks < 4; ++ks) qf[q][ks] = *(const bf16x8*)(F.proj() + (size_t)(b * SEQ + q0 + 16 * q + i16) * PW + C_QM + hm * 128 + 32 * ks + 8 * q4);
    u32x2 graw[2][8];
#pragma unroll
    for (int q = 0; q < 2; ++q)
#pragma unroll
        for (int d = 0; d < 8; ++d) graw[q][d] = *(const u32x2*)(F.proj() + (size_t)(b * SEQ + q0 + 16 * q + i16) * PW + C_GM + hm * 128 + 16 * d + 4 * q4);
    f32x4 o[8][2]; float m[2], lp[2];
#pragma unroll
    for (int q = 0; q < 2; ++q) { m[q] = -INFINITY; lp[q] = 0.f;
#pragma unroll
        for (int d = 0; d < 8; ++d) o[d][q] = (f32x4){0.f, 0.f, 0.f, 0.f}; }
#pragma unroll 1
    for (int j = 0; j < 4; ++j) attn_tile<128, 2>(Ki + 64 * j * KS, KS, Vi + 64 * j * VS, VS, qf, o, m, lp, 0, lane);
#pragma unroll
    for (int q = 0; q < 2; ++q) {
        float l = lp[q]; l += __shfl_xor(l, 16); l += __shfl_xor(l, 32); const float inv = 1.f / l;
        const size_t row = (size_t)(b * SEQ + q0 + 16 * q + i16);
#pragma unroll
        for (int d = 0; d < 8; ++d) {
            const int col = hm * 128 + 16 * d + 4 * q4;
            const f32x4 g = unpack4(graw[q][d]);
            *(u32x2*)(F.mix() + row * MIXP + 1536 + col) = pack4(o[d][q] * inv * g);
        }
    }
}

constexpr int XS = 544, BS = 288, XWS = 160, PS = 272;
constexpr int L_XI = 0, L_BI = 128 * XS, L_CI = L_BI + 128 * BS, L_F32 = L_CI + 128 * BS;
static_assert(L_F32 + 12288 <= LDS_XB, "lds");
__device__ __forceinline__ void ssd_dtprep(const Ctx& F, int b, int c, int g, bool write_dec) {
    LAS float* DTs = (LAS float*)(F.lds + L_F32); LAS float* ACs = DTs + 1024;
    const int w = F.wave, lane = F.lane, dir = w >> 2, r = w & 3, h = 4 * g + r, j = dir * 8 + h;
    const size_t row0 = (size_t)b * SEQ + c * 128;
    const float d0 = F.dt()[(row0 + 2 * lane) * 16 + j], d1 = F.dt()[(row0 + 2 * lane + 1) * 16 + j];
    const float a = -expf(F.a_log[j]);
    const float x0 = d0 * a, x1 = d1 * a, ps = x0 + x1; float inc = ps;
#pragma unroll
    for (int off = 1; off < 64; off <<= 1) { const float t = __shfl_up(inc, off); if (lane >= off) inc += t; }
    const float total = __shfl(inc, 63);
    float a0, a1;
    if (dir == 0) { a0 = inc - x1; a1 = inc; } else { a0 = total - (inc - ps); a1 = total - (inc - x1); }
    *(LAS f32x2*)(DTs + w * 128 + 2 * lane) = (f32x2){d0, d1};
    *(LAS f32x2*)(ACs + w * 128 + 2 * lane) = (f32x2){a0, a1};
    *(LAS f32x2*)(ACs + 1024 + w * 128 + 2 * lane) = (f32x2){d0 * expf(total - a0), d1 * expf(total - a1)};
    if (write_dec && lane == 0) F.dec()[(b * 32 + c) * 16 + j] = expf(total);
}
template <int NCOLS>
__device__ __forceinline__ void conv_img(const Ctx& F, int b, int c, int xcol, ldsp img, int stride) {
    constexpr int NCQ = NCOLS / 4, NRG = 512 / NCQ, R = 128 / NRG;
    const int cq = F.tid % NCQ, rg = F.tid / NCQ, col = xcol + 4 * cq;
    f32x4 w[5];
#pragma unroll
    for (int j = 0; j < 5; ++j) w[j] = *(const f32x4*)(F.conv_w + j * 1024 + col);
    const f32x4 bias = *(const f32x4*)(F.conv_b + col);
    const int t0 = c * 128 + rg * R - 2;
    const bf16_t* base = F.proj() + (size_t)b * SEQ * PW + C_X + col;
    f32x4 win[R + 4];
#pragma unroll
    for (int k = 0; k < R + 4; ++k) { const int t = t0 + k, tc = t < 0 ? 0 : (t >= SEQ ? SEQ - 1 : t); const u32x2 raw = *(const u32x2*)(base + (size_t)tc * PW); const bool ok = (t == tc);
        win[k] = unpack4((u32x2){ok ? raw.x : 0u, ok ? raw.y : 0u}); }
#pragma unroll
    for (int r = 0; r < R; ++r) {
        f32x4 y = bias;
#pragma unroll
        for (int j = 0; j < 5; ++j) y = y + w[j] * win[r + j];
        *(LAS u32x2*)(img + (rg * R + r) * stride + cq * 8) = pack4(silu4(y));
    }
}
__device__ __forceinline__ void ssd_pass1_item(const Ctx& F, int item) {
    const int g = item & 1, c = (item >> 1) & 31, b = item >> 6;
    const ldsp XI = F.lds + L_XI, BI = F.lds + L_BI, CI = F.lds + L_CI;
    LAS float* DTs = (LAS float*)(F.lds + L_F32); LAS float* ACs = DTs + 1024;
    __syncthreads();
    ssd_dtprep(F, b, c, g, true);
    conv_img<256>(F, b, c, 256 * g, XI, XS);
    conv_img<128>(F, b, c, 512 + 128 * g, BI, BS);
    conv_img<128>(F, b, c, 768 + 128 * g, CI, BS);
    __syncthreads();
    const int lane = F.lane, i16 = lane & 15, q4 = lane >> 4, w = F.wave, tl = 16 * w + i16;
    const size_t row = (size_t)b * SEQ + c * 128 + tl;
    f32x4 cbt[8];
    {
        bf16x8 cf[4];
#pragma unroll
        for (int ks = 0; ks < 4; ++ks) cf[ks] = ld8(CI + tl * BS + (32 * ks + 8 * q4) * 2);
#pragma unroll
        for (int ks = 0; ks < 4; ++ks) *(bf16x8*)(F.cfb() + ((size_t)(item * 8 + w) * 64 + lane) * 32 + 8 * ks) = cf[ks];
#pragma unroll
        for (int sf = 0; sf < 8; ++sf) {
            cbt[sf] = (f32x4){0.f, 0.f, 0.f, 0.f};
#pragma unroll
            for (int ks = 0; ks < 4; ++ks) cbt[sf] = mfma16(ld8(BI + (16 * sf + i16) * BS + (32 * ks + 8 * q4) * 2), cf[ks], cbt[sf]);
        }
    }
#pragma unroll 1
    for (int r = 0; r < 4; ++r) {
        {
            const int dir = w & 1, nq = w >> 1;
            LAS const float* Wr = ACs + 1024 + (dir * 4 + r) * 128;
            f32x4 acc[2][4];
#pragma unroll
            for (int nf = 0; nf < 2; ++nf)
#pragma unroll
                for (int pf = 0; pf < 4; ++pf) acc[nf][pf] = (f32x4){0.f, 0.f, 0.f, 0.f};
#pragma unroll
            for (int ks = 0; ks < 4; ++ks) {
                const int t0 = 32 * ks + 8 * q4, trow = t0 + (i16 >> 2);
                const f32x4 wlo = *(const LAS f32x4*)(Wr + t0), whi = *(const LAS f32x4*)(Wr + t0 + 4);
                bf16x8 af[2], bfr[4];
#pragma unroll
                for (int nf = 0; nf < 2; ++nf) {
                    ldsp p = BI + trow * BS + (32 * nq + 16 * nf + 4 * (i16 & 3)) * 2;
                    const u32x2 lo = __builtin_bit_cast(u32x2, vtr(p)), hi = __builtin_bit_cast(u32x2, vtr(p + 4 * BS));
                    af[nf] = packfrag(unpack4(lo) * wlo, unpack4(hi) * whi);
                }
#pragma unroll
                for (int pf = 0; pf < 4; ++pf) { ldsp p = XI + trow * XS + (64 * r + 16 * pf + 4 * (i16 & 3)) * 2; bfr[pf] = cat8(vtr(p), vtr(p + 4 * XS)); }
#pragma unroll
                for (int nf = 0; nf < 2; ++nf)
#pragma unroll
                    for (int pf = 0; pf < 4; ++pf) acc[nf][pf] = mfma16(af[nf], bfr[pf], acc[nf][pf]);
            }
            bf16_t* S = F.st() + ((((size_t)(b * 32 + c) * 2 + dir) * 8 + (4 * g + r)) << 13);
#pragma unroll
            for (int nf = 0; nf < 2; ++nf)
#pragma unroll
                for (int pf = 0; pf < 4; ++pf) *(u32x2*)(S + (16 * pf + i16) * 128 + 32 * nq + 16 * nf + 4 * q4) = pack4(acc[nf][pf]);
        }
        {
            const float acf = ACs[r * 128 + tl], acb = ACs[(4 + r) * 128 + tl];
            f32x4 yt[4];
#pragma unroll
            for (int pf = 0; pf < 4; ++pf) yt[pf] = (f32x4){0.f, 0.f, 0.f, 0.f};
#pragma unroll
            for (int kp = 0; kp < 4; ++kp) {
                f32x4 gt[2];
#pragma unroll
                for (int u = 0; u < 2; ++u) {
                    const int sf = 2 * kp + u, s0 = 16 * sf + 4 * q4;
                    const f32x4 dtf = *(const LAS f32x4*)(DTs + r * 128 + s0), af = *(const LAS f32x4*)(ACs + r * 128 + s0);
                    const f32x4 dtb = *(const LAS f32x4*)(DTs + (4 + r) * 128 + s0), ab = *(const LAS f32x4*)(ACs + (4 + r) * 128 + s0);
#pragma unroll
                    for (int e = 0; e < 4; ++e) {
                        const int sx = s0 + e;
                        const float mf = sx <= tl ? dtf[e] * __expf(acf - af[e]) : 0.f;
                        const float mb = sx >= tl ? dtb[e] * __expf(acb - ab[e]) : 0.f;
                        gt[u][e] = cbt[sf][e] * (mf + mb);
                    }
                }
                const bf16x8 gk = packfrag(gt[0], gt[1]);
#pragma unroll
                for (int pf = 0; pf < 4; ++pf) {
                    ldsp xa = XI + (32 * kp + 4 * q4 + (i16 >> 2)) * XS + (64 * r + 16 * pf + 4 * (i16 & 3)) * 2;
                    yt[pf] = mfma16(cat8(vtr(xa), vtr(xa + 16 * XS)), gk, yt[pf]);
                }
            }
            const float dsk = F.d_skip[4 * g + r];
#pragma unroll
            for (int pf = 0; pf < 4; ++pf) {
                const int pc = 64 * r + 16 * pf + 4 * q4;
                const f32x4 xv = unpack4(*(const LAS u32x2*)(XI + tl * XS + pc * 2));
                *(u32x2*)(F.yp() + row * 512 + 256 * g + pc) = pack4(yt[pf] + xv * dsk);
            }
            if (q4 == 0) { F.efb()[row * 16 + 4 * g + r] = __expf(acf); F.efb()[row * 16 + 8 + 4 * g + r] = __expf(acb); }
        }
    }
}
__device__ __forceinline__ void ssd_scan(const Ctx& F, int vb, int vg) {
    for (int it = vb * 512 + F.tid; it < NBATCH * 2 * 8 * 1024; it += vg * 512) {
        const int e8 = it & 1023, h = (it >> 10) & 7, dir = (it >> 13) & 1, b = it >> 14;
        float run[8];
#pragma unroll
        for (int k = 0; k < 8; ++k) run[k] = 0.f;
        for (int s0 = 0; s0 < 32; s0 += 4) {
            u32x4 v[4]; float dc[4]; bf16_t* ad[4];
#pragma unroll
            for (int u = 0; u < 4; ++u) { const int s = s0 + u, c = dir ? 31 - s : s; ad[u] = F.st() + (((((size_t)(b * 32 + c) * 2 + dir) * 8 + h) << 13) + e8 * 8); v[u] = __builtin_nontemporal_load((const u32x4*)ad[u]); dc[u] = F.dec()[(b * 32 + c) * 16 + dir * 8 + h]; }
#pragma unroll
            for (int u = 0; u < 4; ++u) {
                __builtin_nontemporal_store((u32x4){cvt_pk(run[0], run[1]), cvt_pk(run[2], run[3]), cvt_pk(run[4], run[5]), cvt_pk(run[6], run[7])}, (u32x4*)ad[u]);
                run[0] = run[0] * dc[u] + bf_lo(v[u].x); run[1] = run[1] * dc[u] + bf_hi(v[u].x); run[2] = run[2] * dc[u] + bf_lo(v[u].y); run[3] = run[3] * dc[u] + bf_hi(v[u].y);
                run[4] = run[4] * dc[u] + bf_lo(v[u].z); run[5] = run[5] * dc[u] + bf_hi(v[u].z); run[6] = run[6] * dc[u] + bf_lo(v[u].w); run[7] = run[7] * dc[u] + bf_hi(v[u].w);
            }
        }
    }
}
__device__ __forceinline__ void ssd_pass2_item(const Ctx& F, int item) {
    const int g = item & 1, c = (item >> 1) & 31, b = item >> 6;
    const ldsp PV = F.lds;
    const int lane = F.lane, i16 = lane & 15, q4 = lane >> 4, w = F.wave, tl = 16 * w + i16;
    const size_t row = (size_t)b * SEQ + c * 128 + tl;
    bf16x8 cf[4];
#pragma unroll
    for (int ks = 0; ks < 4; ++ks) cf[ks] = *(const bf16x8*)(F.cfb() + ((size_t)(item * 8 + w) * 64 + lane) * 32 + 8 * ks);
    const int pdir = F.tid >> 8, pp = (F.tid >> 2) & 63, pqu = F.tid & 3;
    const bf16_t* psrc = F.st() + (((((size_t)(b * 32 + c) * 2 + pdir) * 8 + 4 * g) << 13) + pp * 128 + 32 * pqu);
    u32x4 pvn[4][4];
#pragma unroll
    for (int r = 0; r < 4; ++r)
#pragma unroll
        for (int k = 0; k < 4; ++k) pvn[r][k] = *(const u32x4*)(psrc + ((size_t)r << 13) + 8 * k);
    __syncthreads();
#pragma unroll
    for (int r = 0; r < 4; ++r)
#pragma unroll
        for (int k = 0; k < 4; ++k) *(LAS u32x4*)(PV + (2 * r + pdir) * (64 * PS) + pp * PS + (32 * pqu + 8 * k) * 2) = pvn[r][k];
    __syncthreads();
    f32x4 gy[4][4]; float ss = 0.f;
#pragma unroll
    for (int r = 0; r < 4; ++r) {
        u32x2 zraw[4], yraw[4];
#pragma unroll
        for (int pf = 0; pf < 4; ++pf) { const int pc = 256 * g + 64 * r + 16 * pf + 4 * q4; zraw[pf] = *(const u32x2*)(F.proj() + row * PW + C_Z + pc); yraw[pf] = *(const u32x2*)(F.yp() + row * 512 + pc); }
        const float ef = F.efb()[row * 16 + 4 * g + r], eb = F.efb()[row * 16 + 8 + 4 * g + r];
        const ldsp PVr = PV + 2 * r * (64 * PS);
        f32x4 yf[4], yb[4];
#pragma unroll
        for (int pf = 0; pf < 4; ++pf) { yf[pf] = (f32x4){0.f, 0.f, 0.f, 0.f}; yb[pf] = (f32x4){0.f, 0.f, 0.f, 0.f}; }
#pragma unroll
        for (int ks = 0; ks < 4; ++ks)
#pragma unroll
            for (int pf = 0; pf < 4; ++pf) {
                yf[pf] = mfma16(ld8(PVr + (16 * pf + i16) * PS + (32 * ks + 8 * q4) * 2), cf[ks], yf[pf]);
                yb[pf] = mfma16(ld8(PVr + 64 * PS + (16 * pf + i16) * PS + (32 * ks + 8 * q4) * 2), cf[ks], yb[pf]);
            }
#pragma unroll
        for (int pf = 0; pf < 4; ++pf) {
            const f32x4 y = (unpack4(yraw[pf]) + yf[pf] * ef + yb[pf] * eb) * unpack4(zraw[pf]);
            gy[r][pf] = y; ss += y.x * y.x + y.y * y.y + y.z * y.z + y.w * y.w;
        }
    }
    ss += __shfl_xor(ss, 16); ss += __shfl_xor(ss, 32);
    const float rinv = rsqrtf(ss * (1.f / 256.f) + EPS);
#pragma unroll
    for (int r = 0; r < 4; ++r)
#pragma unroll
        for (int pf = 0; pf < 4; ++pf) {
            const int pc = 256 * g + 64 * r + 16 * pf + 4 * q4;
            const f32x4 nw = *(const f32x4*)(F.ssd_norm_w + pc);
            *(u32x2*)(F.mix() + row * MIXP + 1024 + pc) = pack4(gy[r][pf] * rinv * nw);
        }
}

__device__ __forceinline__ void final_norm(const Ctx& F) {
    const int gw = F.bid * 8 + F.wave, NGW = F.G * 8, lane = F.lane;
    for (int m = gw; m < TOK; m += NGW) {
        const f32x4* rp = (const f32x4*)(F.rowss() + (size_t)m * 16); const f32x4 s4 = (rp[0] + rp[1]) + (rp[2] + rp[3]);
        const float r = rsqrtf(((s4.x + s4.y) + (s4.z + s4.w)) * (1.f / DM) + EPS);
        float* o = F.out + (size_t)m * DM;
#pragma unroll
        for (int j = 0; j < 4; ++j) { const f32x4 v = __builtin_nontemporal_load((const f32x4*)(o + 4 * lane + 256 * j)), ww = *(const f32x4*)(F.norm_out_w + 4 * lane + 256 * j); __builtin_nontemporal_store(v * r * ww, (f32x4*)(o + 4 * lane + 256 * j)); }
    }
}

#define XB_TMO      128
#define XB_XCNT(j)  (256  + 64 * (j))
#define XB_XSUB(j)  (1280 + 64 * (j))
#define XB_XGEN(j)  (2304 + 64 * (j))
#define XB_TOP      3328
#define XB_TOPGEN   3392
#define XCD_BAR_WORDS 3456
#define XB_SPIN_CAP (1u << 18)

__device__ __forceinline__ unsigned xb_ld(unsigned* p)              { return __hip_atomic_load(p, __ATOMIC_RELAXED, __HIP_MEMORY_SCOPE_AGENT); }
__device__ __forceinline__ unsigned xb_add(unsigned* p, unsigned v) { return __hip_atomic_fetch_add(p, v, __ATOMIC_RELAXED, __HIP_MEMORY_SCOPE_AGENT); }
__device__ __forceinline__ unsigned xb_xcc_id() { return (unsigned)__builtin_amdgcn_s_getreg((3 << 11) | 20) & 0xFu; }
#define XB_SPIN(cond, bar) do { unsigned _sp = 0; while (cond) { __builtin_amdgcn_s_sleep(1); \
    if ((++_sp & 255u) == 0u) { if (xb_ld(&(bar)[XB_TMO])) break; if (_sp > XB_SPIN_CAP) { atomicAdd(&(bar)[XB_TMO], 1u); break; } } } } while (0)

struct XcdBarrier {
    unsigned* bar; unsigned x;
    volatile LAS unsigned* st;
};

__device__ __forceinline__ XcdBarrier xcd_barrier_post(unsigned* bar, volatile LAS unsigned* st, int xb_tid) {
    XcdBarrier b; b.bar = bar; b.x = xb_xcc_id(); b.st = st;
    if (xb_tid == 0) (void)xb_add(&bar[XB_XCNT(b.x)], 1u);
    return b;
}
__device__ __forceinline__ void xcd_barrier_complete(unsigned* bar, unsigned x, unsigned& nloc, unsigned& nx) {
    const unsigned G = gridDim.x * gridDim.y * gridDim.z;
    unsigned sum, cnt, mine, sp = 0u;
    for (;;) {
        sum = 0u; cnt = 0u; mine = 0u;
#pragma unroll
        for (unsigned j = 0; j < 16; ++j) { const unsigned c = xb_ld(&bar[XB_XCNT(j)]); sum += c; cnt += (c > 0u) ? 1u : 0u; mine = (j == x) ? c : mine; }
        if (sum == G) break;
        __builtin_amdgcn_s_sleep(1);
        if ((++sp & 255u) == 0u) { if (xb_ld(&bar[XB_TMO])) break; if (sp > XB_SPIN_CAP) { atomicAdd(&bar[XB_TMO], 1u); break; } }
    }
    nloc = mine > 0u ? mine : 1u; nx = cnt > 0u ? cnt : 1u;
}

__device__ __forceinline__ void xcd_barrier(const XcdBarrier& b, int xb_tid) {
    asm volatile("s_waitcnt vmcnt(0)" ::: "memory");
    __syncthreads();
    if (xb_tid == 0) {
        unsigned* bar = b.bar;
        __builtin_amdgcn_s_waitcnt(0);
        unsigned nloc = b.st[0], nx = b.st[1];
        if (nloc == 0u) { xcd_barrier_complete(bar, b.x, nloc, nx); b.st[0] = nloc; b.st[1] = nx; }
        const unsigned old = xb_add(&bar[XB_XSUB(b.x)], 1u);
        const unsigned gen = old / nloc;
        if (old + 1u == (gen + 1u) * nloc) {
            __builtin_amdgcn_fence(__ATOMIC_RELEASE, "agent");
            asm volatile("s_waitcnt vmcnt(0)" ::: "memory");
            const unsigned og = xb_add(&bar[XB_TOP], 1u);
            const unsigned tg = og / nx;
            if (og + 1u == (tg + 1u) * nx) xb_add(&bar[XB_TOPGEN], 1u);
            else XB_SPIN(xb_ld(&bar[XB_TOPGEN]) == tg, bar);
            __builtin_amdgcn_fence(__ATOMIC_ACQUIRE, "agent");
            xb_add(&bar[XB_XGEN(b.x)], 1u);
            asm volatile("s_waitcnt vmcnt(0)" ::: "memory");
        } else {
            XB_SPIN(xb_ld(&bar[XB_XGEN(b.x)]) == gen, bar);
            __builtin_amdgcn_fence(__ATOMIC_ACQUIRE, "agent");
            asm volatile("s_waitcnt vmcnt(0)" ::: "memory");
        }
    }
    __syncthreads();
}

__global__ void __launch_bounds__(512, 2) hymba_fwd(Args args) {
    extern __shared__ __attribute__((aligned(16))) unsigned char lds_raw[];
    Ctx F;
    F.x = args.in[0]; F.mem = args.in[1]; F.norm_mem_w = args.in[2]; F.norm_in_w = args.in[3]; F.w_in = args.in[4]; F.attn_sink = args.in[5]; F.conv_w = args.in[6]; F.conv_b = args.in[7];
    F.dt_bias = args.in[8]; F.a_log = args.in[9]; F.d_skip = args.in[10]; F.ssd_norm_w = args.in[11]; F.w_mem_kv = args.in[12]; F.w_out = args.in[13]; F.norm_out_w = args.in[14];
    F.out = args.out; F.ws = args.ws;
    F.lds = (ldsp)lds_raw; F.tid = threadIdx.x; F.lane = F.tid & 63; F.wave = __builtin_amdgcn_readfirstlane(F.tid >> 6); F.G = gridDim.x; F.bid = blockIdx.x;
    const int lo = args.lo, hi = args.hi;
    cg::grid_group grid = cg::this_grid();
#define IN(k) (lo <= (k) && (k) < hi)
#define REFRESH() do { F.lane = lane_id_now(); F.tid = F.wave * 64 + F.lane; } while (0)
    if (F.tid == 0) { *(LAS u32x4*)(F.lds + LDS_XB) = (u32x4){0u, 0u, 0u, 0u}; }
    __syncthreads();
    XcdBarrier xbar; xbar.bar = (unsigned*)args.ws; xbar.x = 0; xbar.st = (volatile LAS unsigned*)(F.lds + LDS_XB);
    if (hi - lo > 1) xbar = xcd_barrier_post((unsigned*)args.ws, (volatile LAS unsigned*)(F.lds + LDS_XB), F.tid);
    if (lo < 0) grid.sync();
#define SEAM(k) do { if (IN(k) && IN((k) + 1)) xcd_barrier(xbar, F.tid); } while (0)
    if (IN(0)) { REFRESH(); phase0(F); }
    SEAM(0);
    if (IN(1)) {
        REFRESH();
        { pg8::Gemm g{F.hn(), F.win_t(), TOK, NPHYS, DM, HNP, HNP}; pg8::StaticOrder S; S.init(g.M, g.N, F.G, F.bid); EpiProj E{F.proj(), F.dt(), F.rope(), F.dt_bias}; pg8::gemm_phase(F.lds, g, S, E, F.wave); }
    }
    SEAM(1);
#if DBG_STOP == 1
    { grid.sync(); const int gw = F.bid * 8 + F.wave, NGW = F.G * 8;
      for (int m = gw; m < TOK; m += NGW) for (int j = 0; j < 16; ++j) { const int c = F.lane + 64 * j; float a = 0.f; for (int k = 0; k < 5; ++k) a += bf_lo(F.proj()[(size_t)m * PW + c + 1024 * k]); a += F.dt()[(size_t)m * 16 + (c & 15)] + bf_lo(F.mkv()[(size_t)(m & 4095) * 1024 + c]); F.out[(size_t)m * DM + c] = a; }
      return; }
#endif
    if (IN(2)) {
        REFRESH();
        if ((args.sub & 2) && (F.bid & 1)) for (int sq = F.bid; sq < NBATCH * 4 * 4; sq += F.G) attn_window_seq(F, sq);
        if (args.sub & 1) for (int it = F.bid; it < NBATCH * 32 * 2; it += F.G) ssd_pass1_item(F, it);
        if ((args.sub & 2) && !(F.bid & 1)) for (int sq = F.bid; sq < NBATCH * 4 * 4; sq += F.G) attn_window_seq(F, sq);
    }
    SEAM(2);
#if DBG_STOP == 2
    { grid.sync(); const int gw = F.bid * 8 + F.wave, NGW = F.G * 8;
      for (int m = gw; m < TOK; m += NGW) for (int j = 0; j < 16; ++j) { const int c = F.lane + 64 * j;
        const float a = (DBG_SEL & 1 ? bf_lo(F.mix()[(size_t)m * MIXW + c]) : 0.f), bq = (DBG_SEL & 2 ? bf_lo(F.st()[(size_t)m * 1024 + c]) : 0.f), d = (DBG_SEL & 4 ? F.dec()[(m * 1024 + c) & 8191] : 0.f);
        ((float*)F.proj())[(size_t)m * DM + c] = a + bq + d; }
      __threadfence(); grid.sync();
      for (int m = gw; m < TOK; m += NGW) for (int j = 0; j < 16; ++j) { const int c = F.lane + 64 * j; F.out[(size_t)m * DM + c] = ((float*)F.proj())[(size_t)m * DM + c]; }
      return; }
#endif
    if (IN(3)) {
        REFRESH();
        if (F.G >= 128) {
            if (F.bid < 64) { pg8::Gemm g{F.memn(), F.wmem_t(), NBATCH * 256, 1024, 1024, HNP, HNP}; pg8::StaticOrder S; S.init(g.M, g.N, 64, F.bid); EpiMkv E{F.mkv()}; pg8::gemm_phase(F.lds, g, S, E, F.wave); }
            else ssd_scan(F, F.bid - 64, F.G - 64);
        } else {
            { pg8::Gemm g{F.memn(), F.wmem_t(), NBATCH * 256, 1024, 1024, HNP, HNP}; pg8::StaticOrder S; S.init(g.M, g.N, F.G, F.bid); EpiMkv E{F.mkv()}; pg8::gemm_phase(F.lds, g, S, E, F.wave); }
            ssd_scan(F, F.bid, F.G);
        }
    }
    SEAM(3);
    if (IN(4)) {
        REFRESH();
        if ((args.sub & 2) && (F.bid & 1)) for (int grp = F.bid; grp < NBATCH * 16; grp += F.G) for (int k = 0; k < 4; ++k) attn_mem_item(F, 4 * grp + k, k == 0);
        if (args.sub & 1) for (int it = F.bid; it < NBATCH * 32 * 2; it += F.G) ssd_pass2_item(F, it);
        if ((args.sub & 2) && !(F.bid & 1)) for (int grp = F.bid; grp < NBATCH * 16; grp += F.G) for (int k = 0; k < 4; ++k) attn_mem_item(F, 4 * grp + k, k == 0);
    }
    SEAM(4);
    if (IN(5)) { REFRESH(); __syncthreads(); pg8::Gemm g{F.mix(), F.wout_t(), TOK, DM, MIXW, MIXP, MIXP}; pg8::StaticOrder S; S.init(g.M, g.N, F.G, F.bid); EpiOut E{F.x, F.out, F.rowss()}; pg8::gemm_phase(F.lds, g, S, E, F.wave); }
    SEAM(5);
    if (IN(6)) { REFRESH(); final_norm(F); }
#undef IN
#undef SEAM
}

extern "C" void kernel_launch(void* const* d_in, const int* in_sizes, int n_in, void* d_out, int out_size, void* d_ws, size_t ws_size, hipStream_t stream) {
    static int grid = 0;
    if (grid == 0) {
        if (n_in != 15 || out_size != TOK * DM || ws_size < WS_END) { fprintf(stderr, "kernel_launch: unexpected shapes (n_in %d out %d ws %zu)\n", n_in, out_size, ws_size); grid = -1; return; }
        int dev = 0, cus = 0, per_cu = 0;
        (void)hipGetDevice(&dev); (void)hipDeviceGetAttribute(&cus, hipDeviceAttributeMultiprocessorCount, dev);
        if (hipFuncSetAttribute((const void*)hymba_fwd, hipFuncAttributeMaxDynamicSharedMemorySize, LDS_BYTES) != hipSuccess) { fprintf(stderr, "kernel_launch: hipFuncSetAttribute failed\n"); grid = -1; return; }
        if (hipOccupancyMaxActiveBlocksPerMultiprocessor(&per_cu, (const void*)hymba_fwd, 512, LDS_BYTES) != hipSuccess || per_cu < 1) { fprintf(stderr, "kernel_launch: occupancy query says %d\n", per_cu); per_cu = 1; }
        (void)hipGetLastError();
        grid = cus > 0 ? cus : 256;
    }
    if (grid < 0) return;
    Args a{};
    for (int i = 0; i < 15; ++i) a.in[i] = (const float*)d_in[i];
    a.out = (float*)d_out; a.ws = (unsigned char*)d_ws; a.sub = 3;
    (void)hipMemsetAsync(d_ws, 0, 16384, stream);
#if PROBE_PHASES
    for (int k = 0; k < NPHASE; ++k) if ((PROBE_PHASES >> k) & 1) { a.lo = k; a.hi = k + 1; a.sub = PROBE_SUB; hipLaunchKernelGGL(hymba_fwd, dim3(grid), dim3(512), LDS_BYTES, stream, a); }
#endif
#if MK_ONE_LAUNCH
    a.lo = 0; a.hi = NPHASE; a.sub = 3;
    void* kargs[] = {&a};
    hipError_t e = hipLaunchCooperativeKernel((const void*)hymba_fwd, dim3(grid), dim3(512), kargs, LDS_BYTES, stream);
    if (e != hipSuccess) fprintf(stderr, "kernel_launch: cooperative launch failed: %s (grid %d)\n", hipGetErrorString(e), grid);
#else
    for (int k = 0; k < NPHASE; ++k) { a.lo = k; a.hi = k + 1; hipLaunchKernelGGL(hymba_fwd, dim3(grid), dim3(512), LDS_BYTES, stream, a); }
#endif
}
```

```cpp
#include <hip/hip_runtime.h>
#include <hip/hip_cooperative_groups.h>
#include <cstdio>
#include <cstdint>
namespace cg = cooperative_groups;

#ifndef MK_ONE_LAUNCH
#define MK_ONE_LAUNCH 1
#endif

#define LAS __attribute__((address_space(3)))
typedef unsigned short bf16_t;
typedef short bf16x8 __attribute__((ext_vector_type(8)));
typedef short s16x4 __attribute__((ext_vector_type(4)));
typedef float f32x4 __attribute__((ext_vector_type(4)));
typedef float f32x2 __attribute__((ext_vector_type(2)));
typedef unsigned u32x4 __attribute__((ext_vector_type(4)));
typedef unsigned u32x2 __attribute__((ext_vector_type(2)));
typedef LAS unsigned char* ldsp;

constexpr int SEQ = 4096, NBATCH = 16, TOK = SEQ * NBATCH, DM = 1024;
constexpr int INW = 5136, NPHYS = 5376, PW = 5184;
constexpr int HNP = 1088, MIXP = 2112;
constexpr int C_Q = 0, C_K = 1024, C_V = 1280, C_G = 1536, C_Z = 2560, C_X = 3072, C_QM = 4096, C_GM = 4608;
constexpr int MIXW = 2048;
constexpr float LOG2E = 1.4426950408889634f;
constexpr float EPS = 1e-6f;
constexpr int NPHASE = 7;

constexpr size_t MiB = (size_t)1 << 20;
constexpr size_t WS_ROWSS = 956 * MiB, WS_ROPE = 1 * MiB, WS_WIN = 2 * MiB, WS_WOUT = 14 * MiB, WS_WMEM = 19 * MiB, WS_MEMN = 22 * MiB,
                 WS_MKV = 31 * MiB, WS_DT = 39 * MiB, WS_DEC = 43 * MiB, WS_PROJ = 44 * MiB, WS_MIX = 692 * MiB, WS_END = 960 * MiB;

constexpr int LDS_BYTES = 155648 + 16;
constexpr int LDS_XB = 155648;

__device__ __forceinline__ unsigned cvt_pk(float lo, float hi) { unsigned r; asm volatile("v_cvt_pk_bf16_f32 %0, %1, %2" : "=v"(r) : "v"(lo), "v"(hi)); return r; }
typedef __bf16 bf16x2_t __attribute__((ext_vector_type(2)));
__device__ __forceinline__ unsigned cvt_pk_c(float lo, float hi) { const f32x2 v = {lo, hi}; return __builtin_bit_cast(unsigned, __builtin_convertvector(v, bf16x2_t)); }
__device__ __forceinline__ float bf_lo(unsigned u) { return __uint_as_float(u << 16); }
__device__ __forceinline__ float bf_hi(unsigned u) { return __uint_as_float(u & 0xffff0000u); }
__device__ __forceinline__ f32x4 unpack4(u32x2 v) { return (f32x4){bf_lo(v.x), bf_hi(v.x), bf_lo(v.y), bf_hi(v.y)}; }
__device__ __forceinline__ u32x2 pack4(f32x4 v) { return (u32x2){cvt_pk_c(v.x, v.y), cvt_pk_c(v.z, v.w)}; }
__device__ __forceinline__ float silu_f(float x) { return x * __builtin_amdgcn_rcpf(1.f + __expf(-x)); }
__device__ __forceinline__ f32x4 silu4(f32x4 v) { return (f32x4){silu_f(v.x), silu_f(v.y), silu_f(v.z), silu_f(v.w)}; }
__device__ __forceinline__ float softplus_f(float x) { return x > 20.f ? x : log1pf(expf(x)); }
__device__ __forceinline__ float ex2(float x) { return __builtin_amdgcn_exp2f(x); }
typedef short v4i16_t __attribute__((ext_vector_type(4)));
__device__ __forceinline__ s16x4 vtr(ldsp p) { return __builtin_bit_cast(s16x4, __builtin_amdgcn_ds_read_tr16_b64_v4i16((LAS v4i16_t*)p)); }
__device__ __forceinline__ bf16x8 cat8(s16x4 a, s16x4 b) { return (bf16x8){a[0], a[1], a[2], a[3], b[0], b[1], b[2], b[3]}; }
__device__ __forceinline__ bf16x8 ld8(ldsp p) { return *(const LAS bf16x8*)p; }
__device__ __forceinline__ f32x4 mfma16(bf16x8 a, bf16x8 b, f32x4 c) { return __builtin_amdgcn_mfma_f32_16x16x32_bf16(a, b, c, 0, 0, 0); }
__device__ __forceinline__ bf16x8 packfrag(f32x4 a, f32x4 b) { u32x4 r = {cvt_pk_c(a.x, a.y), cvt_pk_c(a.z, a.w), cvt_pk_c(b.x, b.y), cvt_pk_c(b.z, b.w)}; return __builtin_bit_cast(bf16x8, r); }

__device__ __forceinline__ f32x4 zero4() { f32x4 z; asm volatile("v_mov_b32 %0, 0\n\tv_mov_b32 %1, 0\n\tv_mov_b32 %2, 0\n\tv_mov_b32 %3, 0" : "=v"(z.x), "=v"(z.y), "=v"(z.z), "=v"(z.w)); return z; }
__device__ __forceinline__ int lane_id_now() { int l; asm volatile("v_mbcnt_lo_u32_b32 %0, -1, 0\n\tv_mbcnt_hi_u32_b32 %0, -1, %0" : "=v"(l)); return l; }
__host__ __device__ __forceinline__ int perm_plain(int c) { const int bj = c >> 7, wc = (c >> 5) & 3, n = (c >> 4) & 1, fq = (c >> 2) & 3, i = c & 3; return 128 * bj + 32 * wc + 8 * fq + 4 * n + i; }
__host__ __device__ __forceinline__ int perm_rot(int c) { const int bj = c >> 7, wc = (c >> 5) & 3, n = (c >> 4) & 1, fq = (c >> 2) & 3, i = c & 3; return 64 * wc + 32 * bj + 8 * fq + 4 * n + i; }

namespace pg8 {
constexpr int BM = 256, BK = 64, HALF = 128, HTB = HALF * BK * 2, STAGE_BYTES = 8 * HTB, NXCD = 8, WGM = 8;
__host__ __device__ __forceinline__ int lds_byte(int r, int c) { const int st = (r >> 4) * 2 + (c >> 5), rr = r & 15, cc = c & 31, ob = rr * 64 + cc * 2; return st * 1024 + (ob ^ (((ob >> 9) & 1) << 5)); }
__host__ __device__ __forceinline__ void stage_rc(int b, int& R, int& C) { const int st = b / 1024, sb = b % 1024, swz = sb ^ (((sb >> 9) & 1) << 5); R = (st >> 1) * 16 + swz / 64; C = (st & 1) * 32 + (swz % 64) / 2; }
struct Unit { int pm, pn; };
struct Gemm { const bf16_t* A; const bf16_t* Bt; int M, N, K, lda, ldb; };
struct StaticOrder {
    int nM, nN, nwg, G, c;
    __device__ void init(int M, int N, int G_, int c_) { nM = M / BM; nN = N / BM; nwg = nM * nN; G = G_; c = c_; }
    __device__ bool next(int i, Unit& u) const {
        const long L = (long)i * G + c; if (L >= nwg) return false;
        int wgid = (int)L; { const int q = nwg / NXCD, r = nwg % NXCD, xcd = wgid % NXCD, off = wgid / NXCD; wgid = (xcd < r ? xcd * (q + 1) : r * (q + 1) + (xcd - r) * q) + off; }
        const int nig = WGM * nN, gid = wgid / nig, fm = gid * WGM, gsz = (nM - fm) < WGM ? (nM - fm) : WGM;
        u.pm = fm + ((wgid % nig) % gsz); u.pn = (wgid % nig) / gsz; return true;
    }
};
template <class Epi, class Sched>
__device__ __forceinline__ void gemm_phase(ldsp lds, const Gemm g, const Sched& S, const Epi& E, int wave_id) {
    const int lane = lane_id_now(), wid = wave_id, tid = wid * 64 + lane, wr = wid >> 2, wc = wid & 3, fr = lane & 15, fq = lane >> 4;
    const int K = g.K, nt = K / BK;
    unsigned voffA[2], voffB[2];
#pragma unroll
    for (int i = 0; i < 2; ++i) { int R, C; stage_rc(tid * 16 + i * 8192, R, C); voffA[i] = (unsigned)(R * g.lda + C) * 2u; voffB[i] = (unsigned)(R * g.ldb + C) * 2u; }
    const size_t kstep = (size_t)(BK * 2);
    const size_t hstep = (size_t)HALF * g.lda * 2, hstepB = (size_t)HALF * g.ldb * 2;
    const size_t tstep = 2 * hstep, tstepB = 2 * hstepB;
    const unsigned ldsw = (unsigned)wid * 1024u;
    const int aoff = lds_byte(wr * 64 + fr, fq * 8), boff = lds_byte(wc * 32 + fr, fq * 8);
#define PG8_SA(b, h) (((b) * 2 + (h)) * HTB)
#define PG8_SB(b, h) ((4 + (b) * 2 + (h)) * HTB)
#define PG8_STAGE(bufoff, gbase, voff) do { _Pragma("unroll") for (int _i = 0; _i < 2; ++_i) \
        __builtin_amdgcn_global_load_lds((const unsigned*)((const char*)(gbase) + (voff)[_i]), (LAS unsigned*)(lds + (bufoff) + ldsw + _i * 8192), 16, 0, 0); } while (0)
#define PG8_LDA(dst, b, h) do { _Pragma("unroll") for (int m = 0; m < 4; ++m) _Pragma("unroll") for (int k = 0; k < 2; ++k) dst[m][k] = *(const LAS bf16x8*)(lds + PG8_SA(b, h) + aoff + m * 2048 + k * 1024); } while (0)
#define PG8_LDB(dst, b, h) do { _Pragma("unroll") for (int n = 0; n < 2; ++n) _Pragma("unroll") for (int k = 0; k < 2; ++k) dst[n][k] = *(const LAS bf16x8*)(lds + PG8_SB(b, h) + boff + n * 2048 + k * 1024); } while (0)
#define PG8_MMA(ai, bj, At, Bt) do { __builtin_amdgcn_s_setprio(1); _Pragma("unroll") for (int m = 0; m < 4; ++m) _Pragma("unroll") for (int n = 0; n < 2; ++n) _Pragma("unroll") for (int k = 0; k < 2; ++k) \
        acc[ai][bj][m][n] = __builtin_amdgcn_mfma_f32_16x16x32_bf16(Bt[n][k], At[m][k], acc[ai][bj][m][n], 0, 0, 0); __builtin_amdgcn_s_setprio(0); } while (0)
#define PG8_WAIT_V(n) asm volatile("s_waitcnt vmcnt(" #n ")" ::: "memory")
#define PG8_WAIT_L(n) asm volatile("s_waitcnt lgkmcnt(" #n ")" ::: "memory")
#define PG8_BAR __builtin_amdgcn_s_barrier()
#define PG8_SCHED __builtin_amdgcn_sched_barrier(0)
    Unit cur, nxt; int ui = 0;
    if (!S.next(0, cur)) return;
    f32x4 acc[2][2][4][2];
#pragma unroll
    for (int a = 0; a < 2; ++a)
#pragma unroll
        for (int b = 0; b < 2; ++b)
#pragma unroll
            for (int m = 0; m < 4; ++m)
#pragma unroll
                for (int n = 0; n < 2; ++n) acc[a][b][m][n] = (f32x4){0.f, 0.f, 0.f, 0.f};
    bf16x8 At[4][2], B0[2][2], B1[2][2];
    const char* cA = (const char*)g.A + (size_t)cur.pm * tstep; const char* cB = (const char*)g.Bt + (size_t)cur.pn * tstepB;
    PG8_STAGE(PG8_SB(0, 0), cB, voffB); PG8_STAGE(PG8_SA(0, 0), cA, voffA); PG8_STAGE(PG8_SB(0, 1), cB + hstepB, voffB); PG8_STAGE(PG8_SA(0, 1), cA + hstep, voffA);
    if (wr == 1) PG8_BAR;
    PG8_WAIT_V(4); PG8_BAR;
    PG8_STAGE(PG8_SB(1, 0), cB + kstep, voffB); PG8_STAGE(PG8_SA(1, 0), cA + kstep, voffA); PG8_STAGE(PG8_SB(1, 1), cB + hstepB + kstep, voffB);
    PG8_WAIT_V(6); PG8_BAR;
    for (;;) {
        const bool has_next = S.next(ui + 1, nxt);
        const char* nA = has_next ? (const char*)g.A + (size_t)nxt.pm * tstep : cA; const char* nB = has_next ? (const char*)g.Bt + (size_t)nxt.pn * tstepB : cB;
        for (int t = 0; t < nt; t += 2) {
            const bool last = (t == nt - 2);
            const char* a1 = cA + (size_t)(t + 1) * kstep;
            const char* a2 = last ? nA : cA + (size_t)(t + 2) * kstep; const char* b2 = last ? nB : cB + (size_t)(t + 2) * kstep;
            const char* a3 = a2 + kstep; const char* b3 = b2 + kstep;
            PG8_LDB(B0, 0, 0); PG8_SCHED; PG8_LDA(At, 0, 0); PG8_STAGE(PG8_SA(1, 1), a1 + hstep, voffA);
            PG8_WAIT_L(8); PG8_BAR; PG8_WAIT_L(0); PG8_MMA(0, 0, At, B0); PG8_BAR; PG8_SCHED;
            PG8_LDB(B1, 0, 1); PG8_STAGE(PG8_SB(0, 0), b2, voffB);
            PG8_BAR; PG8_WAIT_L(0); PG8_MMA(0, 1, At, B1); PG8_BAR;
            PG8_LDA(At, 0, 1); PG8_STAGE(PG8_SA(0, 0), a2, voffA);
            PG8_BAR; PG8_WAIT_L(0); PG8_MMA(1, 0, At, B0); PG8_BAR; PG8_SCHED;
            PG8_STAGE(PG8_SB(0, 1), b2 + hstepB, voffB);
            PG8_WAIT_V(6); PG8_BAR; PG8_MMA(1, 1, At, B1); PG8_BAR;
            PG8_LDB(B0, 1, 0); PG8_SCHED; PG8_LDA(At, 1, 0); PG8_STAGE(PG8_SA(0, 1), a2 + hstep, voffA);
            PG8_WAIT_L(8); PG8_BAR; PG8_WAIT_L(0); PG8_MMA(0, 0, At, B0); PG8_BAR; PG8_SCHED;
            PG8_LDB(B1, 1, 1); PG8_STAGE(PG8_SB(1, 0), b3, voffB);
            PG8_BAR; PG8_WAIT_L(0); PG8_MMA(0, 1, At, B1); PG8_BAR;
            PG8_LDA(At, 1, 1); PG8_STAGE(PG8_SA(1, 0), a3, voffA);
            PG8_BAR; PG8_WAIT_L(0); PG8_MMA(1, 0, At, B0); PG8_BAR; PG8_SCHED;
            PG8_STAGE(PG8_SB(1, 1), b3 + hstepB, voffB);
            PG8_WAIT_V(6); PG8_BAR; PG8_MMA(1, 1, At, B1); PG8_BAR;
        }
        E(acc, cur, wr, wc, fr, fq);
        if (!has_next) break;
#pragma unroll
        for (int a = 0; a < 2; ++a)
#pragma unroll
            for (int b = 0; b < 2; ++b)
#pragma unroll
                for (int m = 0; m < 4; ++m)
#pragma unroll
                    for (int n = 0; n < 2; ++n) acc[a][b][m][n] = (f32x4){0.f, 0.f, 0.f, 0.f};
        cur = nxt; cA = nA; cB = nB; ++ui;
    }
    PG8_WAIT_V(0);
    if (wr == 0) PG8_BAR;
    PG8_BAR;
#undef PG8_SA
#undef PG8_SB
#undef PG8_STAGE
#undef PG8_LDA
#undef PG8_LDB
#undef PG8_MMA
#undef PG8_WAIT_V
#undef PG8_WAIT_L
#undef PG8_BAR
#undef PG8_SCHED
}
}

struct EpiProj {
    bf16_t* P; float* DT; const float* rope; const float* dt_bias;
    __device__ __forceinline__ void operator()(const f32x4 (&acc)[2][2][4][2], const pg8::Unit& u, int wr, int wc, int fr, int fq) const {
        const int row0 = u.pm * 256 + wr * 64 + fr, pn = u.pn;
        if (pn < 5) {
            const float sc = pn < 4 ? 0.125f * LOG2E : 1.f;
            const int col = pn * 256 + 64 * wc + 8 * fq;
#pragma unroll
            for (int ai = 0; ai < 2; ++ai)
#pragma unroll
                for (int m = 0; m < 4; ++m) {
                    const int row = row0 + ai * 128 + m * 16, pos = row & (SEQ - 1);
                    const f32x4* cp = (const f32x4*)(rope + pos * 32 + 8 * fq); const f32x4* sp = (const f32x4*)(rope + SEQ * 32 + pos * 32 + 8 * fq);
                    f32x4 o1[2], o2[2];
#pragma unroll
                    for (int n = 0; n < 2; ++n) { const f32x4 c = cp[n], s = sp[n], t1 = acc[ai][0][m][n], t2 = acc[ai][1][m][n]; o1[n] = (t1 * c - t2 * s) * sc; o2[n] = (t1 * s + t2 * c) * sc; }
                    bf16_t* dst = P + (size_t)row * PW + col;
                    __builtin_nontemporal_store((u32x4){cvt_pk(o1[0].x, o1[0].y), cvt_pk(o1[0].z, o1[0].w), cvt_pk(o1[1].x, o1[1].y), cvt_pk(o1[1].z, o1[1].w)}, (u32x4*)dst);
                    __builtin_nontemporal_store((u32x4){cvt_pk(o2[0].x, o2[0].y), cvt_pk(o2[0].z, o2[0].w), cvt_pk(o2[1].x, o2[1].y), cvt_pk(o2[1].z, o2[1].w)}, (u32x4*)(dst + 32));
                }
        } else if (pn < 20) {
            const bool do_silu = (pn >= 6 && pn < 12) || pn >= 18;
            const float sc = (pn == 16 || pn == 17) ? 0.08838834764831845f * LOG2E : 1.f;
            const int col = pn * 256 + 32 * wc + 8 * fq;
#pragma unroll
            for (int ai = 0; ai < 2; ++ai)
#pragma unroll
                for (int m = 0; m < 4; ++m) {
                    const int row = row0 + ai * 128 + m * 16;
#pragma unroll
                    for (int bj = 0; bj < 2; ++bj) {
                        f32x4 v0 = acc[ai][bj][m][0], v1 = acc[ai][bj][m][1];
                        if (do_silu) { v0 = silu4(v0); v1 = silu4(v1); } else { v0 = v0 * sc; v1 = v1 * sc; }
                        __builtin_nontemporal_store((u32x4){cvt_pk(v0.x, v0.y), cvt_pk(v0.z, v0.w), cvt_pk(v1.x, v1.y), cvt_pk(v1.z, v1.w)}, (u32x4*)(P + (size_t)row * PW + col + 128 * bj));
                    }
                }
        } else {
            if (wc == 0 && fq < 2) {
#pragma unroll
                for (int ai = 0; ai < 2; ++ai)
#pragma unroll
                    for (int m = 0; m < 4; ++m) {
                        const int row = row0 + ai * 128 + m * 16;
#pragma unroll
                        for (int n = 0; n < 2; ++n) {
                            const int j0 = 8 * fq + 4 * n; const f32x4 bb = *(const f32x4*)(dt_bias + j0); const f32x4 v = acc[ai][0][m][n] + bb;
                            *(f32x4*)(DT + (size_t)row * 16 + j0) = (f32x4){softplus_f(v.x), softplus_f(v.y), softplus_f(v.z), softplus_f(v.w)};
                        }
                    }
            }
        }
    }
};
struct EpiMkv {
    bf16_t* O;
    __device__ __forceinline__ void operator()(const f32x4 (&acc)[2][2][4][2], const pg8::Unit& u, int wr, int wc, int fr, int fq) const {
        const int row0 = u.pm * 256 + wr * 64 + fr, col = u.pn * 256 + 32 * wc + 8 * fq;
#pragma unroll
        for (int ai = 0; ai < 2; ++ai)
#pragma unroll
            for (int m = 0; m < 4; ++m) {
                const int row = row0 + ai * 128 + m * 16;
#pragma unroll
                for (int bj = 0; bj < 2; ++bj) { const f32x4 v0 = acc[ai][bj][m][0], v1 = acc[ai][bj][m][1];
                    *(u32x4*)(O + (size_t)row * 1024 + col + 128 * bj) = (u32x4){cvt_pk(v0.x, v0.y), cvt_pk(v0.z, v0.w), cvt_pk(v1.x, v1.y), cvt_pk(v1.z, v1.w)}; }
            }
    }
};
struct EpiOut {
    const float* x; float* out; float* rowss;
    __device__ __forceinline__ void operator()(const f32x4 (&acc)[2][2][4][2], const pg8::Unit& u, int wr, int wc, int fr, int fq) const {
        const int row0 = u.pm * 256 + wr * 64 + fr, col = u.pn * 256 + 32 * wc + 8 * fq;
#pragma unroll
        for (int ai = 0; ai < 2; ++ai)
#pragma unroll
            for (int m = 0; m < 4; ++m) {
                const int row = row0 + ai * 128 + m * 16; float ss = 0.f;
#pragma unroll
                for (int bj = 0; bj < 2; ++bj) {
                    const size_t o = (size_t)row * DM + col + 128 * bj;
                    const f32x4 h0 = __builtin_nontemporal_load((const f32x4*)(x + o)) + acc[ai][bj][m][0], h1 = __builtin_nontemporal_load((const f32x4*)(x + o + 4)) + acc[ai][bj][m][1];
                    *(f32x4*)(out + o) = h0; *(f32x4*)(out + o + 4) = h1;
                    ss += h0.x * h0.x + h0.y * h0.y + h0.z * h0.z + h0.w * h0.w + h1.x * h1.x + h1.y * h1.y + h1.z * h1.z + h1.w * h1.w;
                }
                ss += __shfl_xor(ss, 16); ss += __shfl_xor(ss, 32);
                if (fq == 0) rowss[(size_t)row * 16 + u.pn * 4 + wc] = ss;
            }
    }
};

struct Args { const float* in[15]; float* out; unsigned char* ws; int lo, hi; };
struct Ctx {
    const float *x, *mem, *norm_mem_w, *norm_in_w, *w_in, *attn_sink, *conv_w, *conv_b, *dt_bias, *a_log, *d_skip, *ssd_norm_w, *w_mem_kv, *w_out, *norm_out_w;
    float* out; unsigned char* ws;
    __device__ __forceinline__ float* rowss() const { return (float*)(ws + WS_ROWSS); }
    __device__ __forceinline__ float* rope() const { return (float*)(ws + WS_ROPE); }
    __device__ __forceinline__ bf16_t* win_t() const { return (bf16_t*)(ws + WS_WIN); }
    __device__ __forceinline__ bf16_t* wout_t() const { return (bf16_t*)(ws + WS_WOUT); }
    __device__ __forceinline__ bf16_t* wmem_t() const { return (bf16_t*)(ws + WS_WMEM); }
    __device__ __forceinline__ bf16_t* memn() const { return (bf16_t*)(ws + WS_MEMN); }
    __device__ __forceinline__ bf16_t* mkv() const { return (bf16_t*)(ws + WS_MKV); }
    __device__ __forceinline__ float* dt() const { return (float*)(ws + WS_DT); }
    __device__ __forceinline__ float* dec() const { return (float*)(ws + WS_DEC); }
    __device__ __forceinline__ bf16_t* proj() const { return (bf16_t*)(ws + WS_PROJ); }
    __device__ __forceinline__ bf16_t* mix() const { return (bf16_t*)(ws + WS_MIX); }
    __device__ __forceinline__ bf16_t* hn() const { return (bf16_t*)((unsigned char*)out); }
    __device__ __forceinline__ bf16_t* st() const { return (bf16_t*)((unsigned char*)out); }
    __device__ __forceinline__ bf16_t* yp() const { return (bf16_t*)((unsigned char*)out + 128 * MiB); }
    __device__ __forceinline__ bf16_t* cfb() const { return (bf16_t*)((unsigned char*)out + 192 * MiB); }
    __device__ __forceinline__ float* efb() const { return (float*)((unsigned char*)out + 224 * MiB); }
    ldsp lds; int tid, lane, wave, G, bid;
};

__device__ __forceinline__ void rms_row_bf16(const float* xr, const float* w, bf16_t* o, int lane) {
    f32x4 v[4]; float ss = 0.f;
#pragma unroll
    for (int j = 0; j < 4; ++j) { v[j] = __builtin_nontemporal_load((const f32x4*)(xr + 4 * lane + 256 * j)); ss += v[j].x * v[j].x + v[j].y * v[j].y + v[j].z * v[j].z + v[j].w * v[j].w; }
#pragma unroll
    for (int off = 1; off < 64; off <<= 1) ss += __shfl_xor(ss, off);
    const float r = rsqrtf(ss * (1.f / DM) + EPS);
#pragma unroll
    for (int j = 0; j < 4; ++j) { const f32x4 ww = *(const f32x4*)(w + 4 * lane + 256 * j); *(u32x2*)(o + 4 * lane + 256 * j) = pack4(v[j] * r * ww); }
}
template <int MODE>
__device__ __forceinline__ void transpose_w(const Ctx& F, const float* W, int K, int NS, bf16_t* Bt, int NP, int ldb) {
    const int nitems = NP * (K / 8);
    for (int it = F.bid * 512 + F.tid; it < nitems; it += F.G * 512) {
        const int n = it % NP, kg = it / NP, tile = n >> 8, cph = n & 255; int src;
        if (MODE == 0) {
            if (tile < 5) src = tile * 256 + perm_rot(cph);
            else if (tile < 20) { src = tile * 256 + perm_plain(cph); if (src >= 4096) src += 16; }
            else { const int l = perm_plain(cph); src = l < 16 ? 4096 + l : -1; }
        } else src = tile * 256 + perm_plain(cph);
        float v[8];
#pragma unroll
        for (int j = 0; j < 8; ++j) v[j] = src >= 0 ? W[(size_t)(kg * 8 + j) * NS + src] : 0.f;
        *(u32x4*)(Bt + (size_t)n * ldb + kg * 8) = (u32x4){cvt_pk(v[0], v[1]), cvt_pk(v[2], v[3]), cvt_pk(v[4], v[5]), cvt_pk(v[6], v[7])};
    }
}
__device__ __forceinline__ void phase0(const Ctx& F) {
    const int gt = F.bid * 512 + F.tid, NT = F.G * 512;
    for (int i = gt; i < SEQ * 32; i += NT) {
        const int pos = i >> 5, f = i & 31;
        const float inv = 1.0f / exp2f((float)f * (13.287712379549449f / 32.f));
        const float ang = (float)pos * inv;
        const double rev = (double)ang * 0.15915494309189535; const double fr = rev - __builtin_rint(rev);
        const float r = (float)(fr * 6.283185307179586);
        F.rope()[i] = __cosf(r); F.rope()[SEQ * 32 + i] = __sinf(r);
    }
    transpose_w<0>(F, F.w_in, DM, INW, F.win_t(), NPHYS, HNP);
    transpose_w<1>(F, F.w_out, MIXW, DM, F.wout_t(), DM, MIXP);
    transpose_w<1>(F, F.w_mem_kv, DM, DM, F.wmem_t(), DM, HNP);
    const int gw = F.bid * 8 + F.wave, NGW = F.G * 8;
    for (int m = gw; m < NBATCH * 256; m += NGW) rms_row_bf16(F.mem + (size_t)m * DM, F.norm_mem_w, F.memn() + (size_t)m * HNP, F.lane);
    for (int m = gw; m < TOK; m += NGW) rms_row_bf16(F.x + (size_t)m * DM, F.norm_in_w, F.hn() + (size_t)m * HNP, F.lane);
}

template <int DH, int NQF>
__device__ __forceinline__ void attn_tile(ldsp Kt, int KS, ldsp Vt, int VS, const bf16x8 (&qf)[NQF][DH / 32], f32x4 (&o)[DH / 16][NQF], float (&m)[NQF], float (&lp)[NQF], int maskmode, int lane, int qoff = 0) {
    const int i16 = lane & 15, q4 = lane >> 4;
    f32x4 st[4][NQF];
#pragma unroll
    for (int kf = 0; kf < 4; ++kf)
#pragma unroll
        for (int q = 0; q < NQF; ++q) st[kf][q] = (f32x4){0.f, 0.f, 0.f, 0.f};
#pragma unroll
    for (int ks = 0; ks < DH / 32; ++ks)
#pragma unroll
        for (int kf = 0; kf < 4; ++kf) {
            const bf16x8 ka = ld8(Kt + (16 * kf + i16) * KS + (32 * ks + 8 * q4) * 2);
#pragma unroll
            for (int q = 0; q < NQF; ++q) st[kf][q] = mfma16(ka, qf[q][ks], st[kf][q]);
            if (DH > 64 && kf == 3) __builtin_amdgcn_sched_barrier(0);
        }
    if (maskmode) {
        int zb; asm volatile("v_mov_b32 %0, 0" : "=v"(zb));
        const int base = (maskmode == 1 ? 4 * q4 - i16 - qoff : i16 + qoff - 4 * q4) + zb;
#pragma unroll
        for (int kf = 0; kf < 4; ++kf)
#pragma unroll
            for (int q = 0; q < NQF; ++q)
#pragma unroll
                for (int r = 0; r < 4; ++r) { const int off = 16 * (kf - q) + r; const bool bad = (maskmode == 1 ? base + off : base - off) < 0; if (bad) st[kf][q][r] = -INFINITY; }
    }
#pragma unroll
    for (int q = 0; q < NQF; ++q) {
        float mx = st[0][q][0];
#pragma unroll
        for (int kf = 0; kf < 4; ++kf)
#pragma unroll
            for (int r = 0; r < 4; ++r) mx = fmaxf(mx, st[kf][q][r]);
        mx = fmaxf(mx, __shfl_xor(mx, 16)); mx = fmaxf(mx, __shfl_xor(mx, 32));
        const float mn = fmaxf(m[q], mx), alpha = ex2(m[q] - mn); m[q] = mn;
        float ps = 0.f;
#pragma unroll
        for (int kf = 0; kf < 4; ++kf)
#pragma unroll
            for (int r = 0; r < 4; ++r) { const float p = ex2(st[kf][q][r] - mn); st[kf][q][r] = p; ps += p; }
        lp[q] = lp[q] * alpha + ps;
#pragma unroll
        for (int d = 0; d < DH / 16; ++d) o[d][q] = o[d][q] * alpha;
    }
#pragma unroll
    for (int kp = 0; kp < 2; ++kp) {
        bf16x8 pk[NQF];
#pragma unroll
        for (int q = 0; q < NQF; ++q) pk[q] = packfrag(st[2 * kp][q], st[2 * kp + 1][q]);
#pragma unroll
        for (int d = 0; d < DH / 16; ++d) {
            ldsp va = Vt + (32 * kp + 4 * q4 + (i16 >> 2)) * VS + (16 * d + 4 * (i16 & 3)) * 2;
            const bf16x8 vf = cat8(vtr(va), vtr(va + 16 * VS));
#pragma unroll
            for (int q = 0; q < NQF; ++q) o[d][q] = mfma16(vf, pk[q], o[d][q]);
            if (DH > 64 && (d & 3) == 3) __builtin_amdgcn_sched_barrier(0);
        }
    }
}

__device__ __forceinline__ void ring_stage_block(const Ctx& F, const bf16_t* kvbase, int keyblock) {
    constexpr int KS = 144, VS = 160; const ldsp Kb = F.lds + (keyblock & 511) * KS, Vb = F.lds + 512 * KS + (keyblock & 511) * VS;
    const bf16_t* src0 = kvbase + (size_t)keyblock * PW;
    for (int wi = F.wave; wi < 18; wi += 8) {
        const int slot = wi * 64 + F.lane, row = slot / 9, ch = slot - row * 9;
        __builtin_amdgcn_global_load_lds((const unsigned*)(src0 + (size_t)row * PW + C_K + 8 * (ch > 7 ? 7 : ch)), (LAS unsigned*)(Kb + wi * 1024), 16, 0, 0);
    }
    for (int wi = F.wave; wi < 20; wi += 8) {
        const int slot = wi * 64 + F.lane, row = slot / 10, ch = slot - row * 10;
        __builtin_amdgcn_global_load_lds((const unsigned*)(src0 + (size_t)row * PW + C_V + 8 * (ch > 7 ? 7 : ch)), (LAS unsigned*)(Vb + wi * 1024), 16, 0, 0);
    }
}
__device__ __forceinline__ void attn_window_seq(const Ctx& F, int sq) {
    constexpr int KS = 144, VS = 160; const ldsp Ki = F.lds, Vi = F.lds + 512 * KS;
    const int sidx = sq >> 2, b = sidx >> 2, kvh = sidx & 3, i0 = 8 * (sq & 3);
    const int w = F.wave, lane = F.lane, i16 = lane & 15, q4 = lane >> 4, hq = 4 * kvh + (w >> 1);
    const bf16_t* kvbase = F.proj() + (size_t)b * SEQ * PW + 64 * kvh;
    __syncthreads();
    for (int t = 0; t < 3; ++t) { const int kb = 128 * (i0 - 1 + t); if (kb >= 0 && kb < SEQ) ring_stage_block(F, kvbase, kb); }
    const float sink = F.attn_sink[hq] * LOG2E;
#pragma unroll 1
    for (int k = 0; k < 8; ++k) {
        const int i = i0 + k, q0 = 128 * i + 64 * (w & 1);
        __syncthreads();
        { const int nkey0 = 128 * i + 256; if (k < 7 && nkey0 < SEQ) ring_stage_block(F, kvbase, nkey0); }
#pragma unroll 1
        for (int half = 0; half < 2; ++half) {
            const int qh = q0 + 32 * half;
            bf16x8 qf[2][2];
#pragma unroll
            for (int q = 0; q < 2; ++q)
#pragma unroll
                for (int ks = 0; ks < 2; ++ks) qf[q][ks] = *(const bf16x8*)(F.proj() + (size_t)(b * SEQ + qh + 16 * q + i16) * PW + C_Q + hq * 64 + 32 * ks + 8 * q4);
            u32x2 graw[2][4];
#pragma unroll
            for (int q = 0; q < 2; ++q)
#pragma unroll
                for (int d = 0; d < 4; ++d) graw[q][d] = *(const u32x2*)(F.proj() + (size_t)(b * SEQ + qh + 16 * q + i16) * PW + C_G + hq * 64 + 16 * d + 4 * q4);
            f32x4 o[4][2]; float m[2], lp[2];
#pragma unroll
            for (int q = 0; q < 2; ++q) { m[q] = sink; lp[q] = q4 == 0 ? 1.f : 0.f;
#pragma unroll
                for (int d = 0; d < 4; ++d) o[d][q] = (f32x4){0.f, 0.f, 0.f, 0.f}; }
#pragma unroll 1
            for (int j = 0; j < 5; ++j) {
                const int kstart = q0 - 128 + 64 * j; if (kstart < 0 || kstart >= SEQ) continue;
                const int ir = kstart & 511;
                attn_tile<64, 2>(Ki + ir * KS, KS, Vi + ir * VS, VS, qf, o, m, lp, j == 0 ? 1 : (j == 4 ? 2 : 0), lane, 32 * half);
            }
#pragma unroll
            for (int q = 0; q < 2; ++q) {
                float l = lp[q]; l += __shfl_xor(l, 16); l += __shfl_xor(l, 32); const float inv = 1.f / l;
                const size_t row = (size_t)(b * SEQ + qh + 16 * q + i16);
#pragma unroll
                for (int d = 0; d < 4; ++d) {
                    const int col = hq * 64 + 16 * d + 4 * q4;
                    const f32x4 g = unpack4(graw[q][d]);
                    *(u32x2*)(F.mix() + row * MIXP + col) = pack4(o[d][q] * inv * g);
                }
            }
        }
    }
}
__device__ __forceinline__ void attn_mem_item(const Ctx& F, int item, bool stage) {
    constexpr int KS = 272, VS = 288; const ldsp Ki = F.lds, Vi = F.lds + 256 * KS;
    const int qb = item & 15, hm = (item >> 4) & 3, b = item >> 6;
    if (stage) {
    __syncthreads();
#pragma unroll
    for (int c = F.tid; c < 4096; c += 512) {
        const int r = c >> 4, ch = c & 15;
        const bf16_t* src = F.mkv() + (size_t)(b * 256 + r) * 1024 + hm * 128 + 8 * ch;
        *(LAS u32x4*)(Ki + r * KS + ch * 16) = *(const u32x4*)(src);
        *(LAS u32x4*)(Vi + r * VS + ch * 16) = *(const u32x4*)(src + 512);
    }
    __syncthreads();
    }
    const int w = F.wave, lane = F.lane, i16 = lane & 15, q4 = lane >> 4, q0 = 256 * qb + 32 * w;
    bf16x8 qf[2][4];
#pragma unroll
    for (int q = 0; q < 2; ++q)
#pragma unroll
        for (int ks = 0; ks < 4; ++ks) qf[q][ks] = *(const bf16x8*)(F.proj() + (size_t)(b * SEQ + q0 + 16 * q + i16) * PW + C_QM + hm * 128 + 32 * ks + 8 * q4);
    u32x2 graw[2][8];
#pragma unroll
    for (int q = 0; q < 2; ++q)
#pragma unroll
        for (int d = 0; d < 8; ++d) graw[q][d] = *(const u32x2*)(F.proj() + (size_t)(b * SEQ + q0 + 16 * q + i16) * PW + C_GM + hm * 128 + 16 * d + 4 * q4);
    f32x4 o[8][2]; float m[2], lp[2];
#pragma unroll
    for (int q = 0; q < 2; ++q) { m[q] = -INFINITY; lp[q] = 0.f;
#pragma unroll
        for (int d = 0; d < 8; ++d) o[d][q] = (f32x4){0.f, 0.f, 0.f, 0.f}; }
#pragma unroll 1
    for (int j = 0; j < 4; ++j) attn_tile<128, 2>(Ki + 64 * j * KS, KS, Vi + 64 * j * VS, VS, qf, o, m, lp, 0, lane);
#pragma unroll
    for (int q = 0; q < 2; ++q) {
        float l = lp[q]; l += __shfl_xor(l, 16); l += __shfl_xor(l, 32); const float inv = 1.f / l;
        const size_t row = (size_t)(b * SEQ + q0 + 16 * q + i16);
#pragma unroll
        for (int d = 0; d < 8; ++d) {
            const int col = hm * 128 + 16 * d + 4 * q4;
            const f32x4 g = unpack4(graw[q][d]);
            *(u32x2*)(F.mix() + row * MIXP + 1536 + col) = pack4(o[d][q] * inv * g);
        }
    }
}

constexpr int XS = 544, BS = 288, PS = 272;
constexpr int L_XI = 0, L_BI = 128 * XS, L_CI = L_BI + 128 * BS, L_F32 = L_CI + 128 * BS;
static_assert(L_F32 + 12288 <= LDS_XB, "lds");
__device__ __forceinline__ void ssd_dtprep(const Ctx& F, int b, int c, int g, bool write_dec) {
    LAS float* DTs = (LAS float*)(F.lds + L_F32); LAS float* ACs = DTs + 1024;
    const int w = F.wave, lane = F.lane, dir = w >> 2, r = w & 3, h = 4 * g + r, j = dir * 8 + h;
    const size_t row0 = (size_t)b * SEQ + c * 128;
    const float d0 = F.dt()[(row0 + 2 * lane) * 16 + j], d1 = F.dt()[(row0 + 2 * lane + 1) * 16 + j];
    const float a = -expf(F.a_log[j]);
    const float x0 = d0 * a, x1 = d1 * a, ps = x0 + x1; float inc = ps;
#pragma unroll
    for (int off = 1; off < 64; off <<= 1) { const float t = __shfl_up(inc, off); if (lane >= off) inc += t; }
    const float total = __shfl(inc, 63);
    float a0, a1;
    if (dir == 0) { a0 = inc - x1; a1 = inc; } else { a0 = total - (inc - ps); a1 = total - (inc - x1); }
    *(LAS f32x2*)(DTs + w * 128 + 2 * lane) = (f32x2){d0, d1};
    *(LAS f32x2*)(ACs + w * 128 + 2 * lane) = (f32x2){a0, a1};
    *(LAS f32x2*)(ACs + 1024 + w * 128 + 2 * lane) = (f32x2){d0 * expf(total - a0), d1 * expf(total - a1)};
    if (write_dec && lane == 0) F.dec()[(b * 32 + c) * 16 + j] = expf(total);
}
template <int NCOLS>
__device__ __forceinline__ void conv_img(const Ctx& F, int b, int c, int xcol, ldsp img, int stride) {
    constexpr int NCQ = NCOLS / 4, NRG = 512 / NCQ, R = 128 / NRG;
    const int cq = F.tid % NCQ, rg = F.tid / NCQ, col = xcol + 4 * cq;
    f32x4 w[5];
#pragma unroll
    for (int j = 0; j < 5; ++j) w[j] = *(const f32x4*)(F.conv_w + j * 1024 + col);
    const f32x4 bias = *(const f32x4*)(F.conv_b + col);
    const int t0 = c * 128 + rg * R - 2;
    const bf16_t* base = F.proj() + (size_t)b * SEQ * PW + C_X + col;
    f32x4 win[R + 4];
#pragma unroll
    for (int k = 0; k < R + 4; ++k) { const int t = t0 + k, tc = t < 0 ? 0 : (t >= SEQ ? SEQ - 1 : t); const u32x2 raw = *(const u32x2*)(base + (size_t)tc * PW); const bool ok = (t == tc);
        win[k] = unpack4((u32x2){ok ? raw.x : 0u, ok ? raw.y : 0u}); }
#pragma unroll
    for (int r = 0; r < R; ++r) {
        f32x4 y = bias;
#pragma unroll
        for (int j = 0; j < 5; ++j) y = y + w[j] * win[r + j];
        *(LAS u32x2*)(img + (rg * R + r) * stride + cq * 8) = pack4(silu4(y));
    }
}
__device__ __forceinline__ void ssd_pass1_item(const Ctx& F, int item) {
    const int g = item & 1, c = (item >> 1) & 31, b = item >> 6;
    const ldsp XI = F.lds + L_XI, BI = F.lds + L_BI, CI = F.lds + L_CI;
    LAS float* DTs = (LAS float*)(F.lds + L_F32); LAS float* ACs = DTs + 1024;
    __syncthreads();
    ssd_dtprep(F, b, c, g, true);
    conv_img<256>(F, b, c, 256 * g, XI, XS);
    conv_img<128>(F, b, c, 512 + 128 * g, BI, BS);
    conv_img<128>(F, b, c, 768 + 128 * g, CI, BS);
    __syncthreads();
    const int lane = F.lane, i16 = lane & 15, q4 = lane >> 4, w = F.wave, tl = 16 * w + i16;
    const size_t row = (size_t)b * SEQ + c * 128 + tl;
    f32x4 cbt[8];
    {
        bf16x8 cf[4];
#pragma unroll
        for (int ks = 0; ks < 4; ++ks) cf[ks] = ld8(CI + tl * BS + (32 * ks + 8 * q4) * 2);
#pragma unroll
        for (int ks = 0; ks < 4; ++ks) *(bf16x8*)(F.cfb() + ((size_t)(item * 8 + w) * 64 + lane) * 32 + 8 * ks) = cf[ks];
#pragma unroll
        for (int sf = 0; sf < 8; ++sf) {
            cbt[sf] = (f32x4){0.f, 0.f, 0.f, 0.f};
#pragma unroll
            for (int ks = 0; ks < 4; ++ks) cbt[sf] = mfma16(ld8(BI + (16 * sf + i16) * BS + (32 * ks + 8 * q4) * 2), cf[ks], cbt[sf]);
        }
    }
#pragma unroll 1
    for (int r = 0; r < 4; ++r) {
        {
            const int dir = w & 1, nq = w >> 1;
            LAS const float* Wr = ACs + 1024 + (dir * 4 + r) * 128;
            f32x4 acc[2][4];
#pragma unroll
            for (int nf = 0; nf < 2; ++nf)
#pragma unroll
                for (int pf = 0; pf < 4; ++pf) acc[nf][pf] = (f32x4){0.f, 0.f, 0.f, 0.f};
#pragma unroll
            for (int ks = 0; ks < 4; ++ks) {
                const int t0 = 32 * ks + 8 * q4, trow = t0 + (i16 >> 2);
                const f32x4 wlo = *(const LAS f32x4*)(Wr + t0), whi = *(const LAS f32x4*)(Wr + t0 + 4);
                bf16x8 af[2], bfr[4];
#pragma unroll
                for (int nf = 0; nf < 2; ++nf) {
                    ldsp p = BI + trow * BS + (32 * nq + 16 * nf + 4 * (i16 & 3)) * 2;
                    const u32x2 lo = __builtin_bit_cast(u32x2, vtr(p)), hi = __builtin_bit_cast(u32x2, vtr(p + 4 * BS));
                    af[nf] = packfrag(unpack4(lo) * wlo, unpack4(hi) * whi);
                }
#pragma unroll
                for (int pf = 0; pf < 4; ++pf) { ldsp p = XI + trow * XS + (64 * r + 16 * pf + 4 * (i16 & 3)) * 2; bfr[pf] = cat8(vtr(p), vtr(p + 4 * XS)); }
#pragma unroll
                for (int nf = 0; nf < 2; ++nf)
#pragma unroll
                    for (int pf = 0; pf < 4; ++pf) acc[nf][pf] = mfma16(af[nf], bfr[pf], acc[nf][pf]);
            }
            bf16_t* S = F.st() + ((((size_t)(b * 32 + c) * 2 + dir) * 8 + (4 * g + r)) << 13);
#pragma unroll
            for (int nf = 0; nf < 2; ++nf)
#pragma unroll
                for (int pf = 0; pf < 4; ++pf) *(u32x2*)(S + (16 * pf + i16) * 128 + 32 * nq + 16 * nf + 4 * q4) = pack4(acc[nf][pf]);
        }
        {
            const float acf = ACs[r * 128 + tl], acb = ACs[(4 + r) * 128 + tl];
            f32x4 yt[4];
#pragma unroll
            for (int pf = 0; pf < 4; ++pf) yt[pf] = (f32x4){0.f, 0.f, 0.f, 0.f};
#pragma unroll
            for (int kp = 0; kp < 4; ++kp) {
                f32x4 gt[2];
#pragma unroll
                for (int u = 0; u < 2; ++u) {
                    const int sf = 2 * kp + u, s0 = 16 * sf + 4 * q4;
                    const f32x4 dtf = *(const LAS f32x4*)(DTs + r * 128 + s0), af = *(const LAS f32x4*)(ACs + r * 128 + s0);
                    const f32x4 dtb = *(const LAS f32x4*)(DTs + (4 + r) * 128 + s0), ab = *(const LAS f32x4*)(ACs + (4 + r) * 128 + s0);
#pragma unroll
                    for (int e = 0; e < 4; ++e) {
                        const int sx = s0 + e;
                        const float mf = sx <= tl ? dtf[e] * __expf(acf - af[e]) : 0.f;
                        const float mb = sx >= tl ? dtb[e] * __expf(acb - ab[e]) : 0.f;
                        gt[u][e] = cbt[sf][e] * (mf + mb);
                    }
                }
                const bf16x8 gk = packfrag(gt[0], gt[1]);
#pragma unroll
                for (int pf = 0; pf < 4; ++pf) {
                    ldsp xa = XI + (32 * kp + 4 * q4 + (i16 >> 2)) * XS + (64 * r + 16 * pf + 4 * (i16 & 3)) * 2;
                    yt[pf] = mfma16(cat8(vtr(xa), vtr(xa + 16 * XS)), gk, yt[pf]);
                }
            }
            const float dsk = F.d_skip[4 * g + r];
#pragma unroll
            for (int pf = 0; pf < 4; ++pf) {
                const int pc = 64 * r + 16 * pf + 4 * q4;
                const f32x4 xv = unpack4(*(const LAS u32x2*)(XI + tl * XS + pc * 2));
                *(u32x2*)(F.yp() + row * 512 + 256 * g + pc) = pack4(yt[pf] + xv * dsk);
            }
            if (q4 == 0) { F.efb()[row * 16 + 4 * g + r] = __expf(acf); F.efb()[row * 16 + 8 + 4 * g + r] = __expf(acb); }
        }
    }
}
__device__ __forceinline__ void ssd_scan(const Ctx& F, int vb, int vg) {
    for (int it = vb * 512 + F.tid; it < NBATCH * 2 * 8 * 1024; it += vg * 512) {
        const int e8 = it & 1023, h = (it >> 10) & 7, dir = (it >> 13) & 1, b = it >> 14;
        float run[8];
#pragma unroll
        for (int k = 0; k < 8; ++k) run[k] = 0.f;
        for (int s0 = 0; s0 < 32; s0 += 4) {
            u32x4 v[4]; float dc[4]; bf16_t* ad[4];
#pragma unroll
            for (int u = 0; u < 4; ++u) { const int s = s0 + u, c = dir ? 31 - s : s; ad[u] = F.st() + (((((size_t)(b * 32 + c) * 2 + dir) * 8 + h) << 13) + e8 * 8); v[u] = __builtin_nontemporal_load((const u32x4*)ad[u]); dc[u] = F.dec()[(b * 32 + c) * 16 + dir * 8 + h]; }
#pragma unroll
            for (int u = 0; u < 4; ++u) {
                __builtin_nontemporal_store((u32x4){cvt_pk(run[0], run[1]), cvt_pk(run[2], run[3]), cvt_pk(run[4], run[5]), cvt_pk(run[6], run[7])}, (u32x4*)ad[u]);
                run[0] = run[0] * dc[u] + bf_lo(v[u].x); run[1] = run[1] * dc[u] + bf_hi(v[u].x); run[2] = run[2] * dc[u] + bf_lo(v[u].y); run[3] = run[3] * dc[u] + bf_hi(v[u].y);
                run[4] = run[4] * dc[u] + bf_lo(v[u].z); run[5] = run[5] * dc[u] + bf_hi(v[u].z); run[6] = run[6] * dc[u] + bf_lo(v[u].w); run[7] = run[7] * dc[u] + bf_hi(v[u].w);
            }
        }
    }
}
__device__ __forceinline__ void ssd_pass2_item(const Ctx& F, int item) {
    const int g = item & 1, c = (item >> 1) & 31, b = item >> 6;
    const ldsp PV = F.lds;
    const int lane = F.lane, i16 = lane & 15, q4 = lane >> 4, w = F.wave, tl = 16 * w + i16;
    const size_t row = (size_t)b * SEQ + c * 128 + tl;
    bf16x8 cf[4];
#pragma unroll
    for (int ks = 0; ks < 4; ++ks) cf[ks] = *(const bf16x8*)(F.cfb() + ((size_t)(item * 8 + w) * 64 + lane) * 32 + 8 * ks);
    const int pdir = F.tid >> 8, pp = (F.tid >> 2) & 63, pqu = F.tid & 3;
    const bf16_t* psrc = F.st() + (((((size_t)(b * 32 + c) * 2 + pdir) * 8 + 4 * g) << 13) + pp * 128 + 32 * pqu);
    u32x4 pvn[4][4];
#pragma unroll
    for (int r = 0; r < 4; ++r)
#pragma unroll
        for (int k = 0; k < 4; ++k) pvn[r][k] = *(const u32x4*)(psrc + ((size_t)r << 13) + 8 * k);
    __syncthreads();
#pragma unroll
    for (int r = 0; r < 4; ++r)
#pragma unroll
        for (int k = 0; k < 4; ++k) *(LAS u32x4*)(PV + (2 * r + pdir) * (64 * PS) + pp * PS + (32 * pqu + 8 * k) * 2) = pvn[r][k];
    __syncthreads();
    f32x4 gy[4][4]; float ss = 0.f;
#pragma unroll
    for (int r = 0; r < 4; ++r) {
        u32x2 zraw[4], yraw[4];
#pragma unroll
        for (int pf = 0; pf < 4; ++pf) { const int pc = 256 * g + 64 * r + 16 * pf + 4 * q4; zraw[pf] = *(const u32x2*)(F.proj() + row * PW + C_Z + pc); yraw[pf] = *(const u32x2*)(F.yp() + row * 512 + pc); }
        const float ef = F.efb()[row * 16 + 4 * g + r], eb = F.efb()[row * 16 + 8 + 4 * g + r];
        const ldsp PVr = PV + 2 * r * (64 * PS);
        f32x4 yf[4], yb[4];
#pragma unroll
        for (int pf = 0; pf < 4; ++pf) { yf[pf] = (f32x4){0.f, 0.f, 0.f, 0.f}; yb[pf] = (f32x4){0.f, 0.f, 0.f, 0.f}; }
#pragma unroll
        for (int ks = 0; ks < 4; ++ks)
#pragma unroll
            for (int pf = 0; pf < 4; ++pf) {
                yf[pf] = mfma16(ld8(PVr + (16 * pf + i16) * PS + (32 * ks + 8 * q4) * 2), cf[ks], yf[pf]);
                yb[pf] = mfma16(ld8(PVr + 64 * PS + (16 * pf + i16) * PS + (32 * ks + 8 * q4) * 2), cf[ks], yb[pf]);
            }
#pragma unroll
        for (int pf = 0; pf < 4; ++pf) {
            const f32x4 y = (unpack4(yraw[pf]) + yf[pf] * ef + yb[pf] * eb) * unpack4(zraw[pf]);
            gy[r][pf] = y; ss += y.x * y.x + y.y * y.y + y.z * y.z + y.w * y.w;
        }
    }
    ss += __shfl_xor(ss, 16); ss += __shfl_xor(ss, 32);
    const float rinv = rsqrtf(ss * (1.f / 256.f) + EPS);
#pragma unroll
    for (int r = 0; r < 4; ++r)
#pragma unroll
        for (int pf = 0; pf < 4; ++pf) {
            const int pc = 256 * g + 64 * r + 16 * pf + 4 * q4;
            const f32x4 nw = *(const f32x4*)(F.ssd_norm_w + pc);
            *(u32x2*)(F.mix() + row * MIXP + 1024 + pc) = pack4(gy[r][pf] * rinv * nw);
        }
}

__device__ __forceinline__ void final_norm(const Ctx& F) {
    const int gw = F.bid * 8 + F.wave, NGW = F.G * 8, lane = F.lane;
    for (int m = gw; m < TOK; m += NGW) {
        const f32x4* rp = (const f32x4*)(F.rowss() + (size_t)m * 16); const f32x4 s4 = (rp[0] + rp[1]) + (rp[2] + rp[3]);
        const float r = rsqrtf(((s4.x + s4.y) + (s4.z + s4.w)) * (1.f / DM) + EPS);
        float* o = F.out + (size_t)m * DM;
#pragma unroll
        for (int j = 0; j < 4; ++j) { const f32x4 v = __builtin_nontemporal_load((const f32x4*)(o + 4 * lane + 256 * j)), ww = *(const f32x4*)(F.norm_out_w + 4 * lane + 256 * j); __builtin_nontemporal_store(v * r * ww, (f32x4*)(o + 4 * lane + 256 * j)); }
    }
}

#define XB_TMO      128
#define XB_XCNT(j)  (256  + 64 * (j))
#define XB_XSUB(j)  (1280 + 64 * (j))
#define XB_XGEN(j)  (2304 + 64 * (j))
#define XB_TOP      3328
#define XB_TOPGEN   3392
#define XCD_BAR_WORDS 3456
#define XB_SPIN_CAP (1u << 18)

__device__ __forceinline__ unsigned xb_ld(unsigned* p)              { return __hip_atomic_load(p, __ATOMIC_RELAXED, __HIP_MEMORY_SCOPE_AGENT); }
__device__ __forceinline__ unsigned xb_add(unsigned* p, unsigned v) { return __hip_atomic_fetch_add(p, v, __ATOMIC_RELAXED, __HIP_MEMORY_SCOPE_AGENT); }
__device__ __forceinline__ unsigned xb_xcc_id() { return (unsigned)__builtin_amdgcn_s_getreg((3 << 11) | 20) & 0xFu; }
#define XB_SPIN(cond, bar) do { unsigned _sp = 0; while (cond) { __builtin_amdgcn_s_sleep(1); \
    if ((++_sp & 255u) == 0u) { if (xb_ld(&(bar)[XB_TMO])) break; if (_sp > XB_SPIN_CAP) { atomicAdd(&(bar)[XB_TMO], 1u); break; } } } } while (0)

struct XcdBarrier {
    unsigned* bar; unsigned x;
    volatile LAS unsigned* st;
};

__device__ __forceinline__ XcdBarrier xcd_barrier_post(unsigned* bar, volatile LAS unsigned* st, int xb_tid) {
    XcdBarrier b; b.bar = bar; b.x = xb_xcc_id(); b.st = st;
    if (xb_tid == 0) (void)xb_add(&bar[XB_XCNT(b.x)], 1u);
    return b;
}
__device__ __forceinline__ void xcd_barrier_complete(unsigned* bar, unsigned x, unsigned& nloc, unsigned& nx) {
    const unsigned G = gridDim.x * gridDim.y * gridDim.z;
    unsigned sum, cnt, mine, sp = 0u;
    for (;;) {
        sum = 0u; cnt = 0u; mine = 0u;
#pragma unroll
        for (unsigned j = 0; j < 16; ++j) { const unsigned c = xb_ld(&bar[XB_XCNT(j)]); sum += c; cnt += (c > 0u) ? 1u : 0u; mine = (j == x) ? c : mine; }
        if (sum == G) break;
        __builtin_amdgcn_s_sleep(1);
        if ((++sp & 255u) == 0u) { if (xb_ld(&bar[XB_TMO])) break; if (sp > XB_SPIN_CAP) { atomicAdd(&bar[XB_TMO], 1u); break; } }
    }
    nloc = mine > 0u ? mine : 1u; nx = cnt > 0u ? cnt : 1u;
}

__device__ __forceinline__ void xcd_barrier(const XcdBarrier& b, int xb_tid) {
    asm volatile("s_waitcnt vmcnt(0)" ::: "memory");
    __syncthreads();
    if (xb_tid == 0) {
        unsigned* bar = b.bar;
        __builtin_amdgcn_s_waitcnt(0);
        unsigned nloc = b.st[0], nx = b.st[1];
        if (nloc == 0u) { xcd_barrier_complete(bar, b.x, nloc, nx); b.st[0] = nloc; b.st[1] = nx; }
        const unsigned old = xb_add(&bar[XB_XSUB(b.x)], 1u);
        const unsigned gen = old / nloc;
        if (old + 1u == (gen + 1u) * nloc) {
            __builtin_amdgcn_fence(__ATOMIC_RELEASE, "agent");
            asm volatile("s_waitcnt vmcnt(0)" ::: "memory");
            const unsigned og = xb_add(&bar[XB_TOP], 1u);
            const unsigned tg = og / nx;
            if (og + 1u == (tg + 1u) * nx) xb_add(&bar[XB_TOPGEN], 1u);
            else XB_SPIN(xb_ld(&bar[XB_TOPGEN]) == tg, bar);
            __builtin_amdgcn_fence(__ATOMIC_ACQUIRE, "agent");
            xb_add(&bar[XB_XGEN(b.x)], 1u);
            asm volatile("s_waitcnt vmcnt(0)" ::: "memory");
        } else {
            XB_SPIN(xb_ld(&bar[XB_XGEN(b.x)]) == gen, bar);
            __builtin_amdgcn_fence(__ATOMIC_ACQUIRE, "agent");
            asm volatile("s_waitcnt vmcnt(0)" ::: "memory");
        }
    }
    __syncthreads();
}

__global__ void __launch_bounds__(512, 2) hymba_fwd(Args args) {
    extern __shared__ __attribute__((aligned(16))) unsigned char lds_raw[];
    Ctx F;
    F.x = args.in[0]; F.mem = args.in[1]; F.norm_mem_w = args.in[2]; F.norm_in_w = args.in[3]; F.w_in = args.in[4]; F.attn_sink = args.in[5]; F.conv_w = args.in[6]; F.conv_b = args.in[7];
    F.dt_bias = args.in[8]; F.a_log = args.in[9]; F.d_skip = args.in[10]; F.ssd_norm_w = args.in[11]; F.w_mem_kv = args.in[12]; F.w_out = args.in[13]; F.norm_out_w = args.in[14];
    F.out = args.out; F.ws = args.ws;
    F.lds = (ldsp)lds_raw; F.tid = threadIdx.x; F.lane = F.tid & 63; F.wave = __builtin_amdgcn_readfirstlane(F.tid >> 6); F.G = gridDim.x; F.bid = blockIdx.x;
    const int lo = args.lo, hi = args.hi;
    cg::grid_group grid = cg::this_grid();
#define IN(k) (lo <= (k) && (k) < hi)
#define REFRESH() do { F.lane = lane_id_now(); F.tid = F.wave * 64 + F.lane; } while (0)
    if (F.tid == 0) { *(LAS u32x4*)(F.lds + LDS_XB) = (u32x4){0u, 0u, 0u, 0u}; }
    __syncthreads();
    XcdBarrier xbar; xbar.bar = (unsigned*)args.ws; xbar.x = 0; xbar.st = (volatile LAS unsigned*)(F.lds + LDS_XB);
    if (hi - lo > 1) xbar = xcd_barrier_post((unsigned*)args.ws, (volatile LAS unsigned*)(F.lds + LDS_XB), F.tid);
    if (lo < 0) grid.sync();
#define SEAM(k) do { if (IN(k) && IN((k) + 1)) xcd_barrier(xbar, F.tid); } while (0)
    if (IN(0)) { REFRESH(); phase0(F); }
    SEAM(0);
    if (IN(1)) {
        REFRESH();
        { pg8::Gemm g{F.hn(), F.win_t(), TOK, NPHYS, DM, HNP, HNP}; pg8::StaticOrder S; S.init(g.M, g.N, F.G, F.bid); EpiProj E{F.proj(), F.dt(), F.rope(), F.dt_bias}; pg8::gemm_phase(F.lds, g, S, E, F.wave); }
    }
    SEAM(1);
    if (IN(2)) {
        REFRESH();
        if (F.bid & 1) for (int sq = F.bid; sq < NBATCH * 4 * 4; sq += F.G) attn_window_seq(F, sq);
        for (int it = F.bid; it < NBATCH * 32 * 2; it += F.G) ssd_pass1_item(F, it);
        if (!(F.bid & 1)) for (int sq = F.bid; sq < NBATCH * 4 * 4; sq += F.G) attn_window_seq(F, sq);
    }
    SEAM(2);
    if (IN(3)) {
        REFRESH();
        if (F.G >= 128) {
            if (F.bid < 64) { pg8::Gemm g{F.memn(), F.wmem_t(), NBATCH * 256, 1024, 1024, HNP, HNP}; pg8::StaticOrder S; S.init(g.M, g.N, 64, F.bid); EpiMkv E{F.mkv()}; pg8::gemm_phase(F.lds, g, S, E, F.wave); }
            else ssd_scan(F, F.bid - 64, F.G - 64);
        } else {
            { pg8::Gemm g{F.memn(), F.wmem_t(), NBATCH * 256, 1024, 1024, HNP, HNP}; pg8::StaticOrder S; S.init(g.M, g.N, F.G, F.bid); EpiMkv E{F.mkv()}; pg8::gemm_phase(F.lds, g, S, E, F.wave); }
            ssd_scan(F, F.bid, F.G);
        }
    }
    SEAM(3);
    if (IN(4)) {
        REFRESH();
        if (F.bid & 1) for (int grp = F.bid; grp < NBATCH * 16; grp += F.G) for (int k = 0; k < 4; ++k) attn_mem_item(F, 4 * grp + k, k == 0);
        for (int it = F.bid; it < NBATCH * 32 * 2; it += F.G) ssd_pass2_item(F, it);
        if (!(F.bid & 1)) for (int grp = F.bid; grp < NBATCH * 16; grp += F.G) for (int k = 0; k < 4; ++k) attn_mem_item(F, 4 * grp + k, k == 0);
    }
    SEAM(4);
    if (IN(5)) { REFRESH(); __syncthreads(); pg8::Gemm g{F.mix(), F.wout_t(), TOK, DM, MIXW, MIXP, MIXP}; pg8::StaticOrder S; S.init(g.M, g.N, F.G, F.bid); EpiOut E{F.x, F.out, F.rowss()}; pg8::gemm_phase(F.lds, g, S, E, F.wave); }
    SEAM(5);
    if (IN(6)) { REFRESH(); final_norm(F); }
#undef IN
#undef SEAM
}

extern "C" void kernel_launch(void* const* d_in, const int* in_sizes, int n_in, void* d_out, int out_size, void* d_ws, size_t ws_size, hipStream_t stream) {
    static int grid = 0;
    if (grid == 0) {
        if (n_in != 15 || out_size != TOK * DM || ws_size < WS_END) { fprintf(stderr, "kernel_launch: unexpected shapes (n_in %d out %d ws %zu)\n", n_in, out_size, ws_size); grid = -1; return; }
        int dev = 0, cus = 0, per_cu = 0;
        (void)hipGetDevice(&dev); (void)hipDeviceGetAttribute(&cus, hipDeviceAttributeMultiprocessorCount, dev);
        if (hipFuncSetAttribute((const void*)hymba_fwd, hipFuncAttributeMaxDynamicSharedMemorySize, LDS_BYTES) != hipSuccess) { fprintf(stderr, "kernel_launch: hipFuncSetAttribute failed\n"); grid = -1; return; }
        if (hipOccupancyMaxActiveBlocksPerMultiprocessor(&per_cu, (const void*)hymba_fwd, 512, LDS_BYTES) != hipSuccess || per_cu < 1) { fprintf(stderr, "kernel_launch: occupancy query says %d\n", per_cu); per_cu = 1; }
        (void)hipGetLastError();
        grid = cus > 0 ? cus : 256;
    }
    if (grid < 0) return;
    Args a{};
    for (int i = 0; i < 15; ++i) a.in[i] = (const float*)d_in[i];
    a.out = (float*)d_out; a.ws = (unsigned char*)d_ws;
    (void)hipMemsetAsync(d_ws, 0, 16384, stream);
#if MK_ONE_LAUNCH
    a.lo = 0; a.hi = NPHASE;
    void* kargs[] = {&a};
    hipError_t e = hipLaunchCooperativeKernel((const void*)hymba_fwd, dim3(grid), dim3(512), kargs, LDS_BYTES, stream);
    if (e != hipSuccess) fprintf(stderr, "kernel_launch: cooperative launch failed: %s (grid %d)\n", hipGetErrorString(e), grid);
#else
    for (int k = 0; k < NPHASE; ++k) { a.lo = k; a.hi = k + 1; hipLaunchKernelGGL(hymba_fwd, dim3(grid), dim3(512), LDS_BYTES, stream, a); }
#endif
}
```

```cpp
#include <hip/hip_runtime.h>
#include <hip/hip_cooperative_groups.h>
#include <cstdio>
#include <cstdint>
namespace cg = cooperative_groups;

#ifndef MK_ONE_LAUNCH
#define MK_ONE_LAUNCH 1
#endif

#define LAS __attribute__((address_space(3)))
typedef unsigned short bf16_t;
typedef short bf16x8 __attribute__((ext_vector_type(8)));
typedef short s16x4 __attribute__((ext_vector_type(4)));
typedef float f32x4 __attribute__((ext_vector_type(4)));
typedef float f32x2 __attribute__((ext_vector_type(2)));
typedef unsigned u32x4 __attribute__((ext_vector_type(4)));
typedef unsigned u32x2 __attribute__((ext_vector_type(2)));
typedef LAS unsigned char* ldsp;

constexpr int SEQ = 4096, NBATCH = 16, TOK = SEQ * NBATCH, DM = 1024;
constexpr int INW = 5136, NPHYS = 5376, PW = 5184;
constexpr int HNP = 1088, MIXP = 2112;
constexpr int C_Q = 0, C_K = 1024, C_V = 1280, C_G = 1536, C_Z = 2560, C_X = 3072, C_QM = 4096, C_GM = 4608;
constexpr int MIXW = 2048;
constexpr float LOG2E = 1.4426950408889634f;
constexpr float EPS = 1e-6f;
constexpr int NPHASE = 7;

constexpr size_t MiB = (size_t)1 << 20;
constexpr size_t WS_ROWSS = 956 * MiB, WS_ROPE = 1 * MiB, WS_WIN = 2 * MiB, WS_WOUT = 14 * MiB, WS_WMEM = 19 * MiB, WS_MEMN = 22 * MiB,
                 WS_MKV = 31 * MiB, WS_DT = 39 * MiB, WS_DEC = 43 * MiB, WS_PROJ = 44 * MiB, WS_MIX = 692 * MiB, WS_END = 960 * MiB;

constexpr int LDS_BYTES = 155648 + 16;
constexpr int LDS_XB = 155648;

__device__ __forceinline__ unsigned cvt_pk(float lo, float hi) { unsigned r; asm volatile("v_cvt_pk_bf16_f32 %0, %1, %2" : "=v"(r) : "v"(lo), "v"(hi)); return r; }
typedef __bf16 bf16x2_t __attribute__((ext_vector_type(2)));
__device__ __forceinline__ unsigned cvt_pk_c(float lo, float hi) { const f32x2 v = {lo, hi}; return __builtin_bit_cast(unsigned, __builtin_convertvector(v, bf16x2_t)); }
__device__ __forceinline__ float bf_lo(unsigned u) { return __uint_as_float(u << 16); }
__device__ __forceinline__ float bf_hi(unsigned u) { return __uint_as_float(u & 0xffff0000u); }
__device__ __forceinline__ f32x4 unpack4(u32x2 v) { return (f32x4){bf_lo(v.x), bf_hi(v.x), bf_lo(v.y), bf_hi(v.y)}; }
__device__ __forceinline__ u32x2 pack4(f32x4 v) { return (u32x2){cvt_pk_c(v.x, v.y), cvt_pk_c(v.z, v.w)}; }
__device__ __forceinline__ float silu_f(float x) { return x * __builtin_amdgcn_rcpf(1.f + __expf(-x)); }
__device__ __forceinline__ f32x4 silu4(f32x4 v) { return (f32x4){silu_f(v.x), silu_f(v.y), silu_f(v.z), silu_f(v.w)}; }
__device__ __forceinline__ float softplus_f(float x) { return x > 15.f ? x : __logf(1.f + __expf(x)); }
__device__ __forceinline__ float ex2(float x) { return __builtin_amdgcn_exp2f(x); }
typedef short v4i16_t __attribute__((ext_vector_type(4)));
__device__ __forceinline__ s16x4 vtr(ldsp p) { return __builtin_bit_cast(s16x4, __builtin_amdgcn_ds_read_tr16_b64_v4i16((LAS v4i16_t*)p)); }
__device__ __forceinline__ bf16x8 cat8(s16x4 a, s16x4 b) { return (bf16x8){a[0], a[1], a[2], a[3], b[0], b[1], b[2], b[3]}; }
__device__ __forceinline__ bf16x8 ld8(ldsp p) { return *(const LAS bf16x8*)p; }
__device__ __forceinline__ f32x4 mfma16(bf16x8 a, bf16x8 b, f32x4 c) { return __builtin_amdgcn_mfma_f32_16x16x32_bf16(a, b, c, 0, 0, 0); }
__device__ __forceinline__ bf16x8 packfrag(f32x4 a, f32x4 b) { u32x4 r = {cvt_pk_c(a.x, a.y), cvt_pk_c(a.z, a.w), cvt_pk_c(b.x, b.y), cvt_pk_c(b.z, b.w)}; return __builtin_bit_cast(bf16x8, r); }

__device__ __forceinline__ f32x4 zero4() { f32x4 z; asm volatile("v_mov_b32 %0, 0\n\tv_mov_b32 %1, 0\n\tv_mov_b32 %2, 0\n\tv_mov_b32 %3, 0" : "=v"(z.x), "=v"(z.y), "=v"(z.z), "=v"(z.w)); return z; }
__device__ __forceinline__ int lane_id_now() { int l; asm volatile("v_mbcnt_lo_u32_b32 %0, -1, 0\n\tv_mbcnt_hi_u32_b32 %0, -1, %0" : "=v"(l)); return l; }
__host__ __device__ __forceinline__ int perm_plain(int c) { const int bj = c >> 7, wc = (c >> 5) & 3, n = (c >> 4) & 1, fq = (c >> 2) & 3, i = c & 3; return 128 * bj + 32 * wc + 8 * fq + 4 * n + i; }
__host__ __device__ __forceinline__ int perm_rot(int c) { const int bj = c >> 7, wc = (c >> 5) & 3, n = (c >> 4) & 1, fq = (c >> 2) & 3, i = c & 3; return 64 * wc + 32 * bj + 8 * fq + 4 * n + i; }

namespace pg8 {
constexpr int BM = 256, BK = 64, HALF = 128, HTB = HALF * BK * 2, STAGE_BYTES = 8 * HTB, NXCD = 8, WGM = 8;
__host__ __device__ __forceinline__ int lds_byte(int r, int c) { const int st = (r >> 4) * 2 + (c >> 5), rr = r & 15, cc = c & 31, ob = rr * 64 + cc * 2; return st * 1024 + (ob ^ (((ob >> 9) & 1) << 5)); }
__host__ __device__ __forceinline__ void stage_rc(int b, int& R, int& C) { const int st = b / 1024, sb = b % 1024, swz = sb ^ (((sb >> 9) & 1) << 5); R = (st >> 1) * 16 + swz / 64; C = (st & 1) * 32 + (swz % 64) / 2; }
struct Unit { int pm, pn; };
struct Gemm { const bf16_t* A; const bf16_t* Bt; int M, N, K, lda, ldb; };
struct StaticOrder {
    int nM, nN, nwg, G, c;
    __device__ void init(int M, int N, int G_, int c_) { nM = M / BM; nN = N / BM; nwg = nM * nN; G = G_; c = c_; }
    __device__ bool next(int i, Unit& u) const {
        const long L = (long)i * G + c; if (L >= nwg) return false;
        int wgid = (int)L; { const int q = nwg / NXCD, r = nwg % NXCD, xcd = wgid % NXCD, off = wgid / NXCD; wgid = (xcd < r ? xcd * (q + 1) : r * (q + 1) + (xcd - r) * q) + off; }
        const int nig = WGM * nN, gid = wgid / nig, fm = gid * WGM, gsz = (nM - fm) < WGM ? (nM - fm) : WGM;
        u.pm = fm + ((wgid % nig) % gsz); u.pn = (wgid % nig) / gsz; return true;
    }
};
template <class Epi, class Sched>
__device__ __forceinline__ void gemm_phase(ldsp lds, const Gemm g, const Sched& S, const Epi& E, int wave_id) {
    const int lane = lane_id_now(), wid = wave_id, tid = wid * 64 + lane, wr = wid >> 2, wc = wid & 3, fr = lane & 15, fq = lane >> 4;
    const int K = g.K, nt = K / BK;
    unsigned voffA[2], voffB[2];
#pragma unroll
    for (int i = 0; i < 2; ++i) { int R, C; stage_rc(tid * 16 + i * 8192, R, C); voffA[i] = (unsigned)(R * g.lda + C) * 2u; voffB[i] = (unsigned)(R * g.ldb + C) * 2u; }
    const size_t kstep = (size_t)(BK * 2);
    const size_t hstep = (size_t)HALF * g.lda * 2, hstepB = (size_t)HALF * g.ldb * 2;
    const size_t tstep = 2 * hstep, tstepB = 2 * hstepB;
    const unsigned ldsw = (unsigned)wid * 1024u;
    const int aoff = lds_byte(wr * 64 + fr, fq * 8), boff = lds_byte(wc * 32 + fr, fq * 8);
#define PG8_SA(b, h) (((b) * 2 + (h)) * HTB)
#define PG8_SB(b, h) ((4 + (b) * 2 + (h)) * HTB)
#define PG8_STAGE(bufoff, gbase, voff) do { _Pragma("unroll") for (int _i = 0; _i < 2; ++_i) \
        __builtin_amdgcn_global_load_lds((const unsigned*)((const char*)(gbase) + (voff)[_i]), (LAS unsigned*)(lds + (bufoff) + ldsw + _i * 8192), 16, 0, 0); } while (0)
#define PG8_LDA(dst, b, h) do { _Pragma("unroll") for (int m = 0; m < 4; ++m) _Pragma("unroll") for (int k = 0; k < 2; ++k) dst[m][k] = *(const LAS bf16x8*)(lds + PG8_SA(b, h) + aoff + m * 2048 + k * 1024); } while (0)
#define PG8_LDB(dst, b, h) do { _Pragma("unroll") for (int n = 0; n < 2; ++n) _Pragma("unroll") for (int k = 0; k < 2; ++k) dst[n][k] = *(const LAS bf16x8*)(lds + PG8_SB(b, h) + boff + n * 2048 + k * 1024); } while (0)
#define PG8_MMA(ai, bj, At, Bt) do { __builtin_amdgcn_s_setprio(1); _Pragma("unroll") for (int m = 0; m < 4; ++m) _Pragma("unroll") for (int n = 0; n < 2; ++n) _Pragma("unroll") for (int k = 0; k < 2; ++k) \
        acc[ai][bj][m][n] = __builtin_amdgcn_mfma_f32_16x16x32_bf16(Bt[n][k], At[m][k], acc[ai][bj][m][n], 0, 0, 0); __builtin_amdgcn_s_setprio(0); } while (0)
#define PG8_WAIT_V(n) asm volatile("s_waitcnt vmcnt(" #n ")" ::: "memory")
#define PG8_WAIT_L(n) asm volatile("s_waitcnt lgkmcnt(" #n ")" ::: "memory")
#define PG8_BAR __builtin_amdgcn_s_barrier()
#define PG8_SCHED __builtin_amdgcn_sched_barrier(0)
    Unit cur, nxt; int ui = 0;
    if (!S.next(0, cur)) return;
    f32x4 acc[2][2][4][2];
#pragma unroll
    for (int a = 0; a < 2; ++a)
#pragma unroll
        for (int b = 0; b < 2; ++b)
#pragma unroll
            for (int m = 0; m < 4; ++m)
#pragma unroll
                for (int n = 0; n < 2; ++n) acc[a][b][m][n] = (f32x4){0.f, 0.f, 0.f, 0.f};
    bf16x8 At[4][2], B0[2][2], B1[2][2];
    const char* cA = (const char*)g.A + (size_t)cur.pm * tstep; const char* cB = (const char*)g.Bt + (size_t)cur.pn * tstepB;
    PG8_STAGE(PG8_SB(0, 0), cB, voffB); PG8_STAGE(PG8_SA(0, 0), cA, voffA); PG8_STAGE(PG8_SB(0, 1), cB + hstepB, voffB); PG8_STAGE(PG8_SA(0, 1), cA + hstep, voffA);
    if (wr == 1) PG8_BAR;
    PG8_WAIT_V(4); PG8_BAR;
    PG8_STAGE(PG8_SB(1, 0), cB + kstep, voffB); PG8_STAGE(PG8_SA(1, 0), cA + kstep, voffA); PG8_STAGE(PG8_SB(1, 1), cB + hstepB + kstep, voffB);
    PG8_WAIT_V(6); PG8_BAR;
    for (;;) {
        const bool has_next = S.next(ui + 1, nxt);
        const char* nA = has_next ? (const char*)g.A + (size_t)nxt.pm * tstep : cA; const char* nB = has_next ? (const char*)g.Bt + (size_t)nxt.pn * tstepB : cB;
        for (int t = 0; t < nt; t += 2) {
            const bool last = (t == nt - 2);
            const char* a1 = cA + (size_t)(t + 1) * kstep;
            const char* a2 = last ? nA : cA + (size_t)(t + 2) * kstep; const char* b2 = last ? nB : cB + (size_t)(t + 2) * kstep;
            const char* a3 = a2 + kstep; const char* b3 = b2 + kstep;
            PG8_LDB(B0, 0, 0); PG8_SCHED; PG8_LDA(At, 0, 0); PG8_STAGE(PG8_SA(1, 1), a1 + hstep, voffA);
            PG8_WAIT_L(8); PG8_BAR; PG8_WAIT_L(0); PG8_MMA(0, 0, At, B0); PG8_BAR; PG8_SCHED;
            PG8_LDB(B1, 0, 1); PG8_STAGE(PG8_SB(0, 0), b2, voffB);
            PG8_BAR; PG8_WAIT_L(0); PG8_MMA(0, 1, At, B1); PG8_BAR;
            PG8_LDA(At, 0, 1); PG8_STAGE(PG8_SA(0, 0), a2, voffA);
            PG8_BAR; PG8_WAIT_L(0); PG8_MMA(1, 0, At, B0); PG8_BAR; PG8_SCHED;
            PG8_STAGE(PG8_SB(0, 1), b2 + hstepB, voffB);
            PG8_WAIT_V(6); PG8_BAR; PG8_MMA(1, 1, At, B1); PG8_BAR;
            PG8_LDB(B0, 1, 0); PG8_SCHED; PG8_LDA(At, 1, 0); PG8_STAGE(PG8_SA(0, 1), a2 + hstep, voffA);
            PG8_WAIT_L(8); PG8_BAR; PG8_WAIT_L(0); PG8_MMA(0, 0, At, B0); PG8_BAR; PG8_SCHED;
            PG8_LDB(B1, 1, 1); PG8_STAGE(PG8_SB(1, 0), b3, voffB);
            PG8_BAR; PG8_WAIT_L(0); PG8_MMA(0, 1, At, B1); PG8_BAR;
            PG8_LDA(At, 1, 1); PG8_STAGE(PG8_SA(1, 0), a3, voffA);
            PG8_BAR; PG8_WAIT_L(0); PG8_MMA(1, 0, At, B0); PG8_BAR; PG8_SCHED;
            PG8_STAGE(PG8_SB(1, 1), b3 + hstepB, voffB);
            PG8_WAIT_V(6); PG8_BAR; PG8_MMA(1, 1, At, B1); PG8_BAR;
        }
        E(acc, cur, wr, wc, fr, fq);
        if (!has_next) break;
#pragma unroll
        for (int a = 0; a < 2; ++a)
#pragma unroll
            for (int b = 0; b < 2; ++b)
#pragma unroll
                for (int m = 0; m < 4; ++m)
#pragma unroll
                    for (int n = 0; n < 2; ++n) acc[a][b][m][n] = (f32x4){0.f, 0.f, 0.f, 0.f};
        cur = nxt; cA = nA; cB = nB; ++ui;
    }
    PG8_WAIT_V(0);
    if (wr == 0) PG8_BAR;
    PG8_BAR;
#undef PG8_SA
#undef PG8_SB
#undef PG8_STAGE
#undef PG8_LDA
#undef PG8_LDB
#undef PG8_MMA
#undef PG8_WAIT_V
#undef PG8_WAIT_L
#undef PG8_BAR
#undef PG8_SCHED
}
}

struct EpiProj {
    bf16_t* P; float* DT; const float* rope; const float* dt_bias;
    __device__ __forceinline__ void operator()(const f32x4 (&acc)[2][2][4][2], const pg8::Unit& u, int wr, int wc, int fr, int fq) const {
        const int row0 = u.pm * 256 + wr * 64 + fr, pn = u.pn;
        if (pn < 5) {
            const float sc = pn < 4 ? 0.125f * LOG2E : 1.f;
            const int col = pn * 256 + 64 * wc + 8 * fq;
#pragma unroll
            for (int ai = 0; ai < 2; ++ai)
#pragma unroll
                for (int m = 0; m < 4; ++m) {
                    const int row = row0 + ai * 128 + m * 16, pos = row & (SEQ - 1);
                    const f32x4* cp = (const f32x4*)(rope + pos * 32 + 8 * fq); const f32x4* sp = (const f32x4*)(rope + SEQ * 32 + pos * 32 + 8 * fq);
                    f32x4 o1[2], o2[2];
#pragma unroll
                    for (int n = 0; n < 2; ++n) { const f32x4 c = cp[n], s = sp[n], t1 = acc[ai][0][m][n], t2 = acc[ai][1][m][n]; o1[n] = (t1 * c - t2 * s) * sc; o2[n] = (t1 * s + t2 * c) * sc; }
                    bf16_t* dst = P + (size_t)row * PW + col;
                    __builtin_nontemporal_store((u32x4){cvt_pk(o1[0].x, o1[0].y), cvt_pk(o1[0].z, o1[0].w), cvt_pk(o1[1].x, o1[1].y), cvt_pk(o1[1].z, o1[1].w)}, (u32x4*)dst);
                    __builtin_nontemporal_store((u32x4){cvt_pk(o2[0].x, o2[0].y), cvt_pk(o2[0].z, o2[0].w), cvt_pk(o2[1].x, o2[1].y), cvt_pk(o2[1].z, o2[1].w)}, (u32x4*)(dst + 32));
                }
        } else if (pn < 20) {
            const bool do_silu = (pn >= 6 && pn < 12) || pn >= 18;
            const float sc = (pn == 16 || pn == 17) ? 0.08838834764831845f * LOG2E : 1.f;
            const int col = pn * 256 + 32 * wc + 8 * fq;
#pragma unroll
            for (int ai = 0; ai < 2; ++ai)
#pragma unroll
                for (int m = 0; m < 4; ++m) {
                    const int row = row0 + ai * 128 + m * 16;
#pragma unroll
                    for (int bj = 0; bj < 2; ++bj) {
                        f32x4 v0 = acc[ai][bj][m][0], v1 = acc[ai][bj][m][1];
                        if (do_silu) { v0 = silu4(v0); v1 = silu4(v1); } else { v0 = v0 * sc; v1 = v1 * sc; }
                        __builtin_nontemporal_store((u32x4){cvt_pk(v0.x, v0.y), cvt_pk(v0.z, v0.w), cvt_pk(v1.x, v1.y), cvt_pk(v1.z, v1.w)}, (u32x4*)(P + (size_t)row * PW + col + 128 * bj));
                    }
                }
        } else {
            if (wc == 0 && fq < 2) {
#pragma unroll
                for (int ai = 0; ai < 2; ++ai)
#pragma unroll
                    for (int m = 0; m < 4; ++m) {
                        const int row = row0 + ai * 128 + m * 16;
#pragma unroll
                        for (int n = 0; n < 2; ++n) {
                            const int j0 = 8 * fq + 4 * n; const f32x4 bb = *(const f32x4*)(dt_bias + j0); const f32x4 v = acc[ai][0][m][n] + bb;
                            *(f32x4*)(DT + (size_t)row * 16 + j0) = (f32x4){softplus_f(v.x), softplus_f(v.y), softplus_f(v.z), softplus_f(v.w)};
                        }
                    }
            }
        }
    }
};
struct EpiMkv {
    bf16_t* O;
    __device__ __forceinline__ void operator()(const f32x4 (&acc)[2][2][4][2], const pg8::Unit& u, int wr, int wc, int fr, int fq) const {
        const int row0 = u.pm * 256 + wr * 64 + fr, col = u.pn * 256 + 32 * wc + 8 * fq;
#pragma unroll
        for (int ai = 0; ai < 2; ++ai)
#pragma unroll
            for (int m = 0; m < 4; ++m) {
                const int row = row0 + ai * 128 + m * 16;
#pragma unroll
                for (int bj = 0; bj < 2; ++bj) { const f32x4 v0 = acc[ai][bj][m][0], v1 = acc[ai][bj][m][1];
                    *(u32x4*)(O + (size_t)row * 1024 + col + 128 * bj) = (u32x4){cvt_pk(v0.x, v0.y), cvt_pk(v0.z, v0.w), cvt_pk(v1.x, v1.y), cvt_pk(v1.z, v1.w)}; }
            }
    }
};
struct EpiOut {
    const float* x; float* out; float* rowss;
    __device__ __forceinline__ void operator()(const f32x4 (&acc)[2][2][4][2], const pg8::Unit& u, int wr, int wc, int fr, int fq) const {
        const int row0 = u.pm * 256 + wr * 64 + fr, col = u.pn * 256 + 32 * wc + 8 * fq;
#pragma unroll
        for (int ai = 0; ai < 2; ++ai)
#pragma unroll
            for (int m = 0; m < 4; ++m) {
                const int row = row0 + ai * 128 + m * 16; float ss = 0.f;
#pragma unroll
                for (int bj = 0; bj < 2; ++bj) {
                    const size_t o = (size_t)row * DM + col + 128 * bj;
                    const f32x4 h0 = __builtin_nontemporal_load((const f32x4*)(x + o)) + acc[ai][bj][m][0], h1 = __builtin_nontemporal_load((const f32x4*)(x + o + 4)) + acc[ai][bj][m][1];
                    *(f32x4*)(out + o) = h0; *(f32x4*)(out + o + 4) = h1;
                    ss += h0.x * h0.x + h0.y * h0.y + h0.z * h0.z + h0.w * h0.w + h1.x * h1.x + h1.y * h1.y + h1.z * h1.z + h1.w * h1.w;
                }
                ss += __shfl_xor(ss, 16); ss += __shfl_xor(ss, 32);
                if (fq == 0) rowss[(size_t)row * 16 + u.pn * 4 + wc] = ss;
            }
    }
};

struct Args { const float* in[15]; float* out; unsigned char* ws; int lo, hi; };
struct Ctx {
    const float *x, *mem, *norm_mem_w, *norm_in_w, *w_in, *attn_sink, *conv_w, *conv_b, *dt_bias, *a_log, *d_skip, *ssd_norm_w, *w_mem_kv, *w_out, *norm_out_w;
    float* out; unsigned char* ws;
    __device__ __forceinline__ float* rowss() const { return (float*)(ws + WS_ROWSS); }
    __device__ __forceinline__ float* rope() const { return (float*)(ws + WS_ROPE); }
    __device__ __forceinline__ bf16_t* win_t() const { return (bf16_t*)(ws + WS_WIN); }
    __device__ __forceinline__ bf16_t* wout_t() const { return (bf16_t*)(ws + WS_WOUT); }
    __device__ __forceinline__ bf16_t* wmem_t() const { return (bf16_t*)(ws + WS_WMEM); }
    __device__ __forceinline__ bf16_t* memn() const { return (bf16_t*)(ws + WS_MEMN); }
    __device__ __forceinline__ bf16_t* mkv() const { return (bf16_t*)(ws + WS_MKV); }
    __device__ __forceinline__ float* dt() const { return (float*)(ws + WS_DT); }
    __device__ __forceinline__ float* dec() const { return (float*)(ws + WS_DEC); }
    __device__ __forceinline__ bf16_t* proj() const { return (bf16_t*)(ws + WS_PROJ); }
    __device__ __forceinline__ bf16_t* mix() const { return (bf16_t*)(ws + WS_MIX); }
    __device__ __forceinline__ bf16_t* hn() const { return (bf16_t*)((unsigned char*)out); }
    __device__ __forceinline__ bf16_t* st() const { return (bf16_t*)((unsigned char*)out); }
    __device__ __forceinline__ bf16_t* yp() const { return (bf16_t*)((unsigned char*)out + 128 * MiB); }
    __device__ __forceinline__ bf16_t* cfb() const { return (bf16_t*)((unsigned char*)out + 192 * MiB); }
    __device__ __forceinline__ float* efb() const { return (float*)((unsigned char*)out + 224 * MiB); }
    ldsp lds; int tid, lane, wave, G, bid;
};

__device__ __forceinline__ void rms_row_bf16(const float* xr, const float* w, bf16_t* o, int lane) {
    f32x4 v[4]; float ss = 0.f;
#pragma unroll
    for (int j = 0; j < 4; ++j) { v[j] = __builtin_nontemporal_load((const f32x4*)(xr + 4 * lane + 256 * j)); ss += v[j].x * v[j].x + v[j].y * v[j].y + v[j].z * v[j].z + v[j].w * v[j].w; }
#pragma unroll
    for (int off = 1; off < 64; off <<= 1) ss += __shfl_xor(ss, off);
    const float r = rsqrtf(ss * (1.f / DM) + EPS);
#pragma unroll
    for (int j = 0; j < 4; ++j) { const f32x4 ww = *(const f32x4*)(w + 4 * lane + 256 * j); *(u32x2*)(o + 4 * lane + 256 * j) = pack4(v[j] * r * ww); }
}
template <int MODE>
__device__ __forceinline__ void transpose_w(const Ctx& F, const float* W, int K, int NS, bf16_t* Bt, int NP, int ldb) {
    const int nitems = NP * (K / 8);
    for (int it = F.bid * 512 + F.tid; it < nitems; it += F.G * 512) {
        const int n = it % NP, kg = it / NP, tile = n >> 8, cph = n & 255; int src;
        if (MODE == 0) {
            if (tile < 5) src = tile * 256 + perm_rot(cph);
            else if (tile < 20) { src = tile * 256 + perm_plain(cph); if (src >= 4096) src += 16; }
            else { const int l = perm_plain(cph); src = l < 16 ? 4096 + l : -1; }
        } else src = tile * 256 + perm_plain(cph);
        float v[8];
#pragma unroll
        for (int j = 0; j < 8; ++j) v[j] = src >= 0 ? W[(size_t)(kg * 8 + j) * NS + src] : 0.f;
        *(u32x4*)(Bt + (size_t)n * ldb + kg * 8) = (u32x4){cvt_pk(v[0], v[1]), cvt_pk(v[2], v[3]), cvt_pk(v[4], v[5]), cvt_pk(v[6], v[7])};
    }
}
__device__ __forceinline__ void phase0(const Ctx& F) {
    const int gt = F.bid * 512 + F.tid, NT = F.G * 512;
    for (int i = gt; i < SEQ * 32; i += NT) {
        const int pos = i >> 5, f = i & 31;
        const float inv = 1.0f / exp2f((float)f * (13.287712379549449f / 32.f));
        const float ang = (float)pos * inv;
        const double rev = (double)ang * 0.15915494309189535; const double fr = rev - __builtin_rint(rev);
        const float r = (float)(fr * 6.283185307179586);
        F.rope()[i] = __cosf(r); F.rope()[SEQ * 32 + i] = __sinf(r);
    }
    transpose_w<0>(F, F.w_in, DM, INW, F.win_t(), NPHYS, HNP);
    transpose_w<1>(F, F.w_out, MIXW, DM, F.wout_t(), DM, MIXP);
    transpose_w<1>(F, F.w_mem_kv, DM, DM, F.wmem_t(), DM, HNP);
    const int gw = F.bid * 8 + F.wave, NGW = F.G * 8;
    for (int m = gw; m < NBATCH * 256; m += NGW) rms_row_bf16(F.mem + (size_t)m * DM, F.norm_mem_w, F.memn() + (size_t)m * HNP, F.lane);
    for (int m = gw; m < TOK; m += NGW) rms_row_bf16(F.x + (size_t)m * DM, F.norm_in_w, F.hn() + (size_t)m * HNP, F.lane);
}

template <int DH, int NQF>
__device__ __forceinline__ void attn_tile(ldsp Kt, int KS, ldsp Vt, int VS, const bf16x8 (&qf)[NQF][DH / 32], f32x4 (&o)[DH / 16][NQF], float (&m)[NQF], float (&lp)[NQF], int maskmode, int lane, int qoff = 0) {
    const int i16 = lane & 15, q4 = lane >> 4;
    f32x4 st[4][NQF];
#pragma unroll
    for (int kf = 0; kf < 4; ++kf)
#pragma unroll
        for (int q = 0; q < NQF; ++q) st[kf][q] = (f32x4){0.f, 0.f, 0.f, 0.f};
#pragma unroll
    for (int ks = 0; ks < DH / 32; ++ks)
#pragma unroll
        for (int kf = 0; kf < 4; ++kf) {
            const bf16x8 ka = ld8(Kt + (16 * kf + i16) * KS + (32 * ks + 8 * q4) * 2);
#pragma unroll
            for (int q = 0; q < NQF; ++q) st[kf][q] = mfma16(ka, qf[q][ks], st[kf][q]);
            if (DH > 64 && kf == 3) __builtin_amdgcn_sched_barrier(0);
        }
    if (maskmode) {
        int zb; asm volatile("v_mov_b32 %0, 0" : "=v"(zb));
        const int base = (maskmode == 1 ? 4 * q4 - i16 - qoff : i16 + qoff - 4 * q4) + zb;
#pragma unroll
        for (int kf = 0; kf < 4; ++kf)
#pragma unroll
            for (int q = 0; q < NQF; ++q)
#pragma unroll
                for (int r = 0; r < 4; ++r) { const int off = 16 * (kf - q) + r; const bool bad = (maskmode == 1 ? base + off : base - off) < 0; if (bad) st[kf][q][r] = -INFINITY; }
    }
#pragma unroll
    for (int q = 0; q < NQF; ++q) {
        float mx = st[0][q][0];
#pragma unroll
        for (int kf = 0; kf < 4; ++kf)
#pragma unroll
            for (int r = 0; r < 4; ++r) mx = fmaxf(mx, st[kf][q][r]);
        mx = fmaxf(mx, __shfl_xor(mx, 16)); mx = fmaxf(mx, __shfl_xor(mx, 32));
        const float mn = fmaxf(m[q], mx), alpha = ex2(m[q] - mn); m[q] = mn;
        float ps = 0.f;
#pragma unroll
        for (int kf = 0; kf < 4; ++kf)
#pragma unroll
            for (int r = 0; r < 4; ++r) { const float p = ex2(st[kf][q][r] - mn); st[kf][q][r] = p; ps += p; }
        lp[q] = lp[q] * alpha + ps;
#pragma unroll
        for (int d = 0; d < DH / 16; ++d) o[d][q] = o[d][q] * alpha;
    }
#pragma unroll
    for (int kp = 0; kp < 2; ++kp) {
        bf16x8 pk[NQF];
#pragma unroll
        for (int q = 0; q < NQF; ++q) pk[q] = packfrag(st[2 * kp][q], st[2 * kp + 1][q]);
#pragma unroll
        for (int d = 0; d < DH / 16; ++d) {
            ldsp va = Vt + (32 * kp + 4 * q4 + (i16 >> 2)) * VS + (16 * d + 4 * (i16 & 3)) * 2;
            const bf16x8 vf = cat8(vtr(va), vtr(va + 16 * VS));
#pragma unroll
            for (int q = 0; q < NQF; ++q) o[d][q] = mfma16(vf, pk[q], o[d][q]);
            if (DH > 64 && (d & 3) == 3) __builtin_amdgcn_sched_barrier(0);
        }
    }
}

__device__ __forceinline__ void ring_stage_block(const Ctx& F, const bf16_t* kvbase, int keyblock) {
    constexpr int KS = 144, VS = 160; const ldsp Kb = F.lds + (keyblock & 511) * KS, Vb = F.lds + 512 * KS + (keyblock & 511) * VS;
    const bf16_t* src0 = kvbase + (size_t)keyblock * PW;
    for (int wi = F.wave; wi < 18; wi += 8) {
        const int slot = wi * 64 + F.lane, row = slot / 9, ch = slot - row * 9;
        __builtin_amdgcn_global_load_lds((const unsigned*)(src0 + (size_t)row * PW + C_K + 8 * (ch > 7 ? 7 : ch)), (LAS unsigned*)(Kb + wi * 1024), 16, 0, 0);
    }
    for (int wi = F.wave; wi < 20; wi += 8) {
        const int slot = wi * 64 + F.lane, row = slot / 10, ch = slot - row * 10;
        __builtin_amdgcn_global_load_lds((const unsigned*)(src0 + (size_t)row * PW + C_V + 8 * (ch > 7 ? 7 : ch)), (LAS unsigned*)(Vb + wi * 1024), 16, 0, 0);
    }
}
__device__ __forceinline__ void attn_window_seq(const Ctx& F, int sq) {
    constexpr int KS = 144, VS = 160; const ldsp Ki = F.lds, Vi = F.lds + 512 * KS;
    const int sidx = sq >> 2, b = sidx >> 2, kvh = sidx & 3, i0 = 8 * (sq & 3);
    const int w = F.wave, lane = F.lane, i16 = lane & 15, q4 = lane >> 4, hq = 4 * kvh + (w >> 1);
    const bf16_t* kvbase = F.proj() + (size_t)b * SEQ * PW + 64 * kvh;
    __syncthreads();
    for (int t = 0; t < 3; ++t) { const int kb = 128 * (i0 - 1 + t); if (kb >= 0 && kb < SEQ) ring_stage_block(F, kvbase, kb); }
    const float sink = F.attn_sink[hq] * LOG2E;
#pragma unroll 1
    for (int k = 0; k < 8; ++k) {
        const int i = i0 + k, q0 = 128 * i + 64 * (w & 1);
        __syncthreads();
        { const int nkey0 = 128 * i + 256; if (k < 7 && nkey0 < SEQ) ring_stage_block(F, kvbase, nkey0); }
#pragma unroll 1
        for (int half = 0; half < 2; ++half) {
            const int qh = q0 + 32 * half;
            bf16x8 qf[2][2];
#pragma unroll
            for (int q = 0; q < 2; ++q)
#pragma unroll
                for (int ks = 0; ks < 2; ++ks) qf[q][ks] = *(const bf16x8*)(F.proj() + (size_t)(b * SEQ + qh + 16 * q + i16) * PW + C_Q + hq * 64 + 32 * ks + 8 * q4);
            u32x2 graw[2][4];
#pragma unroll
            for (int q = 0; q < 2; ++q)
#pragma unroll
                for (int d = 0; d < 4; ++d) graw[q][d] = *(const u32x2*)(F.proj() + (size_t)(b * SEQ + qh + 16 * q + i16) * PW + C_G + hq * 64 + 16 * d + 4 * q4);
            f32x4 o[4][2]; float m[2], lp[2];
#pragma unroll
            for (int q = 0; q < 2; ++q) { m[q] = sink; lp[q] = q4 == 0 ? 1.f : 0.f;
#pragma unroll
                for (int d = 0; d < 4; ++d) o[d][q] = (f32x4){0.f, 0.f, 0.f, 0.f}; }
#pragma unroll 1
            for (int j = 0; j < 5; ++j) {
                const int kstart = q0 - 128 + 64 * j; if (kstart < 0 || kstart >= SEQ) continue;
                const int ir = kstart & 511;
                attn_tile<64, 2>(Ki + ir * KS, KS, Vi + ir * VS, VS, qf, o, m, lp, j == 0 ? 1 : (j == 4 ? 2 : 0), lane, 32 * half);
            }
#pragma unroll
            for (int q = 0; q < 2; ++q) {
                float l = lp[q]; l += __shfl_xor(l, 16); l += __shfl_xor(l, 32); const float inv = 1.f / l;
                const size_t row = (size_t)(b * SEQ + qh + 16 * q + i16);
#pragma unroll
                for (int d = 0; d < 4; ++d) {
                    const int col = hq * 64 + 16 * d + 4 * q4;
                    const f32x4 g = unpack4(graw[q][d]);
                    *(u32x2*)(F.mix() + row * MIXP + col) = pack4(o[d][q] * inv * g);
                }
            }
        }
    }
}
__device__ __forceinline__ void attn_mem_item(const Ctx& F, int item, bool stage) {
    constexpr int KS = 272, VS = 288; const ldsp Ki = F.lds, Vi = F.lds + 256 * KS;
    const int qb = item & 15, hm = (item >> 4) & 3, b = item >> 6;
    if (stage) {
    __syncthreads();
#pragma unroll
    for (int c = F.tid; c < 4096; c += 512) {
        const int r = c >> 4, ch = c & 15;
        const bf16_t* src = F.mkv() + (size_t)(b * 256 + r) * 1024 + hm * 128 + 8 * ch;
        *(LAS u32x4*)(Ki + r * KS + ch * 16) = *(const u32x4*)(src);
        *(LAS u32x4*)(Vi + r * VS + ch * 16) = *(const u32x4*)(src + 512);
    }
    __syncthreads();
    }
    const int w = F.wave, lane = F.lane, i16 = lane & 15, q4 = lane >> 4, q0 = 256 * qb + 32 * w;
    bf16x8 qf[2][4];
#pragma unroll
    for (int q = 0; q < 2; ++q)
#pragma unroll
        for (int ks = 0; ks < 4; ++ks) qf[q][ks] = *(const bf16x8*)(F.proj() + (size_t)(b * SEQ + q0 + 16 * q + i16) * PW + C_QM + hm * 128 + 32 * ks + 8 * q4);
    u32x2 graw[2][8];
#pragma unroll
    for (int q = 0; q < 2; ++q)
#pragma unroll
        for (int d = 0; d < 8; ++d) graw[q][d] = *(const u32x2*)(F.proj() + (size_t)(b * SEQ + q0 + 16 * q + i16) * PW + C_GM + hm * 128 + 16 * d + 4 * q4);
    f32x4 o[8][2]; float m[2], lp[2];
#pragma unroll
    for (int q = 0; q < 2; ++q) { m[q] = -INFINITY; lp[q] = 0.f;
#pragma unroll
        for (int d = 0; d < 8; ++d) o[d][q] = (f32x4){0.f, 0.f, 0.f, 0.f}; }
#pragma unroll 1
    for (int j = 0; j < 4; ++j) attn_tile<128, 2>(Ki + 64 * j * KS, KS, Vi + 64 * j * VS, VS, qf, o, m, lp, 0, lane);
#pragma unroll
    for (int q = 0; q < 2; ++q) {
        float l = lp[q]; l += __shfl_xor(l, 16); l += __shfl_xor(l, 32); const float inv = 1.f / l;
        const size_t row = (size_t)(b * SEQ + q0 + 16 * q + i16);
#pragma unroll
        for (int d = 0; d < 8; ++d) {
            const int col = hm * 128 + 16 * d + 4 * q4;
            const f32x4 g = unpack4(graw[q][d]);
            *(u32x2*)(F.mix() + row * MIXP + 1536 + col) = pack4(o[d][q] * inv * g);
        }
    }
}

constexpr int XS = 544, BS = 288, PS = 272;
constexpr int L_XI = 0, L_BI = 128 * XS, L_CI = L_BI + 128 * BS, L_F32 = L_CI + 128 * BS;
static_assert(L_F32 + 12288 <= LDS_XB, "lds");
__device__ __forceinline__ void ssd_dtprep(const Ctx& F, int b, int c, int g, bool write_dec) {
    LAS float* DTs = (LAS float*)(F.lds + L_F32); LAS float* ACs = DTs + 1024;
    const int w = F.wave, lane = F.lane, dir = w >> 2, r = w & 3, h = 4 * g + r, j = dir * 8 + h;
    const size_t row0 = (size_t)b * SEQ + c * 128;
    const float d0 = F.dt()[(row0 + 2 * lane) * 16 + j], d1 = F.dt()[(row0 + 2 * lane + 1) * 16 + j];
    const float a = -expf(F.a_log[j]);
    const float x0 = d0 * a, x1 = d1 * a, ps = x0 + x1; float inc = ps;
#pragma unroll
    for (int off = 1; off < 64; off <<= 1) { const float t = __shfl_up(inc, off); if (lane >= off) inc += t; }
    const float total = __shfl(inc, 63);
    float a0, a1;
    if (dir == 0) { a0 = inc - x1; a1 = inc; } else { a0 = total - (inc - ps); a1 = total - (inc - x1); }
    *(LAS f32x2*)(DTs + w * 128 + 2 * lane) = (f32x2){d0, d1};
    *(LAS f32x2*)(ACs + w * 128 + 2 * lane) = (f32x2){a0, a1};
    *(LAS f32x2*)(ACs + 1024 + w * 128 + 2 * lane) = (f32x2){d0 * expf(total - a0), d1 * expf(total - a1)};
    if (write_dec && lane == 0) F.dec()[(b * 32 + c) * 16 + j] = expf(total);
}
template <int NCOLS>
__device__ __forceinline__ void conv_img(const Ctx& F, int b, int c, int xcol, ldsp img, int stride) {
    constexpr int NCQ = NCOLS / 4, NRG = 512 / NCQ, R = 128 / NRG;
    const int cq = F.tid % NCQ, rg = F.tid / NCQ, col = xcol + 4 * cq;
    f32x4 w[5];
#pragma unroll
    for (int j = 0; j < 5; ++j) w[j] = *(const f32x4*)(F.conv_w + j * 1024 + col);
    const f32x4 bias = *(const f32x4*)(F.conv_b + col);
    const int t0 = c * 128 + rg * R - 2;
    const bf16_t* base = F.proj() + (size_t)b * SEQ * PW + C_X + col;
    f32x4 win[R + 4];
#pragma unroll
    for (int k = 0; k < R + 4; ++k) { const int t = t0 + k, tc = t < 0 ? 0 : (t >= SEQ ? SEQ - 1 : t); const u32x2 raw = *(const u32x2*)(base + (size_t)tc * PW); const bool ok = (t == tc);
        win[k] = unpack4((u32x2){ok ? raw.x : 0u, ok ? raw.y : 0u}); }
#pragma unroll
    for (int r = 0; r < R; ++r) {
        f32x4 y = bias;
#pragma unroll
        for (int j = 0; j < 5; ++j) y = y + w[j] * win[r + j];
        *(LAS u32x2*)(img + (rg * R + r) * stride + cq * 8) = pack4(silu4(y));
    }
}
__device__ __forceinline__ void ssd_pass1_item(const Ctx& F, int item) {
    const int g = item & 1, c = (item >> 1) & 31, b = item >> 6;
    const ldsp XI = F.lds + L_XI, BI = F.lds + L_BI, CI = F.lds + L_CI;
    LAS float* DTs = (LAS float*)(F.lds + L_F32); LAS float* ACs = DTs + 1024;
    __syncthreads();
    ssd_dtprep(F, b, c, g, true);
    conv_img<256>(F, b, c, 256 * g, XI, XS);
    conv_img<128>(F, b, c, 512 + 128 * g, BI, BS);
    conv_img<128>(F, b, c, 768 + 128 * g, CI, BS);
    __syncthreads();
    const int lane = F.lane, i16 = lane & 15, q4 = lane >> 4, w = F.wave, tl = 16 * w + i16;
    const size_t row = (size_t)b * SEQ + c * 128 + tl;
    f32x4 cbt[8];
    {
        bf16x8 cf[4];
#pragma unroll
        for (int ks = 0; ks < 4; ++ks) cf[ks] = ld8(CI + tl * BS + (32 * ks + 8 * q4) * 2);
#pragma unroll
        for (int ks = 0; ks < 4; ++ks) *(bf16x8*)(F.cfb() + ((size_t)(item * 8 + w) * 64 + lane) * 32 + 8 * ks) = cf[ks];
#pragma unroll
        for (int sf = 0; sf < 8; ++sf) {
            cbt[sf] = (f32x4){0.f, 0.f, 0.f, 0.f};
#pragma unroll
            for (int ks = 0; ks < 4; ++ks) cbt[sf] = mfma16(ld8(BI + (16 * sf + i16) * BS + (32 * ks + 8 * q4) * 2), cf[ks], cbt[sf]);
        }
    }
#pragma unroll 1
    for (int r = 0; r < 4; ++r) {
        {
            const int dir = w & 1, nq = w >> 1;
            LAS const float* Wr = ACs + 1024 + (dir * 4 + r) * 128;
            f32x4 acc[2][4];
#pragma unroll
            for (int nf = 0; nf < 2; ++nf)
#pragma unroll
                for (int pf = 0; pf < 4; ++pf) acc[nf][pf] = (f32x4){0.f, 0.f, 0.f, 0.f};
#pragma unroll
            for (int ks = 0; ks < 4; ++ks) {
                const int t0 = 32 * ks + 8 * q4, trow = t0 + (i16 >> 2);
                const f32x4 wlo = *(const LAS f32x4*)(Wr + t0), whi = *(const LAS f32x4*)(Wr + t0 + 4);
                bf16x8 af[2], bfr[4];
#pragma unroll
                for (int nf = 0; nf < 2; ++nf) {
                    ldsp p = BI + trow * BS + (32 * nq + 16 * nf + 4 * (i16 & 3)) * 2;
                    const u32x2 lo = __builtin_bit_cast(u32x2, vtr(p)), hi = __builtin_bit_cast(u32x2, vtr(p + 4 * BS));
                    af[nf] = packfrag(unpack4(lo) * wlo, unpack4(hi) * whi);
                }
#pragma unroll
                for (int pf = 0; pf < 4; ++pf) { ldsp p = XI + trow * XS + (64 * r + 16 * pf + 4 * (i16 & 3)) * 2; bfr[pf] = cat8(vtr(p), vtr(p + 4 * XS)); }
#pragma unroll
                for (int nf = 0; nf < 2; ++nf)
#pragma unroll
                    for (int pf = 0; pf < 4; ++pf) acc[nf][pf] = mfma16(af[nf], bfr[pf], acc[nf][pf]);
            }
            bf16_t* S = F.st() + ((((size_t)(b * 32 + c) * 2 + dir) * 8 + (4 * g + r)) << 13);
#pragma unroll
            for (int nf = 0; nf < 2; ++nf)
#pragma unroll
                for (int pf = 0; pf < 4; ++pf) *(u32x2*)(S + (16 * pf + i16) * 128 + 32 * nq + 16 * nf + 4 * q4) = pack4(acc[nf][pf]);
        }
        {
            const float acf = ACs[r * 128 + tl], acb = ACs[(4 + r) * 128 + tl];
            f32x4 yt[4];
#pragma unroll
            for (int pf = 0; pf < 4; ++pf) yt[pf] = (f32x4){0.f, 0.f, 0.f, 0.f};
#pragma unroll
            for (int kp = 0; kp < 4; ++kp) {
                f32x4 gt[2];
#pragma unroll
                for (int u = 0; u < 2; ++u) {
                    const int sf = 2 * kp + u, s0 = 16 * sf + 4 * q4;
                    const f32x4 dtf = *(const LAS f32x4*)(DTs + r * 128 + s0), af = *(const LAS f32x4*)(ACs + r * 128 + s0);
                    const f32x4 dtb = *(const LAS f32x4*)(DTs + (4 + r) * 128 + s0), ab = *(const LAS f32x4*)(ACs + (4 + r) * 128 + s0);
#pragma unroll
                    for (int e = 0; e < 4; ++e) {
                        const int sx = s0 + e;
                        const float mf = sx <= tl ? dtf[e] * __expf(acf - af[e]) : 0.f;
                        const float mb = sx >= tl ? dtb[e] * __expf(acb - ab[e]) : 0.f;
                        gt[u][e] = cbt[sf][e] * (mf + mb);
                    }
                }
                const bf16x8 gk = packfrag(gt[0], gt[1]);
#pragma unroll
                for (int pf = 0; pf < 4; ++pf) {
                    ldsp xa = XI + (32 * kp + 4 * q4 + (i16 >> 2)) * XS + (64 * r + 16 * pf + 4 * (i16 & 3)) * 2;
                    yt[pf] = mfma16(cat8(vtr(xa), vtr(xa + 16 * XS)), gk, yt[pf]);
                }
            }
            const float dsk = F.d_skip[4 * g + r];
#pragma unroll
            for (int pf = 0; pf < 4; ++pf) {
                const int pc = 64 * r + 16 * pf + 4 * q4;
                const f32x4 xv = unpack4(*(const LAS u32x2*)(XI + tl * XS + pc * 2));
                *(u32x2*)(F.yp() + row * 512 + 256 * g + pc) = pack4(yt[pf] + xv * dsk);
            }
            if (q4 == 0) { F.efb()[row * 16 + 4 * g + r] = __expf(acf); F.efb()[row * 16 + 8 + 4 * g + r] = __expf(acb); }
        }
    }
}
__device__ __forceinline__ void ssd_scan(const Ctx& F, int vb, int vg) {
    for (int it = vb * 512 + F.tid; it < NBATCH * 2 * 8 * 1024; it += vg * 512) {
        const int e8 = it & 1023, h = (it >> 10) & 7, dir = (it >> 13) & 1, b = it >> 14;
        float run[8];
#pragma unroll
        for (int k = 0; k < 8; ++k) run[k] = 0.f;
        for (int s0 = 0; s0 < 32; s0 += 4) {
            u32x4 v[4]; float dc[4]; bf16_t* ad[4];
#pragma unroll
            for (int u = 0; u < 4; ++u) { const int s = s0 + u, c = dir ? 31 - s : s; ad[u] = F.st() + (((((size_t)(b * 32 + c) * 2 + dir) * 8 + h) << 13) + e8 * 8); v[u] = __builtin_nontemporal_load((const u32x4*)ad[u]); dc[u] = F.dec()[(b * 32 + c) * 16 + dir * 8 + h]; }
#pragma unroll
            for (int u = 0; u < 4; ++u) {
                __builtin_nontemporal_store((u32x4){cvt_pk(run[0], run[1]), cvt_pk(run[2], run[3]), cvt_pk(run[4], run[5]), cvt_pk(run[6], run[7])}, (u32x4*)ad[u]);
                run[0] = run[0] * dc[u] + bf_lo(v[u].x); run[1] = run[1] * dc[u] + bf_hi(v[u].x); run[2] = run[2] * dc[u] + bf_lo(v[u].y); run[3] = run[3] * dc[u] + bf_hi(v[u].y);
                run[4] = run[4] * dc[u] + bf_lo(v[u].z); run[5] = run[5] * dc[u] + bf_hi(v[u].z); run[6] = run[6] * dc[u] + bf_lo(v[u].w); run[7] = run[7] * dc[u] + bf_hi(v[u].w);
            }
        }
    }
}
__device__ __forceinline__ void ssd_pass2_item(const Ctx& F, int item) {
    const int g = item & 1, c = (item >> 1) & 31, b = item >> 6;
    const ldsp PV = F.lds;
    const int lane = F.lane, i16 = lane & 15, q4 = lane >> 4, w = F.wave, tl = 16 * w + i16;
    const size_t row = (size_t)b * SEQ + c * 128 + tl;
    bf16x8 cf[4];
#pragma unroll
    for (int ks = 0; ks < 4; ++ks) cf[ks] = *(const bf16x8*)(F.cfb() + ((size_t)(item * 8 + w) * 64 + lane) * 32 + 8 * ks);
    const int pdir = F.tid >> 8, pp = (F.tid >> 2) & 63, pqu = F.tid & 3;
    const bf16_t* psrc = F.st() + (((((size_t)(b * 32 + c) * 2 + pdir) * 8 + 4 * g) << 13) + pp * 128 + 32 * pqu);
    u32x4 pvn[4][4];
#pragma unroll
    for (int r = 0; r < 4; ++r)
#pragma unroll
        for (int k = 0; k < 4; ++k) pvn[r][k] = *(const u32x4*)(psrc + ((size_t)r << 13) + 8 * k);
    __syncthreads();
#pragma unroll
    for (int r = 0; r < 4; ++r)
#pragma unroll
        for (int k = 0; k < 4; ++k) *(LAS u32x4*)(PV + (2 * r + pdir) * (64 * PS) + pp * PS + (32 * pqu + 8 * k) * 2) = pvn[r][k];
    __syncthreads();
    f32x4 gy[4][4]; float ss = 0.f;
#pragma unroll
    for (int r = 0; r < 4; ++r) {
        u32x2 zraw[4], yraw[4];
#pragma unroll
        for (int pf = 0; pf < 4; ++pf) { const int pc = 256 * g + 64 * r + 16 * pf + 4 * q4; zraw[pf] = *(const u32x2*)(F.proj() + row * PW + C_Z + pc); yraw[pf] = *(const u32x2*)(F.yp() + row * 512 + pc); }
        const float ef = F.efb()[row * 16 + 4 * g + r], eb = F.efb()[row * 16 + 8 + 4 * g + r];
        const ldsp PVr = PV + 2 * r * (64 * PS);
        f32x4 yf[4], yb[4];
#pragma unroll
        for (int pf = 0; pf < 4; ++pf) { yf[pf] = (f32x4){0.f, 0.f, 0.f, 0.f}; yb[pf] = (f32x4){0.f, 0.f, 0.f, 0.f}; }
#pragma unroll
        for (int ks = 0; ks < 4; ++ks)
#pragma unroll
            for (int pf = 0; pf < 4; ++pf) {
                yf[pf] = mfma16(ld8(PVr + (16 * pf + i16) * PS + (32 * ks + 8 * q4) * 2), cf[ks], yf[pf]);
                yb[pf] = mfma16(ld8(PVr + 64 * PS + (16 * pf + i16) * PS + (32 * ks + 8 * q4) * 2), cf[ks], yb[pf]);
            }
#pragma unroll
        for (int pf = 0; pf < 4; ++pf) {
            const f32x4 y = (unpack4(yraw[pf]) + yf[pf] * ef + yb[pf] * eb) * unpack4(zraw[pf]);
            gy[r][pf] = y; ss += y.x * y.x + y.y * y.y + y.z * y.z + y.w * y.w;
        }
    }
    ss += __shfl_xor(ss, 16); ss += __shfl_xor(ss, 32);
    const float rinv = rsqrtf(ss * (1.f / 256.f) + EPS);
#pragma unroll
    for (int r = 0; r < 4; ++r)
#pragma unroll
        for (int pf = 0; pf < 4; ++pf) {
            const int pc = 256 * g + 64 * r + 16 * pf + 4 * q4;
            const f32x4 nw = *(const f32x4*)(F.ssd_norm_w + pc);
            *(u32x2*)(F.mix() + row * MIXP + 1024 + pc) = pack4(gy[r][pf] * rinv * nw);
        }
}

__device__ __forceinline__ void final_norm(const Ctx& F) {
    const int gw = F.bid * 8 + F.wave, NGW = F.G * 8, lane = F.lane;
    for (int m = gw; m < TOK; m += NGW) {
        const f32x4* rp = (const f32x4*)(F.rowss() + (size_t)m * 16); const f32x4 s4 = (rp[0] + rp[1]) + (rp[2] + rp[3]);
        const float r = rsqrtf(((s4.x + s4.y) + (s4.z + s4.w)) * (1.f / DM) + EPS);
        float* o = F.out + (size_t)m * DM;
#pragma unroll
        for (int j = 0; j < 4; ++j) { const f32x4 v = __builtin_nontemporal_load((const f32x4*)(o + 4 * lane + 256 * j)), ww = *(const f32x4*)(F.norm_out_w + 4 * lane + 256 * j); __builtin_nontemporal_store(v * r * ww, (f32x4*)(o + 4 * lane + 256 * j)); }
    }
}

#define XB_TMO      128
#define XB_XCNT(j)  (256  + 64 * (j))
#define XB_XSUB(j)  (1280 + 64 * (j))
#define XB_XGEN(j)  (2304 + 64 * (j))
#define XB_TOP      3328
#define XB_TOPGEN   3392
#define XCD_BAR_WORDS 3456
#define XB_SPIN_CAP (1u << 18)

__device__ __forceinline__ unsigned xb_ld(unsigned* p)              { return __hip_atomic_load(p, __ATOMIC_RELAXED, __HIP_MEMORY_SCOPE_AGENT); }
__device__ __forceinline__ unsigned xb_add(unsigned* p, unsigned v) { return __hip_atomic_fetch_add(p, v, __ATOMIC_RELAXED, __HIP_MEMORY_SCOPE_AGENT); }
__device__ __forceinline__ unsigned xb_xcc_id() { return (unsigned)__builtin_amdgcn_s_getreg((3 << 11) | 20) & 0xFu; }
#define XB_SPIN(cond, bar) do { unsigned _sp = 0; while (cond) { __builtin_amdgcn_s_sleep(1); \
    if ((++_sp & 255u) == 0u) { if (xb_ld(&(bar)[XB_TMO])) break; if (_sp > XB_SPIN_CAP) { atomicAdd(&(bar)[XB_TMO], 1u); break; } } } } while (0)

struct XcdBarrier {
    unsigned* bar; unsigned x;
    volatile LAS unsigned* st;
};

__device__ __forceinline__ XcdBarrier xcd_barrier_post(unsigned* bar, volatile LAS unsigned* st, int xb_tid) {
    XcdBarrier b; b.bar = bar; b.x = xb_xcc_id(); b.st = st;
    if (xb_tid == 0) (void)xb_add(&bar[XB_XCNT(b.x)], 1u);
    return b;
}
__device__ __forceinline__ void xcd_barrier_complete(unsigned* bar, unsigned x, unsigned& nloc, unsigned& nx) {
    const unsigned G = gridDim.x * gridDim.y * gridDim.z;
    unsigned sum, cnt, mine, sp = 0u;
    for (;;) {
        sum = 0u; cnt = 0u; mine = 0u;
#pragma unroll
        for (unsigned j = 0; j < 16; ++j) { const unsigned c = xb_ld(&bar[XB_XCNT(j)]); sum += c; cnt += (c > 0u) ? 1u : 0u; mine = (j == x) ? c : mine; }
        if (sum == G) break;
        __builtin_amdgcn_s_sleep(1);
        if ((++sp & 255u) == 0u) { if (xb_ld(&bar[XB_TMO])) break; if (sp > XB_SPIN_CAP) { atomicAdd(&bar[XB_TMO], 1u); break; } }
    }
    nloc = mine > 0u ? mine : 1u; nx = cnt > 0u ? cnt : 1u;
}

__device__ __forceinline__ void xcd_barrier(const XcdBarrier& b, int xb_tid) {
    asm volatile("s_waitcnt vmcnt(0)" ::: "memory");
    __syncthreads();
    if (xb_tid == 0) {
        unsigned* bar = b.bar;
        __builtin_amdgcn_s_waitcnt(0);
        unsigned nloc = b.st[0], nx = b.st[1];
        if (nloc == 0u) { xcd_barrier_complete(bar, b.x, nloc, nx); b.st[0] = nloc; b.st[1] = nx; }
        const unsigned old = xb_add(&bar[XB_XSUB(b.x)], 1u);
        const unsigned gen = old / nloc;
        if (old + 1u == (gen + 1u) * nloc) {
            __builtin_amdgcn_fence(__ATOMIC_RELEASE, "agent");
            asm volatile("s_waitcnt vmcnt(0)" ::: "memory");
            const unsigned og = xb_add(&bar[XB_TOP], 1u);
            const unsigned tg = og / nx;
            if (og + 1u == (tg + 1u) * nx) xb_add(&bar[XB_TOPGEN], 1u);
            else XB_SPIN(xb_ld(&bar[XB_TOPGEN]) == tg, bar);
            __builtin_amdgcn_fence(__ATOMIC_ACQUIRE, "agent");
            xb_add(&bar[XB_XGEN(b.x)], 1u);
            asm volatile("s_waitcnt vmcnt(0)" ::: "memory");
        } else {
            XB_SPIN(xb_ld(&bar[XB_XGEN(b.x)]) == gen, bar);
            __builtin_amdgcn_fence(__ATOMIC_ACQUIRE, "agent");
            asm volatile("s_waitcnt vmcnt(0)" ::: "memory");
        }
    }
    __syncthreads();
}

__global__ void __launch_bounds__(512, 2) hymba_fwd(Args args) {
    extern __shared__ __attribute__((aligned(16))) unsigned char lds_raw[];
    Ctx F;
    F.x = args.in[0]; F.mem = args.in[1]; F.norm_mem_w = args.in[2]; F.norm_in_w = args.in[3]; F.w_in = args.in[4]; F.attn_sink = args.in[5]; F.conv_w = args.in[6]; F.conv_b = args.in[7];
    F.dt_bias = args.in[8]; F.a_log = args.in[9]; F.d_skip = args.in[10]; F.ssd_norm_w = args.in[11]; F.w_mem_kv = args.in[12]; F.w_out = args.in[13]; F.norm_out_w = args.in[14];
    F.out = args.out; F.ws = args.ws;
    F.lds = (ldsp)lds_raw; F.tid = threadIdx.x; F.lane = F.tid & 63; F.wave = __builtin_amdgcn_readfirstlane(F.tid >> 6); F.G = gridDim.x; F.bid = blockIdx.x;
    const int lo = args.lo, hi = args.hi;
    cg::grid_group grid = cg::this_grid();
#define IN(k) (lo <= (k) && (k) < hi)
#define REFRESH() do { F.lane = lane_id_now(); F.tid = F.wave * 64 + F.lane; } while (0)
    if (F.tid == 0) { *(LAS u32x4*)(F.lds + LDS_XB) = (u32x4){0u, 0u, 0u, 0u}; }
    __syncthreads();
    XcdBarrier xbar; xbar.bar = (unsigned*)args.ws; xbar.x = 0; xbar.st = (volatile LAS unsigned*)(F.lds + LDS_XB);
    if (hi - lo > 1) xbar = xcd_barrier_post((unsigned*)args.ws, (volatile LAS unsigned*)(F.lds + LDS_XB), F.tid);
    if (lo < 0) grid.sync();
#define SEAM(k) do { if (IN(k) && IN((k) + 1)) xcd_barrier(xbar, F.tid); } while (0)
    if (IN(0)) { REFRESH(); phase0(F); }
    SEAM(0);
    if (IN(1)) {
        REFRESH();
        { pg8::Gemm g{F.hn(), F.win_t(), TOK, NPHYS, DM, HNP, HNP}; pg8::StaticOrder S; S.init(g.M, g.N, F.G, F.bid); EpiProj E{F.proj(), F.dt(), F.rope(), F.dt_bias}; pg8::gemm_phase(F.lds, g, S, E, F.wave); }
    }
    SEAM(1);
    if (IN(2)) {
        REFRESH();
        if (F.bid & 1) for (int sq = F.bid; sq < NBATCH * 4 * 4; sq += F.G) attn_window_seq(F, sq);
        for (int it = F.bid; it < NBATCH * 32 * 2; it += F.G) ssd_pass1_item(F, it);
        if (!(F.bid & 1)) for (int sq = F.bid; sq < NBATCH * 4 * 4; sq += F.G) attn_window_seq(F, sq);
    }
    SEAM(2);
    if (IN(3)) {
        REFRESH();
        if (F.G >= 128) {
            if (F.bid < 64) { pg8::Gemm g{F.memn(), F.wmem_t(), NBATCH * 256, 1024, 1024, HNP, HNP}; pg8::StaticOrder S; S.init(g.M, g.N, 64, F.bid); EpiMkv E{F.mkv()}; pg8::gemm_phase(F.lds, g, S, E, F.wave); }
            else ssd_scan(F, F.bid - 64, F.G - 64);
        } else {
            { pg8::Gemm g{F.memn(), F.wmem_t(), NBATCH * 256, 1024, 1024, HNP, HNP}; pg8::StaticOrder S; S.init(g.M, g.N, F.G, F.bid); EpiMkv E{F.mkv()}; pg8::gemm_phase(F.lds, g, S, E, F.wave); }
            ssd_scan(F, F.bid, F.G);
        }
    }
    SEAM(3);
    if (IN(4)) {
        REFRESH();
        if (F.bid & 1) for (int grp = F.bid; grp < NBATCH * 16; grp += F.G) for (int k = 0; k < 4; ++k) attn_mem_item(F, 4 * grp + k, k == 0);
        for (int it = F.bid; it < NBATCH * 32 * 2; it += F.G) ssd_pass2_item(F, it);
        if (!(F.bid & 1)) for (int grp = F.bid; grp < NBATCH * 16; grp += F.G) for (int k = 0; k < 4; ++k) attn_mem_item(F, 4 * grp + k, k == 0);
    }
    SEAM(4);
    if (IN(5)) { REFRESH(); __syncthreads(); pg8::Gemm g{F.mix(), F.wout_t(), TOK, DM, MIXW, MIXP, MIXP}; pg8::StaticOrder S; S.init(g.M, g.N, F.G, F.bid); EpiOut E{F.x, F.out, F.rowss()}; pg8::gemm_phase(F.lds, g, S, E, F.wave); }
    SEAM(5);
    if (IN(6)) { REFRESH(); final_norm(F); }
#undef IN
#undef SEAM
}

extern "C" void kernel_launch(void* const* d_in, const int* in_sizes, int n_in, void* d_out, int out_size, void* d_ws, size_t ws_size, hipStream_t stream) {
    static int grid = 0;
    if (grid == 0) {
        if (n_in != 15 || out_size != TOK * DM || ws_size < WS_END) { fprintf(stderr, "kernel_launch: unexpected shapes (n_in %d out %d ws %zu)\n", n_in, out_size, ws_size); grid = -1; return; }
        int dev = 0, cus = 0, per_cu = 0;
        (void)hipGetDevice(&dev); (void)hipDeviceGetAttribute(&cus, hipDeviceAttributeMultiprocessorCount, dev);
        if (hipFuncSetAttribute((const void*)hymba_fwd, hipFuncAttributeMaxDynamicSharedMemorySize, LDS_BYTES) != hipSuccess) { fprintf(stderr, "kernel_launch: hipFuncSetAttribute failed\n"); grid = -1; return; }
        if (hipOccupancyMaxActiveBlocksPerMultiprocessor(&per_cu, (const void*)hymba_fwd, 512, LDS_BYTES) != hipSuccess || per_cu < 1) { fprintf(stderr, "kernel_launch: occupancy query says %d\n", per_cu); per_cu = 1; }
        (void)hipGetLastError();
        grid = cus > 0 ? cus : 256;
    }
    if (grid < 0) return;
    Args a{};
    for (int i = 0; i < 15; ++i) a.in[i] = (const float*)d_in[i];
    a.out = (float*)d_out; a.ws = (unsigned char*)d_ws;
    (void)hipMemsetAsync(d_ws, 0, 16384, stream);
#if MK_ONE_LAUNCH
    a.lo = 0; a.hi = NPHASE;
    void* kargs[] = {&a};
    hipError_t e = hipLaunchCooperativeKernel((const void*)hymba_fwd, dim3(grid), dim3(512), kargs, LDS_BYTES, stream);
    if (e != hipSuccess) fprintf(stderr, "kernel_launch: cooperative launch failed: %s (grid %d)\n", hipGetErrorString(e), grid);
#else
    for (int k = 0; k < NPHASE; ++k) { a.lo = k; a.hi = k + 1; hipLaunchKernelGGL(hymba_fwd, dim3(grid), dim3(512), LDS_BYTES, stream, a); }
#endif
}
```

```cpp
#include <hip/hip_runtime.h>
#include <hip/hip_cooperative_groups.h>
#include <cstdio>
#include <cstdint>
namespace cg = cooperative_groups;

#ifndef MK_ONE_LAUNCH
#define MK_ONE_LAUNCH 1
#endif

#define LAS __attribute__((address_space(3)))
typedef unsigned short bf16_t;
typedef short bf16x8 __attribute__((ext_vector_type(8)));
typedef short s16x4 __attribute__((ext_vector_type(4)));
typedef float f32x4 __attribute__((ext_vector_type(4)));
typedef float f32x2 __attribute__((ext_vector_type(2)));
typedef unsigned u32x4 __attribute__((ext_vector_type(4)));
typedef unsigned u32x2 __attribute__((ext_vector_type(2)));
typedef LAS unsigned char* ldsp;

constexpr int SEQ = 4096, NBATCH = 16, TOK = SEQ * NBATCH, DM = 1024;
constexpr int INW = 5136, NPHYS = 5376, PW = 5184;
constexpr int HNP = 1088, MIXP = 2112;
constexpr int C_Q = 0, C_K = 1024, C_V = 1280, C_G = 1536, C_Z = 2560, C_X = 3072, C_QM = 4096, C_GM = 4608;
constexpr int MIXW = 2048;
constexpr float LOG2E = 1.4426950408889634f;
constexpr float EPS = 1e-6f;
constexpr int NPHASE = 7;

constexpr size_t MiB = (size_t)1 << 20;
constexpr size_t WS_ROWSS = 956 * MiB, WS_ROPE = 1 * MiB, WS_WIN = 2 * MiB, WS_WOUT = 14 * MiB, WS_WMEM = 19 * MiB, WS_MEMN = 22 * MiB,
                 WS_MKV = 31 * MiB, WS_DT = 39 * MiB, WS_DEC = 43 * MiB, WS_PROJ = 44 * MiB, WS_MIX = 692 * MiB, WS_END = 960 * MiB;

constexpr int LDS_BYTES = 155648 + 16;
constexpr int LDS_XB = 155648;

__device__ __forceinline__ unsigned cvt_pk(float lo, float hi) { unsigned r; asm volatile("v_cvt_pk_bf16_f32 %0, %1, %2" : "=v"(r) : "v"(lo), "v"(hi)); return r; }
typedef __bf16 bf16x2_t __attribute__((ext_vector_type(2)));
__device__ __forceinline__ unsigned cvt_pk_c(float lo, float hi) { const f32x2 v = {lo, hi}; return __builtin_bit_cast(unsigned, __builtin_convertvector(v, bf16x2_t)); }
__device__ __forceinline__ float bf_lo(unsigned u) { return __uint_as_float(u << 16); }
__device__ __forceinline__ float bf_hi(unsigned u) { return __uint_as_float(u & 0xffff0000u); }
__device__ __forceinline__ f32x4 unpack4(u32x2 v) { return (f32x4){bf_lo(v.x), bf_hi(v.x), bf_lo(v.y), bf_hi(v.y)}; }
__device__ __forceinline__ u32x2 pack4(f32x4 v) { return (u32x2){cvt_pk_c(v.x, v.y), cvt_pk_c(v.z, v.w)}; }
__device__ __forceinline__ float silu_f(float x) { return x * __builtin_amdgcn_rcpf(1.f + __expf(-x)); }
__device__ __forceinline__ f32x4 silu4(f32x4 v) { return (f32x4){silu_f(v.x), silu_f(v.y), silu_f(v.z), silu_f(v.w)}; }
__device__ __forceinline__ float softplus_f(float x) { return x > 15.f ? x : __logf(1.f + __expf(x)); }
__device__ __forceinline__ float ex2(float x) { return __builtin_amdgcn_exp2f(x); }
typedef short v4i16_t __attribute__((ext_vector_type(4)));
__device__ __forceinline__ s16x4 vtr(ldsp p) { return __builtin_bit_cast(s16x4, __builtin_amdgcn_ds_read_tr16_b64_v4i16((LAS v4i16_t*)p)); }
__device__ __forceinline__ bf16x8 cat8(s16x4 a, s16x4 b) { return (bf16x8){a[0], a[1], a[2], a[3], b[0], b[1], b[2], b[3]}; }
__device__ __forceinline__ bf16x8 ld8(ldsp p) { return *(const LAS bf16x8*)p; }
__device__ __forceinline__ f32x4 mfma16(bf16x8 a, bf16x8 b, f32x4 c) { return __builtin_amdgcn_mfma_f32_16x16x32_bf16(a, b, c, 0, 0, 0); }
__device__ __forceinline__ bf16x8 packfrag(f32x4 a, f32x4 b) { u32x4 r = {cvt_pk_c(a.x, a.y), cvt_pk_c(a.z, a.w), cvt_pk_c(b.x, b.y), cvt_pk_c(b.z, b.w)}; return __builtin_bit_cast(bf16x8, r); }

__device__ __forceinline__ f32x4 zero4() { f32x4 z; asm volatile("v_mov_b32 %0, 0\n\tv_mov_b32 %1, 0\n\tv_mov_b32 %2, 0\n\tv_mov_b32 %3, 0" : "=v"(z.x), "=v"(z.y), "=v"(z.z), "=v"(z.w)); return z; }
__device__ __forceinline__ int lane_id_now() { int l; asm volatile("v_mbcnt_lo_u32_b32 %0, -1, 0\n\tv_mbcnt_hi_u32_b32 %0, -1, %0" : "=v"(l)); return l; }
__host__ __device__ __forceinline__ int perm_plain(int c) { const int bj = c >> 7, wc = (c >> 5) & 3, n = (c >> 4) & 1, fq = (c >> 2) & 3, i = c & 3; return 128 * bj + 32 * wc + 8 * fq + 4 * n + i; }
__host__ __device__ __forceinline__ int perm_rot(int c) { const int bj = c >> 7, wc = (c >> 5) & 3, n = (c >> 4) & 1, fq = (c >> 2) & 3, i = c & 3; return 64 * wc + 32 * bj + 8 * fq + 4 * n + i; }

namespace pg8 {
constexpr int BM = 256, BK = 64, HALF = 128, HTB = HALF * BK * 2, STAGE_BYTES = 8 * HTB, NXCD = 8, WGM = 8;
__host__ __device__ __forceinline__ int lds_byte(int r, int c) { const int st = (r >> 4) * 2 + (c >> 5), rr = r & 15, cc = c & 31, ob = rr * 64 + cc * 2; return st * 1024 + (ob ^ (((ob >> 9) & 1) << 5)); }
__host__ __device__ __forceinline__ void stage_rc(int b, int& R, int& C) { const int st = b / 1024, sb = b % 1024, swz = sb ^ (((sb >> 9) & 1) << 5); R = (st >> 1) * 16 + swz / 64; C = (st & 1) * 32 + (swz % 64) / 2; }
struct Unit { int pm, pn; };
struct Gemm { const bf16_t* A; const bf16_t* Bt; int M, N, K, lda, ldb; };
struct StaticOrder {
    int nM, nN, nwg, G, c;
    __device__ void init(int M, int N, int G_, int c_) { nM = M / BM; nN = N / BM; nwg = nM * nN; G = G_; c = c_; }
    __device__ bool next(int i, Unit& u) const {
        const long L = (long)i * G + c; if (L >= nwg) return false;
        int wgid = (int)L; { const int q = nwg / NXCD, r = nwg % NXCD, xcd = wgid % NXCD, off = wgid / NXCD; wgid = (xcd < r ? xcd * (q + 1) : r * (q + 1) + (xcd - r) * q) + off; }
        const int nig = WGM * nN, gid = wgid / nig, fm = gid * WGM, gsz = (nM - fm) < WGM ? (nM - fm) : WGM;
        u.pm = fm + ((wgid % nig) % gsz); u.pn = (wgid % nig) / gsz; return true;
    }
};
template <class Epi, class Sched>
__device__ __forceinline__ void gemm_phase(ldsp lds, const Gemm g, const Sched& S, const Epi& E, int wave_id) {
    const int lane = lane_id_now(), wid = wave_id, tid = wid * 64 + lane, wr = wid >> 2, wc = wid & 3, fr = lane & 15, fq = lane >> 4;
    const int K = g.K, nt = K / BK;
    unsigned voffA[2], voffB[2];
#pragma unroll
    for (int i = 0; i < 2; ++i) { int R, C; stage_rc(tid * 16 + i * 8192, R, C); voffA[i] = (unsigned)(R * g.lda + C) * 2u; voffB[i] = (unsigned)(R * g.ldb + C) * 2u; }
    const size_t kstep = (size_t)(BK * 2);
    const size_t hstep = (size_t)HALF * g.lda * 2, hstepB = (size_t)HALF * g.ldb * 2;
    const size_t tstep = 2 * hstep, tstepB = 2 * hstepB;
    const unsigned ldsw = (unsigned)wid * 1024u;
    const int aoff = lds_byte(wr * 64 + fr, fq * 8), boff = lds_byte(wc * 32 + fr, fq * 8);
#define PG8_SA(b, h) (((b) * 2 + (h)) * HTB)
#define PG8_SB(b, h) ((4 + (b) * 2 + (h)) * HTB)
#define PG8_STAGE(bufoff, gbase, voff) do { _Pragma("unroll") for (int _i = 0; _i < 2; ++_i) \
        __builtin_amdgcn_global_load_lds((const unsigned*)((const char*)(gbase) + (voff)[_i]), (LAS unsigned*)(lds + (bufoff) + ldsw + _i * 8192), 16, 0, 0); } while (0)
#define PG8_LDA(dst, b, h) do { _Pragma("unroll") for (int m = 0; m < 4; ++m) _Pragma("unroll") for (int k = 0; k < 2; ++k) dst[m][k] = *(const LAS bf16x8*)(lds + PG8_SA(b, h) + aoff + m * 2048 + k * 1024); } while (0)
#define PG8_LDB(dst, b, h) do { _Pragma("unroll") for (int n = 0; n < 2; ++n) _Pragma("unroll") for (int k = 0; k < 2; ++k) dst[n][k] = *(const LAS bf16x8*)(lds + PG8_SB(b, h) + boff + n * 2048 + k * 1024); } while (0)
#define PG8_MMA(ai, bj, At, Bt) do { __builtin_amdgcn_s_setprio(1); _Pragma("unroll") for (int m = 0; m < 4; ++m) _Pragma("unroll") for (int n = 0; n < 2; ++n) _Pragma("unroll") for (int k = 0; k < 2; ++k) \
        acc[ai][bj][m][n] = __builtin_amdgcn_mfma_f32_16x16x32_bf16(Bt[n][k], At[m][k], acc[ai][bj][m][n], 0, 0, 0); __builtin_amdgcn_s_setprio(0); } while (0)
#define PG8_WAIT_V(n) asm volatile("s_waitcnt vmcnt(" #n ")" ::: "memory")
#define PG8_WAIT_L(n) asm volatile("s_waitcnt lgkmcnt(" #n ")" ::: "memory")
#define PG8_BAR __builtin_amdgcn_s_barrier()
#define PG8_SCHED __builtin_amdgcn_sched_barrier(0)
    Unit cur, nxt; int ui = 0;
    if (!S.next(0, cur)) return;
    f32x4 acc[2][2][4][2];
#pragma unroll
    for (int a = 0; a < 2; ++a)
#pragma unroll
        for (int b = 0; b < 2; ++b)
#pragma unroll
            for (int m = 0; m < 4; ++m)
#pragma unroll
                for (int n = 0; n < 2; ++n) acc[a][b][m][n] = (f32x4){0.f, 0.f, 0.f, 0.f};
    bf16x8 At[4][2], B0[2][2], B1[2][2];
    const char* cA = (const char*)g.A + (size_t)cur.pm * tstep; const char* cB = (const char*)g.Bt + (size_t)cur.pn * tstepB;
    PG8_STAGE(PG8_SB(0, 0), cB, voffB); PG8_STAGE(PG8_SA(0, 0), cA, voffA); PG8_STAGE(PG8_SB(0, 1), cB + hstepB, voffB); PG8_STAGE(PG8_SA(0, 1), cA + hstep, voffA);
    if (wr == 1) PG8_BAR;
    PG8_WAIT_V(4); PG8_BAR;
    PG8_STAGE(PG8_SB(1, 0), cB + kstep, voffB); PG8_STAGE(PG8_SA(1, 0), cA + kstep, voffA); PG8_STAGE(PG8_SB(1, 1), cB + hstepB + kstep, voffB);
    PG8_WAIT_V(6); PG8_BAR;
    for (;;) {
        const bool has_next = S.next(ui + 1, nxt);
        const char* nA = has_next ? (const char*)g.A + (size_t)nxt.pm * tstep : cA; const char* nB = has_next ? (const char*)g.Bt + (size_t)nxt.pn * tstepB : cB;
        for (int t = 0; t < nt; t += 2) {
            const bool last = (t == nt - 2);
            const char* a1 = cA + (size_t)(t + 1) * kstep;
            const char* a2 = last ? nA : cA + (size_t)(t + 2) * kstep; const char* b2 = last ? nB : cB + (size_t)(t + 2) * kstep;
            const char* a3 = a2 + kstep; const char* b3 = b2 + kstep;
            PG8_LDB(B0, 0, 0); PG8_SCHED; PG8_LDA(At, 0, 0); PG8_STAGE(PG8_SA(1, 1), a1 + hstep, voffA);
            PG8_WAIT_L(8); PG8_BAR; PG8_WAIT_L(0); PG8_MMA(0, 0, At, B0); PG8_BAR; PG8_SCHED;
            PG8_LDB(B1, 0, 1); PG8_STAGE(PG8_SB(0, 0), b2, voffB);
            PG8_BAR; PG8_WAIT_L(0); PG8_MMA(0, 1, At, B1); PG8_BAR;
            PG8_LDA(At, 0, 1); PG8_STAGE(PG8_SA(0, 0), a2, voffA);
            PG8_BAR; PG8_WAIT_L(0); PG8_MMA(1, 0, At, B0); PG8_BAR; PG8_SCHED;
            PG8_STAGE(PG8_SB(0, 1), b2 + hstepB, voffB);
            PG8_WAIT_V(6); PG8_BAR; PG8_MMA(1, 1, At, B1); PG8_BAR;
            PG8_LDB(B0, 1, 0); PG8_SCHED; PG8_LDA(At, 1, 0); PG8_STAGE(PG8_SA(0, 1), a2 + hstep, voffA);
            PG8_WAIT_L(8); PG8_BAR; PG8_WAIT_L(0); PG8_MMA(0, 0, At, B0); PG8_BAR; PG8_SCHED;
            PG8_LDB(B1, 1, 1); PG8_STAGE(PG8_SB(1, 0), b3, voffB);
            PG8_BAR; PG8_WAIT_L(0); PG8_MMA(0, 1, At, B1); PG8_BAR;
            PG8_LDA(At, 1, 1); PG8_STAGE(PG8_SA(1, 0), a3, voffA);
            PG8_BAR; PG8_WAIT_L(0); PG8_MMA(1, 0, At, B0); PG8_BAR; PG8_SCHED;
            PG8_STAGE(PG8_SB(1, 1), b3 + hstepB, voffB);
            PG8_WAIT_V(6); PG8_BAR; PG8_MMA(1, 1, At, B1); PG8_BAR;
        }
        E(acc, cur, wr, wc, fr, fq);
        if (!has_next) break;
#pragma unroll
        for (int a = 0; a < 2; ++a)
#pragma unroll
            for (int b = 0; b < 2; ++b)
#pragma unroll
                for (int m = 0; m < 4; ++m)
#pragma unroll
                    for (int n = 0; n < 2; ++n) acc[a][b][m][n] = (f32x4){0.f, 0.f, 0.f, 0.f};
        cur = nxt; cA = nA; cB = nB; ++ui;
    }
    PG8_WAIT_V(0);
    if (wr == 0) PG8_BAR;
    PG8_BAR;
#undef PG8_SA
#undef PG8_SB
#undef PG8_STAGE
#undef PG8_LDA
#undef PG8_LDB
#undef PG8_MMA
#undef PG8_WAIT_V
#undef PG8_WAIT_L
#undef PG8_BAR
#undef PG8_SCHED
}
}

struct EpiProj {
    bf16_t* P; float* DT; const float* rope; const float* dt_bias;
    __device__ __forceinline__ void operator()(const f32x4 (&acc)[2][2][4][2], const pg8::Unit& u, int wr, int wc, int fr, int fq) const {
        const int row0 = u.pm * 256 + wr * 64 + fr, pn = u.pn;
        if (pn < 5) {
            const float sc = pn < 4 ? 0.125f * LOG2E : 1.f;
            const int col = pn * 256 + 64 * wc + 8 * fq;
#pragma unroll
            for (int ai = 0; ai < 2; ++ai)
#pragma unroll
                for (int m = 0; m < 4; ++m) {
                    const int row = row0 + ai * 128 + m * 16, pos = row & (SEQ - 1);
                    const f32x4* cp = (const f32x4*)(rope + pos * 32 + 8 * fq); const f32x4* sp = (const f32x4*)(rope + SEQ * 32 + pos * 32 + 8 * fq);
                    f32x4 o1[2], o2[2];
#pragma unroll
                    for (int n = 0; n < 2; ++n) { const f32x4 c = cp[n], s = sp[n], t1 = acc[ai][0][m][n], t2 = acc[ai][1][m][n]; o1[n] = (t1 * c - t2 * s) * sc; o2[n] = (t1 * s + t2 * c) * sc; }
                    bf16_t* dst = P + (size_t)row * PW + col;
                    __builtin_nontemporal_store((u32x4){cvt_pk(o1[0].x, o1[0].y), cvt_pk(o1[0].z, o1[0].w), cvt_pk(o1[1].x, o1[1].y), cvt_pk(o1[1].z, o1[1].w)}, (u32x4*)dst);
                    __builtin_nontemporal_store((u32x4){cvt_pk(o2[0].x, o2[0].y), cvt_pk(o2[0].z, o2[0].w), cvt_pk(o2[1].x, o2[1].y), cvt_pk(o2[1].z, o2[1].w)}, (u32x4*)(dst + 32));
                }
        } else if (pn < 20) {
            const bool do_silu = (pn >= 6 && pn < 12) || pn >= 18;
            const float sc = (pn == 16 || pn == 17) ? 0.08838834764831845f * LOG2E : 1.f;
            const int col = pn * 256 + 32 * wc + 8 * fq;
#pragma unroll
            for (int ai = 0; ai < 2; ++ai)
#pragma unroll
                for (int m = 0; m < 4; ++m) {
                    const int row = row0 + ai * 128 + m * 16;
#pragma unroll
                    for (int bj = 0; bj < 2; ++bj) {
                        f32x4 v0 = acc[ai][bj][m][0], v1 = acc[ai][bj][m][1];
                        if (do_silu) { v0 = silu4(v0); v1 = silu4(v1); } else { v0 = v0 * sc; v1 = v1 * sc; }
                        __builtin_nontemporal_store((u32x4){cvt_pk(v0.x, v0.y), cvt_pk(v0.z, v0.w), cvt_pk(v1.x, v1.y), cvt_pk(v1.z, v1.w)}, (u32x4*)(P + (size_t)row * PW + col + 128 * bj));
                    }
                }
        } else {
            if (wc == 0 && fq < 2) {
                const f32x4 bb0 = *(const f32x4*)(dt_bias + 8 * fq), bb1 = *(const f32x4*)(dt_bias + 8 * fq + 4);
#pragma unroll
                for (int ai = 0; ai < 2; ++ai)
#pragma unroll
                    for (int m = 0; m < 4; ++m) {
                        const int row = row0 + ai * 128 + m * 16;
#pragma unroll
                        for (int n = 0; n < 2; ++n) {
                            const int j0 = 8 * fq + 4 * n; const f32x4 v = acc[ai][0][m][n] + (n ? bb1 : bb0);
                            *(f32x4*)(DT + (size_t)row * 16 + j0) = (f32x4){softplus_f(v.x), softplus_f(v.y), softplus_f(v.z), softplus_f(v.w)};
                        }
                    }
            }
        }
    }
};
struct EpiMkv {
    bf16_t* O;
    __device__ __forceinline__ void operator()(const f32x4 (&acc)[2][2][4][2], const pg8::Unit& u, int wr, int wc, int fr, int fq) const {
        const int row0 = u.pm * 256 + wr * 64 + fr, col = u.pn * 256 + 32 * wc + 8 * fq;
#pragma unroll
        for (int ai = 0; ai < 2; ++ai)
#pragma unroll
            for (int m = 0; m < 4; ++m) {
                const int row = row0 + ai * 128 + m * 16;
#pragma unroll
                for (int bj = 0; bj < 2; ++bj) { const f32x4 v0 = acc[ai][bj][m][0], v1 = acc[ai][bj][m][1];
                    *(u32x4*)(O + (size_t)row * 1024 + col + 128 * bj) = (u32x4){cvt_pk(v0.x, v0.y), cvt_pk(v0.z, v0.w), cvt_pk(v1.x, v1.y), cvt_pk(v1.z, v1.w)}; }
            }
    }
};
struct EpiOut {
    const float* x; float* out; float* rowss;
    __device__ __forceinline__ void operator()(const f32x4 (&acc)[2][2][4][2], const pg8::Unit& u, int wr, int wc, int fr, int fq) const {
        const int row0 = u.pm * 256 + wr * 64 + fr, col = u.pn * 256 + 32 * wc + 8 * fq;
#pragma unroll
        for (int ai = 0; ai < 2; ++ai) {
            f32x4 xv[4][2][2];
#pragma unroll
            for (int m = 0; m < 4; ++m)
#pragma unroll
                for (int bj = 0; bj < 2; ++bj) {
                    const size_t o = (size_t)(row0 + ai * 128 + m * 16) * DM + col + 128 * bj;
                    xv[m][bj][0] = __builtin_nontemporal_load((const f32x4*)(x + o)); xv[m][bj][1] = __builtin_nontemporal_load((const f32x4*)(x + o + 4));
                }
#pragma unroll
            for (int m = 0; m < 4; ++m) {
                const int row = row0 + ai * 128 + m * 16; float ss = 0.f;
#pragma unroll
                for (int bj = 0; bj < 2; ++bj) {
                    const size_t o = (size_t)row * DM + col + 128 * bj;
                    const f32x4 h0 = xv[m][bj][0] + acc[ai][bj][m][0], h1 = xv[m][bj][1] + acc[ai][bj][m][1];
                    *(f32x4*)(out + o) = h0; *(f32x4*)(out + o + 4) = h1;
                    ss += h0.x * h0.x + h0.y * h0.y + h0.z * h0.z + h0.w * h0.w + h1.x * h1.x + h1.y * h1.y + h1.z * h1.z + h1.w * h1.w;
                }
                ss += __shfl_xor(ss, 16); ss += __shfl_xor(ss, 32);
                if (fq == 0) rowss[(size_t)row * 16 + u.pn * 4 + wc] = ss;
            }
        }
    }
};

struct Args { const float* in[15]; float* out; unsigned char* ws; int lo, hi; };
struct Ctx {
    const float *x, *mem, *norm_mem_w, *norm_in_w, *w_in, *attn_sink, *conv_w, *conv_b, *dt_bias, *a_log, *d_skip, *ssd_norm_w, *w_mem_kv, *w_out, *norm_out_w;
    float* out; unsigned char* ws;
    __device__ __forceinline__ float* rowss() const { return (float*)(ws + WS_ROWSS); }
    __device__ __forceinline__ float* rope() const { return (float*)(ws + WS_ROPE); }
    __device__ __forceinline__ bf16_t* win_t() const { return (bf16_t*)(ws + WS_WIN); }
    __device__ __forceinline__ bf16_t* wout_t() const { return (bf16_t*)(ws + WS_WOUT); }
    __device__ __forceinline__ bf16_t* wmem_t() const { return (bf16_t*)(ws + WS_WMEM); }
    __device__ __forceinline__ bf16_t* memn() const { return (bf16_t*)(ws + WS_MEMN); }
    __device__ __forceinline__ bf16_t* mkv() const { return (bf16_t*)(ws + WS_MKV); }
    __device__ __forceinline__ float* dt() const { return (float*)(ws + WS_DT); }
    __device__ __forceinline__ float* dec() const { return (float*)(ws + WS_DEC); }
    __device__ __forceinline__ bf16_t* proj() const { return (bf16_t*)(ws + WS_PROJ); }
    __device__ __forceinline__ bf16_t* mix() const { return (bf16_t*)(ws + WS_MIX); }
    __device__ __forceinline__ bf16_t* hn() const { return (bf16_t*)((unsigned char*)out); }
    __device__ __forceinline__ bf16_t* st() const { return (bf16_t*)((unsigned char*)out); }
    __device__ __forceinline__ bf16_t* yp() const { return (bf16_t*)((unsigned char*)out + 128 * MiB); }
    __device__ __forceinline__ bf16_t* cfb() const { return (bf16_t*)((unsigned char*)out + 192 * MiB); }
    __device__ __forceinline__ float* efb() const { return (float*)((unsigned char*)out + 224 * MiB); }
    ldsp lds; int tid, lane, wave, G, bid;
};

__device__ __forceinline__ void rms_row_bf16(const float* xr, const float* w, bf16_t* o, int lane) {
    f32x4 v[4]; float ss = 0.f;
#pragma unroll
    for (int j = 0; j < 4; ++j) { v[j] = __builtin_nontemporal_load((const f32x4*)(xr + 4 * lane + 256 * j)); ss += v[j].x * v[j].x + v[j].y * v[j].y + v[j].z * v[j].z + v[j].w * v[j].w; }
#pragma unroll
    for (int off = 1; off < 64; off <<= 1) ss += __shfl_xor(ss, off);
    const float r = rsqrtf(ss * (1.f / DM) + EPS);
#pragma unroll
    for (int j = 0; j < 4; ++j) { const f32x4 ww = *(const f32x4*)(w + 4 * lane + 256 * j); *(u32x2*)(o + 4 * lane + 256 * j) = pack4(v[j] * r * ww); }
}
template <int MODE>
__device__ __forceinline__ void transpose_w(const Ctx& F, const float* W, int K, int NS, bf16_t* Bt, int NP, int ldb) {
    const int nitems = NP * (K / 8);
    for (int it = F.bid * 512 + F.tid; it < nitems; it += F.G * 512) {
        const int n = it % NP, kg = it / NP, tile = n >> 8, cph = n & 255; int src;
        if (MODE == 0) {
            if (tile < 5) src = tile * 256 + perm_rot(cph);
            else if (tile < 20) { src = tile * 256 + perm_plain(cph); if (src >= 4096) src += 16; }
            else { const int l = perm_plain(cph); src = l < 16 ? 4096 + l : -1; }
        } else src = tile * 256 + perm_plain(cph);
        float v[8];
#pragma unroll
        for (int j = 0; j < 8; ++j) v[j] = src >= 0 ? W[(size_t)(kg * 8 + j) * NS + src] : 0.f;
        *(u32x4*)(Bt + (size_t)n * ldb + kg * 8) = (u32x4){cvt_pk(v[0], v[1]), cvt_pk(v[2], v[3]), cvt_pk(v[4], v[5]), cvt_pk(v[6], v[7])};
    }
}
__device__ __forceinline__ void phase0(const Ctx& F) {
    const int gt = F.bid * 512 + F.tid, NT = F.G * 512;
    for (int i = gt; i < SEQ * 32; i += NT) {
        const int pos = i >> 5, f = i & 31;
        const float inv = 1.0f / exp2f((float)f * (13.287712379549449f / 32.f));
        const float ang = (float)pos * inv;
        const double rev = (double)ang * 0.15915494309189535; const double fr = rev - __builtin_rint(rev);
        const float r = (float)(fr * 6.283185307179586);
        F.rope()[i] = __cosf(r); F.rope()[SEQ * 32 + i] = __sinf(r);
    }
    transpose_w<0>(F, F.w_in, DM, INW, F.win_t(), NPHYS, HNP);
    transpose_w<1>(F, F.w_out, MIXW, DM, F.wout_t(), DM, MIXP);
    transpose_w<1>(F, F.w_mem_kv, DM, DM, F.wmem_t(), DM, HNP);
    const int gw = F.bid * 8 + F.wave, NGW = F.G * 8;
    for (int m = gw; m < NBATCH * 256; m += NGW) rms_row_bf16(F.mem + (size_t)m * DM, F.norm_mem_w, F.memn() + (size_t)m * HNP, F.lane);
    for (int m = gw; m < TOK; m += NGW) rms_row_bf16(F.x + (size_t)m * DM, F.norm_in_w, F.hn() + (size_t)m * HNP, F.lane);
}

template <int DH, int NQF>
__device__ __forceinline__ void attn_tile(ldsp Kt, int KS, ldsp Vt, int VS, const bf16x8 (&qf)[NQF][DH / 32], f32x4 (&o)[DH / 16][NQF], float (&m)[NQF], float (&lp)[NQF], int maskmode, int lane, int qoff = 0) {
    const int i16 = lane & 15, q4 = lane >> 4;
    f32x4 st[4][NQF];
#pragma unroll
    for (int kf = 0; kf < 4; ++kf)
#pragma unroll
        for (int q = 0; q < NQF; ++q) st[kf][q] = (f32x4){0.f, 0.f, 0.f, 0.f};
#pragma unroll
    for (int ks = 0; ks < DH / 32; ++ks)
#pragma unroll
        for (int kf = 0; kf < 4; ++kf) {
            const bf16x8 ka = ld8(Kt + (16 * kf + i16) * KS + (32 * ks + 8 * q4) * 2);
#pragma unroll
            for (int q = 0; q < NQF; ++q) st[kf][q] = mfma16(ka, qf[q][ks], st[kf][q]);
            if (DH > 64 && kf == 3) __builtin_amdgcn_sched_barrier(0);
        }
    if (maskmode) {
        int zb; asm volatile("v_mov_b32 %0, 0" : "=v"(zb));
        const int base = (maskmode == 1 ? 4 * q4 - i16 - qoff : i16 + qoff - 4 * q4) + zb;
#pragma unroll
        for (int kf = 0; kf < 4; ++kf)
#pragma unroll
            for (int q = 0; q < NQF; ++q)
#pragma unroll
                for (int r = 0; r < 4; ++r) { const int off = 16 * (kf - q) + r; const bool bad = (maskmode == 1 ? base + off : base - off) < 0; if (bad) st[kf][q][r] = -INFINITY; }
    }
#pragma unroll
    for (int q = 0; q < NQF; ++q) {
        float mx = st[0][q][0];
#pragma unroll
        for (int kf = 0; kf < 4; ++kf)
#pragma unroll
            for (int r = 0; r < 4; ++r) mx = fmaxf(mx, st[kf][q][r]);
        mx = fmaxf(mx, __shfl_xor(mx, 16)); mx = fmaxf(mx, __shfl_xor(mx, 32));
        const float mn = fmaxf(m[q], mx), alpha = ex2(m[q] - mn); m[q] = mn;
        float ps = 0.f;
#pragma unroll
        for (int kf = 0; kf < 4; ++kf)
#pragma unroll
            for (int r = 0; r < 4; ++r) { const float p = ex2(st[kf][q][r] - mn); st[kf][q][r] = p; ps += p; }
        lp[q] = lp[q] * alpha + ps;
#pragma unroll
        for (int d = 0; d < DH / 16; ++d) o[d][q] = o[d][q] * alpha;
    }
#pragma unroll
    for (int kp = 0; kp < 2; ++kp) {
        bf16x8 pk[NQF];
#pragma unroll
        for (int q = 0; q < NQF; ++q) pk[q] = packfrag(st[2 * kp][q], st[2 * kp + 1][q]);
#pragma unroll
        for (int d = 0; d < DH / 16; ++d) {
            ldsp va = Vt + (32 * kp + 4 * q4 + (i16 >> 2)) * VS + (16 * d + 4 * (i16 & 3)) * 2;
            const bf16x8 vf = cat8(vtr(va), vtr(va + 16 * VS));
#pragma unroll
            for (int q = 0; q < NQF; ++q) o[d][q] = mfma16(vf, pk[q], o[d][q]);
            if (DH > 64 && (d & 3) == 3) __builtin_amdgcn_sched_barrier(0);
        }
    }
}

__device__ __forceinline__ void ring_stage_block(const Ctx& F, const bf16_t* kvbase, int keyblock) {
    constexpr int KS = 144, VS = 160; const ldsp Kb = F.lds + (keyblock & 511) * KS, Vb = F.lds + 512 * KS + (keyblock & 511) * VS;
    const bf16_t* src0 = kvbase + (size_t)keyblock * PW;
    for (int wi = F.wave; wi < 18; wi += 8) {
        const int slot = wi * 64 + F.lane, row = slot / 9, ch = slot - row * 9;
        __builtin_amdgcn_global_load_lds((const unsigned*)(src0 + (size_t)row * PW + C_K + 8 * (ch > 7 ? 7 : ch)), (LAS unsigned*)(Kb + wi * 1024), 16, 0, 0);
    }
    for (int wi = F.wave; wi < 20; wi += 8) {
        const int slot = wi * 64 + F.lane, row = slot / 10, ch = slot - row * 10;
        __builtin_amdgcn_global_load_lds((const unsigned*)(src0 + (size_t)row * PW + C_V + 8 * (ch > 7 ? 7 : ch)), (LAS unsigned*)(Vb + wi * 1024), 16, 0, 0);
    }
}
__device__ __forceinline__ void attn_window_seq(const Ctx& F, int sq) {
    constexpr int KS = 144, VS = 160; const ldsp Ki = F.lds, Vi = F.lds + 512 * KS;
    const int sidx = sq >> 2, b = sidx >> 2, kvh = sidx & 3, i0 = 8 * (sq & 3);
    const int w = F.wave, lane = F.lane, i16 = lane & 15, q4 = lane >> 4, hq = 4 * kvh + (w >> 1);
    const bf16_t* kvbase = F.proj() + (size_t)b * SEQ * PW + 64 * kvh;
    __syncthreads();
    for (int t = 0; t < 3; ++t) { const int kb = 128 * (i0 - 1 + t); if (kb >= 0 && kb < SEQ) ring_stage_block(F, kvbase, kb); }
    const float sink = F.attn_sink[hq] * LOG2E;
#pragma unroll 1
    for (int k = 0; k < 8; ++k) {
        const int i = i0 + k, q0 = 128 * i + 64 * (w & 1);
        __syncthreads();
        { const int nkey0 = 128 * i + 256; if (k < 7 && nkey0 < SEQ) ring_stage_block(F, kvbase, nkey0); }
#pragma unroll 1
        for (int half = 0; half < 2; ++half) {
            const int qh = q0 + 32 * half;
            bf16x8 qf[2][2];
#pragma unroll
            for (int q = 0; q < 2; ++q)
#pragma unroll
                for (int ks = 0; ks < 2; ++ks) qf[q][ks] = *(const bf16x8*)(F.proj() + (size_t)(b * SEQ + qh + 16 * q + i16) * PW + C_Q + hq * 64 + 32 * ks + 8 * q4);
            u32x2 graw[2][4];
#pragma unroll
            for (int q = 0; q < 2; ++q)
#pragma unroll
                for (int d = 0; d < 4; ++d) graw[q][d] = *(const u32x2*)(F.proj() + (size_t)(b * SEQ + qh + 16 * q + i16) * PW + C_G + hq * 64 + 16 * d + 4 * q4);
            f32x4 o[4][2]; float m[2], lp[2];
#pragma unroll
            for (int q = 0; q < 2; ++q) { m[q] = sink; lp[q] = q4 == 0 ? 1.f : 0.f;
#pragma unroll
                for (int d = 0; d < 4; ++d) o[d][q] = (f32x4){0.f, 0.f, 0.f, 0.f}; }
#pragma unroll 1
            for (int j = 0; j < 5; ++j) {
                const int kstart = q0 - 128 + 64 * j; if (kstart < 0 || kstart >= SEQ) continue;
                const int ir = kstart & 511;
                attn_tile<64, 2>(Ki + ir * KS, KS, Vi + ir * VS, VS, qf, o, m, lp, j == 0 ? 1 : (j == 4 ? 2 : 0), lane, 32 * half);
            }
#pragma unroll
            for (int q = 0; q < 2; ++q) {
                float l = lp[q]; l += __shfl_xor(l, 16); l += __shfl_xor(l, 32); const float inv = 1.f / l;
                const size_t row = (size_t)(b * SEQ + qh + 16 * q + i16);
#pragma unroll
                for (int d = 0; d < 4; ++d) {
                    const int col = hq * 64 + 16 * d + 4 * q4;
                    const f32x4 g = unpack4(graw[q][d]);
                    *(u32x2*)(F.mix() + row * MIXP + col) = pack4(o[d][q] * inv * g);
                }
            }
        }
    }
}
__device__ __forceinline__ void attn_mem_item(const Ctx& F, int item, bool stage) {
    constexpr int KS = 272, VS = 288; const ldsp Ki = F.lds, Vi = F.lds + 256 * KS;
    const int qb = item & 15, hm = (item >> 4) & 3, b = item >> 6;
    if (stage) {
    __syncthreads();
#pragma unroll
    for (int c = F.tid; c < 4096; c += 512) {
        const int r = c >> 4, ch = c & 15;
        const bf16_t* src = F.mkv() + (size_t)(b * 256 + r) * 1024 + hm * 128 + 8 * ch;
        *(LAS u32x4*)(Ki + r * KS + ch * 16) = *(const u32x4*)(src);
        *(LAS u32x4*)(Vi + r * VS + ch * 16) = *(const u32x4*)(src + 512);
    }
    __syncthreads();
    }
    const int w = F.wave, lane = F.lane, i16 = lane & 15, q4 = lane >> 4, q0 = 256 * qb + 32 * w;
    bf16x8 qf[2][4];
#pragma unroll
    for (int q = 0; q < 2; ++q)
#pragma unroll
        for (int ks = 0; ks < 4; ++ks) qf[q][ks] = *(const bf16x8*)(F.proj() + (size_t)(b * SEQ + q0 + 16 * q + i16) * PW + C_QM + hm * 128 + 32 * ks + 8 * q4);
    u32x2 graw[2][8];
#pragma unroll
    for (int q = 0; q < 2; ++q)
#pragma unroll
        for (int d = 0; d < 8; ++d) graw[q][d] = *(const u32x2*)(F.proj() + (size_t)(b * SEQ + q0 + 16 * q + i16) * PW + C_GM + hm * 128 + 16 * d + 4 * q4);
    f32x4 o[8][2]; float m[2], lp[2];
#pragma unroll
    for (int q = 0; q < 2; ++q) { m[q] = -INFINITY; lp[q] = 0.f;
#pragma unroll
        for (int d = 0; d < 8; ++d) o[d][q] = (f32x4){0.f, 0.f, 0.f, 0.f}; }
#pragma unroll 1
    for (int j = 0; j < 4; ++j) attn_tile<128, 2>(Ki + 64 * j * KS, KS, Vi + 64 * j * VS, VS, qf, o, m, lp, 0, lane);
#pragma unroll
    for (int q = 0; q < 2; ++q) {
        float l = lp[q]; l += __shfl_xor(l, 16); l += __shfl_xor(l, 32); const float inv = 1.f / l;
        const size_t row = (size_t)(b * SEQ + q0 + 16 * q + i16);
#pragma unroll
        for (int d = 0; d < 8; ++d) {
            const int col = hm * 128 + 16 * d + 4 * q4;
            const f32x4 g = unpack4(graw[q][d]);
            *(u32x2*)(F.mix() + row * MIXP + 1536 + col) = pack4(o[d][q] * inv * g);
        }
    }
}

constexpr int XS = 544, BS = 288, PS = 272;
constexpr int L_XI = 0, L_BI = 128 * XS, L_CI = L_BI + 128 * BS, L_F32 = L_CI + 128 * BS;
static_assert(L_F32 + 12288 <= LDS_XB, "lds");
__device__ __forceinline__ void ssd_dtprep(const Ctx& F, int b, int c, int g, bool write_dec) {
    LAS float* DTs = (LAS float*)(F.lds + L_F32); LAS float* ACs = DTs + 1024;
    const int w = F.wave, lane = F.lane, dir = w >> 2, r = w & 3, h = 4 * g + r, j = dir * 8 + h;
    const size_t row0 = (size_t)b * SEQ + c * 128;
    const float d0 = F.dt()[(row0 + 2 * lane) * 16 + j], d1 = F.dt()[(row0 + 2 * lane + 1) * 16 + j];
    const float a = -expf(F.a_log[j]);
    const float x0 = d0 * a, x1 = d1 * a, ps = x0 + x1; float inc = ps;
#pragma unroll
    for (int off = 1; off < 64; off <<= 1) { const float t = __shfl_up(inc, off); if (lane >= off) inc += t; }
    const float total = __shfl(inc, 63);
    float a0, a1;
    if (dir == 0) { a0 = inc - x1; a1 = inc; } else { a0 = total - (inc - ps); a1 = total - (inc - x1); }
    *(LAS f32x2*)(DTs + w * 128 + 2 * lane) = (f32x2){d0, d1};
    *(LAS f32x2*)(ACs + w * 128 + 2 * lane) = (f32x2){a0, a1};
    *(LAS f32x2*)(ACs + 1024 + w * 128 + 2 * lane) = (f32x2){d0 * expf(total - a0), d1 * expf(total - a1)};
    if (write_dec && lane == 0) F.dec()[(b * 32 + c) * 16 + j] = expf(total);
}
template <int NCOLS>
__device__ __forceinline__ void conv_img(const Ctx& F, int b, int c, int xcol, ldsp img, int stride) {
    constexpr int NCQ = NCOLS / 4, NRG = 512 / NCQ, R = 128 / NRG;
    const int cq = F.tid % NCQ, rg = F.tid / NCQ, col = xcol + 4 * cq;
    f32x4 w[5];
#pragma unroll
    for (int j = 0; j < 5; ++j) w[j] = *(const f32x4*)(F.conv_w + j * 1024 + col);
    const f32x4 bias = *(const f32x4*)(F.conv_b + col);
    const int t0 = c * 128 + rg * R - 2;
    const bf16_t* base = F.proj() + (size_t)b * SEQ * PW + C_X + col;
    f32x4 win[R + 4];
#pragma unroll
    for (int k = 0; k < R + 4; ++k) { const int t = t0 + k, tc = t < 0 ? 0 : (t >= SEQ ? SEQ - 1 : t); const u32x2 raw = *(const u32x2*)(base + (size_t)tc * PW); const bool ok = (t == tc);
        win[k] = unpack4((u32x2){ok ? raw.x : 0u, ok ? raw.y : 0u}); }
#pragma unroll
    for (int r = 0; r < R; ++r) {
        f32x4 y = bias;
#pragma unroll
        for (int j = 0; j < 5; ++j) y = y + w[j] * win[r + j];
        *(LAS u32x2*)(img + (rg * R + r) * stride + cq * 8) = pack4(silu4(y));
    }
}
__device__ __forceinline__ void ssd_pass1_item(const Ctx& F, int item) {
    const int g = item & 1, c = (item >> 1) & 31, b = item >> 6;
    const ldsp XI = F.lds + L_XI, BI = F.lds + L_BI, CI = F.lds + L_CI;
    LAS float* DTs = (LAS float*)(F.lds + L_F32); LAS float* ACs = DTs + 1024;
    __syncthreads();
    ssd_dtprep(F, b, c, g, true);
    conv_img<256>(F, b, c, 256 * g, XI, XS);
    conv_img<128>(F, b, c, 512 + 128 * g, BI, BS);
    conv_img<128>(F, b, c, 768 + 128 * g, CI, BS);
    __syncthreads();
    const int lane = F.lane, i16 = lane & 15, q4 = lane >> 4, w = F.wave, tl = 16 * w + i16;
    const size_t row = (size_t)b * SEQ + c * 128 + tl;
    f32x4 cbt[8];
    {
        bf16x8 cf[4];
#pragma unroll
        for (int ks = 0; ks < 4; ++ks) cf[ks] = ld8(CI + tl * BS + (32 * ks + 8 * q4) * 2);
#pragma unroll
        for (int ks = 0; ks < 4; ++ks) *(bf16x8*)(F.cfb() + ((size_t)(item * 8 + w) * 64 + lane) * 32 + 8 * ks) = cf[ks];
#pragma unroll
        for (int sf = 0; sf < 8; ++sf) {
            cbt[sf] = (f32x4){0.f, 0.f, 0.f, 0.f};
#pragma unroll
            for (int ks = 0; ks < 4; ++ks) cbt[sf] = mfma16(ld8(BI + (16 * sf + i16) * BS + (32 * ks + 8 * q4) * 2), cf[ks], cbt[sf]);
        }
    }
#pragma unroll 1
    for (int r = 0; r < 4; ++r) {
        {
            const int dir = w & 1, nq = w >> 1;
            LAS const float* Wr = ACs + 1024 + (dir * 4 + r) * 128;
            f32x4 acc[2][4];
#pragma unroll
            for (int nf = 0; nf < 2; ++nf)
#pragma unroll
                for (int pf = 0; pf < 4; ++pf) acc[nf][pf] = (f32x4){0.f, 0.f, 0.f, 0.f};
#pragma unroll
            for (int ks = 0; ks < 4; ++ks) {
                const int t0 = 32 * ks + 8 * q4, trow = t0 + (i16 >> 2);
                const f32x4 wlo = *(const LAS f32x4*)(Wr + t0), whi = *(const LAS f32x4*)(Wr + t0 + 4);
                bf16x8 af[2], bfr[4];
#pragma unroll
                for (int nf = 0; nf < 2; ++nf) {
                    ldsp p = BI + trow * BS + (32 * nq + 16 * nf + 4 * (i16 & 3)) * 2;
                    const u32x2 lo = __builtin_bit_cast(u32x2, vtr(p)), hi = __builtin_bit_cast(u32x2, vtr(p + 4 * BS));
                    af[nf] = packfrag(unpack4(lo) * wlo, unpack4(hi) * whi);
                }
#pragma unroll
                for (int pf = 0; pf < 4; ++pf) { ldsp p = XI + trow * XS + (64 * r + 16 * pf + 4 * (i16 & 3)) * 2; bfr[pf] = cat8(vtr(p), vtr(p + 4 * XS)); }
#pragma unroll
                for (int nf = 0; nf < 2; ++nf)
#pragma unroll
                    for (int pf = 0; pf < 4; ++pf) acc[nf][pf] = mfma16(af[nf], bfr[pf], acc[nf][pf]);
            }
            bf16_t* S = F.st() + ((((size_t)(b * 32 + c) * 2 + dir) * 8 + (4 * g + r)) << 13);
#pragma unroll
            for (int nf = 0; nf < 2; ++nf)
#pragma unroll
                for (int pf = 0; pf < 4; ++pf) *(u32x2*)(S + (16 * pf + i16) * 128 + 32 * nq + 16 * nf + 4 * q4) = pack4(acc[nf][pf]);
        }
        {
            const float acf = ACs[r * 128 + tl], acb = ACs[(4 + r) * 128 + tl];
            f32x4 yt[4];
#pragma unroll
            for (int pf = 0; pf < 4; ++pf) yt[pf] = (f32x4){0.f, 0.f, 0.f, 0.f};
#pragma unroll
            for (int kp = 0; kp < 4; ++kp) {
                f32x4 gt[2];
#pragma unroll
                for (int u = 0; u < 2; ++u) {
                    const int sf = 2 * kp + u, s0 = 16 * sf + 4 * q4;
                    const f32x4 dtf = *(const LAS f32x4*)(DTs + r * 128 + s0), af = *(const LAS f32x4*)(ACs + r * 128 + s0);
                    const f32x4 dtb = *(const LAS f32x4*)(DTs + (4 + r) * 128 + s0), ab = *(const LAS f32x4*)(ACs + (4 + r) * 128 + s0);
#pragma unroll
                    for (int e = 0; e < 4; ++e) {
                        const int sx = s0 + e;
                        const float mf = sx <= tl ? dtf[e] * __expf(acf - af[e]) : 0.f;
                        const float mb = sx >= tl ? dtb[e] * __expf(acb - ab[e]) : 0.f;
                        gt[u][e] = cbt[sf][e] * (mf + mb);
                    }
                }
                const bf16x8 gk = packfrag(gt[0], gt[1]);
#pragma unroll
                for (int pf = 0; pf < 4; ++pf) {
                    ldsp xa = XI + (32 * kp + 4 * q4 + (i16 >> 2)) * XS + (64 * r + 16 * pf + 4 * (i16 & 3)) * 2;
                    yt[pf] = mfma16(cat8(vtr(xa), vtr(xa + 16 * XS)), gk, yt[pf]);
                }
            }
            const float dsk = F.d_skip[4 * g + r];
#pragma unroll
            for (int pf = 0; pf < 4; ++pf) {
                const int pc = 64 * r + 16 * pf + 4 * q4;
                const f32x4 xv = unpack4(*(const LAS u32x2*)(XI + tl * XS + pc * 2));
                *(u32x2*)(F.yp() + row * 512 + 256 * g + pc) = pack4(yt[pf] + xv * dsk);
            }
            if (q4 == 0) { F.efb()[row * 16 + 4 * g + r] = __expf(acf); F.efb()[row * 16 + 8 + 4 * g + r] = __expf(acb); }
        }
    }
}
__device__ __forceinline__ void ssd_scan(const Ctx& F, int vb, int vg) {
    for (int it = vb * 512 + F.tid; it < NBATCH * 2 * 8 * 1024; it += vg * 512) {
        const int e8 = it & 1023, h = (it >> 10) & 7, dir = (it >> 13) & 1, b = it >> 14;
        float run[8];
#pragma unroll
        for (int k = 0; k < 8; ++k) run[k] = 0.f;
        for (int s0 = 0; s0 < 32; s0 += 4) {
            u32x4 v[4]; float dc[4]; bf16_t* ad[4];
#pragma unroll
            for (int u = 0; u < 4; ++u) { const int s = s0 + u, c = dir ? 31 - s : s; ad[u] = F.st() + (((((size_t)(b * 32 + c) * 2 + dir) * 8 + h) << 13) + e8 * 8); v[u] = __builtin_nontemporal_load((const u32x4*)ad[u]); dc[u] = F.dec()[(b * 32 + c) * 16 + dir * 8 + h]; }
#pragma unroll
            for (int u = 0; u < 4; ++u) {
                __builtin_nontemporal_store((u32x4){cvt_pk(run[0], run[1]), cvt_pk(run[2], run[3]), cvt_pk(run[4], run[5]), cvt_pk(run[6], run[7])}, (u32x4*)ad[u]);
                run[0] = run[0] * dc[u] + bf_lo(v[u].x); run[1] = run[1] * dc[u] + bf_hi(v[u].x); run[2] = run[2] * dc[u] + bf_lo(v[u].y); run[3] = run[3] * dc[u] + bf_hi(v[u].y);
                run[4] = run[4] * dc[u] + bf_lo(v[u].z); run[5] = run[5] * dc[u] + bf_hi(v[u].z); run[6] = run[6] * dc[u] + bf_lo(v[u].w); run[7] = run[7] * dc[u] + bf_hi(v[u].w);
            }
        }
    }
}
__device__ __forceinline__ void ssd_pass2_item(const Ctx& F, int item) {
    const int g = item & 1, c = (item >> 1) & 31, b = item >> 6;
    const ldsp PV = F.lds;
    const int lane = F.lane, i16 = lane & 15, q4 = lane >> 4, w = F.wave, tl = 16 * w + i16;
    const size_t row = (size_t)b * SEQ + c * 128 + tl;
    bf16x8 cf[4];
#pragma unroll
    for (int ks = 0; ks < 4; ++ks) cf[ks] = *(const bf16x8*)(F.cfb() + ((size_t)(item * 8 + w) * 64 + lane) * 32 + 8 * ks);
    const int pdir = F.tid >> 8, pp = (F.tid >> 2) & 63, pqu = F.tid & 3;
    const bf16_t* psrc = F.st() + (((((size_t)(b * 32 + c) * 2 + pdir) * 8 + 4 * g) << 13) + pp * 128 + 32 * pqu);
    u32x4 pvn[4][4];
#pragma unroll
    for (int r = 0; r < 4; ++r)
#pragma unroll
        for (int k = 0; k < 4; ++k) pvn[r][k] = *(const u32x4*)(psrc + ((size_t)r << 13) + 8 * k);
    __syncthreads();
#pragma unroll
    for (int r = 0; r < 4; ++r)
#pragma unroll
        for (int k = 0; k < 4; ++k) *(LAS u32x4*)(PV + (2 * r + pdir) * (64 * PS) + pp * PS + (32 * pqu + 8 * k) * 2) = pvn[r][k];
    __syncthreads();
    f32x4 gy[4][4]; float ss = 0.f;
#pragma unroll
    for (int r = 0; r < 4; ++r) {
        u32x2 zraw[4], yraw[4];
#pragma unroll
        for (int pf = 0; pf < 4; ++pf) { const int pc = 256 * g + 64 * r + 16 * pf + 4 * q4; zraw[pf] = *(const u32x2*)(F.proj() + row * PW + C_Z + pc); yraw[pf] = *(const u32x2*)(F.yp() + row * 512 + pc); }
        const float ef = F.efb()[row * 16 + 4 * g + r], eb = F.efb()[row * 16 + 8 + 4 * g + r];
        const ldsp PVr = PV + 2 * r * (64 * PS);
        f32x4 yf[4], yb[4];
#pragma unroll
        for (int pf = 0; pf < 4; ++pf) { yf[pf] = (f32x4){0.f, 0.f, 0.f, 0.f}; yb[pf] = (f32x4){0.f, 0.f, 0.f, 0.f}; }
#pragma unroll
        for (int ks = 0; ks < 4; ++ks)
#pragma unroll
            for (int pf = 0; pf < 4; ++pf) {
                yf[pf] = mfma16(ld8(PVr + (16 * pf + i16) * PS + (32 * ks + 8 * q4) * 2), cf[ks], yf[pf]);
                yb[pf] = mfma16(ld8(PVr + 64 * PS + (16 * pf + i16) * PS + (32 * ks + 8 * q4) * 2), cf[ks], yb[pf]);
            }
#pragma unroll
        for (int pf = 0; pf < 4; ++pf) {
            const f32x4 y = (unpack4(yraw[pf]) + yf[pf] * ef + yb[pf] * eb) * unpack4(zraw[pf]);
            gy[r][pf] = y; ss += y.x * y.x + y.y * y.y + y.z * y.z + y.w * y.w;
        }
    }
    ss += __shfl_xor(ss, 16); ss += __shfl_xor(ss, 32);
    const float rinv = rsqrtf(ss * (1.f / 256.f) + EPS);
#pragma unroll
    for (int r = 0; r < 4; ++r)
#pragma unroll
        for (int pf = 0; pf < 4; ++pf) {
            const int pc = 256 * g + 64 * r + 16 * pf + 4 * q4;
            const f32x4 nw = *(const f32x4*)(F.ssd_norm_w + pc);
            *(u32x2*)(F.mix() + row * MIXP + 1024 + pc) = pack4(gy[r][pf] * rinv * nw);
        }
}

__device__ __forceinline__ void final_norm(const Ctx& F) {
    const int gw = F.bid * 8 + F.wave, NGW = F.G * 8, lane = F.lane;
    for (int m = gw; m < TOK; m += NGW) {
        const f32x4* rp = (const f32x4*)(F.rowss() + (size_t)m * 16); const f32x4 s4 = (rp[0] + rp[1]) + (rp[2] + rp[3]);
        const float r = rsqrtf(((s4.x + s4.y) + (s4.z + s4.w)) * (1.f / DM) + EPS);
        float* o = F.out + (size_t)m * DM;
#pragma unroll
        for (int j = 0; j < 4; ++j) { const f32x4 v = __builtin_nontemporal_load((const f32x4*)(o + 4 * lane + 256 * j)), ww = *(const f32x4*)(F.norm_out_w + 4 * lane + 256 * j); __builtin_nontemporal_store(v * r * ww, (f32x4*)(o + 4 * lane + 256 * j)); }
    }
}

#define XB_TMO      128
#define XB_XCNT(j)  (256  + 64 * (j))
#define XB_XSUB(j)  (1280 + 64 * (j))
#define XB_XGEN(j)  (2304 + 64 * (j))
#define XB_TOP      3328
#define XB_TOPGEN   3392
#define XCD_BAR_WORDS 3456
#define XB_SPIN_CAP (1u << 18)

__device__ __forceinline__ unsigned xb_ld(unsigned* p)              { return __hip_atomic_load(p, __ATOMIC_RELAXED, __HIP_MEMORY_SCOPE_AGENT); }
__device__ __forceinline__ unsigned xb_add(unsigned* p, unsigned v) { return __hip_atomic_fetch_add(p, v, __ATOMIC_RELAXED, __HIP_MEMORY_SCOPE_AGENT); }
__device__ __forceinline__ unsigned xb_xcc_id() { return (unsigned)__builtin_amdgcn_s_getreg((3 << 11) | 20) & 0xFu; }
#define XB_SPIN(cond, bar) do { unsigned _sp = 0; while (cond) { __builtin_amdgcn_s_sleep(1); \
    if ((++_sp & 255u) == 0u) { if (xb_ld(&(bar)[XB_TMO])) break; if (_sp > XB_SPIN_CAP) { atomicAdd(&(bar)[XB_TMO], 1u); break; } } } } while (0)

struct XcdBarrier {
    unsigned* bar; unsigned x;
    volatile LAS unsigned* st;
};

__device__ __forceinline__ XcdBarrier xcd_barrier_post(unsigned* bar, volatile LAS unsigned* st, int xb_tid) {
    XcdBarrier b; b.bar = bar; b.x = xb_xcc_id(); b.st = st;
    if (xb_tid == 0) (void)xb_add(&bar[XB_XCNT(b.x)], 1u);
    return b;
}
__device__ __forceinline__ void xcd_barrier_complete(unsigned* bar, unsigned x, unsigned& nloc, unsigned& nx) {
    const unsigned G = gridDim.x * gridDim.y * gridDim.z;
    unsigned sum, cnt, mine, sp = 0u;
    for (;;) {
        sum = 0u; cnt = 0u; mine = 0u;
#pragma unroll
        for (unsigned j = 0; j < 16; ++j) { const unsigned c = xb_ld(&bar[XB_XCNT(j)]); sum += c; cnt += (c > 0u) ? 1u : 0u; mine = (j == x) ? c : mine; }
        if (sum == G) break;
        __builtin_amdgcn_s_sleep(1);
        if ((++sp & 255u) == 0u) { if (xb_ld(&bar[XB_TMO])) break; if (sp > XB_SPIN_CAP) { atomicAdd(&bar[XB_TMO], 1u); break; } }
    }
    nloc = mine > 0u ? mine : 1u; nx = cnt > 0u ? cnt : 1u;
}

__device__ __forceinline__ void xcd_barrier(const XcdBarrier& b, int xb_tid) {
    asm volatile("s_waitcnt vmcnt(0)" ::: "memory");
    __syncthreads();
    if (xb_tid == 0) {
        unsigned* bar = b.bar;
        __builtin_amdgcn_s_waitcnt(0);
        unsigned nloc = b.st[0], nx = b.st[1];
        if (nloc == 0u) { xcd_barrier_complete(bar, b.x, nloc, nx); b.st[0] = nloc; b.st[1] = nx; }
        const unsigned old = xb_add(&bar[XB_XSUB(b.x)], 1u);
        const unsigned gen = old / nloc;
        if (old + 1u == (gen + 1u) * nloc) {
            __builtin_amdgcn_fence(__ATOMIC_RELEASE, "agent");
            asm volatile("s_waitcnt vmcnt(0)" ::: "memory");
            const unsigned og = xb_add(&bar[XB_TOP], 1u);
            const unsigned tg = og / nx;
            if (og + 1u == (tg + 1u) * nx) xb_add(&bar[XB_TOPGEN], 1u);
            else XB_SPIN(xb_ld(&bar[XB_TOPGEN]) == tg, bar);
            __builtin_amdgcn_fence(__ATOMIC_ACQUIRE, "agent");
            xb_add(&bar[XB_XGEN(b.x)], 1u);
            asm volatile("s_waitcnt vmcnt(0)" ::: "memory");
        } else {
            XB_SPIN(xb_ld(&bar[XB_XGEN(b.x)]) == gen, bar);
            __builtin_amdgcn_fence(__ATOMIC_ACQUIRE, "agent");
            asm volatile("s_waitcnt vmcnt(0)" ::: "memory");
        }
    }
    __syncthreads();
}

__global__ void __launch_bounds__(512, 2) hymba_fwd(Args args) {
    extern __shared__ __attribute__((aligned(16))) unsigned char lds_raw[];
    Ctx F;
    F.x = args.in[0]; F.mem = args.in[1]; F.norm_mem_w = args.in[2]; F.norm_in_w = args.in[3]; F.w_in = args.in[4]; F.attn_sink = args.in[5]; F.conv_w = args.in[6]; F.conv_b = args.in[7];
    F.dt_bias = args.in[8]; F.a_log = args.in[9]; F.d_skip = args.in[10]; F.ssd_norm_w = args.in[11]; F.w_mem_kv = args.in[12]; F.w_out = args.in[13]; F.norm_out_w = args.in[14];
    F.out = args.out; F.ws = args.ws;
    F.lds = (ldsp)lds_raw; F.tid = threadIdx.x; F.lane = F.tid & 63; F.wave = __builtin_amdgcn_readfirstlane(F.tid >> 6); F.G = gridDim.x; F.bid = blockIdx.x;
    const int lo = args.lo, hi = args.hi;
    cg::grid_group grid = cg::this_grid();
#define IN(k) (lo <= (k) && (k) < hi)
#define REFRESH() do { F.lane = lane_id_now(); F.tid = F.wave * 64 + F.lane; } while (0)
    if (F.tid == 0) { *(LAS u32x4*)(F.lds + LDS_XB) = (u32x4){0u, 0u, 0u, 0u}; }
    __syncthreads();
    XcdBarrier xbar; xbar.bar = (unsigned*)args.ws; xbar.x = 0; xbar.st = (volatile LAS unsigned*)(F.lds + LDS_XB);
    if (hi - lo > 1) xbar = xcd_barrier_post((unsigned*)args.ws, (volatile LAS unsigned*)(F.lds + LDS_XB), F.tid);
    if (lo < 0) grid.sync();
#define SEAM(k) do { if (IN(k) && IN((k) + 1)) xcd_barrier(xbar, F.tid); } while (0)
    if (IN(0)) { REFRESH(); phase0(F); }
    SEAM(0);
    if (IN(1)) {
        REFRESH();
        { pg8::Gemm g{F.hn(), F.win_t(), TOK, NPHYS, DM, HNP, HNP}; pg8::StaticOrder S; S.init(g.M, g.N, F.G, F.bid); EpiProj E{F.proj(), F.dt(), F.rope(), F.dt_bias}; pg8::gemm_phase(F.lds, g, S, E, F.wave); }
    }
    SEAM(1);
    if (IN(2)) {
        REFRESH();
        if (F.bid & 1) for (int sq = F.bid; sq < NBATCH * 4 * 4; sq += F.G) attn_window_seq(F, sq);
        for (int it = F.bid; it < NBATCH * 32 * 2; it += F.G) ssd_pass1_item(F, it);
        if (!(F.bid & 1)) for (int sq = F.bid; sq < NBATCH * 4 * 4; sq += F.G) attn_window_seq(F, sq);
    }
    SEAM(2);
    if (IN(3)) {
        REFRESH();
        if (F.G >= 128) {
            if (F.bid < 64) { pg8::Gemm g{F.memn(), F.wmem_t(), NBATCH * 256, 1024, 1024, HNP, HNP}; pg8::StaticOrder S; S.init(g.M, g.N, 64, F.bid); EpiMkv E{F.mkv()}; pg8::gemm_phase(F.lds, g, S, E, F.wave); }
            else ssd_scan(F, F.bid - 64, F.G - 64);
        } else {
            { pg8::Gemm g{F.memn(), F.wmem_t(), NBATCH * 256, 1024, 1024, HNP, HNP}; pg8::StaticOrder S; S.init(g.M, g.N, F.G, F.bid); EpiMkv E{F.mkv()}; pg8::gemm_phase(F.lds, g, S, E, F.wave); }
            ssd_scan(F, F.bid, F.G);
        }
    }
    SEAM(3);
    if (IN(4)) {
        REFRESH();
        if (F.bid & 1) for (int grp = F.bid; grp < NBATCH * 16; grp += F.G) for (int k = 0; k < 4; ++k) attn_mem_item(F, 4 * grp + k, k == 0);
        for (int it = F.bid; it < NBATCH * 32 * 2; it += F.G) ssd_pass2_item(F, it);
        if (!(F.bid & 1)) for (int grp = F.bid; grp < NBATCH * 16; grp += F.G) for (int k = 0; k < 4; ++k) attn_mem_item(F, 4 * grp + k, k == 0);
    }
    SEAM(4);
    if (IN(5)) { REFRESH(); __syncthreads(); pg8::Gemm g{F.mix(), F.wout_t(), TOK, DM, MIXW, MIXP, MIXP}; pg8::StaticOrder S; S.init(g.M, g.N, F.G, F.bid); EpiOut E{F.x, F.out, F.rowss()}; pg8::gemm_phase(F.lds, g, S, E, F.wave); }
    SEAM(5);
    if (IN(6)) { REFRESH(); final_norm(F); }
#undef IN
#undef SEAM
}

extern "C" void kernel_launch(void* const* d_in, const int* in_sizes, int n_in, void* d_out, int out_size, void* d_ws, size_t ws_size, hipStream_t stream) {
    static int grid = 0;
    if (grid == 0) {
        if (n_in != 15 || out_size != TOK * DM || ws_size < WS_END) { fprintf(stderr, "kernel_launch: unexpected shapes (n_in %d out %d ws %zu)\n", n_in, out_size, ws_size); grid = -1; return; }
        int dev = 0, cus = 0, per_cu = 0;
        (void)hipGetDevice(&dev); (void)hipDeviceGetAttribute(&cus, hipDeviceAttributeMultiprocessorCount, dev);
        if (hipFuncSetAttribute((const void*)hymba_fwd, hipFuncAttributeMaxDynamicSharedMemorySize, LDS_BYTES) != hipSuccess) { fprintf(stderr, "kernel_launch: hipFuncSetAttribute failed\n"); grid = -1; return; }
        if (hipOccupancyMaxActiveBlocksPerMultiprocessor(&per_cu, (const void*)hymba_fwd, 512, LDS_BYTES) != hipSuccess || per_cu < 1) { fprintf(stderr, "kernel_launch: occupancy query says %d\n", per_cu); per_cu = 1; }
        (void)hipGetLastError();
        grid = cus > 0 ? cus : 256;
    }
    if (grid < 0) return;
    Args a{};
    for (int i = 0; i < 15; ++i) a.in[i] = (const float*)d_in[i];
    a.out = (float*)d_out; a.ws = (unsigned char*)d_ws;
    (void)hipMemsetAsync(d_ws, 0, 16384, stream);
#if MK_ONE_LAUNCH
    a.lo = 0; a.hi = NPHASE;
    void* kargs[] = {&a};
    hipError_t e = hipLaunchCooperativeKernel((const void*)hymba_fwd, dim3(grid), dim3(512), kargs, LDS_BYTES, stream);
    if (e != hipSuccess) fprintf(stderr, "kernel_launch: cooperative launch failed: %s (grid %d)\n", hipGetErrorString(e), grid);
#else
    for (int k = 0; k < NPHASE; ++k) { a.lo = k; a.hi = k + 1; hipLaunchKernelGGL(hymba_fwd, dim3(grid), dim3(512), LDS_BYTES, stream, a); }
#endif
}
```

```cpp
#include <hip/hip_runtime.h>
#include <hip/hip_cooperative_groups.h>
#include <cstdio>
#include <cstdint>
namespace cg = cooperative_groups;

#ifndef MK_ONE_LAUNCH
#define MK_ONE_LAUNCH 1
#endif

#define LAS __attribute__((address_space(3)))
typedef unsigned short bf16_t;
typedef short bf16x8 __attribute__((ext_vector_type(8)));
typedef short s16x4 __attribute__((ext_vector_type(4)));
typedef float f32x4 __attribute__((ext_vector_type(4)));
typedef float f32x2 __attribute__((ext_vector_type(2)));
typedef unsigned u32x4 __attribute__((ext_vector_type(4)));
typedef unsigned u32x2 __attribute__((ext_vector_type(2)));
typedef LAS unsigned char* ldsp;

constexpr int SEQ = 4096, NBATCH = 16, TOK = SEQ * NBATCH, DM = 1024;
constexpr int INW = 5136, NPHYS = 5376, PW = 5184;
constexpr int HNP = 1088, MIXP = 2112;
constexpr int C_Q = 0, C_K = 1024, C_V = 1280, C_G = 1536, C_Z = 2560, C_X = 3072, C_QM = 4096, C_GM = 4608;
constexpr int MIXW = 2048;
constexpr float LOG2E = 1.4426950408889634f;
constexpr float EPS = 1e-6f;
constexpr int NPHASE = 7;

constexpr size_t MiB = (size_t)1 << 20;
constexpr size_t WS_ROWSS = 956 * MiB, WS_ROPE = 1 * MiB, WS_WIN = 2 * MiB, WS_WOUT = 14 * MiB, WS_WMEM = 19 * MiB, WS_MEMN = 22 * MiB,
                 WS_MKV = 31 * MiB, WS_DT = 39 * MiB, WS_DEC = 43 * MiB, WS_PROJ = 44 * MiB, WS_MIX = 692 * MiB, WS_END = 960 * MiB;

constexpr int LDS_BYTES = 155648 + 16;
constexpr int LDS_XB = 155648;

__device__ __forceinline__ unsigned cvt_pk(float lo, float hi) { unsigned r; asm volatile("v_cvt_pk_bf16_f32 %0, %1, %2" : "=v"(r) : "v"(lo), "v"(hi)); return r; }
typedef __bf16 bf16x2_t __attribute__((ext_vector_type(2)));
__device__ __forceinline__ unsigned cvt_pk_c(float lo, float hi) { const f32x2 v = {lo, hi}; return __builtin_bit_cast(unsigned, __builtin_convertvector(v, bf16x2_t)); }
__device__ __forceinline__ float bf_lo(unsigned u) { return __uint_as_float(u << 16); }
__device__ __forceinline__ float bf_hi(unsigned u) { return __uint_as_float(u & 0xffff0000u); }
__device__ __forceinline__ f32x4 unpack4(u32x2 v) { return (f32x4){bf_lo(v.x), bf_hi(v.x), bf_lo(v.y), bf_hi(v.y)}; }
__device__ __forceinline__ u32x2 pack4(f32x4 v) { return (u32x2){cvt_pk_c(v.x, v.y), cvt_pk_c(v.z, v.w)}; }
__device__ __forceinline__ float silu_f(float x) { return x * __builtin_amdgcn_rcpf(1.f + __expf(-x)); }
__device__ __forceinline__ f32x4 silu4(f32x4 v) { return (f32x4){silu_f(v.x), silu_f(v.y), silu_f(v.z), silu_f(v.w)}; }
__device__ __forceinline__ float softplus_f(float x) { return x > 15.f ? x : __logf(1.f + __expf(x)); }
__device__ __forceinline__ float ex2(float x) { return __builtin_amdgcn_exp2f(x); }
typedef short v4i16_t __attribute__((ext_vector_type(4)));
__device__ __forceinline__ s16x4 vtr(ldsp p) { return __builtin_bit_cast(s16x4, __builtin_amdgcn_ds_read_tr16_b64_v4i16((LAS v4i16_t*)p)); }
__device__ __forceinline__ bf16x8 cat8(s16x4 a, s16x4 b) { return (bf16x8){a[0], a[1], a[2], a[3], b[0], b[1], b[2], b[3]}; }
__device__ __forceinline__ bf16x8 ld8(ldsp p) { return *(const LAS bf16x8*)p; }
__device__ __forceinline__ f32x4 mfma16(bf16x8 a, bf16x8 b, f32x4 c) { return __builtin_amdgcn_mfma_f32_16x16x32_bf16(a, b, c, 0, 0, 0); }
__device__ __forceinline__ bf16x8 packfrag(f32x4 a, f32x4 b) { u32x4 r = {cvt_pk_c(a.x, a.y), cvt_pk_c(a.z, a.w), cvt_pk_c(b.x, b.y), cvt_pk_c(b.z, b.w)}; return __builtin_bit_cast(bf16x8, r); }

__device__ __forceinline__ f32x4 zero4() { f32x4 z; asm volatile("v_mov_b32 %0, 0\n\tv_mov_b32 %1, 0\n\tv_mov_b32 %2, 0\n\tv_mov_b32 %3, 0" : "=v"(z.x), "=v"(z.y), "=v"(z.z), "=v"(z.w)); return z; }
__device__ __forceinline__ int lane_id_now() { int l; asm volatile("v_mbcnt_lo_u32_b32 %0, -1, 0\n\tv_mbcnt_hi_u32_b32 %0, -1, %0" : "=v"(l)); return l; }
__host__ __device__ __forceinline__ int perm_plain(int c) { const int bj = c >> 7, wc = (c >> 5) & 3, n = (c >> 4) & 1, fq = (c >> 2) & 3, i = c & 3; return 128 * bj + 32 * wc + 8 * fq + 4 * n + i; }
__host__ __device__ __forceinline__ int perm_rot(int c) { const int bj = c >> 7, wc = (c >> 5) & 3, n = (c >> 4) & 1, fq = (c >> 2) & 3, i = c & 3; return 64 * wc + 32 * bj + 8 * fq + 4 * n + i; }

namespace pg8 {
constexpr int BM = 256, BK = 64, HALF = 128, HTB = HALF * BK * 2, STAGE_BYTES = 8 * HTB, NXCD = 8, WGM = 8;
__host__ __device__ __forceinline__ int lds_byte(int r, int c) { const int st = (r >> 4) * 2 + (c >> 5), rr = r & 15, cc = c & 31, ob = rr * 64 + cc * 2; return st * 1024 + (ob ^ (((ob >> 9) & 1) << 5)); }
__host__ __device__ __forceinline__ void stage_rc(int b, int& R, int& C) { const int st = b / 1024, sb = b % 1024, swz = sb ^ (((sb >> 9) & 1) << 5); R = (st >> 1) * 16 + swz / 64; C = (st & 1) * 32 + (swz % 64) / 2; }
struct Unit { int pm, pn; };
struct Gemm { const bf16_t* A; const bf16_t* Bt; int M, N, K, lda, ldb; };
struct StaticOrder {
    int nM, nN, nwg, G, c;
    __device__ void init(int M, int N, int G_, int c_) { nM = M / BM; nN = N / BM; nwg = nM * nN; G = G_; c = c_; }
    __device__ bool next(int i, Unit& u) const {
        const long L = (long)i * G + c; if (L >= nwg) return false;
        int wgid = (int)L; { const int q = nwg / NXCD, r = nwg % NXCD, xcd = wgid % NXCD, off = wgid / NXCD; wgid = (xcd < r ? xcd * (q + 1) : r * (q + 1) + (xcd - r) * q) + off; }
        const int nig = WGM * nN, gid = wgid / nig, fm = gid * WGM, gsz = (nM - fm) < WGM ? (nM - fm) : WGM;
        u.pm = fm + ((wgid % nig) % gsz); u.pn = (wgid % nig) / gsz; return true;
    }
};
template <class Epi, class Sched>
__device__ __forceinline__ void gemm_phase(ldsp lds, const Gemm g, const Sched& S, const Epi& E, int wave_id) {
    const int lane = lane_id_now(), wid = wave_id, tid = wid * 64 + lane, wr = wid >> 2, wc = wid & 3, fr = lane & 15, fq = lane >> 4;
    const int K = g.K, nt = K / BK;
    unsigned voffA[2], voffB[2];
#pragma unroll
    for (int i = 0; i < 2; ++i) { int R, C; stage_rc(tid * 16 + i * 8192, R, C); voffA[i] = (unsigned)(R * g.lda + C) * 2u; voffB[i] = (unsigned)(R * g.ldb + C) * 2u; }
    const size_t kstep = (size_t)(BK * 2);
    const size_t hstep = (size_t)HALF * g.lda * 2, hstepB = (size_t)HALF * g.ldb * 2;
    const size_t tstep = 2 * hstep, tstepB = 2 * hstepB;
    const unsigned ldsw = (unsigned)wid * 1024u;
    const int aoff = lds_byte(wr * 64 + fr, fq * 8), boff = lds_byte(wc * 32 + fr, fq * 8);
#define PG8_SA(b, h) (((b) * 2 + (h)) * HTB)
#define PG8_SB(b, h) ((4 + (b) * 2 + (h)) * HTB)
#define PG8_STAGE(bufoff, gbase, voff) do { _Pragma("unroll") for (int _i = 0; _i < 2; ++_i) \
        __builtin_amdgcn_global_load_lds((const unsigned*)((const char*)(gbase) + (voff)[_i]), (LAS unsigned*)(lds + (bufoff) + ldsw + _i * 8192), 16, 0, 0); } while (0)
#define PG8_LDA(dst, b, h) do { _Pragma("unroll") for (int m = 0; m < 4; ++m) _Pragma("unroll") for (int k = 0; k < 2; ++k) dst[m][k] = *(const LAS bf16x8*)(lds + PG8_SA(b, h) + aoff + m * 2048 + k * 1024); } while (0)
#define PG8_LDB(dst, b, h) do { _Pragma("unroll") for (int n = 0; n < 2; ++n) _Pragma("unroll") for (int k = 0; k < 2; ++k) dst[n][k] = *(const LAS bf16x8*)(lds + PG8_SB(b, h) + boff + n * 2048 + k * 1024); } while (0)
#define PG8_MMA(ai, bj, At, Bt) do { __builtin_amdgcn_s_setprio(1); _Pragma("unroll") for (int m = 0; m < 4; ++m) _Pragma("unroll") for (int n = 0; n < 2; ++n) _Pragma("unroll") for (int k = 0; k < 2; ++k) \
        acc[ai][bj][m][n] = __builtin_amdgcn_mfma_f32_16x16x32_bf16(Bt[n][k], At[m][k], acc[ai][bj][m][n], 0, 0, 0); __builtin_amdgcn_s_setprio(0); } while (0)
#define PG8_WAIT_V(n) asm volatile("s_waitcnt vmcnt(" #n ")" ::: "memory")
#define PG8_WAIT_L(n) asm volatile("s_waitcnt lgkmcnt(" #n ")" ::: "memory")
#define PG8_BAR __builtin_amdgcn_s_barrier()
#define PG8_SCHED __builtin_amdgcn_sched_barrier(0)
    Unit cur, nxt; int ui = 0;
    if (!S.next(0, cur)) return;
    f32x4 acc[2][2][4][2];
#pragma unroll
    for (int a = 0; a < 2; ++a)
#pragma unroll
        for (int b = 0; b < 2; ++b)
#pragma unroll
            for (int m = 0; m < 4; ++m)
#pragma unroll
                for (int n = 0; n < 2; ++n) acc[a][b][m][n] = (f32x4){0.f, 0.f, 0.f, 0.f};
    bf16x8 At[4][2], B0[2][2], B1[2][2];
    const char* cA = (const char*)g.A + (size_t)cur.pm * tstep; const char* cB = (const char*)g.Bt + (size_t)cur.pn * tstepB;
    PG8_STAGE(PG8_SB(0, 0), cB, voffB); PG8_STAGE(PG8_SA(0, 0), cA, voffA); PG8_STAGE(PG8_SB(0, 1), cB + hstepB, voffB); PG8_STAGE(PG8_SA(0, 1), cA + hstep, voffA);
    if (wr == 1) PG8_BAR;
    PG8_WAIT_V(4); PG8_BAR;
    PG8_STAGE(PG8_SB(1, 0), cB + kstep, voffB); PG8_STAGE(PG8_SA(1, 0), cA + kstep, voffA); PG8_STAGE(PG8_SB(1, 1), cB + hstepB + kstep, voffB);
    PG8_WAIT_V(6); PG8_BAR;
    for (;;) {
        const bool has_next = S.next(ui + 1, nxt);
        const char* nA = has_next ? (const char*)g.A + (size_t)nxt.pm * tstep : cA; const char* nB = has_next ? (const char*)g.Bt + (size_t)nxt.pn * tstepB : cB;
        for (int t = 0; t < nt; t += 2) {
            const bool last = (t == nt - 2);
            const char* a1 = cA + (size_t)(t + 1) * kstep;
            const char* a2 = last ? nA : cA + (size_t)(t + 2) * kstep; const char* b2 = last ? nB : cB + (size_t)(t + 2) * kstep;
            const char* a3 = a2 + kstep; const char* b3 = b2 + kstep;
            PG8_LDB(B0, 0, 0); PG8_SCHED; PG8_LDA(At, 0, 0); PG8_STAGE(PG8_SA(1, 1), a1 + hstep, voffA);
            PG8_WAIT_L(8); PG8_BAR; PG8_WAIT_L(0); PG8_MMA(0, 0, At, B0); PG8_BAR; PG8_SCHED;
            PG8_LDB(B1, 0, 1); PG8_STAGE(PG8_SB(0, 0), b2, voffB);
            PG8_BAR; PG8_WAIT_L(0); PG8_MMA(0, 1, At, B1); PG8_BAR;
            PG8_LDA(At, 0, 1); PG8_STAGE(PG8_SA(0, 0), a2, voffA);
            PG8_BAR; PG8_WAIT_L(0); PG8_MMA(1, 0, At, B0); PG8_BAR; PG8_SCHED;
            PG8_STAGE(PG8_SB(0, 1), b2 + hstepB, voffB);
            PG8_WAIT_V(6); PG8_BAR; PG8_MMA(1, 1, At, B1); PG8_BAR;
            PG8_LDB(B0, 1, 0); PG8_SCHED; PG8_LDA(At, 1, 0); PG8_STAGE(PG8_SA(0, 1), a2 + hstep, voffA);
            PG8_WAIT_L(8); PG8_BAR; PG8_WAIT_L(0); PG8_MMA(0, 0, At, B0); PG8_BAR; PG8_SCHED;
            PG8_LDB(B1, 1, 1); PG8_STAGE(PG8_SB(1, 0), b3, voffB);
            PG8_BAR; PG8_WAIT_L(0); PG8_MMA(0, 1, At, B1); PG8_BAR;
            PG8_LDA(At, 1, 1); PG8_STAGE(PG8_SA(1, 0), a3, voffA);
            PG8_BAR; PG8_WAIT_L(0); PG8_MMA(1, 0, At, B0); PG8_BAR; PG8_SCHED;
            PG8_STAGE(PG8_SB(1, 1), b3 + hstepB, voffB);
            PG8_WAIT_V(6); PG8_BAR; PG8_MMA(1, 1, At, B1); PG8_BAR;
        }
        E(acc, cur, wr, wc, fr, fq);
        if (!has_next) break;
#pragma unroll
        for (int a = 0; a < 2; ++a)
#pragma unroll
            for (int b = 0; b < 2; ++b)
#pragma unroll
                for (int m = 0; m < 4; ++m)
#pragma unroll
                    for (int n = 0; n < 2; ++n) acc[a][b][m][n] = (f32x4){0.f, 0.f, 0.f, 0.f};
        cur = nxt; cA = nA; cB = nB; ++ui;
    }
    PG8_WAIT_V(0);
    if (wr == 0) PG8_BAR;
    PG8_BAR;
#undef PG8_SA
#undef PG8_SB
#undef PG8_STAGE
#undef PG8_LDA
#undef PG8_LDB
#undef PG8_MMA
#undef PG8_WAIT_V
#undef PG8_WAIT_L
#undef PG8_BAR
#undef PG8_SCHED
}
}

struct EpiProj {
    bf16_t* P; float* DT; const float* rope; const float* dt_bias;
    __device__ __forceinline__ void operator()(const f32x4 (&acc)[2][2][4][2], const pg8::Unit& u, int wr, int wc, int fr, int fq) const {
        const int row0 = u.pm * 256 + wr * 64 + fr, pn = u.pn;
        if (pn < 5) {
            const float sc = pn < 4 ? 0.125f * LOG2E : 1.f;
            const int col = pn * 256 + 64 * wc + 8 * fq;
#pragma unroll
            for (int ai = 0; ai < 2; ++ai)
#pragma unroll
                for (int m = 0; m < 4; ++m) {
                    const int row = row0 + ai * 128 + m * 16, pos = row & (SEQ - 1);
                    const f32x4* cp = (const f32x4*)(rope + pos * 32 + 8 * fq); const f32x4* sp = (const f32x4*)(rope + SEQ * 32 + pos * 32 + 8 * fq);
                    f32x4 o1[2], o2[2];
#pragma unroll
                    for (int n = 0; n < 2; ++n) { const f32x4 c = cp[n], s = sp[n], t1 = acc[ai][0][m][n], t2 = acc[ai][1][m][n]; o1[n] = (t1 * c - t2 * s) * sc; o2[n] = (t1 * s + t2 * c) * sc; }
                    bf16_t* dst = P + (size_t)row * PW + col;
                    __builtin_nontemporal_store((u32x4){cvt_pk(o1[0].x, o1[0].y), cvt_pk(o1[0].z, o1[0].w), cvt_pk(o1[1].x, o1[1].y), cvt_pk(o1[1].z, o1[1].w)}, (u32x4*)dst);
                    __builtin_nontemporal_store((u32x4){cvt_pk(o2[0].x, o2[0].y), cvt_pk(o2[0].z, o2[0].w), cvt_pk(o2[1].x, o2[1].y), cvt_pk(o2[1].z, o2[1].w)}, (u32x4*)(dst + 32));
                }
        } else if (pn < 20) {
            const bool do_silu = (pn >= 6 && pn < 12) || pn >= 18;
            const float sc = (pn == 16 || pn == 17) ? 0.08838834764831845f * LOG2E : 1.f;
            const int col = pn * 256 + 32 * wc + 8 * fq;
#pragma unroll
            for (int ai = 0; ai < 2; ++ai)
#pragma unroll
                for (int m = 0; m < 4; ++m) {
                    const int row = row0 + ai * 128 + m * 16;
#pragma unroll
                    for (int bj = 0; bj < 2; ++bj) {
                        f32x4 v0 = acc[ai][bj][m][0], v1 = acc[ai][bj][m][1];
                        if (do_silu) { v0 = silu4(v0); v1 = silu4(v1); } else { v0 = v0 * sc; v1 = v1 * sc; }
                        __builtin_nontemporal_store((u32x4){cvt_pk(v0.x, v0.y), cvt_pk(v0.z, v0.w), cvt_pk(v1.x, v1.y), cvt_pk(v1.z, v1.w)}, (u32x4*)(P + (size_t)row * PW + col + 128 * bj));
                    }
                }
        } else {
            if (wc == 0 && fq < 2) {
                const f32x4 bb0 = *(const f32x4*)(dt_bias + 8 * fq), bb1 = *(const f32x4*)(dt_bias + 8 * fq + 4);
#pragma unroll
                for (int ai = 0; ai < 2; ++ai)
#pragma unroll
                    for (int m = 0; m < 4; ++m) {
                        const int row = row0 + ai * 128 + m * 16;
#pragma unroll
                        for (int n = 0; n < 2; ++n) {
                            const int j0 = 8 * fq + 4 * n; const f32x4 v = acc[ai][0][m][n] + (n ? bb1 : bb0);
                            *(f32x4*)(DT + (size_t)row * 16 + j0) = (f32x4){softplus_f(v.x), softplus_f(v.y), softplus_f(v.z), softplus_f(v.w)};
                        }
                    }
            }
        }
    }
};
struct EpiMkv {
    bf16_t* O;
    __device__ __forceinline__ void operator()(const f32x4 (&acc)[2][2][4][2], const pg8::Unit& u, int wr, int wc, int fr, int fq) const {
        const int row0 = u.pm * 256 + wr * 64 + fr, col = u.pn * 256 + 32 * wc + 8 * fq;
#pragma unroll
        for (int ai = 0; ai < 2; ++ai)
#pragma unroll
            for (int m = 0; m < 4; ++m) {
                const int row = row0 + ai * 128 + m * 16;
#pragma unroll
                for (int bj = 0; bj < 2; ++bj) { const f32x4 v0 = acc[ai][bj][m][0], v1 = acc[ai][bj][m][1];
                    *(u32x4*)(O + (size_t)row * 1024 + col + 128 * bj) = (u32x4){cvt_pk(v0.x, v0.y), cvt_pk(v0.z, v0.w), cvt_pk(v1.x, v1.y), cvt_pk(v1.z, v1.w)}; }
            }
    }
};
struct EpiOut {
    const float* x; float* out; float* rowss;
    __device__ __forceinline__ void operator()(const f32x4 (&acc)[2][2][4][2], const pg8::Unit& u, int wr, int wc, int fr, int fq) const {
        const int row0 = u.pm * 256 + wr * 64 + fr, col = u.pn * 256 + 32 * wc + 8 * fq;
#pragma unroll
        for (int ai = 0; ai < 2; ++ai) {
            f32x4 xv[4][2][2];
#pragma unroll
            for (int m = 0; m < 4; ++m)
#pragma unroll
                for (int bj = 0; bj < 2; ++bj) {
                    const size_t o = (size_t)(row0 + ai * 128 + m * 16) * DM + col + 128 * bj;
                    xv[m][bj][0] = __builtin_nontemporal_load((const f32x4*)(x + o)); xv[m][bj][1] = __builtin_nontemporal_load((const f32x4*)(x + o + 4));
                }
#pragma unroll
            for (int m = 0; m < 4; ++m) {
                const int row = row0 + ai * 128 + m * 16; float ss = 0.f;
#pragma unroll
                for (int bj = 0; bj < 2; ++bj) {
                    const size_t o = (size_t)row * DM + col + 128 * bj;
                    const f32x4 h0 = xv[m][bj][0] + acc[ai][bj][m][0], h1 = xv[m][bj][1] + acc[ai][bj][m][1];
                    *(f32x4*)(out + o) = h0; *(f32x4*)(out + o + 4) = h1;
                    ss += h0.x * h0.x + h0.y * h0.y + h0.z * h0.z + h0.w * h0.w + h1.x * h1.x + h1.y * h1.y + h1.z * h1.z + h1.w * h1.w;
                }
                ss += __shfl_xor(ss, 16); ss += __shfl_xor(ss, 32);
                if (fq == 0) rowss[(size_t)row * 16 + u.pn * 4 + wc] = ss;
            }
        }
    }
};

struct Args { const float* in[15]; float* out; unsigned char* ws; int lo, hi; };
struct Ctx {
    const float *x, *mem, *norm_mem_w, *norm_in_w, *w_in, *attn_sink, *conv_w, *conv_b, *dt_bias, *a_log, *d_skip, *ssd_norm_w, *w_mem_kv, *w_out, *norm_out_w;
    float* out; unsigned char* ws;
    __device__ __forceinline__ float* rowss() const { return (float*)(ws + WS_ROWSS); }
    __device__ __forceinline__ float* rope() const { return (float*)(ws + WS_ROPE); }
    __device__ __forceinline__ bf16_t* win_t() const { return (bf16_t*)(ws + WS_WIN); }
    __device__ __forceinline__ bf16_t* wout_t() const { return (bf16_t*)(ws + WS_WOUT); }
    __device__ __forceinline__ bf16_t* wmem_t() const { return (bf16_t*)(ws + WS_WMEM); }
    __device__ __forceinline__ bf16_t* memn() const { return (bf16_t*)(ws + WS_MEMN); }
    __device__ __forceinline__ bf16_t* mkv() const { return (bf16_t*)(ws + WS_MKV); }
    __device__ __forceinline__ float* dt() const { return (float*)(ws + WS_DT); }
    __device__ __forceinline__ float* dec() const { return (float*)(ws + WS_DEC); }
    __device__ __forceinline__ bf16_t* proj() const { return (bf16_t*)(ws + WS_PROJ); }
    __device__ __forceinline__ bf16_t* mix() const { return (bf16_t*)(ws + WS_MIX); }
    __device__ __forceinline__ bf16_t* hn() const { return (bf16_t*)((unsigned char*)out); }
    __device__ __forceinline__ bf16_t* st() const { return (bf16_t*)((unsigned char*)out); }
    __device__ __forceinline__ bf16_t* yp() const { return (bf16_t*)((unsigned char*)out + 128 * MiB); }
    __device__ __forceinline__ bf16_t* cfb() const { return (bf16_t*)((unsigned char*)out + 192 * MiB); }
    __device__ __forceinline__ float* efb() const { return (float*)((unsigned char*)out + 224 * MiB); }
    ldsp lds; int tid, lane, wave, G, bid;
};

__device__ __forceinline__ void rms_row_bf16(const float* xr, const float* w, bf16_t* o, int lane) {
    f32x4 v[4]; float ss = 0.f;
#pragma unroll
    for (int j = 0; j < 4; ++j) { v[j] = __builtin_nontemporal_load((const f32x4*)(xr + 4 * lane + 256 * j)); ss += v[j].x * v[j].x + v[j].y * v[j].y + v[j].z * v[j].z + v[j].w * v[j].w; }
#pragma unroll
    for (int off = 1; off < 64; off <<= 1) ss += __shfl_xor(ss, off);
    const float r = rsqrtf(ss * (1.f / DM) + EPS);
#pragma unroll
    for (int j = 0; j < 4; ++j) { const f32x4 ww = *(const f32x4*)(w + 4 * lane + 256 * j); *(u32x2*)(o + 4 * lane + 256 * j) = pack4(v[j] * r * ww); }
}
template <int MODE>
__device__ __forceinline__ void transpose_w(const Ctx& F, const float* W, int K, int NS, bf16_t* Bt, int NP, int ldb) {
    const int nitems = NP * (K / 8);
    for (int it = F.bid * 512 + F.tid; it < nitems; it += F.G * 512) {
        const int n = it % NP, kg = it / NP, tile = n >> 8, cph = n & 255; int src;
        if (MODE == 0) {
            if (tile < 5) src = tile * 256 + perm_rot(cph);
            else if (tile < 20) { src = tile * 256 + perm_plain(cph); if (src >= 4096) src += 16; }
            else { const int l = perm_plain(cph); src = l < 16 ? 4096 + l : -1; }
        } else src = tile * 256 + perm_plain(cph);
        float v[8];
#pragma unroll
        for (int j = 0; j < 8; ++j) v[j] = src >= 0 ? W[(size_t)(kg * 8 + j) * NS + src] : 0.f;
        *(u32x4*)(Bt + (size_t)n * ldb + kg * 8) = (u32x4){cvt_pk(v[0], v[1]), cvt_pk(v[2], v[3]), cvt_pk(v[4], v[5]), cvt_pk(v[6], v[7])};
    }
}
__device__ __forceinline__ void phase0(const Ctx& F) {
    const int gt = F.bid * 512 + F.tid, NT = F.G * 512;
    for (int i = gt; i < SEQ * 32; i += NT) {
        const int pos = i >> 5, f = i & 31;
        const float inv = 1.0f / exp2f((float)f * (13.287712379549449f / 32.f));
        const float ang = (float)pos * inv;
        const double rev = (double)ang * 0.15915494309189535; const double fr = rev - __builtin_rint(rev);
        const float r = (float)(fr * 6.283185307179586);
        F.rope()[i] = __cosf(r); F.rope()[SEQ * 32 + i] = __sinf(r);
    }
    transpose_w<0>(F, F.w_in, DM, INW, F.win_t(), NPHYS, HNP);
    transpose_w<1>(F, F.w_out, MIXW, DM, F.wout_t(), DM, MIXP);
    transpose_w<1>(F, F.w_mem_kv, DM, DM, F.wmem_t(), DM, HNP);
    const int gw = F.bid * 8 + F.wave, NGW = F.G * 8;
    for (int m = gw; m < NBATCH * 256; m += NGW) rms_row_bf16(F.mem + (size_t)m * DM, F.norm_mem_w, F.memn() + (size_t)m * HNP, F.lane);
    for (int m = gw; m < TOK; m += NGW) rms_row_bf16(F.x + (size_t)m * DM, F.norm_in_w, F.hn() + (size_t)m * HNP, F.lane);
}

template <int DH, int NQF>
__device__ __forceinline__ void attn_tile(ldsp Kt, int KS, ldsp Vt, int VS, const bf16x8 (&qf)[NQF][DH / 32], f32x4 (&o)[DH / 16][NQF], float (&m)[NQF], float (&lp)[NQF], int maskmode, int lane, int qoff = 0) {
    const int i16 = lane & 15, q4 = lane >> 4;
    f32x4 st[4][NQF];
#pragma unroll
    for (int kf = 0; kf < 4; ++kf)
#pragma unroll
        for (int q = 0; q < NQF; ++q) st[kf][q] = (f32x4){0.f, 0.f, 0.f, 0.f};
#pragma unroll
    for (int ks = 0; ks < DH / 32; ++ks)
#pragma unroll
        for (int kf = 0; kf < 4; ++kf) {
            const bf16x8 ka = ld8(Kt + (16 * kf + i16) * KS + (32 * ks + 8 * q4) * 2);
#pragma unroll
            for (int q = 0; q < NQF; ++q) st[kf][q] = mfma16(ka, qf[q][ks], st[kf][q]);
            if (DH > 64 && kf == 3) __builtin_amdgcn_sched_barrier(0);
        }
    if (maskmode) {
        int zb; asm volatile("v_mov_b32 %0, 0" : "=v"(zb));
        const int base = (maskmode == 1 ? 4 * q4 - i16 - qoff : i16 + qoff - 4 * q4) + zb;
#pragma unroll
        for (int kf = 0; kf < 4; ++kf)
#pragma unroll
            for (int q = 0; q < NQF; ++q)
#pragma unroll
                for (int r = 0; r < 4; ++r) { const int off = 16 * (kf - q) + r; const bool bad = (maskmode == 1 ? base + off : base - off) < 0; if (bad) st[kf][q][r] = -INFINITY; }
    }
#pragma unroll
    for (int q = 0; q < NQF; ++q) {
        float mx = st[0][q][0];
#pragma unroll
        for (int kf = 0; kf < 4; ++kf)
#pragma unroll
            for (int r = 0; r < 4; ++r) mx = fmaxf(mx, st[kf][q][r]);
        mx = fmaxf(mx, __shfl_xor(mx, 16)); mx = fmaxf(mx, __shfl_xor(mx, 32));
        const bool grow = mx > m[q] + 8.f;
        if (__builtin_amdgcn_ballot_w64(grow) != 0ull) {
            const float mn2 = grow ? mx : m[q], alpha = ex2(m[q] - mn2); m[q] = mn2;
            lp[q] = lp[q] * alpha;
#pragma unroll
            for (int d = 0; d < DH / 16; ++d) o[d][q] = o[d][q] * alpha;
        }
        const float mn = m[q];
        float ps = 0.f;
#pragma unroll
        for (int kf = 0; kf < 4; ++kf)
#pragma unroll
            for (int r = 0; r < 4; ++r) { const float p = ex2(st[kf][q][r] - mn); st[kf][q][r] = p; ps += p; }
        lp[q] += ps;
    }
#pragma unroll
    for (int kp = 0; kp < 2; ++kp) {
        bf16x8 pk[NQF];
#pragma unroll
        for (int q = 0; q < NQF; ++q) pk[q] = packfrag(st[2 * kp][q], st[2 * kp + 1][q]);
#pragma unroll
        for (int d = 0; d < DH / 16; ++d) {
            ldsp va = Vt + (32 * kp + 4 * q4 + (i16 >> 2)) * VS + (16 * d + 4 * (i16 & 3)) * 2;
            const bf16x8 vf = cat8(vtr(va), vtr(va + 16 * VS));
#pragma unroll
            for (int q = 0; q < NQF; ++q) o[d][q] = mfma16(vf, pk[q], o[d][q]);
            if (DH > 64 && (d & 3) == 3) __builtin_amdgcn_sched_barrier(0);
        }
    }
}

__device__ __forceinline__ void ring_stage_block(const Ctx& F, const bf16_t* kvbase, int keyblock) {
    constexpr int KS = 144, VS = 160; const ldsp Kb = F.lds + (keyblock & 511) * KS, Vb = F.lds + 512 * KS + (keyblock & 511) * VS;
    const bf16_t* src0 = kvbase + (size_t)keyblock * PW;
    for (int wi = F.wave; wi < 18; wi += 8) {
        const int slot = wi * 64 + F.lane, row = slot / 9, ch = slot - row * 9;
        __builtin_amdgcn_global_load_lds((const unsigned*)(src0 + (size_t)row * PW + C_K + 8 * (ch > 7 ? 7 : ch)), (LAS unsigned*)(Kb + wi * 1024), 16, 0, 0);
    }
    for (int wi = F.wave; wi < 20; wi += 8) {
        const int slot = wi * 64 + F.lane, row = slot / 10, ch = slot - row * 10;
        __builtin_amdgcn_global_load_lds((const unsigned*)(src0 + (size_t)row * PW + C_V + 8 * (ch > 7 ? 7 : ch)), (LAS unsigned*)(Vb + wi * 1024), 16, 0, 0);
    }
}
__device__ __forceinline__ void attn_window_seq(const Ctx& F, int sq) {
    constexpr int KS = 144, VS = 160; const ldsp Ki = F.lds, Vi = F.lds + 512 * KS;
    const int sidx = sq >> 2, b = sidx >> 2, kvh = sidx & 3, i0 = 8 * (sq & 3);
    const int w = F.wave, lane = F.lane, i16 = lane & 15, q4 = lane >> 4, hq = 4 * kvh + (w >> 1);
    const bf16_t* kvbase = F.proj() + (size_t)b * SEQ * PW + 64 * kvh;
    __syncthreads();
    for (int t = 0; t < 3; ++t) { const int kb = 128 * (i0 - 1 + t); if (kb >= 0 && kb < SEQ) ring_stage_block(F, kvbase, kb); }
    const float sink = F.attn_sink[hq] * LOG2E;
#pragma unroll 1
    for (int k = 0; k < 8; ++k) {
        const int i = i0 + k, q0 = 128 * i + 64 * (w & 1);
        __syncthreads();
        { const int nkey0 = 128 * i + 256; if (k < 7 && nkey0 < SEQ) ring_stage_block(F, kvbase, nkey0); }
#pragma unroll 1
        for (int half = 0; half < 2; ++half) {
            const int qh = q0 + 32 * half;
            bf16x8 qf[2][2];
#pragma unroll
            for (int q = 0; q < 2; ++q)
#pragma unroll
                for (int ks = 0; ks < 2; ++ks) qf[q][ks] = *(const bf16x8*)(F.proj() + (size_t)(b * SEQ + qh + 16 * q + i16) * PW + C_Q + hq * 64 + 32 * ks + 8 * q4);
            u32x2 graw[2][4];
#pragma unroll
            for (int q = 0; q < 2; ++q)
#pragma unroll
                for (int d = 0; d < 4; ++d) graw[q][d] = *(const u32x2*)(F.proj() + (size_t)(b * SEQ + qh + 16 * q + i16) * PW + C_G + hq * 64 + 16 * d + 4 * q4);
            f32x4 o[4][2]; float m[2], lp[2];
#pragma unroll
            for (int q = 0; q < 2; ++q) { m[q] = sink; lp[q] = q4 == 0 ? 1.f : 0.f;
#pragma unroll
                for (int d = 0; d < 4; ++d) o[d][q] = (f32x4){0.f, 0.f, 0.f, 0.f}; }
#pragma unroll 1
            for (int j = 0; j < 5; ++j) {
                const int kstart = q0 - 128 + 64 * j; if (kstart < 0 || kstart >= SEQ) continue;
                const int ir = kstart & 511;
                attn_tile<64, 2>(Ki + ir * KS, KS, Vi + ir * VS, VS, qf, o, m, lp, j == 0 ? 1 : (j == 4 ? 2 : 0), lane, 32 * half);
            }
#pragma unroll
            for (int q = 0; q < 2; ++q) {
                float l = lp[q]; l += __shfl_xor(l, 16); l += __shfl_xor(l, 32); const float inv = 1.f / l;
                const size_t row = (size_t)(b * SEQ + qh + 16 * q + i16);
#pragma unroll
                for (int d = 0; d < 4; ++d) {
                    const int col = hq * 64 + 16 * d + 4 * q4;
                    const f32x4 g = unpack4(graw[q][d]);
                    *(u32x2*)(F.mix() + row * MIXP + col) = pack4(o[d][q] * inv * g);
                }
            }
        }
    }
}
__device__ __forceinline__ void attn_mem_item(const Ctx& F, int item, bool stage) {
    constexpr int KS = 272, VS = 288; const ldsp Ki = F.lds, Vi = F.lds + 256 * KS;
    const int qb = item & 15, hm = (item >> 4) & 3, b = item >> 6;
    if (stage) {
    __syncthreads();
#pragma unroll
    for (int c = F.tid; c < 4096; c += 512) {
        const int r = c >> 4, ch = c & 15;
        const bf16_t* src = F.mkv() + (size_t)(b * 256 + r) * 1024 + hm * 128 + 8 * ch;
        *(LAS u32x4*)(Ki + r * KS + ch * 16) = *(const u32x4*)(src);
        *(LAS u32x4*)(Vi + r * VS + ch * 16) = *(const u32x4*)(src + 512);
    }
    __syncthreads();
    }
    const int w = F.wave, lane = F.lane, i16 = lane & 15, q4 = lane >> 4, q0 = 256 * qb + 32 * w;
    bf16x8 qf[2][4];
#pragma unroll
    for (int q = 0; q < 2; ++q)
#pragma unroll
        for (int ks = 0; ks < 4; ++ks) qf[q][ks] = *(const bf16x8*)(F.proj() + (size_t)(b * SEQ + q0 + 16 * q + i16) * PW + C_QM + hm * 128 + 32 * ks + 8 * q4);
    u32x2 graw[2][8];
#pragma unroll
    for (int q = 0; q < 2; ++q)
#pragma unroll
        for (int d = 0; d < 8; ++d) graw[q][d] = *(const u32x2*)(F.proj() + (size_t)(b * SEQ + q0 + 16 * q + i16) * PW + C_GM + hm * 128 + 16 * d + 4 * q4);
    f32x4 o[8][2]; float m[2], lp[2];
#pragma unroll
    for (int q = 0; q < 2; ++q) { m[q] = -INFINITY; lp[q] = 0.f;
#pragma unroll
        for (int d = 0; d < 8; ++d) o[d][q] = (f32x4){0.f, 0.f, 0.f, 0.f}; }
#pragma unroll 1
    for (int j = 0; j < 4; ++j) attn_tile<128, 2>(Ki + 64 * j * KS, KS, Vi + 64 * j * VS, VS, qf, o, m, lp, 0, lane);
#pragma unroll
    for (int q = 0; q < 2; ++q) {
        float l = lp[q]; l += __shfl_xor(l, 16); l += __shfl_xor(l, 32); const float inv = 1.f / l;
        const size_t row = (size_t)(b * SEQ + q0 + 16 * q + i16);
#pragma unroll
        for (int d = 0; d < 8; ++d) {
            const int col = hm * 128 + 16 * d + 4 * q4;
            const f32x4 g = unpack4(graw[q][d]);
            *(u32x2*)(F.mix() + row * MIXP + 1536 + col) = pack4(o[d][q] * inv * g);
        }
    }
}

constexpr int XS = 544, BS = 288, PS = 272;
constexpr int L_XI = 0, L_BI = 128 * XS, L_CI = L_BI + 128 * BS, L_F32 = L_CI + 128 * BS;
static_assert(L_F32 + 12288 <= LDS_XB, "lds");
__device__ __forceinline__ void ssd_dtprep(const Ctx& F, int b, int c, int g, bool write_dec) {
    LAS float* DTs = (LAS float*)(F.lds + L_F32); LAS float* ACs = DTs + 1024;
    const int w = F.wave, lane = F.lane, dir = w >> 2, r = w & 3, h = 4 * g + r, j = dir * 8 + h;
    const size_t row0 = (size_t)b * SEQ + c * 128;
    const float d0 = F.dt()[(row0 + 2 * lane) * 16 + j], d1 = F.dt()[(row0 + 2 * lane + 1) * 16 + j];
    const float a = -expf(F.a_log[j]);
    const float x0 = d0 * a, x1 = d1 * a, ps = x0 + x1; float inc = ps;
#pragma unroll
    for (int off = 1; off < 64; off <<= 1) { const float t = __shfl_up(inc, off); if (lane >= off) inc += t; }
    const float total = __shfl(inc, 63);
    float a0, a1;
    if (dir == 0) { a0 = inc - x1; a1 = inc; } else { a0 = total - (inc - ps); a1 = total - (inc - x1); }
    *(LAS f32x2*)(DTs + w * 128 + 2 * lane) = (f32x2){d0, d1};
    *(LAS f32x2*)(ACs + w * 128 + 2 * lane) = (f32x2){a0, a1};
    *(LAS f32x2*)(ACs + 1024 + w * 128 + 2 * lane) = (f32x2){d0 * expf(total - a0), d1 * expf(total - a1)};
    if (write_dec && lane == 0) F.dec()[(b * 32 + c) * 16 + j] = expf(total);
}
template <int NCOLS>
__device__ __forceinline__ void conv_img(const Ctx& F, int b, int c, int xcol, ldsp img, int stride) {
    constexpr int NCQ = NCOLS / 4, NRG = 512 / NCQ, R = 128 / NRG;
    const int cq = F.tid % NCQ, rg = F.tid / NCQ, col = xcol + 4 * cq;
    f32x4 w[5];
#pragma unroll
    for (int j = 0; j < 5; ++j) w[j] = *(const f32x4*)(F.conv_w + j * 1024 + col);
    const f32x4 bias = *(const f32x4*)(F.conv_b + col);
    const int t0 = c * 128 + rg * R - 2;
    const bf16_t* base = F.proj() + (size_t)b * SEQ * PW + C_X + col;
    f32x4 win[R + 4];
#pragma unroll
    for (int k = 0; k < R + 4; ++k) { const int t = t0 + k, tc = t < 0 ? 0 : (t >= SEQ ? SEQ - 1 : t); const u32x2 raw = *(const u32x2*)(base + (size_t)tc * PW); const bool ok = (t == tc);
        win[k] = unpack4((u32x2){ok ? raw.x : 0u, ok ? raw.y : 0u}); }
#pragma unroll
    for (int r = 0; r < R; ++r) {
        f32x4 y = bias;
#pragma unroll
        for (int j = 0; j < 5; ++j) y = y + w[j] * win[r + j];
        *(LAS u32x2*)(img + (rg * R + r) * stride + cq * 8) = pack4(silu4(y));
    }
}
__device__ __forceinline__ void ssd_pass1_item(const Ctx& F, int item) {
    const int g = item & 1, c = (item >> 1) & 31, b = item >> 6;
    const ldsp XI = F.lds + L_XI, BI = F.lds + L_BI, CI = F.lds + L_CI;
    LAS float* DTs = (LAS float*)(F.lds + L_F32); LAS float* ACs = DTs + 1024;
    __syncthreads();
    ssd_dtprep(F, b, c, g, true);
    conv_img<256>(F, b, c, 256 * g, XI, XS);
    conv_img<128>(F, b, c, 512 + 128 * g, BI, BS);
    conv_img<128>(F, b, c, 768 + 128 * g, CI, BS);
    __syncthreads();
    const int lane = F.lane, i16 = lane & 15, q4 = lane >> 4, w = F.wave, tl = 16 * w + i16;
    const size_t row = (size_t)b * SEQ + c * 128 + tl;
    f32x4 cbt[8];
    {
        bf16x8 cf[4];
#pragma unroll
        for (int ks = 0; ks < 4; ++ks) cf[ks] = ld8(CI + tl * BS + (32 * ks + 8 * q4) * 2);
#pragma unroll
        for (int ks = 0; ks < 4; ++ks) *(bf16x8*)(F.cfb() + ((size_t)(item * 8 + w) * 64 + lane) * 32 + 8 * ks) = cf[ks];
#pragma unroll
        for (int sf = 0; sf < 8; ++sf) {
            cbt[sf] = (f32x4){0.f, 0.f, 0.f, 0.f};
#pragma unroll
            for (int ks = 0; ks < 4; ++ks) cbt[sf] = mfma16(ld8(BI + (16 * sf + i16) * BS + (32 * ks + 8 * q4) * 2), cf[ks], cbt[sf]);
        }
    }
#pragma unroll 1
    for (int r = 0; r < 4; ++r) {
        {
            const int dir = w & 1, nq = w >> 1;
            LAS const float* Wr = ACs + 1024 + (dir * 4 + r) * 128;
            f32x4 acc[2][4];
#pragma unroll
            for (int nf = 0; nf < 2; ++nf)
#pragma unroll
                for (int pf = 0; pf < 4; ++pf) acc[nf][pf] = (f32x4){0.f, 0.f, 0.f, 0.f};
#pragma unroll
            for (int ks = 0; ks < 4; ++ks) {
                const int t0 = 32 * ks + 8 * q4, trow = t0 + (i16 >> 2);
                const f32x4 wlo = *(const LAS f32x4*)(Wr + t0), whi = *(const LAS f32x4*)(Wr + t0 + 4);
                bf16x8 af[2], bfr[4];
#pragma unroll
                for (int nf = 0; nf < 2; ++nf) {
                    ldsp p = BI + trow * BS + (32 * nq + 16 * nf + 4 * (i16 & 3)) * 2;
                    const u32x2 lo = __builtin_bit_cast(u32x2, vtr(p)), hi = __builtin_bit_cast(u32x2, vtr(p + 4 * BS));
                    af[nf] = packfrag(unpack4(lo) * wlo, unpack4(hi) * whi);
                }
#pragma unroll
                for (int pf = 0; pf < 4; ++pf) { ldsp p = XI + trow * XS + (64 * r + 16 * pf + 4 * (i16 & 3)) * 2; bfr[pf] = cat8(vtr(p), vtr(p + 4 * XS)); }
#pragma unroll
                for (int nf = 0; nf < 2; ++nf)
#pragma unroll
                    for (int pf = 0; pf < 4; ++pf) acc[nf][pf] = mfma16(af[nf], bfr[pf], acc[nf][pf]);
            }
            bf16_t* S = F.st() + ((((size_t)(b * 32 + c) * 2 + dir) * 8 + (4 * g + r)) << 13);
#pragma unroll
            for (int nf = 0; nf < 2; ++nf)
#pragma unroll
                for (int pf = 0; pf < 4; ++pf) *(u32x2*)(S + (16 * pf + i16) * 128 + 32 * nq + 16 * nf + 4 * q4) = pack4(acc[nf][pf]);
        }
        {
            const float acf = ACs[r * 128 + tl], acb = ACs[(4 + r) * 128 + tl];
            f32x4 yt[4];
#pragma unroll
            for (int pf = 0; pf < 4; ++pf) yt[pf] = (f32x4){0.f, 0.f, 0.f, 0.f};
#pragma unroll
            for (int kp = 0; kp < 4; ++kp) {
                f32x4 gt[2];
#pragma unroll
                for (int u = 0; u < 2; ++u) {
                    const int sf = 2 * kp + u, s0 = 16 * sf + 4 * q4;
                    const f32x4 dtf = *(const LAS f32x4*)(DTs + r * 128 + s0), af = *(const LAS f32x4*)(ACs + r * 128 + s0);
                    const f32x4 dtb = *(const LAS f32x4*)(DTs + (4 + r) * 128 + s0), ab = *(const LAS f32x4*)(ACs + (4 + r) * 128 + s0);
#pragma unroll
                    for (int e = 0; e < 4; ++e) {
                        const int sx = s0 + e;
                        const float mf = sx <= tl ? dtf[e] * __expf(acf - af[e]) : 0.f;
                        const float mb = sx >= tl ? dtb[e] * __expf(acb - ab[e]) : 0.f;
                        gt[u][e] = cbt[sf][e] * (mf + mb);
                    }
                }
                const bf16x8 gk = packfrag(gt[0], gt[1]);
#pragma unroll
                for (int pf = 0; pf < 4; ++pf) {
                    ldsp xa = XI + (32 * kp + 4 * q4 + (i16 >> 2)) * XS + (64 * r + 16 * pf + 4 * (i16 & 3)) * 2;
                    yt[pf] = mfma16(cat8(vtr(xa), vtr(xa + 16 * XS)), gk, yt[pf]);
                }
            }
            const float dsk = F.d_skip[4 * g + r];
#pragma unroll
            for (int pf = 0; pf < 4; ++pf) {
                const int pc = 64 * r + 16 * pf + 4 * q4;
                const f32x4 xv = unpack4(*(const LAS u32x2*)(XI + tl * XS + pc * 2));
                *(u32x2*)(F.yp() + row * 512 + 256 * g + pc) = pack4(yt[pf] + xv * dsk);
            }
            if (q4 == 0) { F.efb()[row * 16 + 4 * g + r] = __expf(acf); F.efb()[row * 16 + 8 + 4 * g + r] = __expf(acb); }
        }
    }
}
__device__ __forceinline__ void ssd_scan(const Ctx& F, int vb, int vg) {
    for (int it = vb * 512 + F.tid; it < NBATCH * 2 * 8 * 1024; it += vg * 512) {
        const int e8 = it & 1023, h = (it >> 10) & 7, dir = (it >> 13) & 1, b = it >> 14;
        float run[8];
#pragma unroll
        for (int k = 0; k < 8; ++k) run[k] = 0.f;
        for (int s0 = 0; s0 < 32; s0 += 4) {
            u32x4 v[4]; float dc[4]; bf16_t* ad[4];
#pragma unroll
            for (int u = 0; u < 4; ++u) { const int s = s0 + u, c = dir ? 31 - s : s; ad[u] = F.st() + (((((size_t)(b * 32 + c) * 2 + dir) * 8 + h) << 13) + e8 * 8); v[u] = __builtin_nontemporal_load((const u32x4*)ad[u]); dc[u] = F.dec()[(b * 32 + c) * 16 + dir * 8 + h]; }
#pragma unroll
            for (int u = 0; u < 4; ++u) {
                __builtin_nontemporal_store((u32x4){cvt_pk(run[0], run[1]), cvt_pk(run[2], run[3]), cvt_pk(run[4], run[5]), cvt_pk(run[6], run[7])}, (u32x4*)ad[u]);
                run[0] = run[0] * dc[u] + bf_lo(v[u].x); run[1] = run[1] * dc[u] + bf_hi(v[u].x); run[2] = run[2] * dc[u] + bf_lo(v[u].y); run[3] = run[3] * dc[u] + bf_hi(v[u].y);
                run[4] = run[4] * dc[u] + bf_lo(v[u].z); run[5] = run[5] * dc[u] + bf_hi(v[u].z); run[6] = run[6] * dc[u] + bf_lo(v[u].w); run[7] = run[7] * dc[u] + bf_hi(v[u].w);
            }
        }
    }
}
__device__ __forceinline__ void ssd_pass2_item(const Ctx& F, int item) {
    const int g = item & 1, c = (item >> 1) & 31, b = item >> 6;
    const ldsp PV = F.lds;
    const int lane = F.lane, i16 = lane & 15, q4 = lane >> 4, w = F.wave, tl = 16 * w + i16;
    const size_t row = (size_t)b * SEQ + c * 128 + tl;
    bf16x8 cf[4];
#pragma unroll
    for (int ks = 0; ks < 4; ++ks) cf[ks] = *(const bf16x8*)(F.cfb() + ((size_t)(item * 8 + w) * 64 + lane) * 32 + 8 * ks);
    const int pdir = F.tid >> 8, pp = (F.tid >> 2) & 63, pqu = F.tid & 3;
    const bf16_t* psrc = F.st() + (((((size_t)(b * 32 + c) * 2 + pdir) * 8 + 4 * g) << 13) + pp * 128 + 32 * pqu);
    u32x4 pvn[4][4];
#pragma unroll
    for (int r = 0; r < 4; ++r)
#pragma unroll
        for (int k = 0; k < 4; ++k) pvn[r][k] = *(const u32x4*)(psrc + ((size_t)r << 13) + 8 * k);
    __syncthreads();
#pragma unroll
    for (int r = 0; r < 4; ++r)
#pragma unroll
        for (int k = 0; k < 4; ++k) *(LAS u32x4*)(PV + (2 * r + pdir) * (64 * PS) + pp * PS + (32 * pqu + 8 * k) * 2) = pvn[r][k];
    __syncthreads();
    f32x4 gy[4][4]; float ss = 0.f;
#pragma unroll
    for (int r = 0; r < 4; ++r) {
        u32x2 zraw[4], yraw[4];
#pragma unroll
        for (int pf = 0; pf < 4; ++pf) { const int pc = 256 * g + 64 * r + 16 * pf + 4 * q4; zraw[pf] = *(const u32x2*)(F.proj() + row * PW + C_Z + pc); yraw[pf] = *(const u32x2*)(F.yp() + row * 512 + pc); }
        const float ef = F.efb()[row * 16 + 4 * g + r], eb = F.efb()[row * 16 + 8 + 4 * g + r];
        const ldsp PVr = PV + 2 * r * (64 * PS);
        f32x4 yf[4], yb[4];
#pragma unroll
        for (int pf = 0; pf < 4; ++pf) { yf[pf] = (f32x4){0.f, 0.f, 0.f, 0.f}; yb[pf] = (f32x4){0.f, 0.f, 0.f, 0.f}; }
#pragma unroll
        for (int ks = 0; ks < 4; ++ks)
#pragma unroll
            for (int pf = 0; pf < 4; ++pf) {
                yf[pf] = mfma16(ld8(PVr + (16 * pf + i16) * PS + (32 * ks + 8 * q4) * 2), cf[ks], yf[pf]);
                yb[pf] = mfma16(ld8(PVr + 64 * PS + (16 * pf + i16) * PS + (32 * ks + 8 * q4) * 2), cf[ks], yb[pf]);
            }
#pragma unroll
        for (int pf = 0; pf < 4; ++pf) {
            const f32x4 y = (unpack4(yraw[pf]) + yf[pf] * ef + yb[pf] * eb) * unpack4(zraw[pf]);
            gy[r][pf] = y; ss += y.x * y.x + y.y * y.y + y.z * y.z + y.w * y.w;
        }
    }
    ss += __shfl_xor(ss, 16); ss += __shfl_xor(ss, 32);
    const float rinv = rsqrtf(ss * (1.f / 256.f) + EPS);
#pragma unroll
    for (int r = 0; r < 4; ++r)
#pragma unroll
        for (int pf = 0; pf < 4; ++pf) {
            const int pc = 256 * g + 64 * r + 16 * pf + 4 * q4;
            const f32x4 nw = *(const f32x4*)(F.ssd_norm_w + pc);
            *(u32x2*)(F.mix() + row * MIXP + 1024 + pc) = pack4(gy[r][pf] * rinv * nw);
        }
}

__device__ __forceinline__ void final_norm(const Ctx& F) {
    const int gw = F.bid * 8 + F.wave, NGW = F.G * 8, lane = F.lane;
    for (int m = gw; m < TOK; m += NGW) {
        const f32x4* rp = (const f32x4*)(F.rowss() + (size_t)m * 16); const f32x4 s4 = (rp[0] + rp[1]) + (rp[2] + rp[3]);
        const float r = rsqrtf(((s4.x + s4.y) + (s4.z + s4.w)) * (1.f / DM) + EPS);
        float* o = F.out + (size_t)m * DM;
#pragma unroll
        for (int j = 0; j < 4; ++j) { const f32x4 v = __builtin_nontemporal_load((const f32x4*)(o + 4 * lane + 256 * j)), ww = *(const f32x4*)(F.norm_out_w + 4 * lane + 256 * j); __builtin_nontemporal_store(v * r * ww, (f32x4*)(o + 4 * lane + 256 * j)); }
    }
}

#define XB_TMO      128
#define XB_XCNT(j)  (256  + 64 * (j))
#define XB_XSUB(j)  (1280 + 64 * (j))
#define XB_XGEN(j)  (2304 + 64 * (j))
#define XB_TOP      3328
#define XB_TOPGEN   3392
#define XCD_BAR_WORDS 3456
#define XB_SPIN_CAP (1u << 18)

__device__ __forceinline__ unsigned xb_ld(unsigned* p)              { return __hip_atomic_load(p, __ATOMIC_RELAXED, __HIP_MEMORY_SCOPE_AGENT); }
__device__ __forceinline__ unsigned xb_add(unsigned* p, unsigned v) { return __hip_atomic_fetch_add(p, v, __ATOMIC_RELAXED, __HIP_MEMORY_SCOPE_AGENT); }
__device__ __forceinline__ unsigned xb_xcc_id() { return (unsigned)__builtin_amdgcn_s_getreg((3 << 11) | 20) & 0xFu; }
#define XB_SPIN(cond, bar) do { unsigned _sp = 0; while (cond) { __builtin_amdgcn_s_sleep(1); \
    if ((++_sp & 255u) == 0u) { if (xb_ld(&(bar)[XB_TMO])) break; if (_sp > XB_SPIN_CAP) { atomicAdd(&(bar)[XB_TMO], 1u); break; } } } } while (0)

struct XcdBarrier {
    unsigned* bar; unsigned x;
    volatile LAS unsigned* st;
};

__device__ __forceinline__ XcdBarrier xcd_barrier_post(unsigned* bar, volatile LAS unsigned* st, int xb_tid) {
    XcdBarrier b; b.bar = bar; b.x = xb_xcc_id(); b.st = st;
    if (xb_tid == 0) (void)xb_add(&bar[XB_XCNT(b.x)], 1u);
    return b;
}
__device__ __forceinline__ void xcd_barrier_complete(unsigned* bar, unsigned x, unsigned& nloc, unsigned& nx) {
    const unsigned G = gridDim.x * gridDim.y * gridDim.z;
    unsigned sum, cnt, mine, sp = 0u;
    for (;;) {
        sum = 0u; cnt = 0u; mine = 0u;
#pragma unroll
        for (unsigned j = 0; j < 16; ++j) { const unsigned c = xb_ld(&bar[XB_XCNT(j)]); sum += c; cnt += (c > 0u) ? 1u : 0u; mine = (j == x) ? c : mine; }
        if (sum == G) break;
        __builtin_amdgcn_s_sleep(1);
        if ((++sp & 255u) == 0u) { if (xb_ld(&bar[XB_TMO])) break; if (sp > XB_SPIN_CAP) { atomicAdd(&bar[XB_TMO], 1u); break; } }
    }
    nloc = mine > 0u ? mine : 1u; nx = cnt > 0u ? cnt : 1u;
}

__device__ __forceinline__ void xcd_barrier(const XcdBarrier& b, int xb_tid) {
    asm volatile("s_waitcnt vmcnt(0)" ::: "memory");
    __syncthreads();
    if (xb_tid == 0) {
        unsigned* bar = b.bar;
        __builtin_amdgcn_s_waitcnt(0);
        unsigned nloc = b.st[0], nx = b.st[1];
        if (nloc == 0u) { xcd_barrier_complete(bar, b.x, nloc, nx); b.st[0] = nloc; b.st[1] = nx; }
        const unsigned old = xb_add(&bar[XB_XSUB(b.x)], 1u);
        const unsigned gen = old / nloc;
        if (old + 1u == (gen + 1u) * nloc) {
            __builtin_amdgcn_fence(__ATOMIC_RELEASE, "agent");
            asm volatile("s_waitcnt vmcnt(0)" ::: "memory");
            const unsigned og = xb_add(&bar[XB_TOP], 1u);
            const unsigned tg = og / nx;
            if (og + 1u == (tg + 1u) * nx) xb_add(&bar[XB_TOPGEN], 1u);
            else XB_SPIN(xb_ld(&bar[XB_TOPGEN]) == tg, bar);
            __builtin_amdgcn_fence(__ATOMIC_ACQUIRE, "agent");
            xb_add(&bar[XB_XGEN(b.x)], 1u);
            asm volatile("s_waitcnt vmcnt(0)" ::: "memory");
        } else {
            XB_SPIN(xb_ld(&bar[XB_XGEN(b.x)]) == gen, bar);
            __builtin_amdgcn_fence(__ATOMIC_ACQUIRE, "agent");
            asm volatile("s_waitcnt vmcnt(0)" ::: "memory");
        }
    }
    __syncthreads();
}

__global__ void __launch_bounds__(512, 2) hymba_fwd(Args args) {
    extern __shared__ __attribute__((aligned(16))) unsigned char lds_raw[];
    Ctx F;
    F.x = args.in[0]; F.mem = args.in[1]; F.norm_mem_w = args.in[2]; F.norm_in_w = args.in[3]; F.w_in = args.in[4]; F.attn_sink = args.in[5]; F.conv_w = args.in[6]; F.conv_b = args.in[7];
    F.dt_bias = args.in[8]; F.a_log = args.in[9]; F.d_skip = args.in[10]; F.ssd_norm_w = args.in[11]; F.w_mem_kv = args.in[12]; F.w_out = args.in[13]; F.norm_out_w = args.in[14];
    F.out = args.out; F.ws = args.ws;
    F.lds = (ldsp)lds_raw; F.tid = threadIdx.x; F.lane = F.tid & 63; F.wave = __builtin_amdgcn_readfirstlane(F.tid >> 6); F.G = gridDim.x; F.bid = blockIdx.x;
    const int lo = args.lo, hi = args.hi;
    cg::grid_group grid = cg::this_grid();
#define IN(k) (lo <= (k) && (k) < hi)
#define REFRESH() do { F.lane = lane_id_now(); F.tid = F.wave * 64 + F.lane; } while (0)
    if (F.tid == 0) { *(LAS u32x4*)(F.lds + LDS_XB) = (u32x4){0u, 0u, 0u, 0u}; }
    __syncthreads();
    XcdBarrier xbar; xbar.bar = (unsigned*)args.ws; xbar.x = 0; xbar.st = (volatile LAS unsigned*)(F.lds + LDS_XB);
    if (hi - lo > 1) xbar = xcd_barrier_post((unsigned*)args.ws, (volatile LAS unsigned*)(F.lds + LDS_XB), F.tid);
    if (lo < 0) grid.sync();
#define SEAM(k) do { if (IN(k) && IN((k) + 1)) xcd_barrier(xbar, F.tid); } while (0)
    if (IN(0)) { REFRESH(); phase0(F); }
    SEAM(0);
    if (IN(1)) {
        REFRESH();
        { pg8::Gemm g{F.hn(), F.win_t(), TOK, NPHYS, DM, HNP, HNP}; pg8::StaticOrder S; S.init(g.M, g.N, F.G, F.bid); EpiProj E{F.proj(), F.dt(), F.rope(), F.dt_bias}; pg8::gemm_phase(F.lds, g, S, E, F.wave); }
    }
    SEAM(1);
    if (IN(2)) {
        REFRESH();
        if (F.bid & 1) for (int sq = F.bid; sq < NBATCH * 4 * 4; sq += F.G) attn_window_seq(F, sq);
        for (int it = F.bid; it < NBATCH * 32 * 2; it += F.G) ssd_pass1_item(F, it);
        if (!(F.bid & 1)) for (int sq = F.bid; sq < NBATCH * 4 * 4; sq += F.G) attn_window_seq(F, sq);
    }
    SEAM(2);
    if (IN(3)) {
        REFRESH();
        if (F.G >= 128) {
            if (F.bid < 64) { pg8::Gemm g{F.memn(), F.wmem_t(), NBATCH * 256, 1024, 1024, HNP, HNP}; pg8::StaticOrder S; S.init(g.M, g.N, 64, F.bid); EpiMkv E{F.mkv()}; pg8::gemm_phase(F.lds, g, S, E, F.wave); }
            else ssd_scan(F, F.bid - 64, F.G - 64);
        } else {
            { pg8::Gemm g{F.memn(), F.wmem_t(), NBATCH * 256, 1024, 1024, HNP, HNP}; pg8::StaticOrder S; S.init(g.M, g.N, F.G, F.bid); EpiMkv E{F.mkv()}; pg8::gemm_phase(F.lds, g, S, E, F.wave); }
            ssd_scan(F, F.bid, F.G);
        }
    }
    SEAM(3);
    if (IN(4)) {
        REFRESH();
        if (F.bid & 1) for (int grp = F.bid; grp < NBATCH * 16; grp += F.G) for (int k = 0; k < 4; ++k) attn_mem_item(F, 4 * grp + k, k == 0);
        for (int it = F.bid; it < NBATCH * 32 * 2; it += F.G) ssd_pass2_item(F, it);
        if (!(F.bid & 1)) for (int grp = F.bid; grp < NBATCH * 16; grp += F.G) for (int k = 0; k < 4; ++k) attn_mem_item(F, 4 * grp + k, k == 0);
    }
    SEAM(4);
    if (IN(5)) { REFRESH(); __syncthreads(); pg8::Gemm g{F.mix(), F.wout_t(), TOK, DM, MIXW, MIXP, MIXP}; pg8::StaticOrder S; S.init(g.M, g.N, F.G, F.bid); EpiOut E{F.x, F.out, F.rowss()}; pg8::gemm_phase(F.lds, g, S, E, F.wave); }
    SEAM(5);
    if (IN(6)) { REFRESH(); final_norm(F); }
#undef IN
#undef SEAM
}

extern "C" void kernel_launch(void* const* d_in, const int* in_sizes, int n_in, void* d_out, int out_size, void* d_ws, size_t ws_size, hipStream_t stream) {
    static int grid = 0;
    if (grid == 0) {
        if (n_in != 15 || out_size != TOK * DM || ws_size < WS_END) { fprintf(stderr, "kernel_launch: unexpected shapes (n_in %d out %d ws %zu)\n", n_in, out_size, ws_size); grid = -1; return; }
        int dev = 0, cus = 0, per_cu = 0;
        (void)hipGetDevice(&dev); (void)hipDeviceGetAttribute(&cus, hipDeviceAttributeMultiprocessorCount, dev);
        if (hipFuncSetAttribute((const void*)hymba_fwd, hipFuncAttributeMaxDynamicSharedMemorySize, LDS_BYTES) != hipSuccess) { fprintf(stderr, "kernel_launch: hipFuncSetAttribute failed\n"); grid = -1; return; }
        if (hipOccupancyMaxActiveBlocksPerMultiprocessor(&per_cu, (const void*)hymba_fwd, 512, LDS_BYTES) != hipSuccess || per_cu < 1) { fprintf(stderr, "kernel_launch: occupancy query says %d\n", per_cu); per_cu = 1; }
        (void)hipGetLastError();
        grid = cus > 0 ? cus : 256;
    }
    if (grid < 0) return;
    Args a{};
    for (int i = 0; i < 15; ++i) a.in[i] = (const float*)d_in[i];
    a.out = (float*)d_out; a.ws = (unsigned char*)d_ws;
    (void)hipMemsetAsync(d_ws, 0, 16384, stream);
#if MK_ONE_LAUNCH
    a.lo = 0; a.hi = NPHASE;
    void* kargs[] = {&a};
    hipError_t e = hipLaunchCooperativeKernel((const void*)hymba_fwd, dim3(grid), dim3(512), kargs, LDS_BYTES, stream);
    if (e != hipSuccess) fprintf(stderr, "kernel_launch: cooperative launch failed: %s (grid %d)\n", hipGetErrorString(e), grid);
#else
    for (int k = 0; k < NPHASE; ++k) { a.lo = k; a.hi = k + 1; hipLaunchKernelGGL(hymba_fwd, dim3(grid), dim3(512), LDS_BYTES, stream, a); }
#endif
}
```

```cpp
#include <hip/hip_runtime.h>
#include <hip/hip_cooperative_groups.h>
#include <cstdio>
#include <cstdint>
namespace cg = cooperative_groups;

#ifndef MK_ONE_LAUNCH
#define MK_ONE_LAUNCH 1
#endif

#define LAS __attribute__((address_space(3)))
typedef unsigned short bf16_t;
typedef short bf16x8 __attribute__((ext_vector_type(8)));
typedef short s16x4 __attribute__((ext_vector_type(4)));
typedef float f32x4 __attribute__((ext_vector_type(4)));
typedef float f32x2 __attribute__((ext_vector_type(2)));
typedef unsigned u32x4 __attribute__((ext_vector_type(4)));
typedef unsigned u32x2 __attribute__((ext_vector_type(2)));
typedef LAS unsigned char* ldsp;

constexpr int SEQ = 4096, NBATCH = 16, TOK = SEQ * NBATCH, DM = 1024;
constexpr int INW = 5136, NPHYS = 5376, PW = 5184;
constexpr int HNP = 1088, MIXP = 2112;
constexpr int C_Q = 0, C_K = 1024, C_V = 1280, C_G = 1536, C_Z = 2560, C_X = 3072, C_QM = 4096, C_GM = 4608;
constexpr int MIXW = 2048;
constexpr float LOG2E = 1.4426950408889634f;
constexpr float EPS = 1e-6f;
constexpr int NPHASE = 7;

constexpr size_t MiB = (size_t)1 << 20;
constexpr size_t WS_ROWSS = 956 * MiB, WS_ROPE = 1 * MiB, WS_WIN = 2 * MiB, WS_WOUT = 14 * MiB, WS_WMEM = 19 * MiB, WS_MEMN = 22 * MiB,
                 WS_MKV = 31 * MiB, WS_DT = 39 * MiB, WS_DEC = 43 * MiB, WS_PROJ = 44 * MiB, WS_MIX = 692 * MiB, WS_END = 960 * MiB;

constexpr int LDS_BYTES = 155648 + 16;
constexpr int LDS_XB = 155648;

__device__ __forceinline__ unsigned cvt_pk(float lo, float hi) { unsigned r; asm volatile("v_cvt_pk_bf16_f32 %0, %1, %2" : "=v"(r) : "v"(lo), "v"(hi)); return r; }
typedef __bf16 bf16x2_t __attribute__((ext_vector_type(2)));
__device__ __forceinline__ unsigned cvt_pk_c(float lo, float hi) { const f32x2 v = {lo, hi}; return __builtin_bit_cast(unsigned, __builtin_convertvector(v, bf16x2_t)); }
__device__ __forceinline__ float bf_lo(unsigned u) { return __uint_as_float(u << 16); }
__device__ __forceinline__ float bf_hi(unsigned u) { return __uint_as_float(u & 0xffff0000u); }
__device__ __forceinline__ f32x4 unpack4(u32x2 v) { return (f32x4){bf_lo(v.x), bf_hi(v.x), bf_lo(v.y), bf_hi(v.y)}; }
__device__ __forceinline__ u32x2 pack4(f32x4 v) { return (u32x2){cvt_pk_c(v.x, v.y), cvt_pk_c(v.z, v.w)}; }
__device__ __forceinline__ float silu_f(float x) { return x * __builtin_amdgcn_rcpf(1.f + __expf(-x)); }
__device__ __forceinline__ f32x4 silu4(f32x4 v) { return (f32x4){silu_f(v.x), silu_f(v.y), silu_f(v.z), silu_f(v.w)}; }
__device__ __forceinline__ float softplus_f(float x) { return x > 15.f ? x : __logf(1.f + __expf(x)); }
__device__ __forceinline__ float ex2(float x) { return __builtin_amdgcn_exp2f(x); }
typedef short v4i16_t __attribute__((ext_vector_type(4)));
__device__ __forceinline__ s16x4 vtr(ldsp p) { return __builtin_bit_cast(s16x4, __builtin_amdgcn_ds_read_tr16_b64_v4i16((LAS v4i16_t*)p)); }
__device__ __forceinline__ bf16x8 cat8(s16x4 a, s16x4 b) { return (bf16x8){a[0], a[1], a[2], a[3], b[0], b[1], b[2], b[3]}; }
__device__ __forceinline__ bf16x8 ld8(ldsp p) { return *(const LAS bf16x8*)p; }
__device__ __forceinline__ f32x4 mfma16(bf16x8 a, bf16x8 b, f32x4 c) { return __builtin_amdgcn_mfma_f32_16x16x32_bf16(a, b, c, 0, 0, 0); }
__device__ __forceinline__ bf16x8 packfrag(f32x4 a, f32x4 b) { u32x4 r = {cvt_pk_c(a.x, a.y), cvt_pk_c(a.z, a.w), cvt_pk_c(b.x, b.y), cvt_pk_c(b.z, b.w)}; return __builtin_bit_cast(bf16x8, r); }

__device__ __forceinline__ f32x4 zero4() { f32x4 z; asm volatile("v_mov_b32 %0, 0\n\tv_mov_b32 %1, 0\n\tv_mov_b32 %2, 0\n\tv_mov_b32 %3, 0" : "=v"(z.x), "=v"(z.y), "=v"(z.z), "=v"(z.w)); return z; }
__device__ __forceinline__ int lane_id_now() { int l; asm volatile("v_mbcnt_lo_u32_b32 %0, -1, 0\n\tv_mbcnt_hi_u32_b32 %0, -1, %0" : "=v"(l)); return l; }
__host__ __device__ __forceinline__ int perm_plain(int c) { const int bj = c >> 7, wc = (c >> 5) & 3, n = (c >> 4) & 1, fq = (c >> 2) & 3, i = c & 3; return 128 * bj + 32 * wc + 8 * fq + 4 * n + i; }
__host__ __device__ __forceinline__ int perm_rot(int c) { const int bj = c >> 7, wc = (c >> 5) & 3, n = (c >> 4) & 1, fq = (c >> 2) & 3, i = c & 3; return 64 * wc + 32 * bj + 8 * fq + 4 * n + i; }

namespace pg8 {
constexpr int BM = 256, BK = 64, HALF = 128, HTB = HALF * BK * 2, STAGE_BYTES = 8 * HTB, NXCD = 8, WGM = 8;
__host__ __device__ __forceinline__ int lds_byte(int r, int c) { const int st = (r >> 4) * 2 + (c >> 5), rr = r & 15, cc = c & 31, ob = rr * 64 + cc * 2; return st * 1024 + (ob ^ (((ob >> 9) & 1) << 5)); }
__host__ __device__ __forceinline__ void stage_rc(int b, int& R, int& C) { const int st = b / 1024, sb = b % 1024, swz = sb ^ (((sb >> 9) & 1) << 5); R = (st >> 1) * 16 + swz / 64; C = (st & 1) * 32 + (swz % 64) / 2; }
struct Unit { int pm, pn; };
struct Gemm { const bf16_t* A; const bf16_t* Bt; int M, N, K, lda, ldb; };
struct StaticOrder {
    int nM, nN, nwg, G, c;
    __device__ void init(int M, int N, int G_, int c_) { nM = M / BM; nN = N / BM; nwg = nM * nN; G = G_; c = c_; }
    __device__ bool next(int i, Unit& u) const {
        const long L = (long)i * G + c; if (L >= nwg) return false;
        int wgid = (int)L; { const int q = nwg / NXCD, r = nwg % NXCD, xcd = wgid % NXCD, off = wgid / NXCD; wgid = (xcd < r ? xcd * (q + 1) : r * (q + 1) + (xcd - r) * q) + off; }
        const int nig = WGM * nN, gid = wgid / nig, fm = gid * WGM, gsz = (nM - fm) < WGM ? (nM - fm) : WGM;
        u.pm = fm + ((wgid % nig) % gsz); u.pn = (wgid % nig) / gsz; return true;
    }
};
template <class Epi, class Sched>
__device__ __forceinline__ void gemm_phase(ldsp lds, const Gemm g, const Sched& S, const Epi& E, int wave_id) {
    const int lane = lane_id_now(), wid = wave_id, tid = wid * 64 + lane, wr = wid >> 2, wc = wid & 3, fr = lane & 15, fq = lane >> 4;
    const int K = g.K, nt = K / BK;
    unsigned voffA[2], voffB[2];
#pragma unroll
    for (int i = 0; i < 2; ++i) { int R, C; stage_rc(tid * 16 + i * 8192, R, C); voffA[i] = (unsigned)(R * g.lda + C) * 2u; voffB[i] = (unsigned)(R * g.ldb + C) * 2u; }
    const size_t kstep = (size_t)(BK * 2);
    const size_t hstep = (size_t)HALF * g.lda * 2, hstepB = (size_t)HALF * g.ldb * 2;
    const size_t tstep = 2 * hstep, tstepB = 2 * hstepB;
    const unsigned ldsw = (unsigned)wid * 1024u;
    const int aoff = lds_byte(wr * 64 + fr, fq * 8), boff = lds_byte(wc * 32 + fr, fq * 8);
#define PG8_SA(b, h) (((b) * 2 + (h)) * HTB)
#define PG8_SB(b, h) ((4 + (b) * 2 + (h)) * HTB)
#define PG8_STAGE(bufoff, gbase, voff) do { _Pragma("unroll") for (int _i = 0; _i < 2; ++_i) \
        __builtin_amdgcn_global_load_lds((const unsigned*)((const char*)(gbase) + (voff)[_i]), (LAS unsigned*)(lds + (bufoff) + ldsw + _i * 8192), 16, 0, 0); } while (0)
#define PG8_LDA(dst, b, h) do { _Pragma("unroll") for (int m = 0; m < 4; ++m) _Pragma("unroll") for (int k = 0; k < 2; ++k) dst[m][k] = *(const LAS bf16x8*)(lds + PG8_SA(b, h) + aoff + m * 2048 + k * 1024); } while (0)
#define PG8_LDB(dst, b, h) do { _Pragma("unroll") for (int n = 0; n < 2; ++n) _Pragma("unroll") for (int k = 0; k < 2; ++k) dst[n][k] = *(const LAS bf16x8*)(lds + PG8_SB(b, h) + boff + n * 2048 + k * 1024); } while (0)
#define PG8_MMA(ai, bj, At, Bt) do { __builtin_amdgcn_s_setprio(1); _Pragma("unroll") for (int m = 0; m < 4; ++m) _Pragma("unroll") for (int n = 0; n < 2; ++n) _Pragma("unroll") for (int k = 0; k < 2; ++k) \
        acc[ai][bj][m][n] = __builtin_amdgcn_mfma_f32_16x16x32_bf16(Bt[n][k], At[m][k], acc[ai][bj][m][n], 0, 0, 0); __builtin_amdgcn_s_setprio(0); } while (0)
#define PG8_WAIT_V(n) asm volatile("s_waitcnt vmcnt(" #n ")" ::: "memory")
#define PG8_WAIT_L(n) asm volatile("s_waitcnt lgkmcnt(" #n ")" ::: "memory")
#define PG8_BAR __builtin_amdgcn_s_barrier()
#define PG8_SCHED __builtin_amdgcn_sched_barrier(0)
    Unit cur, nxt; int ui = 0;
    if (!S.next(0, cur)) return;
    f32x4 acc[2][2][4][2];
#pragma unroll
    for (int a = 0; a < 2; ++a)
#pragma unroll
        for (int b = 0; b < 2; ++b)
#pragma unroll
            for (int m = 0; m < 4; ++m)
#pragma unroll
                for (int n = 0; n < 2; ++n) acc[a][b][m][n] = (f32x4){0.f, 0.f, 0.f, 0.f};
    bf16x8 At[4][2], B0[2][2], B1[2][2];
    const char* cA = (const char*)g.A + (size_t)cur.pm * tstep; const char* cB = (const char*)g.Bt + (size_t)cur.pn * tstepB;
    PG8_STAGE(PG8_SB(0, 0), cB, voffB); PG8_STAGE(PG8_SA(0, 0), cA, voffA); PG8_STAGE(PG8_SB(0, 1), cB + hstepB, voffB); PG8_STAGE(PG8_SA(0, 1), cA + hstep, voffA);
    if (wr == 1) PG8_BAR;
    PG8_WAIT_V(4); PG8_BAR;
    PG8_STAGE(PG8_SB(1, 0), cB + kstep, voffB); PG8_STAGE(PG8_SA(1, 0), cA + kstep, voffA); PG8_STAGE(PG8_SB(1, 1), cB + hstepB + kstep, voffB);
    PG8_WAIT_V(6); PG8_BAR;
    for (;;) {
        const bool has_next = S.next(ui + 1, nxt);
        const char* nA = has_next ? (const char*)g.A + (size_t)nxt.pm * tstep : cA; const char* nB = has_next ? (const char*)g.Bt + (size_t)nxt.pn * tstepB : cB;
        for (int t = 0; t < nt; t += 2) {
            const bool last = (t == nt - 2);
            const char* a1 = cA + (size_t)(t + 1) * kstep;
            const char* a2 = last ? nA : cA + (size_t)(t + 2) * kstep; const char* b2 = last ? nB : cB + (size_t)(t + 2) * kstep;
            const char* a3 = a2 + kstep; const char* b3 = b2 + kstep;
            PG8_LDB(B0, 0, 0); PG8_SCHED; PG8_LDA(At, 0, 0); PG8_STAGE(PG8_SA(1, 1), a1 + hstep, voffA);
            PG8_WAIT_L(8); PG8_BAR; PG8_WAIT_L(0); PG8_MMA(0, 0, At, B0); PG8_BAR; PG8_SCHED;
            PG8_LDB(B1, 0, 1); PG8_STAGE(PG8_SB(0, 0), b2, voffB);
            PG8_BAR; PG8_WAIT_L(0); PG8_MMA(0, 1, At, B1); PG8_BAR;
            PG8_LDA(At, 0, 1); PG8_STAGE(PG8_SA(0, 0), a2, voffA);
            PG8_BAR; PG8_WAIT_L(0); PG8_MMA(1, 0, At, B0); PG8_BAR; PG8_SCHED;
            PG8_STAGE(PG8_SB(0, 1), b2 + hstepB, voffB);
            PG8_WAIT_V(6); PG8_BAR; PG8_MMA(1, 1, At, B1); PG8_BAR;
            PG8_LDB(B0, 1, 0); PG8_SCHED; PG8_LDA(At, 1, 0); PG8_STAGE(PG8_SA(0, 1), a2 + hstep, voffA);
            PG8_WAIT_L(8); PG8_BAR; PG8_WAIT_L(0); PG8_MMA(0, 0, At, B0); PG8_BAR; PG8_SCHED;
            PG8_LDB(B1, 1, 1); PG8_STAGE(PG8_SB(1, 0), b3, voffB);
            PG8_BAR; PG8_WAIT_L(0); PG8_MMA(0, 1, At, B1); PG8_BAR;
            PG8_LDA(At, 1, 1); PG8_STAGE(PG8_SA(1, 0), a3, voffA);
            PG8_BAR; PG8_WAIT_L(0); PG8_MMA(1, 0, At, B0); PG8_BAR; PG8_SCHED;
            PG8_STAGE(PG8_SB(1, 1), b3 + hstepB, voffB);
            PG8_WAIT_V(6); PG8_BAR; PG8_MMA(1, 1, At, B1); PG8_BAR;
        }
        E(acc, cur, wr, wc, fr, fq);
        if (!has_next) break;
#pragma unroll
        for (int a = 0; a < 2; ++a)
#pragma unroll
            for (int b = 0; b < 2; ++b)
#pragma unroll
                for (int m = 0; m < 4; ++m)
#pragma unroll
                    for (int n = 0; n < 2; ++n) acc[a][b][m][n] = (f32x4){0.f, 0.f, 0.f, 0.f};
        cur = nxt; cA = nA; cB = nB; ++ui;
    }
    PG8_WAIT_V(0);
    if (wr == 0) PG8_BAR;
    PG8_BAR;
#undef PG8_SA
#undef PG8_SB
#undef PG8_STAGE
#undef PG8_LDA
#undef PG8_LDB
#undef PG8_MMA
#undef PG8_WAIT_V
#undef PG8_WAIT_L
#undef PG8_BAR
#undef PG8_SCHED
}
}

struct EpiProj {
    bf16_t* P; float* DT; const float* rope; const float* dt_bias;
    __device__ __forceinline__ void operator()(const f32x4 (&acc)[2][2][4][2], const pg8::Unit& u, int wr, int wc, int fr, int fq) const {
        const int row0 = u.pm * 256 + wr * 64 + fr, pn = u.pn;
        if (pn < 5) {
            const float sc = pn < 4 ? 0.125f * LOG2E : 1.f;
            const int col = pn * 256 + 64 * wc + 8 * fq;
#pragma unroll
            for (int ai = 0; ai < 2; ++ai)
#pragma unroll
                for (int m = 0; m < 4; ++m) {
                    const int row = row0 + ai * 128 + m * 16, pos = row & (SEQ - 1);
                    const f32x4* cp = (const f32x4*)(rope + pos * 32 + 8 * fq); const f32x4* sp = (const f32x4*)(rope + SEQ * 32 + pos * 32 + 8 * fq);
                    f32x4 o1[2], o2[2];
#pragma unroll
                    for (int n = 0; n < 2; ++n) { const f32x4 c = cp[n], s = sp[n], t1 = acc[ai][0][m][n], t2 = acc[ai][1][m][n]; o1[n] = (t1 * c - t2 * s) * sc; o2[n] = (t1 * s + t2 * c) * sc; }
                    bf16_t* dst = P + (size_t)row * PW + col;
                    __builtin_nontemporal_store((u32x4){cvt_pk(o1[0].x, o1[0].y), cvt_pk(o1[0].z, o1[0].w), cvt_pk(o1[1].x, o1[1].y), cvt_pk(o1[1].z, o1[1].w)}, (u32x4*)dst);
                    __builtin_nontemporal_store((u32x4){cvt_pk(o2[0].x, o2[0].y), cvt_pk(o2[0].z, o2[0].w), cvt_pk(o2[1].x, o2[1].y), cvt_pk(o2[1].z, o2[1].w)}, (u32x4*)(dst + 32));
                }
        } else if (pn < 20) {
            const bool do_silu = (pn >= 6 && pn < 12) || pn >= 18;
            const float sc = (pn == 16 || pn == 17) ? 0.08838834764831845f * LOG2E : 1.f;
            const int col = pn * 256 + 32 * wc + 8 * fq;
#pragma unroll
            for (int ai = 0; ai < 2; ++ai)
#pragma unroll
                for (int m = 0; m < 4; ++m) {
                    const int row = row0 + ai * 128 + m * 16;
#pragma unroll
                    for (int bj = 0; bj < 2; ++bj) {
                        f32x4 v0 = acc[ai][bj][m][0], v1 = acc[ai][bj][m][1];
                        if (do_silu) { v0 = silu4(v0); v1 = silu4(v1); } else { v0 = v0 * sc; v1 = v1 * sc; }
                        __builtin_nontemporal_store((u32x4){cvt_pk(v0.x, v0.y), cvt_pk(v0.z, v0.w), cvt_pk(v1.x, v1.y), cvt_pk(v1.z, v1.w)}, (u32x4*)(P + (size_t)row * PW + col + 128 * bj));
                    }
                }
        } else {
            if (wc == 0 && fq < 2) {
                const f32x4 bb0 = *(const f32x4*)(dt_bias + 8 * fq), bb1 = *(const f32x4*)(dt_bias + 8 * fq + 4);
#pragma unroll
                for (int ai = 0; ai < 2; ++ai)
#pragma unroll
                    for (int m = 0; m < 4; ++m) {
                        const int row = row0 + ai * 128 + m * 16;
#pragma unroll
                        for (int n = 0; n < 2; ++n) {
                            const int j0 = 8 * fq + 4 * n; const f32x4 v = acc[ai][0][m][n] + (n ? bb1 : bb0);
                            *(f32x4*)(DT + (size_t)row * 16 + j0) = (f32x4){softplus_f(v.x), softplus_f(v.y), softplus_f(v.z), softplus_f(v.w)};
                        }
                    }
            }
        }
    }
};
struct EpiMkv {
    bf16_t* O;
    __device__ __forceinline__ void operator()(const f32x4 (&acc)[2][2][4][2], const pg8::Unit& u, int wr, int wc, int fr, int fq) const {
        const int row0 = u.pm * 256 + wr * 64 + fr, col = u.pn * 256 + 32 * wc + 8 * fq;
#pragma unroll
        for (int ai = 0; ai < 2; ++ai)
#pragma unroll
            for (int m = 0; m < 4; ++m) {
                const int row = row0 + ai * 128 + m * 16;
#pragma unroll
                for (int bj = 0; bj < 2; ++bj) { const f32x4 v0 = acc[ai][bj][m][0], v1 = acc[ai][bj][m][1];
                    *(u32x4*)(O + (size_t)row * 1024 + col + 128 * bj) = (u32x4){cvt_pk(v0.x, v0.y), cvt_pk(v0.z, v0.w), cvt_pk(v1.x, v1.y), cvt_pk(v1.z, v1.w)}; }
            }
    }
};
struct EpiOut {
    const float* x; float* out; float* rowss;
    __device__ __forceinline__ void operator()(const f32x4 (&acc)[2][2][4][2], const pg8::Unit& u, int wr, int wc, int fr, int fq) const {
        const int row0 = u.pm * 256 + wr * 64 + fr, col = u.pn * 256 + 32 * wc + 8 * fq;
#pragma unroll
        for (int ai = 0; ai < 2; ++ai) {
            f32x4 xv[4][2][2];
#pragma unroll
            for (int m = 0; m < 4; ++m)
#pragma unroll
                for (int bj = 0; bj < 2; ++bj) {
                    const size_t o = (size_t)(row0 + ai * 128 + m * 16) * DM + col + 128 * bj;
                    xv[m][bj][0] = __builtin_nontemporal_load((const f32x4*)(x + o)); xv[m][bj][1] = __builtin_nontemporal_load((const f32x4*)(x + o + 4));
                }
#pragma unroll
            for (int m = 0; m < 4; ++m) {
                const int row = row0 + ai * 128 + m * 16; float ss = 0.f;
#pragma unroll
                for (int bj = 0; bj < 2; ++bj) {
                    const size_t o = (size_t)row * DM + col + 128 * bj;
                    const f32x4 h0 = xv[m][bj][0] + acc[ai][bj][m][0], h1 = xv[m][bj][1] + acc[ai][bj][m][1];
                    *(f32x4*)(out + o) = h0; *(f32x4*)(out + o + 4) = h1;
                    ss += h0.x * h0.x + h0.y * h0.y + h0.z * h0.z + h0.w * h0.w + h1.x * h1.x + h1.y * h1.y + h1.z * h1.z + h1.w * h1.w;
                }
                ss += __shfl_xor(ss, 16); ss += __shfl_xor(ss, 32);
                if (fq == 0) rowss[(size_t)row * 16 + u.pn * 4 + wc] = ss;
            }
        }
    }
};

struct Args { const float* in[15]; float* out; unsigned char* ws; int lo, hi; };
struct Ctx {
    const float *x, *mem, *norm_mem_w, *norm_in_w, *w_in, *attn_sink, *conv_w, *conv_b, *dt_bias, *a_log, *d_skip, *ssd_norm_w, *w_mem_kv, *w_out, *norm_out_w;
    float* out; unsigned char* ws;
    __device__ __forceinline__ float* rowss() const { return (float*)(ws + WS_ROWSS); }
    __device__ __forceinline__ float* rope() const { return (float*)(ws + WS_ROPE); }
    __device__ __forceinline__ bf16_t* win_t() const { return (bf16_t*)(ws + WS_WIN); }
    __device__ __forceinline__ bf16_t* wout_t() const { return (bf16_t*)(ws + WS_WOUT); }
    __device__ __forceinline__ bf16_t* wmem_t() const { return (bf16_t*)(ws + WS_WMEM); }
    __device__ __forceinline__ bf16_t* memn() const { return (bf16_t*)(ws + WS_MEMN); }
    __device__ __forceinline__ bf16_t* mkv() const { return (bf16_t*)(ws + WS_MKV); }
    __device__ __forceinline__ float* dt() const { return (float*)(ws + WS_DT); }
    __device__ __forceinline__ float* dec() const { return (float*)(ws + WS_DEC); }
    __device__ __forceinline__ bf16_t* proj() const { return (bf16_t*)(ws + WS_PROJ); }
    __device__ __forceinline__ bf16_t* mix() const { return (bf16_t*)(ws + WS_MIX); }
    __device__ __forceinline__ bf16_t* hn() const { return (bf16_t*)((unsigned char*)out); }
    __device__ __forceinline__ bf16_t* st() const { return (bf16_t*)((unsigned char*)out); }
    __device__ __forceinline__ bf16_t* yp() const { return (bf16_t*)((unsigned char*)out + 128 * MiB); }
    __device__ __forceinline__ bf16_t* cfb() const { return (bf16_t*)((unsigned char*)out + 192 * MiB); }
    __device__ __forceinline__ float* efb() const { return (float*)((unsigned char*)out + 224 * MiB); }
    ldsp lds; int tid, lane, wave, G, bid;
};

__device__ __forceinline__ void rms_row_bf16(const float* xr, const float* w, bf16_t* o, int lane) {
    f32x4 v[4]; float ss = 0.f;
#pragma unroll
    for (int j = 0; j < 4; ++j) { v[j] = __builtin_nontemporal_load((const f32x4*)(xr + 4 * lane + 256 * j)); ss += v[j].x * v[j].x + v[j].y * v[j].y + v[j].z * v[j].z + v[j].w * v[j].w; }
#pragma unroll
    for (int off = 1; off < 64; off <<= 1) ss += __shfl_xor(ss, off);
    const float r = rsqrtf(ss * (1.f / DM) + EPS);
#pragma unroll
    for (int j = 0; j < 4; ++j) { const f32x4 ww = *(const f32x4*)(w + 4 * lane + 256 * j); *(u32x2*)(o + 4 * lane + 256 * j) = pack4(v[j] * r * ww); }
}
template <int MODE>
__device__ __forceinline__ void transpose_w(const Ctx& F, const float* W, int K, int NS, bf16_t* Bt, int NP, int ldb) {
    const int nitems = NP * (K / 8);
    for (int it = F.bid * 512 + F.tid; it < nitems; it += F.G * 512) {
        const int n = it % NP, kg = it / NP, tile = n >> 8, cph = n & 255; int src;
        if (MODE == 0) {
            if (tile < 5) src = tile * 256 + perm_rot(cph);
            else if (tile < 20) { src = tile * 256 + perm_plain(cph); if (src >= 4096) src += 16; }
            else { const int l = perm_plain(cph); src = l < 16 ? 4096 + l : -1; }
        } else src = tile * 256 + perm_plain(cph);
        float v[8];
#pragma unroll
        for (int j = 0; j < 8; ++j) v[j] = src >= 0 ? W[(size_t)(kg * 8 + j) * NS + src] : 0.f;
        *(u32x4*)(Bt + (size_t)n * ldb + kg * 8) = (u32x4){cvt_pk(v[0], v[1]), cvt_pk(v[2], v[3]), cvt_pk(v[4], v[5]), cvt_pk(v[6], v[7])};
    }
}
__device__ __forceinline__ void phase0(const Ctx& F) {
    const int gt = F.bid * 512 + F.tid, NT = F.G * 512;
    for (int i = gt; i < SEQ * 32; i += NT) {
        const int pos = i >> 5, f = i & 31;
        const float inv = 1.0f / exp2f((float)f * (13.287712379549449f / 32.f));
        const float ang = (float)pos * inv;
        const double rev = (double)ang * 0.15915494309189535; const double fr = rev - __builtin_rint(rev);
        const float r = (float)(fr * 6.283185307179586);
        F.rope()[i] = __cosf(r); F.rope()[SEQ * 32 + i] = __sinf(r);
    }
    transpose_w<0>(F, F.w_in, DM, INW, F.win_t(), NPHYS, HNP);
    transpose_w<1>(F, F.w_out, MIXW, DM, F.wout_t(), DM, MIXP);
    transpose_w<1>(F, F.w_mem_kv, DM, DM, F.wmem_t(), DM, HNP);
    const int gw = F.bid * 8 + F.wave, NGW = F.G * 8;
    for (int m = gw; m < NBATCH * 256; m += NGW) rms_row_bf16(F.mem + (size_t)m * DM, F.norm_mem_w, F.memn() + (size_t)m * HNP, F.lane);
    for (int m = gw; m < TOK; m += NGW) rms_row_bf16(F.x + (size_t)m * DM, F.norm_in_w, F.hn() + (size_t)m * HNP, F.lane);
}

template <int DH, int NQF>
__device__ __forceinline__ void attn_tile(ldsp Kt, int KS, ldsp Vt, int VS, const bf16x8 (&qf)[NQF][DH / 32], f32x4 (&o)[DH / 16][NQF], float (&m)[NQF], float (&lp)[NQF], int maskmode, int lane, int qoff = 0) {
    const int i16 = lane & 15, q4 = lane >> 4;
    f32x4 st[4][NQF];
#pragma unroll
    for (int kf = 0; kf < 4; ++kf)
#pragma unroll
        for (int q = 0; q < NQF; ++q) st[kf][q] = (f32x4){0.f, 0.f, 0.f, 0.f};
#pragma unroll
    for (int ks = 0; ks < DH / 32; ++ks)
#pragma unroll
        for (int kf = 0; kf < 4; ++kf) {
            const bf16x8 ka = ld8(Kt + (16 * kf + i16) * KS + (32 * ks + 8 * q4) * 2);
#pragma unroll
            for (int q = 0; q < NQF; ++q) st[kf][q] = mfma16(ka, qf[q][ks], st[kf][q]);
            if (DH > 64 && kf == 3) __builtin_amdgcn_sched_barrier(0);
        }
    if (maskmode) {
        int zb; asm volatile("v_mov_b32 %0, 0" : "=v"(zb));
        const int base = (maskmode == 1 ? 4 * q4 - i16 - qoff : i16 + qoff - 4 * q4) + zb;
#pragma unroll
        for (int kf = 0; kf < 4; ++kf)
#pragma unroll
            for (int q = 0; q < NQF; ++q)
#pragma unroll
                for (int r = 0; r < 4; ++r) { const int off = 16 * (kf - q) + r; const bool bad = (maskmode == 1 ? base + off : base - off) < 0; if (bad) st[kf][q][r] = -INFINITY; }
    }
#pragma unroll
    for (int q = 0; q < NQF; ++q) {
        float mx = st[0][q][0];
#pragma unroll
        for (int kf = 0; kf < 4; ++kf)
#pragma unroll
            for (int r = 0; r < 4; ++r) mx = fmaxf(mx, st[kf][q][r]);
        if (__builtin_amdgcn_ballot_w64(mx > m[q] + 8.f) != 0ull) {
            mx = fmaxf(mx, __shfl_xor(mx, 16)); mx = fmaxf(mx, __shfl_xor(mx, 32));
            const bool grow = mx > m[q] + 8.f;
            const float mn2 = grow ? mx : m[q], alpha = ex2(m[q] - mn2); m[q] = mn2;
            lp[q] = lp[q] * alpha;
#pragma unroll
            for (int d = 0; d < DH / 16; ++d) o[d][q] = o[d][q] * alpha;
        }
        const float mn = m[q];
        float ps = 0.f;
#pragma unroll
        for (int kf = 0; kf < 4; ++kf)
#pragma unroll
            for (int r = 0; r < 4; ++r) { const float p = ex2(st[kf][q][r] - mn); st[kf][q][r] = p; ps += p; }
        lp[q] += ps;
    }
#pragma unroll
    for (int kp = 0; kp < 2; ++kp) {
        bf16x8 pk[NQF];
#pragma unroll
        for (int q = 0; q < NQF; ++q) pk[q] = packfrag(st[2 * kp][q], st[2 * kp + 1][q]);
#pragma unroll
        for (int d = 0; d < DH / 16; ++d) {
            ldsp va = Vt + (32 * kp + 4 * q4 + (i16 >> 2)) * VS + (16 * d + 4 * (i16 & 3)) * 2;
            const bf16x8 vf = cat8(vtr(va), vtr(va + 16 * VS));
#pragma unroll
            for (int q = 0; q < NQF; ++q) o[d][q] = mfma16(vf, pk[q], o[d][q]);
            if (DH > 64 && (d & 3) == 3) __builtin_amdgcn_sched_barrier(0);
        }
    }
}

__device__ __forceinline__ void ring_stage_block(const Ctx& F, const bf16_t* kvbase, int keyblock) {
    constexpr int KS = 144, VS = 160; const ldsp Kb = F.lds + (keyblock & 511) * KS, Vb = F.lds + 512 * KS + (keyblock & 511) * VS;
    const bf16_t* src0 = kvbase + (size_t)keyblock * PW;
    for (int wi = F.wave; wi < 18; wi += 8) {
        const int slot = wi * 64 + F.lane, row = slot / 9, ch = slot - row * 9;
        __builtin_amdgcn_global_load_lds((const unsigned*)(src0 + (size_t)row * PW + C_K + 8 * (ch > 7 ? 7 : ch)), (LAS unsigned*)(Kb + wi * 1024), 16, 0, 0);
    }
    for (int wi = F.wave; wi < 20; wi += 8) {
        const int slot = wi * 64 + F.lane, row = slot / 10, ch = slot - row * 10;
        __builtin_amdgcn_global_load_lds((const unsigned*)(src0 + (size_t)row * PW + C_V + 8 * (ch > 7 ? 7 : ch)), (LAS unsigned*)(Vb + wi * 1024), 16, 0, 0);
    }
}
__device__ __forceinline__ void attn_window_seq(const Ctx& F, int sq) {
    constexpr int KS = 144, VS = 160; const ldsp Ki = F.lds, Vi = F.lds + 512 * KS;
    const int sidx = sq >> 2, b = sidx >> 2, kvh = sidx & 3, i0 = 8 * (sq & 3);
    const int w = F.wave, lane = F.lane, i16 = lane & 15, q4 = lane >> 4, hq = 4 * kvh + (w >> 1);
    const bf16_t* kvbase = F.proj() + (size_t)b * SEQ * PW + 64 * kvh;
    __syncthreads();
    for (int t = 0; t < 3; ++t) { const int kb = 128 * (i0 - 1 + t); if (kb >= 0 && kb < SEQ) ring_stage_block(F, kvbase, kb); }
    const float sink = F.attn_sink[hq] * LOG2E;
#pragma unroll 1
    for (int k = 0; k < 8; ++k) {
        const int i = i0 + k, q0 = 128 * i + 64 * (w & 1);
        __syncthreads();
        { const int nkey0 = 128 * i + 256; if (k < 7 && nkey0 < SEQ) ring_stage_block(F, kvbase, nkey0); }
#pragma unroll 1
        for (int half = 0; half < 2; ++half) {
            const int qh = q0 + 32 * half;
            bf16x8 qf[2][2];
#pragma unroll
            for (int q = 0; q < 2; ++q)
#pragma unroll
                for (int ks = 0; ks < 2; ++ks) qf[q][ks] = *(const bf16x8*)(F.proj() + (size_t)(b * SEQ + qh + 16 * q + i16) * PW + C_Q + hq * 64 + 32 * ks + 8 * q4);
            u32x2 graw[2][4];
#pragma unroll
            for (int q = 0; q < 2; ++q)
#pragma unroll
                for (int d = 0; d < 4; ++d) graw[q][d] = *(const u32x2*)(F.proj() + (size_t)(b * SEQ + qh + 16 * q + i16) * PW + C_G + hq * 64 + 16 * d + 4 * q4);
            f32x4 o[4][2]; float m[2], lp[2];
#pragma unroll
            for (int q = 0; q < 2; ++q) { m[q] = sink; lp[q] = q4 == 0 ? 1.f : 0.f;
#pragma unroll
                for (int d = 0; d < 4; ++d) o[d][q] = (f32x4){0.f, 0.f, 0.f, 0.f}; }
#pragma unroll 1
            for (int j = 0; j < 5; ++j) {
                const int kstart = q0 - 128 + 64 * j; if (kstart < 0 || kstart >= SEQ) continue;
                const int ir = kstart & 511;
                attn_tile<64, 2>(Ki + ir * KS, KS, Vi + ir * VS, VS, qf, o, m, lp, j == 0 ? 1 : (j == 4 ? 2 : 0), lane, 32 * half);
            }
#pragma unroll
            for (int q = 0; q < 2; ++q) {
                float l = lp[q]; l += __shfl_xor(l, 16); l += __shfl_xor(l, 32); const float inv = 1.f / l;
                const size_t row = (size_t)(b * SEQ + qh + 16 * q + i16);
#pragma unroll
                for (int d = 0; d < 4; ++d) {
                    const int col = hq * 64 + 16 * d + 4 * q4;
                    const f32x4 g = unpack4(graw[q][d]);
                    *(u32x2*)(F.mix() + row * MIXP + col) = pack4(o[d][q] * inv * g);
                }
            }
        }
    }
}
__device__ __forceinline__ void attn_mem_item(const Ctx& F, int item, bool stage) {
    constexpr int KS = 272, VS = 288; const ldsp Ki = F.lds, Vi = F.lds + 256 * KS;
    const int qb = item & 15, hm = (item >> 4) & 3, b = item >> 6;
    if (stage) {
    __syncthreads();
#pragma unroll
    for (int c = F.tid; c < 4096; c += 512) {
        const int r = c >> 4, ch = c & 15;
        const bf16_t* src = F.mkv() + (size_t)(b * 256 + r) * 1024 + hm * 128 + 8 * ch;
        *(LAS u32x4*)(Ki + r * KS + ch * 16) = *(const u32x4*)(src);
        *(LAS u32x4*)(Vi + r * VS + ch * 16) = *(const u32x4*)(src + 512);
    }
    __syncthreads();
    }
    const int w = F.wave, lane = F.lane, i16 = lane & 15, q4 = lane >> 4, q0 = 256 * qb + 32 * w;
    bf16x8 qf[2][4];
#pragma unroll
    for (int q = 0; q < 2; ++q)
#pragma unroll
        for (int ks = 0; ks < 4; ++ks) qf[q][ks] = *(const bf16x8*)(F.proj() + (size_t)(b * SEQ + q0 + 16 * q + i16) * PW + C_QM + hm * 128 + 32 * ks + 8 * q4);
    u32x2 graw[2][8];
#pragma unroll
    for (int q = 0; q < 2; ++q)
#pragma unroll
        for (int d = 0; d < 8; ++d) graw[q][d] = *(const u32x2*)(F.proj() + (size_t)(b * SEQ + q0 + 16 * q + i16) * PW + C_GM + hm * 128 + 16 * d + 4 * q4);
    f32x4 o[8][2]; float m[2], lp[2];
#pragma unroll
    for (int q = 0; q < 2; ++q) { m[q] = -INFINITY; lp[q] = 0.f;
#pragma unroll
        for (int d = 0; d < 8; ++d) o[d][q] = (f32x4){0.f, 0.f, 0.f, 0.f}; }
#pragma unroll 1
    for (int j = 0; j < 4; ++j) attn_tile<128, 2>(Ki + 64 * j * KS, KS, Vi + 64 * j * VS, VS, qf, o, m, lp, 0, lane);
#pragma unroll
    for (int q = 0; q < 2; ++q) {
        float l = lp[q]; l += __shfl_xor(l, 16); l += __shfl_xor(l, 32); const float inv = 1.f / l;
        const size_t row = (size_t)(b * SEQ + q0 + 16 * q + i16);
#pragma unroll
        for (int d = 0; d < 8; ++d) {
            const int col = hm * 128 + 16 * d + 4 * q4;
            const f32x4 g = unpack4(graw[q][d]);
            *(u32x2*)(F.mix() + row * MIXP + 1536 + col) = pack4(o[d][q] * inv * g);
        }
    }
}

constexpr int XS = 544, BS = 288, PS = 272;
constexpr int L_XI = 0, L_BI = 128 * XS, L_CI = L_BI + 128 * BS, L_F32 = L_CI + 128 * BS;
static_assert(L_F32 + 12288 <= LDS_XB, "lds");
__device__ __forceinline__ void ssd_dtprep(const Ctx& F, int b, int c, int g, bool write_dec) {
    LAS float* DTs = (LAS float*)(F.lds + L_F32); LAS float* ACs = DTs + 1024;
    const int w = F.wave, lane = F.lane, dir = w >> 2, r = w & 3, h = 4 * g + r, j = dir * 8 + h;
    const size_t row0 = (size_t)b * SEQ + c * 128;
    const float d0 = F.dt()[(row0 + 2 * lane) * 16 + j], d1 = F.dt()[(row0 + 2 * lane + 1) * 16 + j];
    const float a = -expf(F.a_log[j]);
    const float x0 = d0 * a, x1 = d1 * a, ps = x0 + x1; float inc = ps;
#pragma unroll
    for (int off = 1; off < 64; off <<= 1) { const float t = __shfl_up(inc, off); if (lane >= off) inc += t; }
    const float total = __shfl(inc, 63);
    float a0, a1;
    if (dir == 0) { a0 = inc - x1; a1 = inc; } else { a0 = total - (inc - ps); a1 = total - (inc - x1); }
    *(LAS f32x2*)(DTs + w * 128 + 2 * lane) = (f32x2){d0, d1};
    *(LAS f32x2*)(ACs + w * 128 + 2 * lane) = (f32x2){a0, a1};
    *(LAS f32x2*)(ACs + 1024 + w * 128 + 2 * lane) = (f32x2){d0 * expf(total - a0), d1 * expf(total - a1)};
    if (write_dec && lane == 0) F.dec()[(b * 32 + c) * 16 + j] = expf(total);
}
template <int NCOLS>
__device__ __forceinline__ void conv_img(const Ctx& F, int b, int c, int xcol, ldsp img, int stride) {
    constexpr int NCQ = NCOLS / 4, NRG = 512 / NCQ, R = 128 / NRG;
    const int cq = F.tid % NCQ, rg = F.tid / NCQ, col = xcol + 4 * cq;
    f32x4 w[5];
#pragma unroll
    for (int j = 0; j < 5; ++j) w[j] = *(const f32x4*)(F.conv_w + j * 1024 + col);
    const f32x4 bias = *(const f32x4*)(F.conv_b + col);
    const int t0 = c * 128 + rg * R - 2;
    const bf16_t* base = F.proj() + (size_t)b * SEQ * PW + C_X + col;
    f32x4 win[R + 4];
#pragma unroll
    for (int k = 0; k < R + 4; ++k) { const int t = t0 + k, tc = t < 0 ? 0 : (t >= SEQ ? SEQ - 1 : t); const u32x2 raw = *(const u32x2*)(base + (size_t)tc * PW); const bool ok = (t == tc);
        win[k] = unpack4((u32x2){ok ? raw.x : 0u, ok ? raw.y : 0u}); }
#pragma unroll
    for (int r = 0; r < R; ++r) {
        f32x4 y = bias;
#pragma unroll
        for (int j = 0; j < 5; ++j) y = y + w[j] * win[r + j];
        *(LAS u32x2*)(img + (rg * R + r) * stride + cq * 8) = pack4(silu4(y));
    }
}
__device__ __forceinline__ void ssd_pass1_item(const Ctx& F, int item) {
    const int g = item & 1, c = (item >> 1) & 31, b = item >> 6;
    const ldsp XI = F.lds + L_XI, BI = F.lds + L_BI, CI = F.lds + L_CI;
    LAS float* DTs = (LAS float*)(F.lds + L_F32); LAS float* ACs = DTs + 1024;
    __syncthreads();
    ssd_dtprep(F, b, c, g, true);
    conv_img<256>(F, b, c, 256 * g, XI, XS);
    conv_img<128>(F, b, c, 512 + 128 * g, BI, BS);
    conv_img<128>(F, b, c, 768 + 128 * g, CI, BS);
    __syncthreads();
    const int lane = F.lane, i16 = lane & 15, q4 = lane >> 4, w = F.wave, tl = 16 * w + i16;
    const size_t row = (size_t)b * SEQ + c * 128 + tl;
    f32x4 cbt[8];
    {
        bf16x8 cf[4];
#pragma unroll
        for (int ks = 0; ks < 4; ++ks) cf[ks] = ld8(CI + tl * BS + (32 * ks + 8 * q4) * 2);
#pragma unroll
        for (int ks = 0; ks < 4; ++ks) *(bf16x8*)(F.cfb() + ((size_t)(item * 8 + w) * 64 + lane) * 32 + 8 * ks) = cf[ks];
#pragma unroll
        for (int sf = 0; sf < 8; ++sf) {
            cbt[sf] = (f32x4){0.f, 0.f, 0.f, 0.f};
#pragma unroll
            for (int ks = 0; ks < 4; ++ks) cbt[sf] = mfma16(ld8(BI + (16 * sf + i16) * BS + (32 * ks + 8 * q4) * 2), cf[ks], cbt[sf]);
        }
    }
#pragma unroll 1
    for (int r = 0; r < 4; ++r) {
        {
            const int dir = w & 1, nq = w >> 1;
            LAS const float* Wr = ACs + 1024 + (dir * 4 + r) * 128;
            f32x4 acc[2][4];
#pragma unroll
            for (int nf = 0; nf < 2; ++nf)
#pragma unroll
                for (int pf = 0; pf < 4; ++pf) acc[nf][pf] = (f32x4){0.f, 0.f, 0.f, 0.f};
#pragma unroll
            for (int ks = 0; ks < 4; ++ks) {
                const int t0 = 32 * ks + 8 * q4, trow = t0 + (i16 >> 2);
                const f32x4 wlo = *(const LAS f32x4*)(Wr + t0), whi = *(const LAS f32x4*)(Wr + t0 + 4);
                bf16x8 af[2], bfr[4];
#pragma unroll
                for (int nf = 0; nf < 2; ++nf) {
                    ldsp p = BI + trow * BS + (32 * nq + 16 * nf + 4 * (i16 & 3)) * 2;
                    const u32x2 lo = __builtin_bit_cast(u32x2, vtr(p)), hi = __builtin_bit_cast(u32x2, vtr(p + 4 * BS));
                    af[nf] = packfrag(unpack4(lo) * wlo, unpack4(hi) * whi);
                }
#pragma unroll
                for (int pf = 0; pf < 4; ++pf) { ldsp p = XI + trow * XS + (64 * r + 16 * pf + 4 * (i16 & 3)) * 2; bfr[pf] = cat8(vtr(p), vtr(p + 4 * XS)); }
#pragma unroll
                for (int nf = 0; nf < 2; ++nf)
#pragma unroll
                    for (int pf = 0; pf < 4; ++pf) acc[nf][pf] = mfma16(af[nf], bfr[pf], acc[nf][pf]);
            }
            bf16_t* S = F.st() + ((((size_t)(b * 32 + c) * 2 + dir) * 8 + (4 * g + r)) << 13);
#pragma unroll
            for (int nf = 0; nf < 2; ++nf)
#pragma unroll
                for (int pf = 0; pf < 4; ++pf) *(u32x2*)(S + (16 * pf + i16) * 128 + 32 * nq + 16 * nf + 4 * q4) = pack4(acc[nf][pf]);
        }
        {
            const float acf = ACs[r * 128 + tl], acb = ACs[(4 + r) * 128 + tl];
            f32x4 yt[4];
#pragma unroll
            for (int pf = 0; pf < 4; ++pf) yt[pf] = (f32x4){0.f, 0.f, 0.f, 0.f};
#pragma unroll
            for (int kp = 0; kp < 4; ++kp) {
                f32x4 gt[2];
#pragma unroll
                for (int u = 0; u < 2; ++u) {
                    const int sf = 2 * kp + u, s0 = 16 * sf + 4 * q4;
                    const f32x4 dtf = *(const LAS f32x4*)(DTs + r * 128 + s0), af = *(const LAS f32x4*)(ACs + r * 128 + s0);
                    const f32x4 dtb = *(const LAS f32x4*)(DTs + (4 + r) * 128 + s0), ab = *(const LAS f32x4*)(ACs + (4 + r) * 128 + s0);
#pragma unroll
                    for (int e = 0; e < 4; ++e) {
                        const int sx = s0 + e;
                        const float mf = sx <= tl ? dtf[e] * __expf(acf - af[e]) : 0.f;
                        const float mb = sx >= tl ? dtb[e] * __expf(acb - ab[e]) : 0.f;
                        gt[u][e] = cbt[sf][e] * (mf + mb);
                    }
                }
                const bf16x8 gk = packfrag(gt[0], gt[1]);
#pragma unroll
                for (int pf = 0; pf < 4; ++pf) {
                    ldsp xa = XI + (32 * kp + 4 * q4 + (i16 >> 2)) * XS + (64 * r + 16 * pf + 4 * (i16 & 3)) * 2;
                    yt[pf] = mfma16(cat8(vtr(xa), vtr(xa + 16 * XS)), gk, yt[pf]);
                }
            }
            const float dsk = F.d_skip[4 * g + r];
#pragma unroll
            for (int pf = 0; pf < 4; ++pf) {
                const int pc = 64 * r + 16 * pf + 4 * q4;
                const f32x4 xv = unpack4(*(const LAS u32x2*)(XI + tl * XS + pc * 2));
                *(u32x2*)(F.yp() + row * 512 + 256 * g + pc) = pack4(yt[pf] + xv * dsk);
            }
            if (q4 == 0) { F.efb()[row * 16 + 4 * g + r] = __expf(acf); F.efb()[row * 16 + 8 + 4 * g + r] = __expf(acb); }
        }
    }
}
__device__ __forceinline__ void ssd_scan(const Ctx& F, int vb, int vg) {
    for (int it = vb * 512 + F.tid; it < NBATCH * 2 * 8 * 1024; it += vg * 512) {
        const int e8 = it & 1023, h = (it >> 10) & 7, dir = (it >> 13) & 1, b = it >> 14;
        float run[8];
#pragma unroll
        for (int k = 0; k < 8; ++k) run[k] = 0.f;
        for (int s0 = 0; s0 < 32; s0 += 4) {
            u32x4 v[4]; float dc[4]; bf16_t* ad[4];
#pragma unroll
            for (int u = 0; u < 4; ++u) { const int s = s0 + u, c = dir ? 31 - s : s; ad[u] = F.st() + (((((size_t)(b * 32 + c) * 2 + dir) * 8 + h) << 13) + e8 * 8); v[u] = __builtin_nontemporal_load((const u32x4*)ad[u]); dc[u] = F.dec()[(b * 32 + c) * 16 + dir * 8 + h]; }
#pragma unroll
            for (int u = 0; u < 4; ++u) {
                __builtin_nontemporal_store((u32x4){cvt_pk(run[0], run[1]), cvt_pk(run[2], run[3]), cvt_pk(run[4], run[5]), cvt_pk(run[6], run[7])}, (u32x4*)ad[u]);
                run[0] = run[0] * dc[u] + bf_lo(v[u].x); run[1] = run[1] * dc[u] + bf_hi(v[u].x); run[2] = run[2] * dc[u] + bf_lo(v[u].y); run[3] = run[3] * dc[u] + bf_hi(v[u].y);
                run[4] = run[4] * dc[u] + bf_lo(v[u].z); run[5] = run[5] * dc[u] + bf_hi(v[u].z); run[6] = run[6] * dc[u] + bf_lo(v[u].w); run[7] = run[7] * dc[u] + bf_hi(v[u].w);
            }
        }
    }
}
__device__ __forceinline__ void ssd_pass2_item(const Ctx& F, int item) {
    const int g = item & 1, c = (item >> 1) & 31, b = item >> 6;
    const ldsp PV = F.lds;
    const int lane = F.lane, i16 = lane & 15, q4 = lane >> 4, w = F.wave, tl = 16 * w + i16;
    const size_t row = (size_t)b * SEQ + c * 128 + tl;
    bf16x8 cf[4];
#pragma unroll
    for (int ks = 0; ks < 4; ++ks) cf[ks] = *(const bf16x8*)(F.cfb() + ((size_t)(item * 8 + w) * 64 + lane) * 32 + 8 * ks);
    const int pdir = F.tid >> 8, pp = (F.tid >> 2) & 63, pqu = F.tid & 3;
    const bf16_t* psrc = F.st() + (((((size_t)(b * 32 + c) * 2 + pdir) * 8 + 4 * g) << 13) + pp * 128 + 32 * pqu);
    u32x4 pvn[4][4];
#pragma unroll
    for (int r = 0; r < 4; ++r)
#pragma unroll
        for (int k = 0; k < 4; ++k) pvn[r][k] = *(const u32x4*)(psrc + ((size_t)r << 13) + 8 * k);
    __syncthreads();
#pragma unroll
    for (int r = 0; r < 4; ++r)
#pragma unroll
        for (int k = 0; k < 4; ++k) *(LAS u32x4*)(PV + (2 * r + pdir) * (64 * PS) + pp * PS + (32 * pqu + 8 * k) * 2) = pvn[r][k];
    __syncthreads();
    f32x4 gy[4][4]; float ss = 0.f;
#pragma unroll
    for (int r = 0; r < 4; ++r) {
        u32x2 zraw[4], yraw[4];
#pragma unroll
        for (int pf = 0; pf < 4; ++pf) { const int pc = 256 * g + 64 * r + 16 * pf + 4 * q4; zraw[pf] = *(const u32x2*)(F.proj() + row * PW + C_Z + pc); yraw[pf] = *(const u32x2*)(F.yp() + row * 512 + pc); }
        const float ef = F.efb()[row * 16 + 4 * g + r], eb = F.efb()[row * 16 + 8 + 4 * g + r];
        const ldsp PVr = PV + 2 * r * (64 * PS);
        f32x4 yf[4], yb[4];
#pragma unroll
        for (int pf = 0; pf < 4; ++pf) { yf[pf] = (f32x4){0.f, 0.f, 0.f, 0.f}; yb[pf] = (f32x4){0.f, 0.f, 0.f, 0.f}; }
#pragma unroll
        for (int ks = 0; ks < 4; ++ks)
#pragma unroll
            for (int pf = 0; pf < 4; ++pf) {
                yf[pf] = mfma16(ld8(PVr + (16 * pf + i16) * PS + (32 * ks + 8 * q4) * 2), cf[ks], yf[pf]);
                yb[pf] = mfma16(ld8(PVr + 64 * PS + (16 * pf + i16) * PS + (32 * ks + 8 * q4) * 2), cf[ks], yb[pf]);
            }
#pragma unroll
        for (int pf = 0; pf < 4; ++pf) {
            const f32x4 y = (unpack4(yraw[pf]) + yf[pf] * ef + yb[pf] * eb) * unpack4(zraw[pf]);
            gy[r][pf] = y; ss += y.x * y.x + y.y * y.y + y.z * y.z + y.w * y.w;
        }
    }
    ss += __shfl_xor(ss, 16); ss += __shfl_xor(ss, 32);
    const float rinv = rsqrtf(ss * (1.f / 256.f) + EPS);
#pragma unroll
    for (int r = 0; r < 4; ++r)
#pragma unroll
        for (int pf = 0; pf < 4; ++pf) {
            const int pc = 256 * g + 64 * r + 16 * pf + 4 * q4;
            const f32x4 nw = *(const f32x4*)(F.ssd_norm_w + pc);
            *(u32x2*)(F.mix() + row * MIXP + 1024 + pc) = pack4(gy[r][pf] * rinv * nw);
        }
}

__device__ __forceinline__ void final_norm(const Ctx& F) {
    const int gw = F.bid * 8 + F.wave, NGW = F.G * 8, lane = F.lane;
    for (int m = gw; m < TOK; m += NGW) {
        const f32x4* rp = (const f32x4*)(F.rowss() + (size_t)m * 16); const f32x4 s4 = (rp[0] + rp[1]) + (rp[2] + rp[3]);
        const float r = rsqrtf(((s4.x + s4.y) + (s4.z + s4.w)) * (1.f / DM) + EPS);
        float* o = F.out + (size_t)m * DM;
#pragma unroll
        for (int j = 0; j < 4; ++j) { const f32x4 v = __builtin_nontemporal_load((const f32x4*)(o + 4 * lane + 256 * j)), ww = *(const f32x4*)(F.norm_out_w + 4 * lane + 256 * j); __builtin_nontemporal_store(v * r * ww, (f32x4*)(o + 4 * lane + 256 * j)); }
    }
}

#define XB_TMO      128
#define XB_XCNT(j)  (256  + 64 * (j))
#define XB_XSUB(j)  (1280 + 64 * (j))
#define XB_XGEN(j)  (2304 + 64 * (j))
#define XB_TOP      3328
#define XB_TOPGEN   3392
#define XCD_BAR_WORDS 3456
#define XB_SPIN_CAP (1u << 18)

__device__ __forceinline__ unsigned xb_ld(unsigned* p)              { return __hip_atomic_load(p, __ATOMIC_RELAXED, __HIP_MEMORY_SCOPE_AGENT); }
__device__ __forceinline__ unsigned xb_add(unsigned* p, unsigned v) { return __hip_atomic_fetch_add(p, v, __ATOMIC_RELAXED, __HIP_MEMORY_SCOPE_AGENT); }
__device__ __forceinline__ unsigned xb_xcc_id() { return (unsigned)__builtin_amdgcn_s_getreg((3 << 11) | 20) & 0xFu; }
#define XB_SPIN(cond, bar) do { unsigned _sp = 0; while (cond) { __builtin_amdgcn_s_sleep(1); \
    if ((++_sp & 255u) == 0u) { if (xb_ld(&(bar)[XB_TMO])) break; if (_sp > XB_SPIN_CAP) { atomicAdd(&(bar)[XB_TMO], 1u); break; } } } } while (0)

struct XcdBarrier {
    unsigned* bar; unsigned x;
    volatile LAS unsigned* st;
};

__device__ __forceinline__ XcdBarrier xcd_barrier_post(unsigned* bar, volatile LAS unsigned* st, int xb_tid) {
    XcdBarrier b; b.bar = bar; b.x = xb_xcc_id(); b.st = st;
    if (xb_tid == 0) (void)xb_add(&bar[XB_XCNT(b.x)], 1u);
    return b;
}
__device__ __forceinline__ void xcd_barrier_complete(unsigned* bar, unsigned x, unsigned& nloc, unsigned& nx) {
    const unsigned G = gridDim.x * gridDim.y * gridDim.z;
    unsigned sum, cnt, mine, sp = 0u;
    for (;;) {
        sum = 0u; cnt = 0u; mine = 0u;
#pragma unroll
        for (unsigned j = 0; j < 16; ++j) { const unsigned c = xb_ld(&bar[XB_XCNT(j)]); sum += c; cnt += (c > 0u) ? 1u : 0u; mine = (j == x) ? c : mine; }
        if (sum == G) break;
        __builtin_amdgcn_s_sleep(1);
        if ((++sp & 255u) == 0u) { if (xb_ld(&bar[XB_TMO])) break; if (sp > XB_SPIN_CAP) { atomicAdd(&bar[XB_TMO], 1u); break; } }
    }
    nloc = mine > 0u ? mine : 1u; nx = cnt > 0u ? cnt : 1u;
}

__device__ __forceinline__ void xcd_barrier(const XcdBarrier& b, int xb_tid) {
    asm volatile("s_waitcnt vmcnt(0)" ::: "memory");
    __syncthreads();
    if (xb_tid == 0) {
        unsigned* bar = b.bar;
        __builtin_amdgcn_s_waitcnt(0);
        unsigned nloc = b.st[0], nx = b.st[1];
        if (nloc == 0u) { xcd_barrier_complete(bar, b.x, nloc, nx); b.st[0] = nloc; b.st[1] = nx; }
        const unsigned old = xb_add(&bar[XB_XSUB(b.x)], 1u);
        const unsigned gen = old / nloc;
        if (old + 1u == (gen + 1u) * nloc) {
            __builtin_amdgcn_fence(__ATOMIC_RELEASE, "agent");
            asm volatile("s_waitcnt vmcnt(0)" ::: "memory");
            const unsigned og = xb_add(&bar[XB_TOP], 1u);
            const unsigned tg = og / nx;
            if (og + 1u == (tg + 1u) * nx) xb_add(&bar[XB_TOPGEN], 1u);
            else XB_SPIN(xb_ld(&bar[XB_TOPGEN]) == tg, bar);
            __builtin_amdgcn_fence(__ATOMIC_ACQUIRE, "agent");
            xb_add(&bar[XB_XGEN(b.x)], 1u);
            asm volatile("s_waitcnt vmcnt(0)" ::: "memory");
        } else {
            XB_SPIN(xb_ld(&bar[XB_XGEN(b.x)]) == gen, bar);
            __builtin_amdgcn_fence(__ATOMIC_ACQUIRE, "agent");
            asm volatile("s_waitcnt vmcnt(0)" ::: "memory");
        }
    }
    __syncthreads();
}

__global__ void __launch_bounds__(512, 2) hymba_fwd(Args args) {
    extern __shared__ __attribute__((aligned(16))) unsigned char lds_raw[];
    Ctx F;
    F.x = args.in[0]; F.mem = args.in[1]; F.norm_mem_w = args.in[2]; F.norm_in_w = args.in[3]; F.w_in = args.in[4]; F.attn_sink = args.in[5]; F.conv_w = args.in[6]; F.conv_b = args.in[7];
    F.dt_bias = args.in[8]; F.a_log = args.in[9]; F.d_skip = args.in[10]; F.ssd_norm_w = args.in[11]; F.w_mem_kv = args.in[12]; F.w_out = args.in[13]; F.norm_out_w = args.in[14];
    F.out = args.out; F.ws = args.ws;
    F.lds = (ldsp)lds_raw; F.tid = threadIdx.x; F.lane = F.tid & 63; F.wave = __builtin_amdgcn_readfirstlane(F.tid >> 6); F.G = gridDim.x; F.bid = blockIdx.x;
    const int lo = args.lo, hi = args.hi;
    cg::grid_group grid = cg::this_grid();
#define IN(k) (lo <= (k) && (k) < hi)
#define REFRESH() do { F.lane = lane_id_now(); F.tid = F.wave * 64 + F.lane; } while (0)
    if (F.tid == 0) { *(LAS u32x4*)(F.lds + LDS_XB) = (u32x4){0u, 0u, 0u, 0u}; }
    __syncthreads();
    XcdBarrier xbar; xbar.bar = (unsigned*)args.ws; xbar.x = 0; xbar.st = (volatile LAS unsigned*)(F.lds + LDS_XB);
    if (hi - lo > 1) xbar = xcd_barrier_post((unsigned*)args.ws, (volatile LAS unsigned*)(F.lds + LDS_XB), F.tid);
    if (lo < 0) grid.sync();
#define SEAM(k) do { if (IN(k) && IN((k) + 1)) xcd_barrier(xbar, F.tid); } while (0)
    if (IN(0)) { REFRESH(); phase0(F); }
    SEAM(0);
    if (IN(1)) {
        REFRESH();
        { pg8::Gemm g{F.hn(), F.win_t(), TOK, NPHYS, DM, HNP, HNP}; pg8::StaticOrder S; S.init(g.M, g.N, F.G, F.bid); EpiProj E{F.proj(), F.dt(), F.rope(), F.dt_bias}; pg8::gemm_phase(F.lds, g, S, E, F.wave); }
    }
    SEAM(1);
    if (IN(2)) {
        REFRESH();
        if (F.bid & 1) for (int sq = F.bid; sq < NBATCH * 4 * 4; sq += F.G) attn_window_seq(F, sq);
        for (int it = F.bid; it < NBATCH * 32 * 2; it += F.G) ssd_pass1_item(F, it);
        if (!(F.bid & 1)) for (int sq = F.bid; sq < NBATCH * 4 * 4; sq += F.G) attn_window_seq(F, sq);
    }
    SEAM(2);
    if (IN(3)) {
        REFRESH();
        if (F.G >= 128) {
            if (F.bid < 64) { pg8::Gemm g{F.memn(), F.wmem_t(), NBATCH * 256, 1024, 1024, HNP, HNP}; pg8::StaticOrder S; S.init(g.M, g.N, 64, F.bid); EpiMkv E{F.mkv()}; pg8::gemm_phase(F.lds, g, S, E, F.wave); }
            else ssd_scan(F, F.bid - 64, F.G - 64);
        } else {
            { pg8::Gemm g{F.memn(), F.wmem_t(), NBATCH * 256, 1024, 1024, HNP, HNP}; pg8::StaticOrder S; S.init(g.M, g.N, F.G, F.bid); EpiMkv E{F.mkv()}; pg8::gemm_phase(F.lds, g, S, E, F.wave); }
            ssd_scan(F, F.bid, F.G);
        }
    }
    SEAM(3);
    if (IN(4)) {
        REFRESH();
        if (F.bid & 1) for (int grp = F.bid; grp < NBATCH * 16; grp += F.G) for (int k = 0; k < 4; ++k) attn_mem_item(F, 4 * grp + k, k == 0);
        for (int it = F.bid; it < NBATCH * 32 * 2; it += F.G) ssd_pass2_item(F, it);
        if (!(F.bid & 1)) for (int grp = F.bid; grp < NBATCH * 16; grp += F.G) for (int k = 0; k < 4; ++k) attn_mem_item(F, 4 * grp + k, k == 0);
    }
    SEAM(4);
    if (IN(5)) { REFRESH(); __syncthreads(); pg8::Gemm g{F.mix(), F.wout_t(), TOK, DM, MIXW, MIXP, MIXP}; pg8::StaticOrder S; S.init(g.M, g.N, F.G, F.bid); EpiOut E{F.x, F.out, F.rowss()}; pg8::gemm_phase(F.lds, g, S, E, F.wave); }
    SEAM(5);
    if (IN(6)) { REFRESH(); final_norm(F); }
#undef IN
#undef SEAM
}

extern "C" void kernel_launch(void* const* d_in, const int* in_sizes, int n_in, void* d_out, int out_size, void* d_ws, size_t ws_size, hipStream_t stream) {
    static int grid = 0;
    if (grid == 0) {
        if (n_in != 15 || out_size != TOK * DM || ws_size < WS_END) { fprintf(stderr, "kernel_launch: unexpected shapes (n_in %d out %d ws %zu)\n", n_in, out_size, ws_size); grid = -1; return; }
        int dev = 0, cus = 0, per_cu = 0;
        (void)hipGetDevice(&dev); (void)hipDeviceGetAttribute(&cus, hipDeviceAttributeMultiprocessorCount, dev);
        if (hipFuncSetAttribute((const void*)hymba_fwd, hipFuncAttributeMaxDynamicSharedMemorySize, LDS_BYTES) != hipSuccess) { fprintf(stderr, "kernel_launch: hipFuncSetAttribute failed\n"); grid = -1; return; }
        if (hipOccupancyMaxActiveBlocksPerMultiprocessor(&per_cu, (const void*)hymba_fwd, 512, LDS_BYTES) != hipSuccess || per_cu < 1) { fprintf(stderr, "kernel_launch: occupancy query says %d\n", per_cu); per_cu = 1; }
        (void)hipGetLastError();
        grid = cus > 0 ? cus : 256;
    }
    if (grid < 0) return;
    Args a{};
    for (int i = 0; i < 15; ++i) a.in[i] = (const float*)d_in[i];
    a.out = (float*)d_out; a.ws = (unsigned char*)d_ws;
    (void)hipMemsetAsync(d_ws, 0, 16384, stream);
#if MK_ONE_LAUNCH
    a.lo = 0; a.hi = NPHASE;
    void* kargs[] = {&a};
    hipError_t e = hipLaunchCooperativeKernel((const void*)hymba_fwd, dim3(grid), dim3(512), kargs, LDS_BYTES, stream);
    if (e != hipSuccess) fprintf(stderr, "kernel_launch: cooperative launch failed: %s (grid %d)\n", hipGetErrorString(e), grid);
#else
    for (int k = 0; k < NPHASE; ++k) { a.lo = k; a.hi = k + 1; hipLaunchKernelGGL(hymba_fwd, dim3(grid), dim3(512), LDS_BYTES, stream, a); }
#endif
}
```

```cpp
#include <hip/hip_runtime.h>
#include <hip/hip_cooperative_groups.h>
#include <cstdio>
#include <cstdint>
namespace cg = cooperative_groups;

#ifndef MK_ONE_LAUNCH
#define MK_ONE_LAUNCH 1
#endif

#define LAS __attribute__((address_space(3)))
typedef unsigned short bf16_t;
typedef short bf16x8 __attribute__((ext_vector_type(8)));
typedef short s16x4 __attribute__((ext_vector_type(4)));
typedef float f32x4 __attribute__((ext_vector_type(4)));
typedef float f32x2 __attribute__((ext_vector_type(2)));
typedef unsigned u32x4 __attribute__((ext_vector_type(4)));
typedef unsigned u32x2 __attribute__((ext_vector_type(2)));
typedef LAS unsigned char* ldsp;

constexpr int SEQ = 4096, NBATCH = 16, TOK = SEQ * NBATCH, DM = 1024;
constexpr int INW = 5136, NPHYS = 5376, PW = 5184;
constexpr int HNP = 1088, MIXP = 2112;
constexpr int C_Q = 0, C_K = 1024, C_V = 1280, C_G = 1536, C_Z = 2560, C_X = 3072, C_QM = 4096, C_GM = 4608;
constexpr int MIXW = 2048;
constexpr float LOG2E = 1.4426950408889634f;
constexpr float EPS = 1e-6f;
constexpr int NPHASE = 7;

constexpr size_t MiB = (size_t)1 << 20;
constexpr size_t WS_ROWSS = 956 * MiB, WS_ROPE = 1 * MiB, WS_WIN = 2 * MiB, WS_WOUT = 14 * MiB, WS_WMEM = 19 * MiB, WS_MEMN = 22 * MiB,
                 WS_MKV = 31 * MiB, WS_DT = 39 * MiB, WS_DEC = 43 * MiB, WS_PROJ = 44 * MiB, WS_MIX = 692 * MiB, WS_END = 960 * MiB;

constexpr int LDS_BYTES = 155648 + 16;
constexpr int LDS_XB = 155648;

__device__ __forceinline__ unsigned cvt_pk(float lo, float hi) { unsigned r; asm volatile("v_cvt_pk_bf16_f32 %0, %1, %2" : "=v"(r) : "v"(lo), "v"(hi)); return r; }
typedef __bf16 bf16x2_t __attribute__((ext_vector_type(2)));
__device__ __forceinline__ unsigned cvt_pk_c(float lo, float hi) { const f32x2 v = {lo, hi}; return __builtin_bit_cast(unsigned, __builtin_convertvector(v, bf16x2_t)); }
__device__ __forceinline__ float bf_lo(unsigned u) { return __uint_as_float(u << 16); }
__device__ __forceinline__ float bf_hi(unsigned u) { return __uint_as_float(u & 0xffff0000u); }
__device__ __forceinline__ f32x4 unpack4(u32x2 v) { return (f32x4){bf_lo(v.x), bf_hi(v.x), bf_lo(v.y), bf_hi(v.y)}; }
__device__ __forceinline__ u32x2 pack4(f32x4 v) { return (u32x2){cvt_pk_c(v.x, v.y), cvt_pk_c(v.z, v.w)}; }
__device__ __forceinline__ float silu_f(float x) { return x * __builtin_amdgcn_rcpf(1.f + __expf(-x)); }
__device__ __forceinline__ f32x4 silu4(f32x4 v) { return (f32x4){silu_f(v.x), silu_f(v.y), silu_f(v.z), silu_f(v.w)}; }
__device__ __forceinline__ float softplus_f(float x) { return x > 15.f ? x : __logf(1.f + __expf(x)); }
__device__ __forceinline__ float ex2(float x) { return __builtin_amdgcn_exp2f(x); }
typedef short v4i16_t __attribute__((ext_vector_type(4)));
__device__ __forceinline__ s16x4 vtr(ldsp p) { return __builtin_bit_cast(s16x4, __builtin_amdgcn_ds_read_tr16_b64_v4i16((LAS v4i16_t*)p)); }
__device__ __forceinline__ bf16x8 cat8(s16x4 a, s16x4 b) { return (bf16x8){a[0], a[1], a[2], a[3], b[0], b[1], b[2], b[3]}; }
__device__ __forceinline__ bf16x8 ld8(ldsp p) { return *(const LAS bf16x8*)p; }
__device__ __forceinline__ f32x4 mfma16(bf16x8 a, bf16x8 b, f32x4 c) { return __builtin_amdgcn_mfma_f32_16x16x32_bf16(a, b, c, 0, 0, 0); }
__device__ __forceinline__ bf16x8 packfrag(f32x4 a, f32x4 b) { u32x4 r = {cvt_pk_c(a.x, a.y), cvt_pk_c(a.z, a.w), cvt_pk_c(b.x, b.y), cvt_pk_c(b.z, b.w)}; return __builtin_bit_cast(bf16x8, r); }

__device__ __forceinline__ f32x4 zero4() { f32x4 z; asm volatile("v_mov_b32 %0, 0\n\tv_mov_b32 %1, 0\n\tv_mov_b32 %2, 0\n\tv_mov_b32 %3, 0" : "=v"(z.x), "=v"(z.y), "=v"(z.z), "=v"(z.w)); return z; }
__device__ __forceinline__ int lane_id_now() { int l; asm volatile("v_mbcnt_lo_u32_b32 %0, -1, 0\n\tv_mbcnt_hi_u32_b32 %0, -1, %0" : "=v"(l)); return l; }
__host__ __device__ __forceinline__ int perm_plain(int c) { const int bj = c >> 7, wc = (c >> 5) & 3, n = (c >> 4) & 1, fq = (c >> 2) & 3, i = c & 3; return 128 * bj + 32 * wc + 8 * fq + 4 * n + i; }
__host__ __device__ __forceinline__ int perm_rot(int c) { const int bj = c >> 7, wc = (c >> 5) & 3, n = (c >> 4) & 1, fq = (c >> 2) & 3, i = c & 3; return 64 * wc + 32 * bj + 8 * fq + 4 * n + i; }

namespace pg8 {
constexpr int BM = 256, BK = 64, HALF = 128, HTB = HALF * BK * 2, STAGE_BYTES = 8 * HTB, NXCD = 8, WGM = 8;
__host__ __device__ __forceinline__ int lds_byte(int r, int c) { const int st = (r >> 4) * 2 + (c >> 5), rr = r & 15, cc = c & 31, ob = rr * 64 + cc * 2; return st * 1024 + (ob ^ (((ob >> 9) & 1) << 5)); }
__host__ __device__ __forceinline__ void stage_rc(int b, int& R, int& C) { const int st = b / 1024, sb = b % 1024, swz = sb ^ (((sb >> 9) & 1) << 5); R = (st >> 1) * 16 + swz / 64; C = (st & 1) * 32 + (swz % 64) / 2; }
struct Unit { int pm, pn; };
struct Gemm { const bf16_t* A; const bf16_t* Bt; int M, N, K, lda, ldb; };
struct StaticOrder {
    int nM, nN, nwg, G, c;
    __device__ void init(int M, int N, int G_, int c_) { nM = M / BM; nN = N / BM; nwg = nM * nN; G = G_; c = c_; }
    __device__ bool next(int i, Unit& u) const {
        const long L = (long)i * G + c; if (L >= nwg) return false;
        int wgid = (int)L; { const int q = nwg / NXCD, r = nwg % NXCD, xcd = wgid % NXCD, off = wgid / NXCD; wgid = (xcd < r ? xcd * (q + 1) : r * (q + 1) + (xcd - r) * q) + off; }
        const int nig = WGM * nN, gid = wgid / nig, fm = gid * WGM, gsz = (nM - fm) < WGM ? (nM - fm) : WGM;
        u.pm = fm + ((wgid % nig) % gsz); u.pn = (wgid % nig) / gsz; return true;
    }
};
template <class Epi, class Sched>
__device__ __forceinline__ void gemm_phase(ldsp lds, const Gemm g, const Sched& S, const Epi& E, int wave_id) {
    const int lane = lane_id_now(), wid = wave_id, tid = wid * 64 + lane, wr = wid >> 2, wc = wid & 3, fr = lane & 15, fq = lane >> 4;
    const int K = g.K, nt = K / BK;
    unsigned voffA[2], voffB[2];
#pragma unroll
    for (int i = 0; i < 2; ++i) { int R, C; stage_rc(tid * 16 + i * 8192, R, C); voffA[i] = (unsigned)(R * g.lda + C) * 2u; voffB[i] = (unsigned)(R * g.ldb + C) * 2u; }
    const size_t kstep = (size_t)(BK * 2);
    const size_t hstep = (size_t)HALF * g.lda * 2, hstepB = (size_t)HALF * g.ldb * 2;
    const size_t tstep = 2 * hstep, tstepB = 2 * hstepB;
    const unsigned ldsw = (unsigned)wid * 1024u;
    const int aoff = lds_byte(wr * 64 + fr, fq * 8), boff = lds_byte(wc * 32 + fr, fq * 8);
#define PG8_SA(b, h) (((b) * 2 + (h)) * HTB)
#define PG8_SB(b, h) ((4 + (b) * 2 + (h)) * HTB)
#define PG8_STAGE(bufoff, gbase, voff) do { _Pragma("unroll") for (int _i = 0; _i < 2; ++_i) \
        __builtin_amdgcn_global_load_lds((const unsigned*)((const char*)(gbase) + (voff)[_i]), (LAS unsigned*)(lds + (bufoff) + ldsw + _i * 8192), 16, 0, 0); } while (0)
#define PG8_LDA(dst, b, h) do { _Pragma("unroll") for (int m = 0; m < 4; ++m) _Pragma("unroll") for (int k = 0; k < 2; ++k) dst[m][k] = *(const LAS bf16x8*)(lds + PG8_SA(b, h) + aoff + m * 2048 + k * 1024); } while (0)
#define PG8_LDB(dst, b, h) do { _Pragma("unroll") for (int n = 0; n < 2; ++n) _Pragma("unroll") for (int k = 0; k < 2; ++k) dst[n][k] = *(const LAS bf16x8*)(lds + PG8_SB(b, h) + boff + n * 2048 + k * 1024); } while (0)
#define PG8_MMA(ai, bj, At, Bt) do { __builtin_amdgcn_s_setprio(1); _Pragma("unroll") for (int m = 0; m < 4; ++m) _Pragma("unroll") for (int n = 0; n < 2; ++n) _Pragma("unroll") for (int k = 0; k < 2; ++k) \
        acc[ai][bj][m][n] = __builtin_amdgcn_mfma_f32_16x16x32_bf16(Bt[n][k], At[m][k], acc[ai][bj][m][n], 0, 0, 0); __builtin_amdgcn_s_setprio(0); } while (0)
#define PG8_WAIT_V(n) asm volatile("s_waitcnt vmcnt(" #n ")" ::: "memory")
#define PG8_WAIT_L(n) asm volatile("s_waitcnt lgkmcnt(" #n ")" ::: "memory")
#define PG8_BAR __builtin_amdgcn_s_barrier()
#define PG8_SCHED __builtin_amdgcn_sched_barrier(0)
    Unit cur, nxt; int ui = 0;
    if (!S.next(0, cur)) return;
    f32x4 acc[2][2][4][2];
#pragma unroll
    for (int a = 0; a < 2; ++a)
#pragma unroll
        for (int b = 0; b < 2; ++b)
#pragma unroll
            for (int m = 0; m < 4; ++m)
#pragma unroll
                for (int n = 0; n < 2; ++n) acc[a][b][m][n] = (f32x4){0.f, 0.f, 0.f, 0.f};
    bf16x8 At[4][2], B0[2][2], B1[2][2];
    const char* cA = (const char*)g.A + (size_t)cur.pm * tstep; const char* cB = (const char*)g.Bt + (size_t)cur.pn * tstepB;
    PG8_STAGE(PG8_SB(0, 0), cB, voffB); PG8_STAGE(PG8_SA(0, 0), cA, voffA); PG8_STAGE(PG8_SB(0, 1), cB + hstepB, voffB); PG8_STAGE(PG8_SA(0, 1), cA + hstep, voffA);
    if (wr == 1) PG8_BAR;
    PG8_WAIT_V(4); PG8_BAR;
    PG8_STAGE(PG8_SB(1, 0), cB + kstep, voffB); PG8_STAGE(PG8_SA(1, 0), cA + kstep, voffA); PG8_STAGE(PG8_SB(1, 1), cB + hstepB + kstep, voffB);
    PG8_WAIT_V(6); PG8_BAR;
    for (;;) {
        const bool has_next = S.next(ui + 1, nxt);
        const char* nA = has_next ? (const char*)g.A + (size_t)nxt.pm * tstep : cA; const char* nB = has_next ? (const char*)g.Bt + (size_t)nxt.pn * tstepB : cB;
        for (int t = 0; t < nt; t += 2) {
            const bool last = (t == nt - 2);
            const char* a1 = cA + (size_t)(t + 1) * kstep;
            const char* a2 = last ? nA : cA + (size_t)(t + 2) * kstep; const char* b2 = last ? nB : cB + (size_t)(t + 2) * kstep;
            const char* a3 = a2 + kstep; const char* b3 = b2 + kstep;
            PG8_LDB(B0, 0, 0); PG8_SCHED; PG8_LDA(At, 0, 0); PG8_STAGE(PG8_SA(1, 1), a1 + hstep, voffA);
            PG8_WAIT_L(8); PG8_BAR; PG8_WAIT_L(0); PG8_MMA(0, 0, At, B0); PG8_BAR; PG8_SCHED;
            PG8_LDB(B1, 0, 1); PG8_STAGE(PG8_SB(0, 0), b2, voffB);
            PG8_BAR; PG8_WAIT_L(0); PG8_MMA(0, 1, At, B1); PG8_BAR;
            PG8_LDA(At, 0, 1); PG8_STAGE(PG8_SA(0, 0), a2, voffA);
            PG8_BAR; PG8_WAIT_L(0); PG8_MMA(1, 0, At, B0); PG8_BAR; PG8_SCHED;
            PG8_STAGE(PG8_SB(0, 1), b2 + hstepB, voffB);
            PG8_WAIT_V(6); PG8_BAR; PG8_MMA(1, 1, At, B1); PG8_BAR;
            PG8_LDB(B0, 1, 0); PG8_SCHED; PG8_LDA(At, 1, 0); PG8_STAGE(PG8_SA(0, 1), a2 + hstep, voffA);
            PG8_WAIT_L(8); PG8_BAR; PG8_WAIT_L(0); PG8_MMA(0, 0, At, B0); PG8_BAR; PG8_SCHED;
            PG8_LDB(B1, 1, 1); PG8_STAGE(PG8_SB(1, 0), b3, voffB);
            PG8_BAR; PG8_WAIT_L(0); PG8_MMA(0, 1, At, B1); PG8_BAR;
            PG8_LDA(At, 1, 1); PG8_STAGE(PG8_SA(1, 0), a3, voffA);
            PG8_BAR; PG8_WAIT_L(0); PG8_MMA(1, 0, At, B0); PG8_BAR; PG8_SCHED;
            PG8_STAGE(PG8_SB(1, 1), b3 + hstepB, voffB);
            PG8_WAIT_V(6); PG8_BAR; PG8_MMA(1, 1, At, B1); PG8_BAR;
        }
        E(acc, cur, wr, wc, fr, fq);
        if (!has_next) break;
#pragma unroll
        for (int a = 0; a < 2; ++a)
#pragma unroll
            for (int b = 0; b < 2; ++b)
#pragma unroll
                for (int m = 0; m < 4; ++m)
#pragma unroll
                    for (int n = 0; n < 2; ++n) acc[a][b][m][n] = (f32x4){0.f, 0.f, 0.f, 0.f};
        cur = nxt; cA = nA; cB = nB; ++ui;
    }
    PG8_WAIT_V(0);
    if (wr == 0) PG8_BAR;
    PG8_BAR;
#undef PG8_SA
#undef PG8_SB
#undef PG8_STAGE
#undef PG8_LDA
#undef PG8_LDB
#undef PG8_MMA
#undef PG8_WAIT_V
#undef PG8_WAIT_L
#undef PG8_BAR
#undef PG8_SCHED
}
}

struct EpiProj {
    bf16_t* P; float* DT; const float* rope; const float* dt_bias;
    __device__ __forceinline__ void operator()(const f32x4 (&acc)[2][2][4][2], const pg8::Unit& u, int wr, int wc, int fr, int fq) const {
        const int row0 = u.pm * 256 + wr * 64 + fr, pn = u.pn;
        if (pn < 5) {
            const float sc = pn < 4 ? 0.125f * LOG2E : 1.f;
            const int col = pn * 256 + 64 * wc + 8 * fq;
#pragma unroll
            for (int ai = 0; ai < 2; ++ai)
#pragma unroll
                for (int m = 0; m < 4; ++m) {
                    const int row = row0 + ai * 128 + m * 16, pos = row & (SEQ - 1);
                    const f32x4* cp = (const f32x4*)(rope + pos * 32 + 8 * fq); const f32x4* sp = (const f32x4*)(rope + SEQ * 32 + pos * 32 + 8 * fq);
                    f32x4 o1[2], o2[2];
#pragma unroll
                    for (int n = 0; n < 2; ++n) { const f32x4 c = cp[n], s = sp[n], t1 = acc[ai][0][m][n], t2 = acc[ai][1][m][n]; o1[n] = (t1 * c - t2 * s) * sc; o2[n] = (t1 * s + t2 * c) * sc; }
                    bf16_t* dst = P + (size_t)row * PW + col;
                    __builtin_nontemporal_store((u32x4){cvt_pk(o1[0].x, o1[0].y), cvt_pk(o1[0].z, o1[0].w), cvt_pk(o1[1].x, o1[1].y), cvt_pk(o1[1].z, o1[1].w)}, (u32x4*)dst);
                    __builtin_nontemporal_store((u32x4){cvt_pk(o2[0].x, o2[0].y), cvt_pk(o2[0].z, o2[0].w), cvt_pk(o2[1].x, o2[1].y), cvt_pk(o2[1].z, o2[1].w)}, (u32x4*)(dst + 32));
                }
        } else if (pn < 20) {
            const bool do_silu = (pn >= 6 && pn < 12) || pn >= 18;
            const float sc = (pn == 16 || pn == 17) ? 0.08838834764831845f * LOG2E : 1.f;
            const int col = pn * 256 + 32 * wc + 8 * fq;
#pragma unroll
            for (int ai = 0; ai < 2; ++ai)
#pragma unroll
                for (int m = 0; m < 4; ++m) {
                    const int row = row0 + ai * 128 + m * 16;
#pragma unroll
                    for (int bj = 0; bj < 2; ++bj) {
                        f32x4 v0 = acc[ai][bj][m][0], v1 = acc[ai][bj][m][1];
                        if (do_silu) { v0 = silu4(v0); v1 = silu4(v1); } else { v0 = v0 * sc; v1 = v1 * sc; }
                        __builtin_nontemporal_store((u32x4){cvt_pk(v0.x, v0.y), cvt_pk(v0.z, v0.w), cvt_pk(v1.x, v1.y), cvt_pk(v1.z, v1.w)}, (u32x4*)(P + (size_t)row * PW + col + 128 * bj));
                    }
                }
        } else {
            if (wc == 0 && fq < 2) {
                const f32x4 bb0 = *(const f32x4*)(dt_bias + 8 * fq), bb1 = *(const f32x4*)(dt_bias + 8 * fq + 4);
#pragma unroll
                for (int ai = 0; ai < 2; ++ai)
#pragma unroll
                    for (int m = 0; m < 4; ++m) {
                        const int row = row0 + ai * 128 + m * 16;
#pragma unroll
                        for (int n = 0; n < 2; ++n) {
                            const int j0 = 8 * fq + 4 * n; const f32x4 v = acc[ai][0][m][n] + (n ? bb1 : bb0);
                            *(f32x4*)(DT + (size_t)row * 16 + j0) = (f32x4){softplus_f(v.x), softplus_f(v.y), softplus_f(v.z), softplus_f(v.w)};
                        }
                    }
            }
        }
    }
};
struct EpiMkv {
    bf16_t* O;
    __device__ __forceinline__ void operator()(const f32x4 (&acc)[2][2][4][2], const pg8::Unit& u, int wr, int wc, int fr, int fq) const {
        const int row0 = u.pm * 256 + wr * 64 + fr, col = u.pn * 256 + 32 * wc + 8 * fq;
#pragma unroll
        for (int ai = 0; ai < 2; ++ai)
#pragma unroll
            for (int m = 0; m < 4; ++m) {
                const int row = row0 + ai * 128 + m * 16;
#pragma unroll
                for (int bj = 0; bj < 2; ++bj) { const f32x4 v0 = acc[ai][bj][m][0], v1 = acc[ai][bj][m][1];
                    *(u32x4*)(O + (size_t)row * 1024 + col + 128 * bj) = (u32x4){cvt_pk(v0.x, v0.y), cvt_pk(v0.z, v0.w), cvt_pk(v1.x, v1.y), cvt_pk(v1.z, v1.w)}; }
            }
    }
};
struct EpiOut {
    const float* x; float* out; float* rowss;
    __device__ __forceinline__ void operator()(const f32x4 (&acc)[2][2][4][2], const pg8::Unit& u, int wr, int wc, int fr, int fq) const {
        const int row0 = u.pm * 256 + wr * 64 + fr, col = u.pn * 256 + 32 * wc + 8 * fq;
#pragma unroll
        for (int ai = 0; ai < 2; ++ai) {
            f32x4 xv[4][2][2];
#pragma unroll
            for (int m = 0; m < 4; ++m)
#pragma unroll
                for (int bj = 0; bj < 2; ++bj) {
                    const size_t o = (size_t)(row0 + ai * 128 + m * 16) * DM + col + 128 * bj;
                    xv[m][bj][0] = __builtin_nontemporal_load((const f32x4*)(x + o)); xv[m][bj][1] = __builtin_nontemporal_load((const f32x4*)(x + o + 4));
                }
#pragma unroll
            for (int m = 0; m < 4; ++m) {
                const int row = row0 + ai * 128 + m * 16; float ss = 0.f;
#pragma unroll
                for (int bj = 0; bj < 2; ++bj) {
                    const size_t o = (size_t)row * DM + col + 128 * bj;
                    const f32x4 h0 = xv[m][bj][0] + acc[ai][bj][m][0], h1 = xv[m][bj][1] + acc[ai][bj][m][1];
                    *(f32x4*)(out + o) = h0; *(f32x4*)(out + o + 4) = h1;
                    ss += h0.x * h0.x + h0.y * h0.y + h0.z * h0.z + h0.w * h0.w + h1.x * h1.x + h1.y * h1.y + h1.z * h1.z + h1.w * h1.w;
                }
                ss += __shfl_xor(ss, 16); ss += __shfl_xor(ss, 32);
                if (fq == 0) rowss[(size_t)row * 16 + u.pn * 4 + wc] = ss;
            }
        }
    }
};

struct Args { const float* in[15]; float* out; unsigned char* ws; int lo, hi; };
struct Ctx {
    const float *x, *mem, *norm_mem_w, *norm_in_w, *w_in, *attn_sink, *conv_w, *conv_b, *dt_bias, *a_log, *d_skip, *ssd_norm_w, *w_mem_kv, *w_out, *norm_out_w;
    float* out; unsigned char* ws;
    __device__ __forceinline__ float* rowss() const { return (float*)(ws + WS_ROWSS); }
    __device__ __forceinline__ float* rope() const { return (float*)(ws + WS_ROPE); }
    __device__ __forceinline__ bf16_t* win_t() const { return (bf16_t*)(ws + WS_WIN); }
    __device__ __forceinline__ bf16_t* wout_t() const { return (bf16_t*)(ws + WS_WOUT); }
    __device__ __forceinline__ bf16_t* wmem_t() const { return (bf16_t*)(ws + WS_WMEM); }
    __device__ __forceinline__ bf16_t* memn() const { return (bf16_t*)(ws + WS_MEMN); }
    __device__ __forceinline__ bf16_t* mkv() const { return (bf16_t*)(ws + WS_MKV); }
    __device__ __forceinline__ float* dt() const { return (float*)(ws + WS_DT); }
    __device__ __forceinline__ float* dec() const { return (float*)(ws + WS_DEC); }
    __device__ __forceinline__ bf16_t* proj() const { return (bf16_t*)(ws + WS_PROJ); }
    __device__ __forceinline__ bf16_t* mix() const { return (bf16_t*)(ws + WS_MIX); }
    __device__ __forceinline__ bf16_t* hn() const { return (bf16_t*)((unsigned char*)out); }
    __device__ __forceinline__ bf16_t* st() const { return (bf16_t*)((unsigned char*)out); }
    __device__ __forceinline__ bf16_t* yp() const { return (bf16_t*)((unsigned char*)out + 128 * MiB); }
    __device__ __forceinline__ bf16_t* cfb() const { return (bf16_t*)((unsigned char*)out + 192 * MiB); }
    __device__ __forceinline__ float* efb() const { return (float*)((unsigned char*)out + 224 * MiB); }
    ldsp lds; int tid, lane, wave, G, bid;
};

__device__ __forceinline__ void rms_row_bf16(const float* xr, const float* w, bf16_t* o, int lane) {
    f32x4 v[4]; float ss = 0.f;
#pragma unroll
    for (int j = 0; j < 4; ++j) { v[j] = __builtin_nontemporal_load((const f32x4*)(xr + 4 * lane + 256 * j)); ss += v[j].x * v[j].x + v[j].y * v[j].y + v[j].z * v[j].z + v[j].w * v[j].w; }
#pragma unroll
    for (int off = 1; off < 64; off <<= 1) ss += __shfl_xor(ss, off);
    const float r = rsqrtf(ss * (1.f / DM) + EPS);
#pragma unroll
    for (int j = 0; j < 4; ++j) { const f32x4 ww = *(const f32x4*)(w + 4 * lane + 256 * j); *(u32x2*)(o + 4 * lane + 256 * j) = pack4(v[j] * r * ww); }
}
template <int MODE>
__device__ __forceinline__ void transpose_w(const Ctx& F, const float* W, int K, int NS, bf16_t* Bt, int NP, int ldb) {
    const int nitems = NP * (K / 8);
    for (int it = F.bid * 512 + F.tid; it < nitems; it += F.G * 512) {
        const int n = it % NP, kg = it / NP, tile = n >> 8, cph = n & 255; int src;
        if (MODE == 0) {
            if (tile < 5) src = tile * 256 + perm_rot(cph);
            else if (tile < 20) { src = tile * 256 + perm_plain(cph); if (src >= 4096) src += 16; }
            else { const int l = perm_plain(cph); src = l < 16 ? 4096 + l : -1; }
        } else src = tile * 256 + perm_plain(cph);
        float v[8];
#pragma unroll
        for (int j = 0; j < 8; ++j) v[j] = src >= 0 ? W[(size_t)(kg * 8 + j) * NS + src] : 0.f;
        *(u32x4*)(Bt + (size_t)n * ldb + kg * 8) = (u32x4){cvt_pk(v[0], v[1]), cvt_pk(v[2], v[3]), cvt_pk(v[4], v[5]), cvt_pk(v[6], v[7])};
    }
}
__device__ __forceinline__ void phase0(const Ctx& F) {
    const int gt = F.bid * 512 + F.tid, NT = F.G * 512;
    for (int i = gt; i < SEQ * 32; i += NT) {
        const int pos = i >> 5, f = i & 31;
        const float inv = 1.0f / exp2f((float)f * (13.287712379549449f / 32.f));
        const float ang = (float)pos * inv;
        const double rev = (double)ang * 0.15915494309189535; const double fr = rev - __builtin_rint(rev);
        const float r = (float)(fr * 6.283185307179586);
        F.rope()[i] = __cosf(r); F.rope()[SEQ * 32 + i] = __sinf(r);
    }
    transpose_w<0>(F, F.w_in, DM, INW, F.win_t(), NPHYS, HNP);
    transpose_w<1>(F, F.w_out, MIXW, DM, F.wout_t(), DM, MIXP);
    transpose_w<1>(F, F.w_mem_kv, DM, DM, F.wmem_t(), DM, HNP);
    const int gw = F.bid * 8 + F.wave, NGW = F.G * 8;
    for (int m = gw; m < NBATCH * 256; m += NGW) rms_row_bf16(F.mem + (size_t)m * DM, F.norm_mem_w, F.memn() + (size_t)m * HNP, F.lane);
    for (int m = gw; m < TOK; m += NGW) rms_row_bf16(F.x + (size_t)m * DM, F.norm_in_w, F.hn() + (size_t)m * HNP, F.lane);
}

template <int DH, int NQF>
__device__ __forceinline__ void attn_tile(ldsp Kt, int KS, ldsp Vt, int VS, const bf16x8 (&qf)[NQF][DH / 32], f32x4 (&o)[DH / 16][NQF], float (&m)[NQF], float (&lp)[NQF], int maskmode, int lane, int qoff = 0, bool first = false) {
    const int i16 = lane & 15, q4 = lane >> 4;
    f32x4 st[4][NQF];
#pragma unroll
    for (int kf = 0; kf < 4; ++kf)
#pragma unroll
        for (int q = 0; q < NQF; ++q) { const float nm = -m[q]; st[kf][q] = (f32x4){nm, nm, nm, nm}; }
#pragma unroll
    for (int ks = 0; ks < DH / 32; ++ks)
#pragma unroll
        for (int kf = 0; kf < 4; ++kf) {
            const bf16x8 ka = ld8(Kt + (16 * kf + i16) * KS + (32 * ks + 8 * q4) * 2);
#pragma unroll
            for (int q = 0; q < NQF; ++q) st[kf][q] = mfma16(ka, qf[q][ks], st[kf][q]);
            if (DH > 64 && kf == 3) __builtin_amdgcn_sched_barrier(0);
        }
    if (maskmode) {
        int zb; asm volatile("v_mov_b32 %0, 0" : "=v"(zb));
        const int base = (maskmode == 1 ? 4 * q4 - i16 - qoff : i16 + qoff - 4 * q4) + zb;
#pragma unroll
        for (int kf = 0; kf < 4; ++kf)
#pragma unroll
            for (int q = 0; q < NQF; ++q)
#pragma unroll
                for (int r = 0; r < 4; ++r) { const int off = 16 * (kf - q) + r; const bool bad = (maskmode == 1 ? base + off : base - off) < 0; if (bad) st[kf][q][r] = -INFINITY; }
    }
#pragma unroll
    for (int q = 0; q < NQF; ++q) {
        float mx = st[0][q][0];
#pragma unroll
        for (int kf = 0; kf < 4; ++kf)
#pragma unroll
            for (int r = 0; r < 4; ++r) mx = fmaxf(mx, st[kf][q][r]);
        if (first || __builtin_amdgcn_ballot_w64(mx > 8.f) != 0ull) {
            mx = fmaxf(mx, __shfl_xor(mx, 16)); mx = fmaxf(mx, __shfl_xor(mx, 32));
            const float delta = (first || mx > 8.f) ? mx : 0.f; m[q] += delta;
            if (!first) {
                const float alpha = ex2(-delta);
                lp[q] = lp[q] * alpha;
#pragma unroll
                for (int d = 0; d < DH / 16; ++d) o[d][q] = o[d][q] * alpha;
            }
#pragma unroll
            for (int kf = 0; kf < 4; ++kf) st[kf][q] = st[kf][q] - delta;
        }
        float ps = 0.f;
#pragma unroll
        for (int kf = 0; kf < 4; ++kf)
#pragma unroll
            for (int r = 0; r < 4; ++r) { const float p = ex2(st[kf][q][r]); st[kf][q][r] = p; ps += p; }
        lp[q] += ps;
    }
#pragma unroll
    for (int kp = 0; kp < 2; ++kp) {
        bf16x8 pk[NQF];
#pragma unroll
        for (int q = 0; q < NQF; ++q) pk[q] = packfrag(st[2 * kp][q], st[2 * kp + 1][q]);
#pragma unroll
        for (int d = 0; d < DH / 16; ++d) {
            ldsp va = Vt + (32 * kp + 4 * q4 + (i16 >> 2)) * VS + (16 * d + 4 * (i16 & 3)) * 2;
            const bf16x8 vf = cat8(vtr(va), vtr(va + 16 * VS));
#pragma unroll
            for (int q = 0; q < NQF; ++q) o[d][q] = mfma16(vf, pk[q], o[d][q]);
            if (DH > 64 && (d & 3) == 3) __builtin_amdgcn_sched_barrier(0);
        }
    }
}

__device__ __forceinline__ void ring_stage_block(const Ctx& F, const bf16_t* kvbase, int keyblock) {
    constexpr int KS = 144, VS = 160; const ldsp Kb = F.lds + (keyblock & 511) * KS, Vb = F.lds + 512 * KS + (keyblock & 511) * VS;
    const bf16_t* src0 = kvbase + (size_t)keyblock * PW;
    for (int wi = F.wave; wi < 18; wi += 8) {
        const int slot = wi * 64 + F.lane, row = slot / 9, ch = slot - row * 9;
        __builtin_amdgcn_global_load_lds((const unsigned*)(src0 + (size_t)row * PW + C_K + 8 * (ch > 7 ? 7 : ch)), (LAS unsigned*)(Kb + wi * 1024), 16, 0, 0);
    }
    for (int wi = F.wave; wi < 20; wi += 8) {
        const int slot = wi * 64 + F.lane, row = slot / 10, ch = slot - row * 10;
        __builtin_amdgcn_global_load_lds((const unsigned*)(src0 + (size_t)row * PW + C_V + 8 * (ch > 7 ? 7 : ch)), (LAS unsigned*)(Vb + wi * 1024), 16, 0, 0);
    }
}
__device__ __forceinline__ void attn_window_seq(const Ctx& F, int sq) {
    constexpr int KS = 144, VS = 160; const ldsp Ki = F.lds, Vi = F.lds + 512 * KS;
    const int sidx = sq >> 2, b = sidx >> 2, kvh = sidx & 3, i0 = 8 * (sq & 3);
    const int w = F.wave, lane = F.lane, i16 = lane & 15, q4 = lane >> 4, hq = 4 * kvh + (w >> 1);
    const bf16_t* kvbase = F.proj() + (size_t)b * SEQ * PW + 64 * kvh;
    __syncthreads();
    for (int t = 0; t < 3; ++t) { const int kb = 128 * (i0 - 1 + t); if (kb >= 0 && kb < SEQ) ring_stage_block(F, kvbase, kb); }
    const float sink = F.attn_sink[hq] * LOG2E;
#pragma unroll 1
    for (int k = 0; k < 8; ++k) {
        const int i = i0 + k, q0 = 128 * i + 64 * (w & 1);
        __syncthreads();
        { const int nkey0 = 128 * i + 256; if (k < 7 && nkey0 < SEQ) ring_stage_block(F, kvbase, nkey0); }
#pragma unroll 1
        for (int half = 0; half < 2; ++half) {
            const int qh = q0 + 32 * half;
            bf16x8 qf[2][2];
#pragma unroll
            for (int q = 0; q < 2; ++q)
#pragma unroll
                for (int ks = 0; ks < 2; ++ks) qf[q][ks] = *(const bf16x8*)(F.proj() + (size_t)(b * SEQ + qh + 16 * q + i16) * PW + C_Q + hq * 64 + 32 * ks + 8 * q4);
            u32x2 graw[2][4];
#pragma unroll
            for (int q = 0; q < 2; ++q)
#pragma unroll
                for (int d = 0; d < 4; ++d) graw[q][d] = *(const u32x2*)(F.proj() + (size_t)(b * SEQ + qh + 16 * q + i16) * PW + C_G + hq * 64 + 16 * d + 4 * q4);
            f32x4 o[4][2]; float m[2], lp[2];
#pragma unroll
            for (int q = 0; q < 2; ++q) { m[q] = sink; lp[q] = q4 == 0 ? 1.f : 0.f;
#pragma unroll
                for (int d = 0; d < 4; ++d) o[d][q] = (f32x4){0.f, 0.f, 0.f, 0.f}; }
#pragma unroll 1
            for (int j = 0; j < 5; ++j) {
                const int kstart = q0 - 128 + 64 * j; if (kstart < 0 || kstart >= SEQ) continue;
                const int ir = kstart & 511;
                attn_tile<64, 2>(Ki + ir * KS, KS, Vi + ir * VS, VS, qf, o, m, lp, j == 0 ? 1 : (j == 4 ? 2 : 0), lane, 32 * half);
            }
#pragma unroll
            for (int q = 0; q < 2; ++q) {
                float l = lp[q]; l += __shfl_xor(l, 16); l += __shfl_xor(l, 32); const float inv = 1.f / l;
                const size_t row = (size_t)(b * SEQ + qh + 16 * q + i16);
#pragma unroll
                for (int d = 0; d < 4; ++d) {
                    const int col = hq * 64 + 16 * d + 4 * q4;
                    const f32x4 g = unpack4(graw[q][d]);
                    *(u32x2*)(F.mix() + row * MIXP + col) = pack4(o[d][q] * inv * g);
                }
            }
        }
    }
}
__device__ __forceinline__ void attn_mem_item(const Ctx& F, int item, bool stage) {
    constexpr int KS = 272, VS = 288; const ldsp Ki = F.lds, Vi = F.lds + 256 * KS;
    const int qb = item & 15, hm = (item >> 4) & 3, b = item >> 6;
    if (stage) {
    __syncthreads();
#pragma unroll
    for (int c = F.tid; c < 4096; c += 512) {
        const int r = c >> 4, ch = c & 15;
        const bf16_t* src = F.mkv() + (size_t)(b * 256 + r) * 1024 + hm * 128 + 8 * ch;
        *(LAS u32x4*)(Ki + r * KS + ch * 16) = *(const u32x4*)(src);
        *(LAS u32x4*)(Vi + r * VS + ch * 16) = *(const u32x4*)(src + 512);
    }
    __syncthreads();
    }
    const int w = F.wave, lane = F.lane, i16 = lane & 15, q4 = lane >> 4, q0 = 256 * qb + 32 * w;
    bf16x8 qf[2][4];
#pragma unroll
    for (int q = 0; q < 2; ++q)
#pragma unroll
        for (int ks = 0; ks < 4; ++ks) qf[q][ks] = *(const bf16x8*)(F.proj() + (size_t)(b * SEQ + q0 + 16 * q + i16) * PW + C_QM + hm * 128 + 32 * ks + 8 * q4);
    u32x2 graw[2][8];
#pragma unroll
    for (int q = 0; q < 2; ++q)
#pragma unroll
        for (int d = 0; d < 8; ++d) graw[q][d] = *(const u32x2*)(F.proj() + (size_t)(b * SEQ + q0 + 16 * q + i16) * PW + C_GM + hm * 128 + 16 * d + 4 * q4);
    f32x4 o[8][2]; float m[2], lp[2];
#pragma unroll
    for (int q = 0; q < 2; ++q) { m[q] = 0.f; lp[q] = 0.f;
#pragma unroll
        for (int d = 0; d < 8; ++d) o[d][q] = (f32x4){0.f, 0.f, 0.f, 0.f}; }
#pragma unroll 1
    for (int j = 0; j < 4; ++j) attn_tile<128, 2>(Ki + 64 * j * KS, KS, Vi + 64 * j * VS, VS, qf, o, m, lp, 0, lane, 0, j == 0);
#pragma unroll
    for (int q = 0; q < 2; ++q) {
        float l = lp[q]; l += __shfl_xor(l, 16); l += __shfl_xor(l, 32); const float inv = 1.f / l;
        const size_t row = (size_t)(b * SEQ + q0 + 16 * q + i16);
#pragma unroll
        for (int d = 0; d < 8; ++d) {
            const int col = hm * 128 + 16 * d + 4 * q4;
            const f32x4 g = unpack4(graw[q][d]);
            *(u32x2*)(F.mix() + row * MIXP + 1536 + col) = pack4(o[d][q] * inv * g);
        }
    }
}

constexpr int XS = 544, BS = 288, PS = 272;
constexpr int L_XI = 0, L_BI = 128 * XS, L_CI = L_BI + 128 * BS, L_F32 = L_CI + 128 * BS;
static_assert(L_F32 + 12288 <= LDS_XB, "lds");
__device__ __forceinline__ void ssd_dtprep(const Ctx& F, int b, int c, int g, bool write_dec) {
    LAS float* DTs = (LAS float*)(F.lds + L_F32); LAS float* ACs = DTs + 1024;
    const int w = F.wave, lane = F.lane, dir = w >> 2, r = w & 3, h = 4 * g + r, j = dir * 8 + h;
    const size_t row0 = (size_t)b * SEQ + c * 128;
    const float d0 = F.dt()[(row0 + 2 * lane) * 16 + j], d1 = F.dt()[(row0 + 2 * lane + 1) * 16 + j];
    const float a = -expf(F.a_log[j]);
    const float x0 = d0 * a, x1 = d1 * a, ps = x0 + x1; float inc = ps;
#pragma unroll
    for (int off = 1; off < 64; off <<= 1) { const float t = __shfl_up(inc, off); if (lane >= off) inc += t; }
    const float total = __shfl(inc, 63);
    float a0, a1;
    if (dir == 0) { a0 = inc - x1; a1 = inc; } else { a0 = total - (inc - ps); a1 = total - (inc - x1); }
    *(LAS f32x2*)(DTs + w * 128 + 2 * lane) = (f32x2){d0, d1};
    *(LAS f32x2*)(ACs + w * 128 + 2 * lane) = (f32x2){a0, a1};
    *(LAS f32x2*)(ACs + 1024 + w * 128 + 2 * lane) = (f32x2){d0 * expf(total - a0), d1 * expf(total - a1)};
    if (write_dec && lane == 0) F.dec()[(b * 32 + c) * 16 + j] = expf(total);
}
template <int NCOLS>
__device__ __forceinline__ void conv_img(const Ctx& F, int b, int c, int xcol, ldsp img, int stride) {
    constexpr int NCQ = NCOLS / 4, NRG = 512 / NCQ, R = 128 / NRG;
    const int cq = F.tid % NCQ, rg = F.tid / NCQ, col = xcol + 4 * cq;
    f32x4 w[5];
#pragma unroll
    for (int j = 0; j < 5; ++j) w[j] = *(const f32x4*)(F.conv_w + j * 1024 + col);
    const f32x4 bias = *(const f32x4*)(F.conv_b + col);
    const int t0 = c * 128 + rg * R - 2;
    const bf16_t* base = F.proj() + (size_t)b * SEQ * PW + C_X + col;
    f32x4 win[R + 4];
#pragma unroll
    for (int k = 0; k < R + 4; ++k) { const int t = t0 + k, tc = t < 0 ? 0 : (t >= SEQ ? SEQ - 1 : t); const u32x2 raw = *(const u32x2*)(base + (size_t)tc * PW); const bool ok = (t == tc);
        win[k] = unpack4((u32x2){ok ? raw.x : 0u, ok ? raw.y : 0u}); }
#pragma unroll
    for (int r = 0; r < R; ++r) {
        f32x4 y = bias;
#pragma unroll
        for (int j = 0; j < 5; ++j) y = y + w[j] * win[r + j];
        *(LAS u32x2*)(img + (rg * R + r) * stride + cq * 8) = pack4(silu4(y));
    }
}
__device__ __forceinline__ void ssd_pass1_item(const Ctx& F, int item) {
    const int g = item & 1, c = (item >> 1) & 31, b = item >> 6;
    const ldsp XI = F.lds + L_XI, BI = F.lds + L_BI, CI = F.lds + L_CI;
    LAS float* DTs = (LAS float*)(F.lds + L_F32); LAS float* ACs = DTs + 1024;
    __syncthreads();
    ssd_dtprep(F, b, c, g, true);
    conv_img<256>(F, b, c, 256 * g, XI, XS);
    conv_img<128>(F, b, c, 512 + 128 * g, BI, BS);
    conv_img<128>(F, b, c, 768 + 128 * g, CI, BS);
    __syncthreads();
    const int lane = F.lane, i16 = lane & 15, q4 = lane >> 4, w = F.wave, tl = 16 * w + i16;
    const size_t row = (size_t)b * SEQ + c * 128 + tl;
    f32x4 cbt[8];
    {
        bf16x8 cf[4];
#pragma unroll
        for (int ks = 0; ks < 4; ++ks) cf[ks] = ld8(CI + tl * BS + (32 * ks + 8 * q4) * 2);
#pragma unroll
        for (int ks = 0; ks < 4; ++ks) *(bf16x8*)(F.cfb() + ((size_t)(item * 8 + w) * 64 + lane) * 32 + 8 * ks) = cf[ks];
#pragma unroll
        for (int sf = 0; sf < 8; ++sf) {
            cbt[sf] = (f32x4){0.f, 0.f, 0.f, 0.f};
#pragma unroll
            for (int ks = 0; ks < 4; ++ks) cbt[sf] = mfma16(ld8(BI + (16 * sf + i16) * BS + (32 * ks + 8 * q4) * 2), cf[ks], cbt[sf]);
        }
    }
#pragma unroll 1
    for (int r = 0; r < 4; ++r) {
        {
            const int dir = w & 1, nq = w >> 1;
            LAS const float* Wr = ACs + 1024 + (dir * 4 + r) * 128;
            f32x4 acc[2][4];
#pragma unroll
            for (int nf = 0; nf < 2; ++nf)
#pragma unroll
                for (int pf = 0; pf < 4; ++pf) acc[nf][pf] = (f32x4){0.f, 0.f, 0.f, 0.f};
#pragma unroll
            for (int ks = 0; ks < 4; ++ks) {
                const int t0 = 32 * ks + 8 * q4, trow = t0 + (i16 >> 2);
                const f32x4 wlo = *(const LAS f32x4*)(Wr + t0), whi = *(const LAS f32x4*)(Wr + t0 + 4);
                bf16x8 af[2], bfr[4];
#pragma unroll
                for (int nf = 0; nf < 2; ++nf) {
                    ldsp p = BI + trow * BS + (32 * nq + 16 * nf + 4 * (i16 & 3)) * 2;
                    const u32x2 lo = __builtin_bit_cast(u32x2, vtr(p)), hi = __builtin_bit_cast(u32x2, vtr(p + 4 * BS));
                    af[nf] = packfrag(unpack4(lo) * wlo, unpack4(hi) * whi);
                }
#pragma unroll
                for (int pf = 0; pf < 4; ++pf) { ldsp p = XI + trow * XS + (64 * r + 16 * pf + 4 * (i16 & 3)) * 2; bfr[pf] = cat8(vtr(p), vtr(p + 4 * XS)); }
#pragma unroll
                for (int nf = 0; nf < 2; ++nf)
#pragma unroll
                    for (int pf = 0; pf < 4; ++pf) acc[nf][pf] = mfma16(af[nf], bfr[pf], acc[nf][pf]);
            }
            bf16_t* S = F.st() + ((((size_t)(b * 32 + c) * 2 + dir) * 8 + (4 * g + r)) << 13);
#pragma unroll
            for (int nf = 0; nf < 2; ++nf)
#pragma unroll
                for (int pf = 0; pf < 4; ++pf) *(u32x2*)(S + (16 * pf + i16) * 128 + 32 * nq + 16 * nf + 4 * q4) = pack4(acc[nf][pf]);
        }
        {
            const float acf = ACs[r * 128 + tl], acb = ACs[(4 + r) * 128 + tl];
            f32x4 yt[4];
#pragma unroll
            for (int pf = 0; pf < 4; ++pf) yt[pf] = (f32x4){0.f, 0.f, 0.f, 0.f};
#pragma unroll
            for (int kp = 0; kp < 4; ++kp) {
                f32x4 gt[2];
#pragma unroll
                for (int u = 0; u < 2; ++u) {
                    const int sf = 2 * kp + u, s0 = 16 * sf + 4 * q4;
                    const f32x4 dtf = *(const LAS f32x4*)(DTs + r * 128 + s0), af = *(const LAS f32x4*)(ACs + r * 128 + s0);
                    const f32x4 dtb = *(const LAS f32x4*)(DTs + (4 + r) * 128 + s0), ab = *(const LAS f32x4*)(ACs + (4 + r) * 128 + s0);
#pragma unroll
                    for (int e = 0; e < 4; ++e) {
                        const int sx = s0 + e;
                        const float mf = sx <= tl ? dtf[e] * __expf(acf - af[e]) : 0.f;
                        const float mb = sx >= tl ? dtb[e] * __expf(acb - ab[e]) : 0.f;
                        gt[u][e] = cbt[sf][e] * (mf + mb);
                    }
                }
                const bf16x8 gk = packfrag(gt[0], gt[1]);
#pragma unroll
                for (int pf = 0; pf < 4; ++pf) {
                    ldsp xa = XI + (32 * kp + 4 * q4 + (i16 >> 2)) * XS + (64 * r + 16 * pf + 4 * (i16 & 3)) * 2;
                    yt[pf] = mfma16(cat8(vtr(xa), vtr(xa + 16 * XS)), gk, yt[pf]);
                }
            }
            const float dsk = F.d_skip[4 * g + r];
#pragma unroll
            for (int pf = 0; pf < 4; ++pf) {
                const int pc = 64 * r + 16 * pf + 4 * q4;
                const f32x4 xv = unpack4(*(const LAS u32x2*)(XI + tl * XS + pc * 2));
                *(u32x2*)(F.yp() + row * 512 + 256 * g + pc) = pack4(yt[pf] + xv * dsk);
            }
            if (q4 == 0) { F.efb()[row * 16 + 4 * g + r] = __expf(acf); F.efb()[row * 16 + 8 + 4 * g + r] = __expf(acb); }
        }
    }
}
__device__ __forceinline__ void ssd_scan(const Ctx& F, int vb, int vg) {
    for (int it = vb * 512 + F.tid; it < NBATCH * 2 * 8 * 1024; it += vg * 512) {
        const int e8 = it & 1023, h = (it >> 10) & 7, dir = (it >> 13) & 1, b = it >> 14;
        float run[8];
#pragma unroll
        for (int k = 0; k < 8; ++k) run[k] = 0.f;
        for (int s0 = 0; s0 < 32; s0 += 4) {
            u32x4 v[4]; float dc[4]; bf16_t* ad[4];
#pragma unroll
            for (int u = 0; u < 4; ++u) { const int s = s0 + u, c = dir ? 31 - s : s; ad[u] = F.st() + (((((size_t)(b * 32 + c) * 2 + dir) * 8 + h) << 13) + e8 * 8); v[u] = __builtin_nontemporal_load((const u32x4*)ad[u]); dc[u] = F.dec()[(b * 32 + c) * 16 + dir * 8 + h]; }
#pragma unroll
            for (int u = 0; u < 4; ++u) {
                __builtin_nontemporal_store((u32x4){cvt_pk(run[0], run[1]), cvt_pk(run[2], run[3]), cvt_pk(run[4], run[5]), cvt_pk(run[6], run[7])}, (u32x4*)ad[u]);
                run[0] = run[0] * dc[u] + bf_lo(v[u].x); run[1] = run[1] * dc[u] + bf_hi(v[u].x); run[2] = run[2] * dc[u] + bf_lo(v[u].y); run[3] = run[3] * dc[u] + bf_hi(v[u].y);
                run[4] = run[4] * dc[u] + bf_lo(v[u].z); run[5] = run[5] * dc[u] + bf_hi(v[u].z); run[6] = run[6] * dc[u] + bf_lo(v[u].w); run[7] = run[7] * dc[u] + bf_hi(v[u].w);
            }
        }
    }
}
__device__ __forceinline__ void ssd_pass2_item(const Ctx& F, int item) {
    const int g = item & 1, c = (item >> 1) & 31, b = item >> 6;
    const ldsp PV = F.lds;
    const int lane = F.lane, i16 = lane & 15, q4 = lane >> 4, w = F.wave, tl = 16 * w + i16;
    const size_t row = (size_t)b * SEQ + c * 128 + tl;
    bf16x8 cf[4];
#pragma unroll
    for (int ks = 0; ks < 4; ++ks) cf[ks] = *(const bf16x8*)(F.cfb() + ((size_t)(item * 8 + w) * 64 + lane) * 32 + 8 * ks);
    const int pdir = F.tid >> 8, pp = (F.tid >> 2) & 63, pqu = F.tid & 3;
    const bf16_t* psrc = F.st() + (((((size_t)(b * 32 + c) * 2 + pdir) * 8 + 4 * g) << 13) + pp * 128 + 32 * pqu);
    u32x4 pvn[4][4];
#pragma unroll
    for (int r = 0; r < 4; ++r)
#pragma unroll
        for (int k = 0; k < 4; ++k) pvn[r][k] = *(const u32x4*)(psrc + ((size_t)r << 13) + 8 * k);
    __syncthreads();
#pragma unroll
    for (int r = 0; r < 4; ++r)
#pragma unroll
        for (int k = 0; k < 4; ++k) *(LAS u32x4*)(PV + (2 * r + pdir) * (64 * PS) + pp * PS + (32 * pqu + 8 * k) * 2) = pvn[r][k];
    __syncthreads();
    f32x4 gy[4][4]; float ss = 0.f;
#pragma unroll
    for (int r = 0; r < 4; ++r) {
        u32x2 zraw[4], yraw[4];
#pragma unroll
        for (int pf = 0; pf < 4; ++pf) { const int pc = 256 * g + 64 * r + 16 * pf + 4 * q4; zraw[pf] = *(const u32x2*)(F.proj() + row * PW + C_Z + pc); yraw[pf] = *(const u32x2*)(F.yp() + row * 512 + pc); }
        const float ef = F.efb()[row * 16 + 4 * g + r], eb = F.efb()[row * 16 + 8 + 4 * g + r];
        const ldsp PVr = PV + 2 * r * (64 * PS);
        f32x4 yf[4], yb[4];
#pragma unroll
        for (int pf = 0; pf < 4; ++pf) { yf[pf] = (f32x4){0.f, 0.f, 0.f, 0.f}; yb[pf] = (f32x4){0.f, 0.f, 0.f, 0.f}; }
#pragma unroll
        for (int ks = 0; ks < 4; ++ks)
#pragma unroll
            for (int pf = 0; pf < 4; ++pf) {
                yf[pf] = mfma16(ld8(PVr + (16 * pf + i16) * PS + (32 * ks + 8 * q4) * 2), cf[ks], yf[pf]);
                yb[pf] = mfma16(ld8(PVr + 64 * PS + (16 * pf + i16) * PS + (32 * ks + 8 * q4) * 2), cf[ks], yb[pf]);
            }
#pragma unroll
        for (int pf = 0; pf < 4; ++pf) {
            const f32x4 y = (unpack4(yraw[pf]) + yf[pf] * ef + yb[pf] * eb) * unpack4(zraw[pf]);
            gy[r][pf] = y; ss += y.x * y.x + y.y * y.y + y.z * y.z + y.w * y.w;
        }
    }
    ss += __shfl_xor(ss, 16); ss += __shfl_xor(ss, 32);
    const float rinv = rsqrtf(ss * (1.f / 256.f) + EPS);
#pragma unroll
    for (int r = 0; r < 4; ++r)
#pragma unroll
        for (int pf = 0; pf < 4; ++pf) {
            const int pc = 256 * g + 64 * r + 16 * pf + 4 * q4;
            const f32x4 nw = *(const f32x4*)(F.ssd_norm_w + pc);
            *(u32x2*)(F.mix() + row * MIXP + 1024 + pc) = pack4(gy[r][pf] * rinv * nw);
        }
}

__device__ __forceinline__ void final_norm(const Ctx& F) {
    const int gw = F.bid * 8 + F.wave, NGW = F.G * 8, lane = F.lane;
    for (int m = gw; m < TOK; m += NGW) {
        const f32x4* rp = (const f32x4*)(F.rowss() + (size_t)m * 16); const f32x4 s4 = (rp[0] + rp[1]) + (rp[2] + rp[3]);
        const float r = rsqrtf(((s4.x + s4.y) + (s4.z + s4.w)) * (1.f / DM) + EPS);
        float* o = F.out + (size_t)m * DM;
#pragma unroll
        for (int j = 0; j < 4; ++j) { const f32x4 v = __builtin_nontemporal_load((const f32x4*)(o + 4 * lane + 256 * j)), ww = *(const f32x4*)(F.norm_out_w + 4 * lane + 256 * j); __builtin_nontemporal_store(v * r * ww, (f32x4*)(o + 4 * lane + 256 * j)); }
    }
}

#define XB_TMO      128
#define XB_XCNT(j)  (256  + 64 * (j))
#define XB_XSUB(j)  (1280 + 64 * (j))
#define XB_XGEN(j)  (2304 + 64 * (j))
#define XB_TOP      3328
#define XB_TOPGEN   3392
#define XCD_BAR_WORDS 3456
#define XB_SPIN_CAP (1u << 18)

__device__ __forceinline__ unsigned xb_ld(unsigned* p)              { return __hip_atomic_load(p, __ATOMIC_RELAXED, __HIP_MEMORY_SCOPE_AGENT); }
__device__ __forceinline__ unsigned xb_add(unsigned* p, unsigned v) { return __hip_atomic_fetch_add(p, v, __ATOMIC_RELAXED, __HIP_MEMORY_SCOPE_AGENT); }
__device__ __forceinline__ unsigned xb_xcc_id() { return (unsigned)__builtin_amdgcn_s_getreg((3 << 11) | 20) & 0xFu; }
#define XB_SPIN(cond, bar) do { unsigned _sp = 0; while (cond) { __builtin_amdgcn_s_sleep(1); \
    if ((++_sp & 255u) == 0u) { if (xb_ld(&(bar)[XB_TMO])) break; if (_sp > XB_SPIN_CAP) { atomicAdd(&(bar)[XB_TMO], 1u); break; } } } } while (0)

struct XcdBarrier {
    unsigned* bar; unsigned x;
    volatile LAS unsigned* st;
};

__device__ __forceinline__ XcdBarrier xcd_barrier_post(unsigned* bar, volatile LAS unsigned* st, int xb_tid) {
    XcdBarrier b; b.bar = bar; b.x = xb_xcc_id(); b.st = st;
    if (xb_tid == 0) (void)xb_add(&bar[XB_XCNT(b.x)], 1u);
    return b;
}
__device__ __forceinline__ void xcd_barrier_complete(unsigned* bar, unsigned x, unsigned& nloc, unsigned& nx) {
    const unsigned G = gridDim.x * gridDim.y * gridDim.z;
    unsigned sum, cnt, mine, sp = 0u;
    for (;;) {
        sum = 0u; cnt = 0u; mine = 0u;
#pragma unroll
        for (unsigned j = 0; j < 16; ++j) { const unsigned c = xb_ld(&bar[XB_XCNT(j)]); sum += c; cnt += (c > 0u) ? 1u : 0u; mine = (j == x) ? c : mine; }
        if (sum == G) break;
        __builtin_amdgcn_s_sleep(1);
        if ((++sp & 255u) == 0u) { if (xb_ld(&bar[XB_TMO])) break; if (sp > XB_SPIN_CAP) { atomicAdd(&bar[XB_TMO], 1u); break; } }
    }
    nloc = mine > 0u ? mine : 1u; nx = cnt > 0u ? cnt : 1u;
}

__device__ __forceinline__ void xcd_barrier(const XcdBarrier& b, int xb_tid) {
    asm volatile("s_waitcnt vmcnt(0)" ::: "memory");
    __syncthreads();
    if (xb_tid == 0) {
        unsigned* bar = b.bar;
        __builtin_amdgcn_s_waitcnt(0);
        unsigned nloc = b.st[0], nx = b.st[1];
        if (nloc == 0u) { xcd_barrier_complete(bar, b.x, nloc, nx); b.st[0] = nloc; b.st[1] = nx; }
        const unsigned old = xb_add(&bar[XB_XSUB(b.x)], 1u);
        const unsigned gen = old / nloc;
        if (old + 1u == (gen + 1u) * nloc) {
            __builtin_amdgcn_fence(__ATOMIC_RELEASE, "agent");
            asm volatile("s_waitcnt vmcnt(0)" ::: "memory");
            const unsigned og = xb_add(&bar[XB_TOP], 1u);
            const unsigned tg = og / nx;
            if (og + 1u == (tg + 1u) * nx) xb_add(&bar[XB_TOPGEN], 1u);
            else XB_SPIN(xb_ld(&bar[XB_TOPGEN]) == tg, bar);
            __builtin_amdgcn_fence(__ATOMIC_ACQUIRE, "agent");
            xb_add(&bar[XB_XGEN(b.x)], 1u);
            asm volatile("s_waitcnt vmcnt(0)" ::: "memory");
        } else {
            XB_SPIN(xb_ld(&bar[XB_XGEN(b.x)]) == gen, bar);
            __builtin_amdgcn_fence(__ATOMIC_ACQUIRE, "agent");
            asm volatile("s_waitcnt vmcnt(0)" ::: "memory");
        }
    }
    __syncthreads();
}

__global__ void __launch_bounds__(512, 2) hymba_fwd(Args args) {
    extern __shared__ __attribute__((aligned(16))) unsigned char lds_raw[];
    Ctx F;
    F.x = args.in[0]; F.mem = args.in[1]; F.norm_mem_w = args.in[2]; F.norm_in_w = args.in[3]; F.w_in = args.in[4]; F.attn_sink = args.in[5]; F.conv_w = args.in[6]; F.conv_b = args.in[7];
    F.dt_bias = args.in[8]; F.a_log = args.in[9]; F.d_skip = args.in[10]; F.ssd_norm_w = args.in[11]; F.w_mem_kv = args.in[12]; F.w_out = args.in[13]; F.norm_out_w = args.in[14];
    F.out = args.out; F.ws = args.ws;
    F.lds = (ldsp)lds_raw; F.tid = threadIdx.x; F.lane = F.tid & 63; F.wave = __builtin_amdgcn_readfirstlane(F.tid >> 6); F.G = gridDim.x; F.bid = blockIdx.x;
    const int lo = args.lo, hi = args.hi;
    cg::grid_group grid = cg::this_grid();
#define IN(k) (lo <= (k) && (k) < hi)
#define REFRESH() do { F.lane = lane_id_now(); F.tid = F.wave * 64 + F.lane; } while (0)
    if (F.tid == 0) { *(LAS u32x4*)(F.lds + LDS_XB) = (u32x4){0u, 0u, 0u, 0u}; }
    __syncthreads();
    XcdBarrier xbar; xbar.bar = (unsigned*)args.ws; xbar.x = 0; xbar.st = (volatile LAS unsigned*)(F.lds + LDS_XB);
    if (hi - lo > 1) xbar = xcd_barrier_post((unsigned*)args.ws, (volatile LAS unsigned*)(F.lds + LDS_XB), F.tid);
    if (lo < 0) grid.sync();
#define SEAM(k) do { if (IN(k) && IN((k) + 1)) xcd_barrier(xbar, F.tid); } while (0)
    if (IN(0)) { REFRESH(); phase0(F); }
    SEAM(0);
    if (IN(1)) {
        REFRESH();
        { pg8::Gemm g{F.hn(), F.win_t(), TOK, NPHYS, DM, HNP, HNP}; pg8::StaticOrder S; S.init(g.M, g.N, F.G, F.bid); EpiProj E{F.proj(), F.dt(), F.rope(), F.dt_bias}; pg8::gemm_phase(F.lds, g, S, E, F.wave); }
    }
    SEAM(1);
    if (IN(2)) {
        REFRESH();
        if (F.bid & 1) for (int sq = F.bid; sq < NBATCH * 4 * 4; sq += F.G) attn_window_seq(F, sq);
        for (int it = F.bid; it < NBATCH * 32 * 2; it += F.G) ssd_pass1_item(F, it);
        if (!(F.bid & 1)) for (int sq = F.bid; sq < NBATCH * 4 * 4; sq += F.G) attn_window_seq(F, sq);
    }
    SEAM(2);
    if (IN(3)) {
        REFRESH();
        if (F.G >= 128) {
            if (F.bid < 64) { pg8::Gemm g{F.memn(), F.wmem_t(), NBATCH * 256, 1024, 1024, HNP, HNP}; pg8::StaticOrder S; S.init(g.M, g.N, 64, F.bid); EpiMkv E{F.mkv()}; pg8::gemm_phase(F.lds, g, S, E, F.wave); }
            else ssd_scan(F, F.bid - 64, F.G - 64);
        } else {
            { pg8::Gemm g{F.memn(), F.wmem_t(), NBATCH * 256, 1024, 1024, HNP, HNP}; pg8::StaticOrder S; S.init(g.M, g.N, F.G, F.bid); EpiMkv E{F.mkv()}; pg8::gemm_phase(F.lds, g, S, E, F.wave); }
            ssd_scan(F, F.bid, F.G);
        }
    }
    SEAM(3);
    if (IN(4)) {
        REFRESH();
        if (F.bid & 1) for (int grp = F.bid; grp < NBATCH * 16; grp += F.G) for (int k = 0; k < 4; ++k) attn_mem_item(F, 4 * grp + k, k == 0);
        for (int it = F.bid; it < NBATCH * 32 * 2; it += F.G) ssd_pass2_item(F, it);
        if (!(F.bid & 1)) for (int grp = F.bid; grp < NBATCH * 16; grp += F.G) for (int k = 0; k < 4; ++k) attn_mem_item(F, 4 * grp + k, k == 0);
    }
    SEAM(4);
    if (IN(5)) { REFRESH(); __syncthreads(); pg8::Gemm g{F.mix(), F.wout_t(), TOK, DM, MIXW, MIXP, MIXP}; pg8::StaticOrder S; S.init(g.M, g.N, F.G, F.bid); EpiOut E{F.x, F.out, F.rowss()}; pg8::gemm_phase(F.lds, g, S, E, F.wave); }
    SEAM(5);
    if (IN(6)) { REFRESH(); final_norm(F); }
#undef IN
#undef SEAM
}

extern "C" void kernel_launch(void* const* d_in, const int* in_sizes, int n_in, void* d_out, int out_size, void* d_ws, size_t ws_size, hipStream_t stream) {
    static int grid = 0;
    if (grid == 0) {
        if (n_in != 15 || out_size != TOK * DM || ws_size < WS_END) { fprintf(stderr, "kernel_launch: unexpected shapes (n_in %d out %d ws %zu)\n", n_in, out_size, ws_size); grid = -1; return; }
        int dev = 0, cus = 0, per_cu = 0;
        (void)hipGetDevice(&dev); (void)hipDeviceGetAttribute(&cus, hipDeviceAttributeMultiprocessorCount, dev);
        if (hipFuncSetAttribute((const void*)hymba_fwd, hipFuncAttributeMaxDynamicSharedMemorySize, LDS_BYTES) != hipSuccess) { fprintf(stderr, "kernel_launch: hipFuncSetAttribute failed\n"); grid = -1; return; }
        if (hipOccupancyMaxActiveBlocksPerMultiprocessor(&per_cu, (const void*)hymba_fwd, 512, LDS_BYTES) != hipSuccess || per_cu < 1) { fprintf(stderr, "kernel_launch: occupancy query says %d\n", per_cu); per_cu = 1; }
        (void)hipGetLastError();
        grid = cus > 0 ? cus : 256;
    }
    if (grid < 0) return;
    Args a{};
    for (int i = 0; i < 15; ++i) a.in[i] = (const float*)d_in[i];
    a.out = (float*)d_out; a.ws = (unsigned char*)d_ws;
    (void)hipMemsetAsync(d_ws, 0, 16384, stream);
#if MK_ONE_LAUNCH
    a.lo = 0; a.hi = NPHASE;
    void* kargs[] = {&a};
    hipError_t e = hipLaunchCooperativeKernel((const void*)hymba_fwd, dim3(grid), dim3(512), kargs, LDS_BYTES, stream);
    if (e != hipSuccess) fprintf(stderr, "kernel_launch: cooperative launch failed: %s (grid %d)\n", hipGetErrorString(e), grid);
#else
    for (int k = 0; k < NPHASE; ++k) { a.lo = k; a.hi = k + 1; hipLaunchKernelGGL(hymba_fwd, dim3(grid), dim3(512), LDS_BYTES, stream, a); }
#endif
}
```

```cpp
#include <hip/hip_runtime.h>
#include <hip/hip_cooperative_groups.h>
#include <cstdio>
#include <cstdint>
namespace cg = cooperative_groups;

#ifndef MK_ONE_LAUNCH
#define MK_ONE_LAUNCH 1
#endif

#define LAS __attribute__((address_space(3)))
typedef unsigned short bf16_t;
typedef short bf16x8 __attribute__((ext_vector_type(8)));
typedef short s16x4 __attribute__((ext_vector_type(4)));
typedef float f32x4 __attribute__((ext_vector_type(4)));
typedef float f32x2 __attribute__((ext_vector_type(2)));
typedef unsigned u32x4 __attribute__((ext_vector_type(4)));
typedef unsigned u32x2 __attribute__((ext_vector_type(2)));
typedef LAS unsigned char* ldsp;

constexpr int SEQ = 4096, NBATCH = 16, TOK = SEQ * NBATCH, DM = 1024;
constexpr int INW = 5136, NPHYS = 5376, PW = 5184;
constexpr int HNP = 1088, MIXP = 2112;
constexpr int C_Q = 0, C_K = 1024, C_V = 1280, C_G = 1536, C_Z = 2560, C_X = 3072, C_QM = 4096, C_GM = 4608;
constexpr int MIXW = 2048;
constexpr float LOG2E = 1.4426950408889634f;
constexpr float EPS = 1e-6f;
constexpr int NPHASE = 7;

constexpr size_t MiB = (size_t)1 << 20;
constexpr size_t WS_ROWSS = 956 * MiB, WS_ROPE = 1 * MiB, WS_WIN = 2 * MiB, WS_WOUT = 14 * MiB, WS_WMEM = 19 * MiB, WS_MEMN = 22 * MiB,
                 WS_MKV = 31 * MiB, WS_DT = 39 * MiB, WS_DEC = 43 * MiB, WS_PROJ = 44 * MiB, WS_MIX = 692 * MiB, WS_END = 960 * MiB;

constexpr int LDS_BYTES = 155648 + 16;
constexpr int LDS_XB = 155648;

__device__ __forceinline__ unsigned cvt_pk(float lo, float hi) { unsigned r; asm volatile("v_cvt_pk_bf16_f32 %0, %1, %2" : "=v"(r) : "v"(lo), "v"(hi)); return r; }
typedef __bf16 bf16x2_t __attribute__((ext_vector_type(2)));
__device__ __forceinline__ unsigned cvt_pk_c(float lo, float hi) { const f32x2 v = {lo, hi}; return __builtin_bit_cast(unsigned, __builtin_convertvector(v, bf16x2_t)); }
__device__ __forceinline__ float bf_lo(unsigned u) { return __uint_as_float(u << 16); }
__device__ __forceinline__ float bf_hi(unsigned u) { return __uint_as_float(u & 0xffff0000u); }
__device__ __forceinline__ f32x4 unpack4(u32x2 v) { return (f32x4){bf_lo(v.x), bf_hi(v.x), bf_lo(v.y), bf_hi(v.y)}; }
__device__ __forceinline__ u32x2 pack4(f32x4 v) { return (u32x2){cvt_pk_c(v.x, v.y), cvt_pk_c(v.z, v.w)}; }
__device__ __forceinline__ float silu_f(float x) { return x * __builtin_amdgcn_rcpf(1.f + __expf(-x)); }
__device__ __forceinline__ f32x4 silu4(f32x4 v) { return (f32x4){silu_f(v.x), silu_f(v.y), silu_f(v.z), silu_f(v.w)}; }
__device__ __forceinline__ float softplus_f(float x) { return x > 15.f ? x : __logf(1.f + __expf(x)); }
__device__ __forceinline__ float ex2(float x) { return __builtin_amdgcn_exp2f(x); }
typedef short v4i16_t __attribute__((ext_vector_type(4)));
__device__ __forceinline__ s16x4 vtr(ldsp p) { return __builtin_bit_cast(s16x4, __builtin_amdgcn_ds_read_tr16_b64_v4i16((LAS v4i16_t*)p)); }
__device__ __forceinline__ bf16x8 cat8(s16x4 a, s16x4 b) { return (bf16x8){a[0], a[1], a[2], a[3], b[0], b[1], b[2], b[3]}; }
__device__ __forceinline__ bf16x8 ld8(ldsp p) { return *(const LAS bf16x8*)p; }
__device__ __forceinline__ f32x4 mfma16(bf16x8 a, bf16x8 b, f32x4 c) { return __builtin_amdgcn_mfma_f32_16x16x32_bf16(a, b, c, 0, 0, 0); }
__device__ __forceinline__ bf16x8 packfrag(f32x4 a, f32x4 b) { u32x4 r = {cvt_pk_c(a.x, a.y), cvt_pk_c(a.z, a.w), cvt_pk_c(b.x, b.y), cvt_pk_c(b.z, b.w)}; return __builtin_bit_cast(bf16x8, r); }

__device__ __forceinline__ f32x4 zero4() { f32x4 z; asm volatile("v_mov_b32 %0, 0\n\tv_mov_b32 %1, 0\n\tv_mov_b32 %2, 0\n\tv_mov_b32 %3, 0" : "=v"(z.x), "=v"(z.y), "=v"(z.z), "=v"(z.w)); return z; }
__device__ __forceinline__ int lane_id_now() { int l; asm volatile("v_mbcnt_lo_u32_b32 %0, -1, 0\n\tv_mbcnt_hi_u32_b32 %0, -1, %0" : "=v"(l)); return l; }
__host__ __device__ __forceinline__ int perm_plain(int c) { const int bj = c >> 7, wc = (c >> 5) & 3, n = (c >> 4) & 1, fq = (c >> 2) & 3, i = c & 3; return 128 * bj + 32 * wc + 8 * fq + 4 * n + i; }
__host__ __device__ __forceinline__ int perm_rot(int c) { const int bj = c >> 7, wc = (c >> 5) & 3, n = (c >> 4) & 1, fq = (c >> 2) & 3, i = c & 3; return 64 * wc + 32 * bj + 8 * fq + 4 * n + i; }

namespace pg8 {
constexpr int BM = 256, BK = 64, HALF = 128, HTB = HALF * BK * 2, STAGE_BYTES = 8 * HTB, NXCD = 8, WGM = 8;
__host__ __device__ __forceinline__ int lds_byte(int r, int c) { const int st = (r >> 4) * 2 + (c >> 5), rr = r & 15, cc = c & 31, ob = rr * 64 + cc * 2; return st * 1024 + (ob ^ (((ob >> 9) & 1) << 5)); }
__host__ __device__ __forceinline__ void stage_rc(int b, int& R, int& C) { const int st = b / 1024, sb = b % 1024, swz = sb ^ (((sb >> 9) & 1) << 5); R = (st >> 1) * 16 + swz / 64; C = (st & 1) * 32 + (swz % 64) / 2; }
struct Unit { int pm, pn; };
struct Gemm { const bf16_t* A; const bf16_t* Bt; int M, N, K, lda, ldb; };
struct StaticOrder {
    int nM, nN, nwg, G, c;
    __device__ void init(int M, int N, int G_, int c_) { nM = M / BM; nN = N / BM; nwg = nM * nN; G = G_; c = c_; }
    __device__ bool next(int i, Unit& u) const {
        const long L = (long)i * G + c; if (L >= nwg) return false;
        int wgid = (int)L; { const int q = nwg / NXCD, r = nwg % NXCD, xcd = wgid % NXCD, off = wgid / NXCD; wgid = (xcd < r ? xcd * (q + 1) : r * (q + 1) + (xcd - r) * q) + off; }
        const int nig = WGM * nN, gid = wgid / nig, fm = gid * WGM, gsz = (nM - fm) < WGM ? (nM - fm) : WGM;
        u.pm = fm + ((wgid % nig) % gsz); u.pn = (wgid % nig) / gsz; return true;
    }
};
template <class Epi, class Sched>
__device__ __forceinline__ void gemm_phase(ldsp lds, const Gemm g, const Sched& S, const Epi& E, int wave_id) {
    const int lane = lane_id_now(), wid = wave_id, tid = wid * 64 + lane, wr = wid >> 2, wc = wid & 3, fr = lane & 15, fq = lane >> 4;
    const int K = g.K, nt = K / BK;
    unsigned voffA[2], voffB[2];
#pragma unroll
    for (int i = 0; i < 2; ++i) { int R, C; stage_rc(tid * 16 + i * 8192, R, C); voffA[i] = (unsigned)(R * g.lda + C) * 2u; voffB[i] = (unsigned)(R * g.ldb + C) * 2u; }
    const size_t kstep = (size_t)(BK * 2);
    const size_t hstep = (size_t)HALF * g.lda * 2, hstepB = (size_t)HALF * g.ldb * 2;
    const size_t tstep = 2 * hstep, tstepB = 2 * hstepB;
    const unsigned ldsw = (unsigned)wid * 1024u;
    const int aoff = lds_byte(wr * 64 + fr, fq * 8), boff = lds_byte(wc * 32 + fr, fq * 8);
#define PG8_SA(b, h) (((b) * 2 + (h)) * HTB)
#define PG8_SB(b, h) ((4 + (b) * 2 + (h)) * HTB)
#define PG8_STAGE(bufoff, gbase, voff) do { _Pragma("unroll") for (int _i = 0; _i < 2; ++_i) \
        __builtin_amdgcn_global_load_lds((const unsigned*)((const char*)(gbase) + (voff)[_i]), (LAS unsigned*)(lds + (bufoff) + ldsw + _i * 8192), 16, 0, 0); } while (0)
#define PG8_LDA(dst, b, h) do { _Pragma("unroll") for (int m = 0; m < 4; ++m) _Pragma("unroll") for (int k = 0; k < 2; ++k) dst[m][k] = *(const LAS bf16x8*)(lds + PG8_SA(b, h) + aoff + m * 2048 + k * 1024); } while (0)
#define PG8_LDB(dst, b, h) do { _Pragma("unroll") for (int n = 0; n < 2; ++n) _Pragma("unroll") for (int k = 0; k < 2; ++k) dst[n][k] = *(const LAS bf16x8*)(lds + PG8_SB(b, h) + boff + n * 2048 + k * 1024); } while (0)
#define PG8_MMA(ai, bj, At, Bt) do { __builtin_amdgcn_s_setprio(1); _Pragma("unroll") for (int m = 0; m < 4; ++m) _Pragma("unroll") for (int n = 0; n < 2; ++n) _Pragma("unroll") for (int k = 0; k < 2; ++k) \
        acc[ai][bj][m][n] = __builtin_amdgcn_mfma_f32_16x16x32_bf16(Bt[n][k], At[m][k], acc[ai][bj][m][n], 0, 0, 0); __builtin_amdgcn_s_setprio(0); } while (0)
#define PG8_WAIT_V(n) asm volatile("s_waitcnt vmcnt(" #n ")" ::: "memory")
#define PG8_WAIT_L(n) asm volatile("s_waitcnt lgkmcnt(" #n ")" ::: "memory")
#define PG8_BAR __builtin_amdgcn_s_barrier()
#define PG8_SCHED __builtin_amdgcn_sched_barrier(0)
    Unit cur, nxt; int ui = 0;
    if (!S.next(0, cur)) return;
    f32x4 acc[2][2][4][2];
#pragma unroll
    for (int a = 0; a < 2; ++a)
#pragma unroll
        for (int b = 0; b < 2; ++b)
#pragma unroll
            for (int m = 0; m < 4; ++m)
#pragma unroll
                for (int n = 0; n < 2; ++n) acc[a][b][m][n] = (f32x4){0.f, 0.f, 0.f, 0.f};
    bf16x8 At[4][2], B0[2][2], B1[2][2];
    const char* cA = (const char*)g.A + (size_t)cur.pm * tstep; const char* cB = (const char*)g.Bt + (size_t)cur.pn * tstepB;
    PG8_STAGE(PG8_SB(0, 0), cB, voffB); PG8_STAGE(PG8_SA(0, 0), cA, voffA); PG8_STAGE(PG8_SB(0, 1), cB + hstepB, voffB); PG8_STAGE(PG8_SA(0, 1), cA + hstep, voffA);
    if (wr == 1) PG8_BAR;
    PG8_WAIT_V(4); PG8_BAR;
    PG8_STAGE(PG8_SB(1, 0), cB + kstep, voffB); PG8_STAGE(PG8_SA(1, 0), cA + kstep, voffA); PG8_STAGE(PG8_SB(1, 1), cB + hstepB + kstep, voffB);
    PG8_WAIT_V(6); PG8_BAR;
    for (;;) {
        const bool has_next = S.next(ui + 1, nxt);
        const char* nA = has_next ? (const char*)g.A + (size_t)nxt.pm * tstep : cA; const char* nB = has_next ? (const char*)g.Bt + (size_t)nxt.pn * tstepB : cB;
        for (int t = 0; t < nt; t += 2) {
            const bool last = (t == nt - 2);
            const char* a1 = cA + (size_t)(t + 1) * kstep;
            const char* a2 = last ? nA : cA + (size_t)(t + 2) * kstep; const char* b2 = last ? nB : cB + (size_t)(t + 2) * kstep;
            const char* a3 = a2 + kstep; const char* b3 = b2 + kstep;
            PG8_LDB(B0, 0, 0); PG8_SCHED; PG8_LDA(At, 0, 0); PG8_STAGE(PG8_SA(1, 1), a1 + hstep, voffA);
            PG8_WAIT_L(8); PG8_BAR; PG8_WAIT_L(0); PG8_MMA(0, 0, At, B0); PG8_BAR; PG8_SCHED;
            PG8_LDB(B1, 0, 1); PG8_STAGE(PG8_SB(0, 0), b2, voffB);
            PG8_BAR; PG8_WAIT_L(0); PG8_MMA(0, 1, At, B1); PG8_BAR;
            PG8_LDA(At, 0, 1); PG8_STAGE(PG8_SA(0, 0), a2, voffA);
            PG8_BAR; PG8_WAIT_L(0); PG8_MMA(1, 0, At, B0); PG8_BAR; PG8_SCHED;
            PG8_STAGE(PG8_SB(0, 1), b2 + hstepB, voffB);
            PG8_WAIT_V(6); PG8_BAR; PG8_MMA(1, 1, At, B1); PG8_BAR;
            PG8_LDB(B0, 1, 0); PG8_SCHED; PG8_LDA(At, 1, 0); PG8_STAGE(PG8_SA(0, 1), a2 + hstep, voffA);
            PG8_WAIT_L(8); PG8_BAR; PG8_WAIT_L(0); PG8_MMA(0, 0, At, B0); PG8_BAR; PG8_SCHED;
            PG8_LDB(B1, 1, 1); PG8_STAGE(PG8_SB(1, 0), b3, voffB);
            PG8_BAR; PG8_WAIT_L(0); PG8_MMA(0, 1, At, B1); PG8_BAR;
            PG8_LDA(At, 1, 1); PG8_STAGE(PG8_SA(1, 0), a3, voffA);
            PG8_BAR; PG8_WAIT_L(0); PG8_MMA(1, 0, At, B0); PG8_BAR; PG8_SCHED;
            PG8_STAGE(PG8_SB(1, 1), b3 + hstepB, voffB);
            PG8_WAIT_V(6); PG8_BAR; PG8_MMA(1, 1, At, B1); PG8_BAR;
        }
        E(acc, cur, wr, wc, fr, fq);
        if (!has_next) break;
#pragma unroll
        for (int a = 0; a < 2; ++a)
#pragma unroll
            for (int b = 0; b < 2; ++b)
#pragma unroll
                for (int m = 0; m < 4; ++m)
#pragma unroll
                    for (int n = 0; n < 2; ++n) acc[a][b][m][n] = (f32x4){0.f, 0.f, 0.f, 0.f};
        cur = nxt; cA = nA; cB = nB; ++ui;
    }
    PG8_WAIT_V(0);
    if (wr == 0) PG8_BAR;
    PG8_BAR;
#undef PG8_SA
#undef PG8_SB
#undef PG8_STAGE
#undef PG8_LDA
#undef PG8_LDB
#undef PG8_MMA
#undef PG8_WAIT_V
#undef PG8_WAIT_L
#undef PG8_BAR
#undef PG8_SCHED
}
}

struct EpiProj {
    bf16_t* P; float* DT; const float* rope; const float* dt_bias;
    __device__ __forceinline__ void operator()(const f32x4 (&acc)[2][2][4][2], const pg8::Unit& u, int wr, int wc, int fr, int fq) const {
        const int row0 = u.pm * 256 + wr * 64 + fr, pn = u.pn;
        if (pn < 5) {
            const float sc = pn < 4 ? 0.125f * LOG2E : 1.f;
            const int col = pn * 256 + 64 * wc + 8 * fq;
#pragma unroll
            for (int ai = 0; ai < 2; ++ai)
#pragma unroll
                for (int m = 0; m < 4; ++m) {
                    const int row = row0 + ai * 128 + m * 16, pos = row & (SEQ - 1);
                    const f32x4* cp = (const f32x4*)(rope + pos * 32 + 8 * fq); const f32x4* sp = (const f32x4*)(rope + SEQ * 32 + pos * 32 + 8 * fq);
                    f32x4 o1[2], o2[2];
#pragma unroll
                    for (int n = 0; n < 2; ++n) { const f32x4 c = cp[n], s = sp[n], t1 = acc[ai][0][m][n], t2 = acc[ai][1][m][n]; o1[n] = (t1 * c - t2 * s) * sc; o2[n] = (t1 * s + t2 * c) * sc; }
                    bf16_t* dst = P + (size_t)row * PW + col;
                    __builtin_nontemporal_store((u32x4){cvt_pk(o1[0].x, o1[0].y), cvt_pk(o1[0].z, o1[0].w), cvt_pk(o1[1].x, o1[1].y), cvt_pk(o1[1].z, o1[1].w)}, (u32x4*)dst);
                    __builtin_nontemporal_store((u32x4){cvt_pk(o2[0].x, o2[0].y), cvt_pk(o2[0].z, o2[0].w), cvt_pk(o2[1].x, o2[1].y), cvt_pk(o2[1].z, o2[1].w)}, (u32x4*)(dst + 32));
                }
        } else if (pn < 20) {
            const bool do_silu = (pn >= 6 && pn < 12) || pn >= 18;
            const float sc = (pn == 16 || pn == 17) ? 0.08838834764831845f * LOG2E : 1.f;
            const int col = pn * 256 + 32 * wc + 8 * fq;
#pragma unroll
            for (int ai = 0; ai < 2; ++ai)
#pragma unroll
                for (int m = 0; m < 4; ++m) {
                    const int row = row0 + ai * 128 + m * 16;
#pragma unroll
                    for (int bj = 0; bj < 2; ++bj) {
                        f32x4 v0 = acc[ai][bj][m][0], v1 = acc[ai][bj][m][1];
                        if (do_silu) { v0 = silu4(v0); v1 = silu4(v1); } else { v0 = v0 * sc; v1 = v1 * sc; }
                        __builtin_nontemporal_store((u32x4){cvt_pk(v0.x, v0.y), cvt_pk(v0.z, v0.w), cvt_pk(v1.x, v1.y), cvt_pk(v1.z, v1.w)}, (u32x4*)(P + (size_t)row * PW + col + 128 * bj));
                    }
                }
        } else {
            if (wc == 0 && fq < 2) {
                const f32x4 bb0 = *(const f32x4*)(dt_bias + 8 * fq), bb1 = *(const f32x4*)(dt_bias + 8 * fq + 4);
#pragma unroll
                for (int ai = 0; ai < 2; ++ai)
#pragma unroll
                    for (int m = 0; m < 4; ++m) {
                        const int row = row0 + ai * 128 + m * 16;
#pragma unroll
                        for (int n = 0; n < 2; ++n) {
                            const int j0 = 8 * fq + 4 * n; const f32x4 v = acc[ai][0][m][n] + (n ? bb1 : bb0);
                            *(f32x4*)(DT + (size_t)row * 16 + j0) = (f32x4){softplus_f(v.x), softplus_f(v.y), softplus_f(v.z), softplus_f(v.w)};
                        }
                    }
            }
        }
    }
};
struct EpiMkv {
    bf16_t* O;
    __device__ __forceinline__ void operator()(const f32x4 (&acc)[2][2][4][2], const pg8::Unit& u, int wr, int wc, int fr, int fq) const {
        const int row0 = u.pm * 256 + wr * 64 + fr, col = u.pn * 256 + 32 * wc + 8 * fq;
#pragma unroll
        for (int ai = 0; ai < 2; ++ai)
#pragma unroll
            for (int m = 0; m < 4; ++m) {
                const int row = row0 + ai * 128 + m * 16;
#pragma unroll
                for (int bj = 0; bj < 2; ++bj) { const f32x4 v0 = acc[ai][bj][m][0], v1 = acc[ai][bj][m][1];
                    *(u32x4*)(O + (size_t)row * 1024 + col + 128 * bj) = (u32x4){cvt_pk(v0.x, v0.y), cvt_pk(v0.z, v0.w), cvt_pk(v1.x, v1.y), cvt_pk(v1.z, v1.w)}; }
            }
    }
};
struct EpiOut {
    const float* x; float* out; float* rowss;
    __device__ __forceinline__ void operator()(const f32x4 (&acc)[2][2][4][2], const pg8::Unit& u, int wr, int wc, int fr, int fq) const {
        const int row0 = u.pm * 256 + wr * 64 + fr, col = u.pn * 256 + 32 * wc + 8 * fq;
#pragma unroll
        for (int ai = 0; ai < 2; ++ai) {
            f32x4 xv[4][2][2];
#pragma unroll
            for (int m = 0; m < 4; ++m)
#pragma unroll
                for (int bj = 0; bj < 2; ++bj) {
                    const size_t o = (size_t)(row0 + ai * 128 + m * 16) * DM + col + 128 * bj;
                    xv[m][bj][0] = __builtin_nontemporal_load((const f32x4*)(x + o)); xv[m][bj][1] = __builtin_nontemporal_load((const f32x4*)(x + o + 4));
                }
#pragma unroll
            for (int m = 0; m < 4; ++m) {
                const int row = row0 + ai * 128 + m * 16; float ss = 0.f;
#pragma unroll
                for (int bj = 0; bj < 2; ++bj) {
                    const size_t o = (size_t)row * DM + col + 128 * bj;
                    const f32x4 h0 = xv[m][bj][0] + acc[ai][bj][m][0], h1 = xv[m][bj][1] + acc[ai][bj][m][1];
                    *(f32x4*)(out + o) = h0; *(f32x4*)(out + o + 4) = h1;
                    ss += h0.x * h0.x + h0.y * h0.y + h0.z * h0.z + h0.w * h0.w + h1.x * h1.x + h1.y * h1.y + h1.z * h1.z + h1.w * h1.w;
                }
                ss += __shfl_xor(ss, 16); ss += __shfl_xor(ss, 32);
                if (fq == 0) rowss[(size_t)row * 16 + u.pn * 4 + wc] = ss;
            }
        }
    }
};

struct Args { const float* in[15]; float* out; unsigned char* ws; int lo, hi; };
struct Ctx {
    const float *x, *mem, *norm_mem_w, *norm_in_w, *w_in, *attn_sink, *conv_w, *conv_b, *dt_bias, *a_log, *d_skip, *ssd_norm_w, *w_mem_kv, *w_out, *norm_out_w;
    float* out; unsigned char* ws;
    __device__ __forceinline__ float* rowss() const { return (float*)(ws + WS_ROWSS); }
    __device__ __forceinline__ float* rope() const { return (float*)(ws + WS_ROPE); }
    __device__ __forceinline__ bf16_t* win_t() const { return (bf16_t*)(ws + WS_WIN); }
    __device__ __forceinline__ bf16_t* wout_t() const { return (bf16_t*)(ws + WS_WOUT); }
    __device__ __forceinline__ bf16_t* wmem_t() const { return (bf16_t*)(ws + WS_WMEM); }
    __device__ __forceinline__ bf16_t* memn() const { return (bf16_t*)(ws + WS_MEMN); }
    __device__ __forceinline__ bf16_t* mkv() const { return (bf16_t*)(ws + WS_MKV); }
    __device__ __forceinline__ float* dt() const { return (float*)(ws + WS_DT); }
    __device__ __forceinline__ float* dec() const { return (float*)(ws + WS_DEC); }
    __device__ __forceinline__ bf16_t* proj() const { return (bf16_t*)(ws + WS_PROJ); }
    __device__ __forceinline__ bf16_t* mix() const { return (bf16_t*)(ws + WS_MIX); }
    __device__ __forceinline__ bf16_t* hn() const { return (bf16_t*)((unsigned char*)out); }
    __device__ __forceinline__ bf16_t* st() const { return (bf16_t*)((unsigned char*)out); }
    __device__ __forceinline__ bf16_t* yp() const { return (bf16_t*)((unsigned char*)out + 128 * MiB); }
    __device__ __forceinline__ bf16_t* cfb() const { return (bf16_t*)((unsigned char*)out + 192 * MiB); }
    __device__ __forceinline__ float* efb() const { return (float*)((unsigned char*)out + 224 * MiB); }
    ldsp lds; int tid, lane, wave, G, bid;
};

__device__ __forceinline__ void rms_row_bf16(const float* xr, const float* w, bf16_t* o, int lane) {
    f32x4 v[4]; float ss = 0.f;
#pragma unroll
    for (int j = 0; j < 4; ++j) { v[j] = __builtin_nontemporal_load((const f32x4*)(xr + 4 * lane + 256 * j)); ss += v[j].x * v[j].x + v[j].y * v[j].y + v[j].z * v[j].z + v[j].w * v[j].w; }
#pragma unroll
    for (int off = 1; off < 64; off <<= 1) ss += __shfl_xor(ss, off);
    const float r = rsqrtf(ss * (1.f / DM) + EPS);
#pragma unroll
    for (int j = 0; j < 4; ++j) { const f32x4 ww = *(const f32x4*)(w + 4 * lane + 256 * j); *(u32x2*)(o + 4 * lane + 256 * j) = pack4(v[j] * r * ww); }
}
template <int MODE>
__device__ __forceinline__ void transpose_w(const Ctx& F, const float* W, int K, int NS, bf16_t* Bt, int NP, int ldb) {
    const int nitems = NP * (K / 8);
    for (int it = F.bid * 512 + F.tid; it < nitems; it += F.G * 512) {
        const int n = it % NP, kg = it / NP, tile = n >> 8, cph = n & 255; int src;
        if (MODE == 0) {
            if (tile < 5) src = tile * 256 + perm_rot(cph);
            else if (tile < 20) { src = tile * 256 + perm_plain(cph); if (src >= 4096) src += 16; }
            else { const int l = perm_plain(cph); src = l < 16 ? 4096 + l : -1; }
        } else src = tile * 256 + perm_plain(cph);
        float v[8];
#pragma unroll
        for (int j = 0; j < 8; ++j) v[j] = src >= 0 ? W[(size_t)(kg * 8 + j) * NS + src] : 0.f;
        *(u32x4*)(Bt + (size_t)n * ldb + kg * 8) = (u32x4){cvt_pk(v[0], v[1]), cvt_pk(v[2], v[3]), cvt_pk(v[4], v[5]), cvt_pk(v[6], v[7])};
    }
}
__device__ __forceinline__ void phase0(const Ctx& F) {
    const int gt = F.bid * 512 + F.tid, NT = F.G * 512;
    for (int i = gt; i < SEQ * 32; i += NT) {
        const int pos = i >> 5, f = i & 31;
        const float inv = 1.0f / exp2f((float)f * (13.287712379549449f / 32.f));
        const float ang = (float)pos * inv;
        const double rev = (double)ang * 0.15915494309189535; const double fr = rev - __builtin_rint(rev);
        const float r = (float)(fr * 6.283185307179586);
        F.rope()[i] = __cosf(r); F.rope()[SEQ * 32 + i] = __sinf(r);
    }
    transpose_w<0>(F, F.w_in, DM, INW, F.win_t(), NPHYS, HNP);
    transpose_w<1>(F, F.w_out, MIXW, DM, F.wout_t(), DM, MIXP);
    transpose_w<1>(F, F.w_mem_kv, DM, DM, F.wmem_t(), DM, HNP);
    const int gw = F.bid * 8 + F.wave, NGW = F.G * 8;
    for (int m = gw; m < NBATCH * 256; m += NGW) rms_row_bf16(F.mem + (size_t)m * DM, F.norm_mem_w, F.memn() + (size_t)m * HNP, F.lane);
    for (int m = gw; m < TOK; m += NGW) rms_row_bf16(F.x + (size_t)m * DM, F.norm_in_w, F.hn() + (size_t)m * HNP, F.lane);
}

template <int DH, int NQF>
__device__ __forceinline__ void attn_tile(ldsp Kt, int KS, ldsp Vt, int VS, const bf16x8 (&qf)[NQF][DH / 32], f32x4 (&o)[DH / 16][NQF], float (&m)[NQF], float (&lp)[NQF], int maskmode, int lane, int qoff = 0, bool first = false) {
    const int i16 = lane & 15, q4 = lane >> 4;
    f32x4 st[4][NQF];
#pragma unroll
    for (int kf = 0; kf < 4; ++kf)
#pragma unroll
        for (int q = 0; q < NQF; ++q) { const float nm = -m[q]; st[kf][q] = (f32x4){nm, nm, nm, nm}; }
#pragma unroll
    for (int ks = 0; ks < DH / 32; ++ks)
#pragma unroll
        for (int kf = 0; kf < 4; ++kf) {
            const bf16x8 ka = ld8(Kt + (16 * kf + i16) * KS + (32 * ks + 8 * q4) * 2);
#pragma unroll
            for (int q = 0; q < NQF; ++q) st[kf][q] = mfma16(ka, qf[q][ks], st[kf][q]);
            if (DH > 64 && kf == 3) __builtin_amdgcn_sched_barrier(0);
        }
    if (maskmode) {
        int zb; asm volatile("v_mov_b32 %0, 0" : "=v"(zb));
        const int base = (maskmode == 1 ? 4 * q4 - i16 - qoff : i16 + qoff - 4 * q4) + zb;
#pragma unroll
        for (int kf = 0; kf < 4; ++kf)
#pragma unroll
            for (int q = 0; q < NQF; ++q)
#pragma unroll
                for (int r = 0; r < 4; ++r) { const int off = 16 * (kf - q) + r; const bool bad = (maskmode == 1 ? base + off : base - off) < 0; if (bad) st[kf][q][r] = -INFINITY; }
    }
#pragma unroll
    for (int q = 0; q < NQF; ++q) {
        float mx = st[0][q][0];
#pragma unroll
        for (int kf = 0; kf < 4; ++kf)
#pragma unroll
            for (int r = 0; r < 4; ++r) mx = fmaxf(mx, st[kf][q][r]);
        if (first || __builtin_amdgcn_ballot_w64(mx > 8.f) != 0ull) {
            mx = fmaxf(mx, __shfl_xor(mx, 16)); mx = fmaxf(mx, __shfl_xor(mx, 32));
            const float delta = (first || mx > 8.f) ? mx : 0.f; m[q] += delta;
            if (!first) {
                const float alpha = ex2(-delta);
                lp[q] = lp[q] * alpha;
#pragma unroll
                for (int d = 0; d < DH / 16; ++d) o[d][q] = o[d][q] * alpha;
            }
#pragma unroll
            for (int kf = 0; kf < 4; ++kf) st[kf][q] = st[kf][q] - delta;
        }
        float ps = 0.f;
#pragma unroll
        for (int kf = 0; kf < 4; ++kf)
#pragma unroll
            for (int r = 0; r < 4; ++r) { const float p = ex2(st[kf][q][r]); st[kf][q][r] = p; ps += p; }
        lp[q] += ps;
    }
#pragma unroll
    for (int kp = 0; kp < 2; ++kp) {
        bf16x8 pk[NQF];
#pragma unroll
        for (int q = 0; q < NQF; ++q) pk[q] = packfrag(st[2 * kp][q], st[2 * kp + 1][q]);
#pragma unroll
        for (int d = 0; d < DH / 16; ++d) {
            ldsp va = Vt + (32 * kp + 4 * q4 + (i16 >> 2)) * VS + (16 * d + 4 * (i16 & 3)) * 2;
            const bf16x8 vf = cat8(vtr(va), vtr(va + 16 * VS));
#pragma unroll
            for (int q = 0; q < NQF; ++q) o[d][q] = mfma16(vf, pk[q], o[d][q]);
            if (DH > 64 && (d & 3) == 3) __builtin_amdgcn_sched_barrier(0);
        }
    }
}

__device__ __forceinline__ void ring_stage_block(const Ctx& F, const bf16_t* kvbase, int keyblock) {
    constexpr int KS = 144, VS = 160; const ldsp Kb = F.lds + (keyblock & 511) * KS, Vb = F.lds + 512 * KS + (keyblock & 511) * VS;
    const bf16_t* src0 = kvbase + (size_t)keyblock * PW;
    for (int wi = F.wave; wi < 18; wi += 8) {
        const int slot = wi * 64 + F.lane, row = slot / 9, ch = slot - row * 9;
        __builtin_amdgcn_global_load_lds((const unsigned*)(src0 + (size_t)row * PW + C_K + 8 * (ch > 7 ? 7 : ch)), (LAS unsigned*)(Kb + wi * 1024), 16, 0, 0);
    }
    for (int wi = F.wave; wi < 20; wi += 8) {
        const int slot = wi * 64 + F.lane, row = slot / 10, ch = slot - row * 10;
        __builtin_amdgcn_global_load_lds((const unsigned*)(src0 + (size_t)row * PW + C_V + 8 * (ch > 7 ? 7 : ch)), (LAS unsigned*)(Vb + wi * 1024), 16, 0, 0);
    }
}
__device__ __forceinline__ void attn_window_seq(const Ctx& F, int sq) {
    constexpr int KS = 144, VS = 160; const ldsp Ki = F.lds, Vi = F.lds + 512 * KS;
    const int sidx = sq >> 2, b = sidx >> 2, kvh = sidx & 3, i0 = 8 * (sq & 3);
    const int w = F.wave, lane = F.lane, i16 = lane & 15, q4 = lane >> 4, hq = 4 * kvh + (w >> 1);
    const bf16_t* kvbase = F.proj() + (size_t)b * SEQ * PW + 64 * kvh;
    __syncthreads();
    for (int t = 0; t < 3; ++t) { const int kb = 128 * (i0 - 1 + t); if (kb >= 0 && kb < SEQ) ring_stage_block(F, kvbase, kb); }
    const float sink = F.attn_sink[hq] * LOG2E;
#pragma unroll 1
    for (int k = 0; k < 8; ++k) {
        const int i = i0 + k, q0 = 128 * i + 64 * (w & 1);
        __syncthreads();
        { const int nkey0 = 128 * i + 256; if (k < 7 && nkey0 < SEQ) ring_stage_block(F, kvbase, nkey0); }
#pragma unroll 1
        for (int half = 0; half < 2; ++half) {
            const int qh = q0 + 32 * half;
            bf16x8 qf[2][2];
#pragma unroll
            for (int q = 0; q < 2; ++q)
#pragma unroll
                for (int ks = 0; ks < 2; ++ks) qf[q][ks] = *(const bf16x8*)(F.proj() + (size_t)(b * SEQ + qh + 16 * q + i16) * PW + C_Q + hq * 64 + 32 * ks + 8 * q4);
            u32x2 graw[2][4];
#pragma unroll
            for (int q = 0; q < 2; ++q)
#pragma unroll
                for (int d = 0; d < 4; ++d) graw[q][d] = *(const u32x2*)(F.proj() + (size_t)(b * SEQ + qh + 16 * q + i16) * PW + C_G + hq * 64 + 16 * d + 4 * q4);
            f32x4 o[4][2]; float m[2], lp[2];
#pragma unroll
            for (int q = 0; q < 2; ++q) { m[q] = sink; lp[q] = q4 == 0 ? 1.f : 0.f;
#pragma unroll
                for (int d = 0; d < 4; ++d) o[d][q] = (f32x4){0.f, 0.f, 0.f, 0.f}; }
#pragma unroll 1
            for (int j = 0; j < 5; ++j) {
                const int kstart = q0 - 128 + 64 * j; if (kstart < 0 || kstart >= SEQ) continue;
                const int ir = kstart & 511;
                attn_tile<64, 2>(Ki + ir * KS, KS, Vi + ir * VS, VS, qf, o, m, lp, j == 0 ? 1 : (j == 4 ? 2 : 0), lane, 32 * half);
            }
#pragma unroll
            for (int q = 0; q < 2; ++q) {
                float l = lp[q]; l += __shfl_xor(l, 16); l += __shfl_xor(l, 32); const float inv = 1.f / l;
                const size_t row = (size_t)(b * SEQ + qh + 16 * q + i16);
#pragma unroll
                for (int d = 0; d < 4; ++d) {
                    const int col = hq * 64 + 16 * d + 4 * q4;
                    const f32x4 g = unpack4(graw[q][d]);
                    *(u32x2*)(F.mix() + row * MIXP + col) = pack4(o[d][q] * inv * g);
                }
            }
        }
    }
}
__device__ __forceinline__ void attn_mem_item(const Ctx& F, int item, bool stage) {
    constexpr int KS = 272, VS = 288; const ldsp Ki = F.lds, Vi = F.lds + 256 * KS;
    const int qb = item & 15, hm = (item >> 4) & 3, b = item >> 6;
    if (stage) {
    __syncthreads();
#pragma unroll
    for (int c = F.tid; c < 4096; c += 512) {
        const int r = c >> 4, ch = c & 15;
        const bf16_t* src = F.mkv() + (size_t)(b * 256 + r) * 1024 + hm * 128 + 8 * ch;
        *(LAS u32x4*)(Ki + r * KS + ch * 16) = *(const u32x4*)(src);
        *(LAS u32x4*)(Vi + r * VS + ch * 16) = *(const u32x4*)(src + 512);
    }
    __syncthreads();
    }
    const int w = F.wave, lane = F.lane, i16 = lane & 15, q4 = lane >> 4, q0 = 256 * qb + 32 * w;
    bf16x8 qf[2][4];
#pragma unroll
    for (int q = 0; q < 2; ++q)
#pragma unroll
        for (int ks = 0; ks < 4; ++ks) qf[q][ks] = *(const bf16x8*)(F.proj() + (size_t)(b * SEQ + q0 + 16 * q + i16) * PW + C_QM + hm * 128 + 32 * ks + 8 * q4);
    u32x2 graw[2][8];
#pragma unroll
    for (int q = 0; q < 2; ++q)
#pragma unroll
        for (int d = 0; d < 8; ++d) graw[q][d] = *(const u32x2*)(F.proj() + (size_t)(b * SEQ + q0 + 16 * q + i16) * PW + C_GM + hm * 128 + 16 * d + 4 * q4);
    f32x4 o[8][2]; float m[2], lp[2];
#pragma unroll
    for (int q = 0; q < 2; ++q) { m[q] = 0.f; lp[q] = 0.f;
#pragma unroll
        for (int d = 0; d < 8; ++d) o[d][q] = (f32x4){0.f, 0.f, 0.f, 0.f}; }
#pragma unroll 1
    for (int j = 0; j < 4; ++j) attn_tile<128, 2>(Ki + 64 * j * KS, KS, Vi + 64 * j * VS, VS, qf, o, m, lp, 0, lane, 0, j == 0);
#pragma unroll
    for (int q = 0; q < 2; ++q) {
        float l = lp[q]; l += __shfl_xor(l, 16); l += __shfl_xor(l, 32); const float inv = 1.f / l;
        const size_t row = (size_t)(b * SEQ + q0 + 16 * q + i16);
#pragma unroll
        for (int d = 0; d < 8; ++d) {
            const int col = hm * 128 + 16 * d + 4 * q4;
            const f32x4 g = unpack4(graw[q][d]);
            *(u32x2*)(F.mix() + row * MIXP + 1536 + col) = pack4(o[d][q] * inv * g);
        }
    }
}

constexpr int XS = 544, BS = 288, PS = 272;
constexpr int L_XI = 0, L_BI = 128 * XS, L_CI = L_BI + 128 * BS, L_F32 = L_CI + 128 * BS;
static_assert(L_F32 + 12288 <= LDS_XB, "lds");
__device__ __forceinline__ void ssd_dtprep(const Ctx& F, int b, int c, int g, bool write_dec) {
    LAS float* DTs = (LAS float*)(F.lds + L_F32); LAS float* ACs = DTs + 1024;
    const int w = F.wave, lane = F.lane, dir = w >> 2, r = w & 3, h = 4 * g + r, j = dir * 8 + h;
    const size_t row0 = (size_t)b * SEQ + c * 128;
    const float d0 = F.dt()[(row0 + 2 * lane) * 16 + j], d1 = F.dt()[(row0 + 2 * lane + 1) * 16 + j];
    const float a = -expf(F.a_log[j]);
    const float x0 = d0 * a, x1 = d1 * a, ps = x0 + x1; float inc = ps;
#pragma unroll
    for (int off = 1; off < 64; off <<= 1) { const float t = __shfl_up(inc, off); if (lane >= off) inc += t; }
    const float total = __shfl(inc, 63);
    float a0, a1;
    if (dir == 0) { a0 = inc - x1; a1 = inc; } else { a0 = total - (inc - ps); a1 = total - (inc - x1); }
    *(LAS f32x2*)(DTs + w * 128 + 2 * lane) = (f32x2){d0, d1};
    *(LAS f32x2*)(ACs + w * 128 + 2 * lane) = (f32x2){a0, a1};
    *(LAS f32x2*)(ACs + 1024 + w * 128 + 2 * lane) = (f32x2){d0 * expf(total - a0), d1 * expf(total - a1)};
    if (write_dec && lane == 0) F.dec()[(b * 32 + c) * 16 + j] = expf(total);
}
template <int NCOLS>
__device__ __forceinline__ void conv_img(const Ctx& F, int b, int c, int xcol, ldsp img, int stride) {
    constexpr int NCQ = NCOLS / 4, NRG = 512 / NCQ, R = 128 / NRG;
    const int cq = F.tid % NCQ, rg = F.tid / NCQ, col = xcol + 4 * cq;
    f32x4 w[5];
#pragma unroll
    for (int j = 0; j < 5; ++j) w[j] = *(const f32x4*)(F.conv_w + j * 1024 + col);
    const f32x4 bias = *(const f32x4*)(F.conv_b + col);
    const int t0 = c * 128 + rg * R - 2;
    const bf16_t* base = F.proj() + (size_t)b * SEQ * PW + C_X + col;
    f32x4 win[R + 4];
#pragma unroll
    for (int k = 0; k < R + 4; ++k) { const int t = t0 + k, tc = t < 0 ? 0 : (t >= SEQ ? SEQ - 1 : t); const u32x2 raw = *(const u32x2*)(base + (size_t)tc * PW); const bool ok = (t == tc);
        win[k] = unpack4((u32x2){ok ? raw.x : 0u, ok ? raw.y : 0u}); }
#pragma unroll
    for (int r = 0; r < R; ++r) {
        f32x4 y = bias;
#pragma unroll
        for (int j = 0; j < 5; ++j) y = y + w[j] * win[r + j];
        *(LAS u32x2*)(img + (rg * R + r) * stride + cq * 8) = pack4(silu4(y));
    }
}
__device__ __forceinline__ void ssd_pass1_item(const Ctx& F, int item) {
    const int g = item & 1, c = (item >> 1) & 31, b = item >> 6;
    const ldsp XI = F.lds + L_XI, BI = F.lds + L_BI, CI = F.lds + L_CI;
    LAS float* DTs = (LAS float*)(F.lds + L_F32); LAS float* ACs = DTs + 1024;
    __syncthreads();
    ssd_dtprep(F, b, c, g, true);
    conv_img<256>(F, b, c, 256 * g, XI, XS);
    conv_img<128>(F, b, c, 512 + 128 * g, BI, BS);
    conv_img<128>(F, b, c, 768 + 128 * g, CI, BS);
    __syncthreads();
    const int lane = F.lane, i16 = lane & 15, q4 = lane >> 4, w = F.wave, tl = 16 * w + i16;
    const size_t row = (size_t)b * SEQ + c * 128 + tl;
    f32x4 cbt[8];
    {
        bf16x8 cf[4];
#pragma unroll
        for (int ks = 0; ks < 4; ++ks) cf[ks] = ld8(CI + tl * BS + (32 * ks + 8 * q4) * 2);
#pragma unroll
        for (int ks = 0; ks < 4; ++ks) *(bf16x8*)(F.cfb() + ((size_t)(item * 8 + w) * 64 + lane) * 32 + 8 * ks) = cf[ks];
#pragma unroll
        for (int sf = 0; sf < 8; ++sf) {
            cbt[sf] = (f32x4){0.f, 0.f, 0.f, 0.f};
#pragma unroll
            for (int ks = 0; ks < 4; ++ks) cbt[sf] = mfma16(ld8(BI + (16 * sf + i16) * BS + (32 * ks + 8 * q4) * 2), cf[ks], cbt[sf]);
        }
    }
#pragma unroll 1
    for (int r = 0; r < 4; ++r) {
        {
            const int dir = w & 1, nq = w >> 1;
            LAS const float* Wr = ACs + 1024 + (dir * 4 + r) * 128;
            f32x4 acc[2][4];
#pragma unroll
            for (int nf = 0; nf < 2; ++nf)
#pragma unroll
                for (int pf = 0; pf < 4; ++pf) acc[nf][pf] = (f32x4){0.f, 0.f, 0.f, 0.f};
#pragma unroll
            for (int ks = 0; ks < 4; ++ks) {
                const int t0 = 32 * ks + 8 * q4, trow = t0 + (i16 >> 2);
                const f32x4 wlo = *(const LAS f32x4*)(Wr + t0), whi = *(const LAS f32x4*)(Wr + t0 + 4);
                bf16x8 af[2], bfr[4];
#pragma unroll
                for (int nf = 0; nf < 2; ++nf) {
                    ldsp p = BI + trow * BS + (32 * nq + 16 * nf + 4 * (i16 & 3)) * 2;
                    const u32x2 lo = __builtin_bit_cast(u32x2, vtr(p)), hi = __builtin_bit_cast(u32x2, vtr(p + 4 * BS));
                    af[nf] = packfrag(unpack4(lo) * wlo, unpack4(hi) * whi);
                }
#pragma unroll
                for (int pf = 0; pf < 4; ++pf) { ldsp p = XI + trow * XS + (64 * r + 16 * pf + 4 * (i16 & 3)) * 2; bfr[pf] = cat8(vtr(p), vtr(p + 4 * XS)); }
#pragma unroll
                for (int nf = 0; nf < 2; ++nf)
#pragma unroll
                    for (int pf = 0; pf < 4; ++pf) acc[nf][pf] = mfma16(af[nf], bfr[pf], acc[nf][pf]);
            }
            bf16_t* S = F.st() + ((((size_t)(b * 32 + c) * 2 + dir) * 8 + (4 * g + r)) << 13);
#pragma unroll
            for (int nf = 0; nf < 2; ++nf)
#pragma unroll
                for (int pf = 0; pf < 4; ++pf) *(u32x2*)(S + (16 * pf + i16) * 128 + 32 * nq + 16 * nf + 4 * q4) = pack4(acc[nf][pf]);
        }
        {
            const float acf = ACs[r * 128 + tl], acb = ACs[(4 + r) * 128 + tl];
            f32x4 yt[4];
#pragma unroll
            for (int pf = 0; pf < 4; ++pf) yt[pf] = (f32x4){0.f, 0.f, 0.f, 0.f};
#pragma unroll
            for (int kp = 0; kp < 4; ++kp) {
                f32x4 gt[2];
#pragma unroll
                for (int u = 0; u < 2; ++u) {
                    const int sf = 2 * kp + u, s0 = 16 * sf + 4 * q4;
                    if (sf < w) {
                        const f32x4 dtf = *(const LAS f32x4*)(DTs + r * 128 + s0), af = *(const LAS f32x4*)(ACs + r * 128 + s0);
#pragma unroll
                        for (int e = 0; e < 4; ++e) gt[u][e] = cbt[sf][e] * (dtf[e] * __expf(acf - af[e]));
                    } else if (sf > w) {
                        const f32x4 dtb = *(const LAS f32x4*)(DTs + (4 + r) * 128 + s0), ab = *(const LAS f32x4*)(ACs + (4 + r) * 128 + s0);
#pragma unroll
                        for (int e = 0; e < 4; ++e) gt[u][e] = cbt[sf][e] * (dtb[e] * __expf(acb - ab[e]));
                    } else {
                        const f32x4 dtf = *(const LAS f32x4*)(DTs + r * 128 + s0), af = *(const LAS f32x4*)(ACs + r * 128 + s0);
                        const f32x4 dtb = *(const LAS f32x4*)(DTs + (4 + r) * 128 + s0), ab = *(const LAS f32x4*)(ACs + (4 + r) * 128 + s0);
#pragma unroll
                        for (int e = 0; e < 4; ++e) {
                            const int sx = s0 + e;
                            const float mf = sx <= tl ? dtf[e] * __expf(acf - af[e]) : 0.f;
                            const float mb = sx >= tl ? dtb[e] * __expf(acb - ab[e]) : 0.f;
                            gt[u][e] = cbt[sf][e] * (mf + mb);
                        }
                    }
                }
                const bf16x8 gk = packfrag(gt[0], gt[1]);
#pragma unroll
                for (int pf = 0; pf < 4; ++pf) {
                    ldsp xa = XI + (32 * kp + 4 * q4 + (i16 >> 2)) * XS + (64 * r + 16 * pf + 4 * (i16 & 3)) * 2;
                    yt[pf] = mfma16(cat8(vtr(xa), vtr(xa + 16 * XS)), gk, yt[pf]);
                }
            }
            const float dsk = F.d_skip[4 * g + r];
#pragma unroll
            for (int pf = 0; pf < 4; ++pf) {
                const int pc = 64 * r + 16 * pf + 4 * q4;
                const f32x4 xv = unpack4(*(const LAS u32x2*)(XI + tl * XS + pc * 2));
                *(u32x2*)(F.yp() + row * 512 + 256 * g + pc) = pack4(yt[pf] + xv * dsk);
            }
            if (q4 == 0) { F.efb()[row * 16 + 4 * g + r] = __expf(acf); F.efb()[row * 16 + 8 + 4 * g + r] = __expf(acb); }
        }
    }
}
__device__ __forceinline__ void ssd_scan(const Ctx& F, int vb, int vg) {
    for (int it = vb * 512 + F.tid; it < NBATCH * 2 * 8 * 1024; it += vg * 512) {
        const int e8 = it & 1023, h = (it >> 10) & 7, dir = (it >> 13) & 1, b = it >> 14;
        float run[8];
#pragma unroll
        for (int k = 0; k < 8; ++k) run[k] = 0.f;
        for (int s0 = 0; s0 < 32; s0 += 4) {
            u32x4 v[4]; float dc[4]; bf16_t* ad[4];
#pragma unroll
            for (int u = 0; u < 4; ++u) { const int s = s0 + u, c = dir ? 31 - s : s; ad[u] = F.st() + (((((size_t)(b * 32 + c) * 2 + dir) * 8 + h) << 13) + e8 * 8); v[u] = __builtin_nontemporal_load((const u32x4*)ad[u]); dc[u] = F.dec()[(b * 32 + c) * 16 + dir * 8 + h]; }
#pragma unroll
            for (int u = 0; u < 4; ++u) {
                __builtin_nontemporal_store((u32x4){cvt_pk(run[0], run[1]), cvt_pk(run[2], run[3]), cvt_pk(run[4], run[5]), cvt_pk(run[6], run[7])}, (u32x4*)ad[u]);
                run[0] = run[0] * dc[u] + bf_lo(v[u].x); run[1] = run[1] * dc[u] + bf_hi(v[u].x); run[2] = run[2] * dc[u] + bf_lo(v[u].y); run[3] = run[3] * dc[u] + bf_hi(v[u].y);
                run[4] = run[4] * dc[u] + bf_lo(v[u].z); run[5] = run[5] * dc[u] + bf_hi(v[u].z); run[6] = run[6] * dc[u] + bf_lo(v[u].w); run[7] = run[7] * dc[u] + bf_hi(v[u].w);
            }
        }
    }
}
__device__ __forceinline__ void ssd_pass2_item(const Ctx& F, int item) {
    const int g = item & 1, c = (item >> 1) & 31, b = item >> 6;
    const ldsp PV = F.lds;
    const int lane = F.lane, i16 = lane & 15, q4 = lane >> 4, w = F.wave, tl = 16 * w + i16;
    const size_t row = (size_t)b * SEQ + c * 128 + tl;
    bf16x8 cf[4];
#pragma unroll
    for (int ks = 0; ks < 4; ++ks) cf[ks] = *(const bf16x8*)(F.cfb() + ((size_t)(item * 8 + w) * 64 + lane) * 32 + 8 * ks);
    const int pdir = F.tid >> 8, pp = (F.tid >> 2) & 63, pqu = F.tid & 3;
    const bf16_t* psrc = F.st() + (((((size_t)(b * 32 + c) * 2 + pdir) * 8 + 4 * g) << 13) + pp * 128 + 32 * pqu);
    u32x4 pvn[4][4];
#pragma unroll
    for (int r = 0; r < 4; ++r)
#pragma unroll
        for (int k = 0; k < 4; ++k) pvn[r][k] = *(const u32x4*)(psrc + ((size_t)r << 13) + 8 * k);
    __syncthreads();
#pragma unroll
    for (int r = 0; r < 4; ++r)
#pragma unroll
        for (int k = 0; k < 4; ++k) *(LAS u32x4*)(PV + (2 * r + pdir) * (64 * PS) + pp * PS + (32 * pqu + 8 * k) * 2) = pvn[r][k];
    __syncthreads();
    f32x4 gy[4][4]; float ss = 0.f;
#pragma unroll
    for (int r = 0; r < 4; ++r) {
        u32x2 zraw[4], yraw[4];
#pragma unroll
        for (int pf = 0; pf < 4; ++pf) { const int pc = 256 * g + 64 * r + 16 * pf + 4 * q4; zraw[pf] = *(const u32x2*)(F.proj() + row * PW + C_Z + pc); yraw[pf] = *(const u32x2*)(F.yp() + row * 512 + pc); }
        const float ef = F.efb()[row * 16 + 4 * g + r], eb = F.efb()[row * 16 + 8 + 4 * g + r];
        const ldsp PVr = PV + 2 * r * (64 * PS);
        f32x4 yf[4], yb[4];
#pragma unroll
        for (int pf = 0; pf < 4; ++pf) { yf[pf] = (f32x4){0.f, 0.f, 0.f, 0.f}; yb[pf] = (f32x4){0.f, 0.f, 0.f, 0.f}; }
#pragma unroll
        for (int ks = 0; ks < 4; ++ks)
#pragma unroll
            for (int pf = 0; pf < 4; ++pf) {
                yf[pf] = mfma16(ld8(PVr + (16 * pf + i16) * PS + (32 * ks + 8 * q4) * 2), cf[ks], yf[pf]);
                yb[pf] = mfma16(ld8(PVr + 64 * PS + (16 * pf + i16) * PS + (32 * ks + 8 * q4) * 2), cf[ks], yb[pf]);
            }
#pragma unroll
        for (int pf = 0; pf < 4; ++pf) {
            const f32x4 y = (unpack4(yraw[pf]) + yf[pf] * ef + yb[pf] * eb) * unpack4(zraw[pf]);
            gy[r][pf] = y; ss += y.x * y.x + y.y * y.y + y.z * y.z + y.w * y.w;
        }
    }
    ss += __shfl_xor(ss, 16); ss += __shfl_xor(ss, 32);
    const float rinv = rsqrtf(ss * (1.f / 256.f) + EPS);
#pragma unroll
    for (int r = 0; r < 4; ++r)
#pragma unroll
        for (int pf = 0; pf < 4; ++pf) {
            const int pc = 256 * g + 64 * r + 16 * pf + 4 * q4;
            const f32x4 nw = *(const f32x4*)(F.ssd_norm_w + pc);
            *(u32x2*)(F.mix() + row * MIXP + 1024 + pc) = pack4(gy[r][pf] * rinv * nw);
        }
}

__device__ __forceinline__ void final_norm(const Ctx& F) {
    const int gw = F.bid * 8 + F.wave, NGW = F.G * 8, lane = F.lane;
    for (int m = gw; m < TOK; m += NGW) {
        const f32x4* rp = (const f32x4*)(F.rowss() + (size_t)m * 16); const f32x4 s4 = (rp[0] + rp[1]) + (rp[2] + rp[3]);
        const float r = rsqrtf(((s4.x + s4.y) + (s4.z + s4.w)) * (1.f / DM) + EPS);
        float* o = F.out + (size_t)m * DM;
#pragma unroll
        for (int j = 0; j < 4; ++j) { const f32x4 v = __builtin_nontemporal_load((const f32x4*)(o + 4 * lane + 256 * j)), ww = *(const f32x4*)(F.norm_out_w + 4 * lane + 256 * j); __builtin_nontemporal_store(v * r * ww, (f32x4*)(o + 4 * lane + 256 * j)); }
    }
}

#define XB_TMO      128
#define XB_XCNT(j)  (256  + 64 * (j))
#define XB_XSUB(j)  (1280 + 64 * (j))
#define XB_XGEN(j)  (2304 + 64 * (j))
#define XB_TOP      3328
#define XB_TOPGEN   3392
#define XCD_BAR_WORDS 3456
#define XB_SPIN_CAP (1u << 18)

__device__ __forceinline__ unsigned xb_ld(unsigned* p)              { return __hip_atomic_load(p, __ATOMIC_RELAXED, __HIP_MEMORY_SCOPE_AGENT); }
__device__ __forceinline__ unsigned xb_add(unsigned* p, unsigned v) { return __hip_atomic_fetch_add(p, v, __ATOMIC_RELAXED, __HIP_MEMORY_SCOPE_AGENT); }
__device__ __forceinline__ unsigned xb_xcc_id() { return (unsigned)__builtin_amdgcn_s_getreg((3 << 11) | 20) & 0xFu; }
#define XB_SPIN(cond, bar) do { unsigned _sp = 0; while (cond) { __builtin_amdgcn_s_sleep(1); \
    if ((++_sp & 255u) == 0u) { if (xb_ld(&(bar)[XB_TMO])) break; if (_sp > XB_SPIN_CAP) { atomicAdd(&(bar)[XB_TMO], 1u); break; } } } } while (0)

struct XcdBarrier {
    unsigned* bar; unsigned x;
    volatile LAS unsigned* st;
};

__device__ __forceinline__ XcdBarrier xcd_barrier_post(unsigned* bar, volatile LAS unsigned* st, int xb_tid) {
    XcdBarrier b; b.bar = bar; b.x = xb_xcc_id(); b.st = st;
    if (xb_tid == 0) (void)xb_add(&bar[XB_XCNT(b.x)], 1u);
    return b;
}
__device__ __forceinline__ void xcd_barrier_complete(unsigned* bar, unsigned x, unsigned& nloc, unsigned& nx) {
    const unsigned G = gridDim.x * gridDim.y * gridDim.z;
    unsigned sum, cnt, mine, sp = 0u;
    for (;;) {
        sum = 0u; cnt = 0u; mine = 0u;
#pragma unroll
        for (unsigned j = 0; j < 16; ++j) { const unsigned c = xb_ld(&bar[XB_XCNT(j)]); sum += c; cnt += (c > 0u) ? 1u : 0u; mine = (j == x) ? c : mine; }
        if (sum == G) break;
        __builtin_amdgcn_s_sleep(1);
        if ((++sp & 255u) == 0u) { if (xb_ld(&bar[XB_TMO])) break; if (sp > XB_SPIN_CAP) { atomicAdd(&bar[XB_TMO], 1u); break; } }
    }
    nloc = mine > 0u ? mine : 1u; nx = cnt > 0u ? cnt : 1u;
}

__device__ __forceinline__ void xcd_barrier(const XcdBarrier& b, int xb_tid) {
    asm volatile("s_waitcnt vmcnt(0)" ::: "memory");
    __syncthreads();
    if (xb_tid == 0) {
        unsigned* bar = b.bar;
        __builtin_amdgcn_s_waitcnt(0);
        unsigned nloc = b.st[0], nx = b.st[1];
        if (nloc == 0u) { xcd_barrier_complete(bar, b.x, nloc, nx); b.st[0] = nloc; b.st[1] = nx; }
        const unsigned old = xb_add(&bar[XB_XSUB(b.x)], 1u);
        const unsigned gen = old / nloc;
        if (old + 1u == (gen + 1u) * nloc) {
            __builtin_amdgcn_fence(__ATOMIC_RELEASE, "agent");
            asm volatile("s_waitcnt vmcnt(0)" ::: "memory");
            const unsigned og = xb_add(&bar[XB_TOP], 1u);
            const unsigned tg = og / nx;
            if (og + 1u == (tg + 1u) * nx) xb_add(&bar[XB_TOPGEN], 1u);
            else XB_SPIN(xb_ld(&bar[XB_TOPGEN]) == tg, bar);
            __builtin_amdgcn_fence(__ATOMIC_ACQUIRE, "agent");
            xb_add(&bar[XB_XGEN(b.x)], 1u);
            asm volatile("s_waitcnt vmcnt(0)" ::: "memory");
        } else {
            XB_SPIN(xb_ld(&bar[XB_XGEN(b.x)]) == gen, bar);
            __builtin_amdgcn_fence(__ATOMIC_ACQUIRE, "agent");
            asm volatile("s_waitcnt vmcnt(0)" ::: "memory");
        }
    }
    __syncthreads();
}

__global__ void __launch_bounds__(512, 2) hymba_fwd(Args args) {
    extern __shared__ __attribute__((aligned(16))) unsigned char lds_raw[];
    Ctx F;
    F.x = args.in[0]; F.mem = args.in[1]; F.norm_mem_w = args.in[2]; F.norm_in_w = args.in[3]; F.w_in = args.in[4]; F.attn_sink = args.in[5]; F.conv_w = args.in[6]; F.conv_b = args.in[7];
    F.dt_bias = args.in[8]; F.a_log = args.in[9]; F.d_skip = args.in[10]; F.ssd_norm_w = args.in[11]; F.w_mem_kv = args.in[12]; F.w_out = args.in[13]; F.norm_out_w = args.in[14];
    F.out = args.out; F.ws = args.ws;
    F.lds = (ldsp)lds_raw; F.tid = threadIdx.x; F.lane = F.tid & 63; F.wave = __builtin_amdgcn_readfirstlane(F.tid >> 6); F.G = gridDim.x; F.bid = blockIdx.x;
    const int lo = args.lo, hi = args.hi;
    cg::grid_group grid = cg::this_grid();
#define IN(k) (lo <= (k) && (k) < hi)
#define REFRESH() do { F.lane = lane_id_now(); F.tid = F.wave * 64 + F.lane; } while (0)
    if (F.tid == 0) { *(LAS u32x4*)(F.lds + LDS_XB) = (u32x4){0u, 0u, 0u, 0u}; }
    __syncthreads();
    XcdBarrier xbar; xbar.bar = (unsigned*)args.ws; xbar.x = 0; xbar.st = (volatile LAS unsigned*)(F.lds + LDS_XB);
    if (hi - lo > 1) xbar = xcd_barrier_post((unsigned*)args.ws, (volatile LAS unsigned*)(F.lds + LDS_XB), F.tid);
    if (lo < 0) grid.sync();
#define SEAM(k) do { if (IN(k) && IN((k) + 1)) xcd_barrier(xbar, F.tid); } while (0)
    if (IN(0)) { REFRESH(); phase0(F); }
    SEAM(0);
    if (IN(1)) {
        REFRESH();
        { pg8::Gemm g{F.hn(), F.win_t(), TOK, NPHYS, DM, HNP, HNP}; pg8::StaticOrder S; S.init(g.M, g.N, F.G, F.bid); EpiProj E{F.proj(), F.dt(), F.rope(), F.dt_bias}; pg8::gemm_phase(F.lds, g, S, E, F.wave); }
    }
    SEAM(1);
    if (IN(2)) {
        REFRESH();
        if (F.bid & 1) for (int sq = F.bid; sq < NBATCH * 4 * 4; sq += F.G) attn_window_seq(F, sq);
        for (int it = F.bid; it < NBATCH * 32 * 2; it += F.G) ssd_pass1_item(F, it);
        if (!(F.bid & 1)) for (int sq = F.bid; sq < NBATCH * 4 * 4; sq += F.G) attn_window_seq(F, sq);
    }
    SEAM(2);
    if (IN(3)) {
        REFRESH();
        if (F.G >= 128) {
            if (F.bid < 64) { pg8::Gemm g{F.memn(), F.wmem_t(), NBATCH * 256, 1024, 1024, HNP, HNP}; pg8::StaticOrder S; S.init(g.M, g.N, 64, F.bid); EpiMkv E{F.mkv()}; pg8::gemm_phase(F.lds, g, S, E, F.wave); }
            else ssd_scan(F, F.bid - 64, F.G - 64);
        } else {
            { pg8::Gemm g{F.memn(), F.wmem_t(), NBATCH * 256, 1024, 1024, HNP, HNP}; pg8::StaticOrder S; S.init(g.M, g.N, F.G, F.bid); EpiMkv E{F.mkv()}; pg8::gemm_phase(F.lds, g, S, E, F.wave); }
            ssd_scan(F, F.bid, F.G);
        }
    }
    SEAM(3);
    if (IN(4)) {
        REFRESH();
        if (F.bid & 1) for (int grp = F.bid; grp < NBATCH * 16; grp += F.G) for (int k = 0; k < 4; ++k) attn_mem_item(F, 4 * grp + k, k == 0);
        for (int it = F.bid; it < NBATCH * 32 * 2; it += F.G) ssd_pass2_item(F, it);
        if (!(F.bid & 1)) for (int grp = F.bid; grp < NBATCH * 16; grp += F.G) for (int k = 0; k < 4; ++k) attn_mem_item(F, 4 * grp + k, k == 0);
    }
    SEAM(4);
    if (IN(5)) { REFRESH(); __syncthreads(); pg8::Gemm g{F.mix(), F.wout_t(), TOK, DM, MIXW, MIXP, MIXP}; pg8::StaticOrder S; S.init(g.M, g.N, F.G, F.bid); EpiOut E{F.x, F.out, F.rowss()}; pg8::gemm_phase(F.lds, g, S, E, F.wave); }
    SEAM(5);
    if (IN(6)) { REFRESH(); final_norm(F); }
#undef IN
#undef SEAM
}

extern "C" void kernel_launch(void* const* d_in, const int* in_sizes, int n_in, void* d_out, int out_size, void* d_ws, size_t ws_size, hipStream_t stream) {
    static int grid = 0;
    if (grid == 0) {
        if (n_in != 15 || out_size != TOK * DM || ws_size < WS_END) { fprintf(stderr, "kernel_launch: unexpected shapes (n_in %d out %d ws %zu)\n", n_in, out_size, ws_size); grid = -1; return; }
        int dev = 0, cus = 0, per_cu = 0;
        (void)hipGetDevice(&dev); (void)hipDeviceGetAttribute(&cus, hipDeviceAttributeMultiprocessorCount, dev);
        if (hipFuncSetAttribute((const void*)hymba_fwd, hipFuncAttributeMaxDynamicSharedMemorySize, LDS_BYTES) != hipSuccess) { fprintf(stderr, "kernel_launch: hipFuncSetAttribute failed\n"); grid = -1; return; }
        if (hipOccupancyMaxActiveBlocksPerMultiprocessor(&per_cu, (const void*)hymba_fwd, 512, LDS_BYTES) != hipSuccess || per_cu < 1) { fprintf(stderr, "kernel_launch: occupancy query says %d\n", per_cu); per_cu = 1; }
        (void)hipGetLastError();
        grid = cus > 0 ? cus : 256;
    }
    if (grid < 0) return;
    Args a{};
    for (int i = 0; i < 15; ++i) a.in[i] = (const float*)d_in[i];
    a.out = (float*)d_out; a.ws = (unsigned char*)d_ws;
    (void)hipMemsetAsync(d_ws, 0, 16384, stream);
#if MK_ONE_LAUNCH
    a.lo = 0; a.hi = NPHASE;
    void* kargs[] = {&a};
    hipError_t e = hipLaunchCooperativeKernel((const void*)hymba_fwd, dim3(grid), dim3(512), kargs, LDS_BYTES, stream);
    if (e != hipSuccess) fprintf(stderr, "kernel_launch: cooperative launch failed: %s (grid %d)\n", hipGetErrorString(e), grid);
#else
    for (int k = 0; k < NPHASE; ++k) { a.lo = k; a.hi = k + 1; hipLaunchKernelGGL(hymba_fwd, dim3(grid), dim3(512), LDS_BYTES, stream, a); }
#endif
}
```

```cpp
#include <hip/hip_runtime.h>
#include <hip/hip_cooperative_groups.h>
#include <cstdio>
#include <cstdint>
namespace cg = cooperative_groups;

#ifndef MK_ONE_LAUNCH
#define MK_ONE_LAUNCH 1
#endif

#define LAS __attribute__((address_space(3)))
typedef unsigned short bf16_t;
typedef short bf16x8 __attribute__((ext_vector_type(8)));
typedef short s16x4 __attribute__((ext_vector_type(4)));
typedef float f32x4 __attribute__((ext_vector_type(4)));
typedef float f32x2 __attribute__((ext_vector_type(2)));
typedef unsigned u32x4 __attribute__((ext_vector_type(4)));
typedef unsigned u32x2 __attribute__((ext_vector_type(2)));
typedef LAS unsigned char* ldsp;

constexpr int SEQ = 4096, NBATCH = 16, TOK = SEQ * NBATCH, DM = 1024;
constexpr int INW = 5136, NPHYS = 5376, PW = 5184;
constexpr int HNP = 1088, MIXP = 2112;
constexpr int C_Q = 0, C_K = 1024, C_V = 1280, C_G = 1536, C_Z = 2560, C_X = 3072, C_QM = 4096, C_GM = 4608;
constexpr int MIXW = 2048;
constexpr float LOG2E = 1.4426950408889634f;
constexpr float EPS = 1e-6f;
constexpr int NPHASE = 7;

constexpr size_t MiB = (size_t)1 << 20;
constexpr size_t WS_ROWSS = 956 * MiB, WS_ROPE = 1 * MiB, WS_WIN = 2 * MiB, WS_WOUT = 14 * MiB, WS_WMEM = 19 * MiB, WS_MEMN = 22 * MiB,
                 WS_MKV = 31 * MiB, WS_DT = 39 * MiB, WS_DEC = 43 * MiB, WS_PROJ = 44 * MiB, WS_MIX = 692 * MiB, WS_END = 960 * MiB;

constexpr int LDS_BYTES = 155648 + 16;
constexpr int LDS_XB = 155648;

__device__ __forceinline__ unsigned cvt_pk(float lo, float hi) { unsigned r; asm volatile("v_cvt_pk_bf16_f32 %0, %1, %2" : "=v"(r) : "v"(lo), "v"(hi)); return r; }
typedef __bf16 bf16x2_t __attribute__((ext_vector_type(2)));
__device__ __forceinline__ unsigned cvt_pk_c(float lo, float hi) { const f32x2 v = {lo, hi}; return __builtin_bit_cast(unsigned, __builtin_convertvector(v, bf16x2_t)); }
__device__ __forceinline__ float bf_lo(unsigned u) { return __uint_as_float(u << 16); }
__device__ __forceinline__ float bf_hi(unsigned u) { return __uint_as_float(u & 0xffff0000u); }
__device__ __forceinline__ f32x4 unpack4(u32x2 v) { return (f32x4){bf_lo(v.x), bf_hi(v.x), bf_lo(v.y), bf_hi(v.y)}; }
__device__ __forceinline__ u32x2 pack4(f32x4 v) { return (u32x2){cvt_pk_c(v.x, v.y), cvt_pk_c(v.z, v.w)}; }
__device__ __forceinline__ float silu_f(float x) { return x * __builtin_amdgcn_rcpf(1.f + __expf(-x)); }
__device__ __forceinline__ f32x4 silu4(f32x4 v) { return (f32x4){silu_f(v.x), silu_f(v.y), silu_f(v.z), silu_f(v.w)}; }
__device__ __forceinline__ float softplus_f(float x) { return x > 15.f ? x : __logf(1.f + __expf(x)); }
__device__ __forceinline__ float ex2(float x) { return __builtin_amdgcn_exp2f(x); }
typedef short v4i16_t __attribute__((ext_vector_type(4)));
__device__ __forceinline__ s16x4 vtr(ldsp p) { return __builtin_bit_cast(s16x4, __builtin_amdgcn_ds_read_tr16_b64_v4i16((LAS v4i16_t*)p)); }
__device__ __forceinline__ bf16x8 cat8(s16x4 a, s16x4 b) { return (bf16x8){a[0], a[1], a[2], a[3], b[0], b[1], b[2], b[3]}; }
__device__ __forceinline__ bf16x8 ld8(ldsp p) { return *(const LAS bf16x8*)p; }
__device__ __forceinline__ f32x4 mfma16(bf16x8 a, bf16x8 b, f32x4 c) { return __builtin_amdgcn_mfma_f32_16x16x32_bf16(a, b, c, 0, 0, 0); }
__device__ __forceinline__ bf16x8 packfrag(f32x4 a, f32x4 b) { u32x4 r = {cvt_pk_c(a.x, a.y), cvt_pk_c(a.z, a.w), cvt_pk_c(b.x, b.y), cvt_pk_c(b.z, b.w)}; return __builtin_bit_cast(bf16x8, r); }

__device__ __forceinline__ f32x4 zero4() { f32x4 z; asm volatile("v_mov_b32 %0, 0\n\tv_mov_b32 %1, 0\n\tv_mov_b32 %2, 0\n\tv_mov_b32 %3, 0" : "=v"(z.x), "=v"(z.y), "=v"(z.z), "=v"(z.w)); return z; }
__device__ __forceinline__ int lane_id_now() { int l; asm volatile("v_mbcnt_lo_u32_b32 %0, -1, 0\n\tv_mbcnt_hi_u32_b32 %0, -1, %0" : "=v"(l)); return l; }
__host__ __device__ __forceinline__ int perm_plain(int c) { const int bj = c >> 7, wc = (c >> 5) & 3, n = (c >> 4) & 1, fq = (c >> 2) & 3, i = c & 3; return 128 * bj + 32 * wc + 8 * fq + 4 * n + i; }
__host__ __device__ __forceinline__ int perm_rot(int c) { const int bj = c >> 7, wc = (c >> 5) & 3, n = (c >> 4) & 1, fq = (c >> 2) & 3, i = c & 3; return 64 * wc + 32 * bj + 8 * fq + 4 * n + i; }

namespace pg8 {
constexpr int BM = 256, BK = 64, HALF = 128, HTB = HALF * BK * 2, STAGE_BYTES = 8 * HTB, NXCD = 8, WGM = 8;
__host__ __device__ __forceinline__ int lds_byte(int r, int c) { const int st = (r >> 4) * 2 + (c >> 5), rr = r & 15, cc = c & 31, ob = rr * 64 + cc * 2; return st * 1024 + (ob ^ (((ob >> 9) & 1) << 5)); }
__host__ __device__ __forceinline__ void stage_rc(int b, int& R, int& C) { const int st = b / 1024, sb = b % 1024, swz = sb ^ (((sb >> 9) & 1) << 5); R = (st >> 1) * 16 + swz / 64; C = (st & 1) * 32 + (swz % 64) / 2; }
struct Unit { int pm, pn; };
struct Gemm { const bf16_t* A; const bf16_t* Bt; int M, N, K, lda, ldb; };
struct StaticOrder {
    int nM, nN, nwg, G, c;
    __device__ void init(int M, int N, int G_, int c_) { nM = M / BM; nN = N / BM; nwg = nM * nN; G = G_; c = c_; }
    __device__ bool next(int i, Unit& u) const {
        const long L = (long)i * G + c; if (L >= nwg) return false;
        int wgid = (int)L; { const int q = nwg / NXCD, r = nwg % NXCD, xcd = wgid % NXCD, off = wgid / NXCD; wgid = (xcd < r ? xcd * (q + 1) : r * (q + 1) + (xcd - r) * q) + off; }
        const int nig = WGM * nN, gid = wgid / nig, fm = gid * WGM, gsz = (nM - fm) < WGM ? (nM - fm) : WGM;
        u.pm = fm + ((wgid % nig) % gsz); u.pn = (wgid % nig) / gsz; return true;
    }
};
template <class Epi, class Sched>
__device__ __forceinline__ void gemm_phase(ldsp lds, const Gemm g, const Sched& S, const Epi& E, int wave_id) {
    const int lane = lane_id_now(), wid = wave_id, tid = wid * 64 + lane, wr = wid >> 2, wc = wid & 3, fr = lane & 15, fq = lane >> 4;
    const int K = g.K, nt = K / BK;
    unsigned voffA[2], voffB[2];
#pragma unroll
    for (int i = 0; i < 2; ++i) { int R, C; stage_rc(tid * 16 + i * 8192, R, C); voffA[i] = (unsigned)(R * g.lda + C) * 2u; voffB[i] = (unsigned)(R * g.ldb + C) * 2u; }
    const size_t kstep = (size_t)(BK * 2);
    const size_t hstep = (size_t)HALF * g.lda * 2, hstepB = (size_t)HALF * g.ldb * 2;
    const size_t tstep = 2 * hstep, tstepB = 2 * hstepB;
    const unsigned ldsw = (unsigned)wid * 1024u;
    const int aoff = lds_byte(wr * 64 + fr, fq * 8), boff = lds_byte(wc * 32 + fr, fq * 8);
#define PG8_SA(b, h) (((b) * 2 + (h)) * HTB)
#define PG8_SB(b, h) ((4 + (b) * 2 + (h)) * HTB)
#define PG8_STAGE(bufoff, gbase, voff) do { _Pragma("unroll") for (int _i = 0; _i < 2; ++_i) \
        __builtin_amdgcn_global_load_lds((const unsigned*)((const char*)(gbase) + (voff)[_i]), (LAS unsigned*)(lds + (bufoff) + ldsw + _i * 8192), 16, 0, 0); } while (0)
#define PG8_LDA(dst, b, h) do { _Pragma("unroll") for (int m = 0; m < 4; ++m) _Pragma("unroll") for (int k = 0; k < 2; ++k) dst[m][k] = *(const LAS bf16x8*)(lds + PG8_SA(b, h) + aoff + m * 2048 + k * 1024); } while (0)
#define PG8_LDB(dst, b, h) do { _Pragma("unroll") for (int n = 0; n < 2; ++n) _Pragma("unroll") for (int k = 0; k < 2; ++k) dst[n][k] = *(const LAS bf16x8*)(lds + PG8_SB(b, h) + boff + n * 2048 + k * 1024); } while (0)
#define PG8_MMA(ai, bj, At, Bt) do { __builtin_amdgcn_s_setprio(1); _Pragma("unroll") for (int m = 0; m < 4; ++m) _Pragma("unroll") for (int n = 0; n < 2; ++n) _Pragma("unroll") for (int k = 0; k < 2; ++k) \
        acc[ai][bj][m][n] = __builtin_amdgcn_mfma_f32_16x16x32_bf16(Bt[n][k], At[m][k], acc[ai][bj][m][n], 0, 0, 0); __builtin_amdgcn_s_setprio(0); } while (0)
#define PG8_WAIT_V(n) asm volatile("s_waitcnt vmcnt(" #n ")" ::: "memory")
#define PG8_WAIT_L(n) asm volatile("s_waitcnt lgkmcnt(" #n ")" ::: "memory")
#define PG8_BAR __builtin_amdgcn_s_barrier()
#define PG8_SCHED __builtin_amdgcn_sched_barrier(0)
    Unit cur, nxt; int ui = 0;
    if (!S.next(0, cur)) return;
    f32x4 acc[2][2][4][2];
#pragma unroll
    for (int a = 0; a < 2; ++a)
#pragma unroll
        for (int b = 0; b < 2; ++b)
#pragma unroll
            for (int m = 0; m < 4; ++m)
#pragma unroll
                for (int n = 0; n < 2; ++n) acc[a][b][m][n] = (f32x4){0.f, 0.f, 0.f, 0.f};
    bf16x8 At[4][2], B0[2][2], B1[2][2];
    const char* cA = (const char*)g.A + (size_t)cur.pm * tstep; const char* cB = (const char*)g.Bt + (size_t)cur.pn * tstepB;
    PG8_STAGE(PG8_SB(0, 0), cB, voffB); PG8_STAGE(PG8_SA(0, 0), cA, voffA); PG8_STAGE(PG8_SB(0, 1), cB + hstepB, voffB); PG8_STAGE(PG8_SA(0, 1), cA + hstep, voffA);
    if (wr == 1) PG8_BAR;
    PG8_WAIT_V(4); PG8_BAR;
    PG8_STAGE(PG8_SB(1, 0), cB + kstep, voffB); PG8_STAGE(PG8_SA(1, 0), cA + kstep, voffA); PG8_STAGE(PG8_SB(1, 1), cB + hstepB + kstep, voffB);
    PG8_WAIT_V(6); PG8_BAR;
    for (;;) {
        const bool has_next = S.next(ui + 1, nxt);
        const char* nA = has_next ? (const char*)g.A + (size_t)nxt.pm * tstep : cA; const char* nB = has_next ? (const char*)g.Bt + (size_t)nxt.pn * tstepB : cB;
        for (int t = 0; t < nt; t += 2) {
            const bool last = (t == nt - 2);
            const char* a1 = cA + (size_t)(t + 1) * kstep;
            const char* a2 = last ? nA : cA + (size_t)(t + 2) * kstep; const char* b2 = last ? nB : cB + (size_t)(t + 2) * kstep;
            const char* a3 = a2 + kstep; const char* b3 = b2 + kstep;
            PG8_LDB(B0, 0, 0); PG8_SCHED; PG8_LDA(At, 0, 0); PG8_STAGE(PG8_SA(1, 1), a1 + hstep, voffA);
            PG8_WAIT_L(8); PG8_BAR; PG8_WAIT_L(0); PG8_MMA(0, 0, At, B0); PG8_BAR; PG8_SCHED;
            PG8_LDB(B1, 0, 1); PG8_STAGE(PG8_SB(0, 0), b2, voffB);
            PG8_BAR; PG8_WAIT_L(0); PG8_MMA(0, 1, At, B1); PG8_BAR;
            PG8_LDA(At, 0, 1); PG8_STAGE(PG8_SA(0, 0), a2, voffA);
            PG8_BAR; PG8_WAIT_L(0); PG8_MMA(1, 0, At, B0); PG8_BAR; PG8_SCHED;
            PG8_STAGE(PG8_SB(0, 1), b2 + hstepB, voffB);
            PG8_WAIT_V(6); PG8_BAR; PG8_MMA(1, 1, At, B1); PG8_BAR;
            PG8_LDB(B0, 1, 0); PG8_SCHED; PG8_LDA(At, 1, 0); PG8_STAGE(PG8_SA(0, 1), a2 + hstep, voffA);
            PG8_WAIT_L(8); PG8_BAR; PG8_WAIT_L(0); PG8_MMA(0, 0, At, B0); PG8_BAR; PG8_SCHED;
            PG8_LDB(B1, 1, 1); PG8_STAGE(PG8_SB(1, 0), b3, voffB);
            PG8_BAR; PG8_WAIT_L(0); PG8_MMA(0, 1, At, B1); PG8_BAR;
            PG8_LDA(At, 1, 1); PG8_STAGE(PG8_SA(1, 0), a3, voffA);
            PG8_BAR; PG8_WAIT_L(0); PG8_MMA(1, 0, At, B0); PG8_BAR; PG8_SCHED;
            PG8_STAGE(PG8_SB(1, 1), b3 + hstepB, voffB);
            PG8_WAIT_V(6); PG8_BAR; PG8_MMA(1, 1, At, B1); PG8_BAR;
        }
        E(acc, cur, wr, wc, fr, fq);
        if (!has_next) break;
#pragma unroll
        for (int a = 0; a < 2; ++a)
#pragma unroll
            for (int b = 0; b < 2; ++b)
#pragma unroll
                for (int m = 0; m < 4; ++m)
#pragma unroll
                    for (int n = 0; n < 2; ++n) acc[a][b][m][n] = (f32x4){0.f, 0.f, 0.f, 0.f};
        cur = nxt; cA = nA; cB = nB; ++ui;
    }
    PG8_WAIT_V(0);
    if (wr == 0) PG8_BAR;
    PG8_BAR;
#undef PG8_SA
#undef PG8_SB
#undef PG8_STAGE
#undef PG8_LDA
#undef PG8_LDB
#undef PG8_MMA
#undef PG8_WAIT_V
#undef PG8_WAIT_L
#undef PG8_BAR
#undef PG8_SCHED
}
}

struct EpiProj {
    bf16_t* P; float* DT; const float* rope; const float* dt_bias;
    __device__ __forceinline__ void operator()(const f32x4 (&acc)[2][2][4][2], const pg8::Unit& u, int wr, int wc, int fr, int fq) const {
        const int row0 = u.pm * 256 + wr * 64 + fr, pn = u.pn;
        if (pn < 5) {
            const float sc = pn < 4 ? 0.125f * LOG2E : 1.f;
            const int col = pn * 256 + 64 * wc + 8 * fq;
#pragma unroll
            for (int ai = 0; ai < 2; ++ai)
#pragma unroll
                for (int m = 0; m < 4; ++m) {
                    const int row = row0 + ai * 128 + m * 16, pos = row & (SEQ - 1);
                    const f32x4* cp = (const f32x4*)(rope + pos * 32 + 8 * fq); const f32x4* sp = (const f32x4*)(rope + SEQ * 32 + pos * 32 + 8 * fq);
                    f32x4 o1[2], o2[2];
#pragma unroll
                    for (int n = 0; n < 2; ++n) { const f32x4 c = cp[n], s = sp[n], t1 = acc[ai][0][m][n], t2 = acc[ai][1][m][n]; o1[n] = (t1 * c - t2 * s) * sc; o2[n] = (t1 * s + t2 * c) * sc; }
                    bf16_t* dst = P + (size_t)row * PW + col;
                    __builtin_nontemporal_store((u32x4){cvt_pk(o1[0].x, o1[0].y), cvt_pk(o1[0].z, o1[0].w), cvt_pk(o1[1].x, o1[1].y), cvt_pk(o1[1].z, o1[1].w)}, (u32x4*)dst);
                    __builtin_nontemporal_store((u32x4){cvt_pk(o2[0].x, o2[0].y), cvt_pk(o2[0].z, o2[0].w), cvt_pk(o2[1].x, o2[1].y), cvt_pk(o2[1].z, o2[1].w)}, (u32x4*)(dst + 32));
                }
        } else if (pn < 20) {
            const bool do_silu = (pn >= 6 && pn < 12) || pn >= 18;
            const float sc = (pn == 16 || pn == 17) ? 0.08838834764831845f * LOG2E : 1.f;
            const int col = pn * 256 + 32 * wc + 8 * fq;
#pragma unroll
            for (int ai = 0; ai < 2; ++ai)
#pragma unroll
                for (int m = 0; m < 4; ++m) {
                    const int row = row0 + ai * 128 + m * 16;
#pragma unroll
                    for (int bj = 0; bj < 2; ++bj) {
                        f32x4 v0 = acc[ai][bj][m][0], v1 = acc[ai][bj][m][1];
                        if (do_silu) { v0 = silu4(v0); v1 = silu4(v1); } else { v0 = v0 * sc; v1 = v1 * sc; }
                        __builtin_nontemporal_store((u32x4){cvt_pk(v0.x, v0.y), cvt_pk(v0.z, v0.w), cvt_pk(v1.x, v1.y), cvt_pk(v1.z, v1.w)}, (u32x4*)(P + (size_t)row * PW + col + 128 * bj));
                    }
                }
        } else {
            if (wc == 0 && fq < 2) {
                const f32x4 bb0 = *(const f32x4*)(dt_bias + 8 * fq), bb1 = *(const f32x4*)(dt_bias + 8 * fq + 4);
#pragma unroll
                for (int ai = 0; ai < 2; ++ai)
#pragma unroll
                    for (int m = 0; m < 4; ++m) {
                        const int row = row0 + ai * 128 + m * 16;
#pragma unroll
                        for (int n = 0; n < 2; ++n) {
                            const int j0 = 8 * fq + 4 * n; const f32x4 v = acc[ai][0][m][n] + (n ? bb1 : bb0);
                            *(f32x4*)(DT + (size_t)row * 16 + j0) = (f32x4){softplus_f(v.x), softplus_f(v.y), softplus_f(v.z), softplus_f(v.w)};
                        }
                    }
            }
        }
    }
};
struct EpiMkv {
    bf16_t* O;
    __device__ __forceinline__ void operator()(const f32x4 (&acc)[2][2][4][2], const pg8::Unit& u, int wr, int wc, int fr, int fq) const {
        const int row0 = u.pm * 256 + wr * 64 + fr, col = u.pn * 256 + 32 * wc + 8 * fq;
#pragma unroll
        for (int ai = 0; ai < 2; ++ai)
#pragma unroll
            for (int m = 0; m < 4; ++m) {
                const int row = row0 + ai * 128 + m * 16;
#pragma unroll
                for (int bj = 0; bj < 2; ++bj) { const f32x4 v0 = acc[ai][bj][m][0], v1 = acc[ai][bj][m][1];
                    *(u32x4*)(O + (size_t)row * 1024 + col + 128 * bj) = (u32x4){cvt_pk(v0.x, v0.y), cvt_pk(v0.z, v0.w), cvt_pk(v1.x, v1.y), cvt_pk(v1.z, v1.w)}; }
            }
    }
};
struct EpiOut {
    const float* x; float* out; float* rowss;
    __device__ __forceinline__ void operator()(const f32x4 (&acc)[2][2][4][2], const pg8::Unit& u, int wr, int wc, int fr, int fq) const {
        const int row0 = u.pm * 256 + wr * 64 + fr, col = u.pn * 256 + 32 * wc + 8 * fq;
#pragma unroll
        for (int ai = 0; ai < 2; ++ai) {
            f32x4 xv[4][2][2];
#pragma unroll
            for (int m = 0; m < 4; ++m)
#pragma unroll
                for (int bj = 0; bj < 2; ++bj) {
                    const size_t o = (size_t)(row0 + ai * 128 + m * 16) * DM + col + 128 * bj;
                    xv[m][bj][0] = __builtin_nontemporal_load((const f32x4*)(x + o)); xv[m][bj][1] = __builtin_nontemporal_load((const f32x4*)(x + o + 4));
                }
#pragma unroll
            for (int m = 0; m < 4; ++m) {
                const int row = row0 + ai * 128 + m * 16; float ss = 0.f;
#pragma unroll
                for (int bj = 0; bj < 2; ++bj) {
                    const size_t o = (size_t)row * DM + col + 128 * bj;
                    const f32x4 h0 = xv[m][bj][0] + acc[ai][bj][m][0], h1 = xv[m][bj][1] + acc[ai][bj][m][1];
                    *(f32x4*)(out + o) = h0; *(f32x4*)(out + o + 4) = h1;
                    ss += h0.x * h0.x + h0.y * h0.y + h0.z * h0.z + h0.w * h0.w + h1.x * h1.x + h1.y * h1.y + h1.z * h1.z + h1.w * h1.w;
                }
                ss += __shfl_xor(ss, 16); ss += __shfl_xor(ss, 32);
                if (fq == 0) rowss[(size_t)row * 16 + u.pn * 4 + wc] = ss;
            }
        }
    }
};

struct Args { const float* in[15]; float* out; unsigned char* ws; int lo, hi; };
struct Ctx {
    const float *x, *mem, *norm_mem_w, *norm_in_w, *w_in, *attn_sink, *conv_w, *conv_b, *dt_bias, *a_log, *d_skip, *ssd_norm_w, *w_mem_kv, *w_out, *norm_out_w;
    float* out; unsigned char* ws;
    __device__ __forceinline__ float* rowss() const { return (float*)(ws + WS_ROWSS); }
    __device__ __forceinline__ float* rope() const { return (float*)(ws + WS_ROPE); }
    __device__ __forceinline__ bf16_t* win_t() const { return (bf16_t*)(ws + WS_WIN); }
    __device__ __forceinline__ bf16_t* wout_t() const { return (bf16_t*)(ws + WS_WOUT); }
    __device__ __forceinline__ bf16_t* wmem_t() const { return (bf16_t*)(ws + WS_WMEM); }
    __device__ __forceinline__ bf16_t* memn() const { return (bf16_t*)(ws + WS_MEMN); }
    __device__ __forceinline__ bf16_t* mkv() const { return (bf16_t*)(ws + WS_MKV); }
    __device__ __forceinline__ float* dt() const { return (float*)(ws + WS_DT); }
    __device__ __forceinline__ float* dec() const { return (float*)(ws + WS_DEC); }
    __device__ __forceinline__ bf16_t* proj() const { return (bf16_t*)(ws + WS_PROJ); }
    __device__ __forceinline__ bf16_t* mix() const { return (bf16_t*)(ws + WS_MIX); }
    __device__ __forceinline__ bf16_t* hn() const { return (bf16_t*)((unsigned char*)out); }
    __device__ __forceinline__ bf16_t* st() const { return (bf16_t*)((unsigned char*)out); }
    __device__ __forceinline__ bf16_t* yp() const { return (bf16_t*)((unsigned char*)out + 128 * MiB); }
    __device__ __forceinline__ bf16_t* cfb() const { return (bf16_t*)((unsigned char*)out + 192 * MiB); }
    __device__ __forceinline__ float* efb() const { return (float*)((unsigned char*)out + 224 * MiB); }
    ldsp lds; int tid, lane, wave, G, bid;
};

__device__ __forceinline__ void rms_row_bf16(const float* xr, const float* w, bf16_t* o, int lane) {
    f32x4 v[4]; float ss = 0.f;
#pragma unroll
    for (int j = 0; j < 4; ++j) { v[j] = __builtin_nontemporal_load((const f32x4*)(xr + 4 * lane + 256 * j)); ss += v[j].x * v[j].x + v[j].y * v[j].y + v[j].z * v[j].z + v[j].w * v[j].w; }
#pragma unroll
    for (int off = 1; off < 64; off <<= 1) ss += __shfl_xor(ss, off);
    const float r = rsqrtf(ss * (1.f / DM) + EPS);
#pragma unroll
    for (int j = 0; j < 4; ++j) { const f32x4 ww = *(const f32x4*)(w + 4 * lane + 256 * j); *(u32x2*)(o + 4 * lane + 256 * j) = pack4(v[j] * r * ww); }
}
template <int MODE>
__device__ __forceinline__ void transpose_w(const Ctx& F, const float* W, int K, int NS, bf16_t* Bt, int NP, int ldb) {
    const int nitems = NP * (K / 8);
    for (int it = F.bid * 512 + F.tid; it < nitems; it += F.G * 512) {
        const int n = it % NP, kg = it / NP, tile = n >> 8, cph = n & 255; int src;
        if (MODE == 0) {
            if (tile < 5) src = tile * 256 + perm_rot(cph);
            else if (tile < 20) { src = tile * 256 + perm_plain(cph); if (src >= 4096) src += 16; }
            else { const int l = perm_plain(cph); src = l < 16 ? 4096 + l : -1; }
        } else src = tile * 256 + perm_plain(cph);
        float v[8];
#pragma unroll
        for (int j = 0; j < 8; ++j) v[j] = src >= 0 ? W[(size_t)(kg * 8 + j) * NS + src] : 0.f;
        *(u32x4*)(Bt + (size_t)n * ldb + kg * 8) = (u32x4){cvt_pk(v[0], v[1]), cvt_pk(v[2], v[3]), cvt_pk(v[4], v[5]), cvt_pk(v[6], v[7])};
    }
}
__device__ __forceinline__ void phase0(const Ctx& F) {
    const int gt = F.bid * 512 + F.tid, NT = F.G * 512;
    for (int i = gt; i < SEQ * 32; i += NT) {
        const int pos = i >> 5, f = i & 31;
        const float inv = 1.0f / exp2f((float)f * (13.287712379549449f / 32.f));
        const float ang = (float)pos * inv;
        const double rev = (double)ang * 0.15915494309189535; const double fr = rev - __builtin_rint(rev);
        const float r = (float)(fr * 6.283185307179586);
        F.rope()[i] = __cosf(r); F.rope()[SEQ * 32 + i] = __sinf(r);
    }
    transpose_w<0>(F, F.w_in, DM, INW, F.win_t(), NPHYS, HNP);
    transpose_w<1>(F, F.w_out, MIXW, DM, F.wout_t(), DM, MIXP);
    transpose_w<1>(F, F.w_mem_kv, DM, DM, F.wmem_t(), DM, HNP);
    const int gw = F.bid * 8 + F.wave, NGW = F.G * 8;
    for (int m = gw; m < NBATCH * 256; m += NGW) rms_row_bf16(F.mem + (size_t)m * DM, F.norm_mem_w, F.memn() + (size_t)m * HNP, F.lane);
    for (int m = gw; m < TOK; m += NGW) rms_row_bf16(F.x + (size_t)m * DM, F.norm_in_w, F.hn() + (size_t)m * HNP, F.lane);
}

template <int DH, int NQF>
__device__ __forceinline__ void attn_tile(ldsp Kt, int KS, ldsp Vt, int VS, const bf16x8 (&qf)[NQF][DH / 32], f32x4 (&o)[DH / 16][NQF], float (&m)[NQF], float (&lp)[NQF], int maskmode, int lane, int qoff = 0, bool first = false) {
    const int i16 = lane & 15, q4 = lane >> 4;
    f32x4 st[4][NQF];
#pragma unroll
    for (int kf = 0; kf < 4; ++kf)
#pragma unroll
        for (int q = 0; q < NQF; ++q) { const float nm = -m[q]; st[kf][q] = (f32x4){nm, nm, nm, nm}; }
#pragma unroll
    for (int ks = 0; ks < DH / 32; ++ks)
#pragma unroll
        for (int kf = 0; kf < 4; ++kf) {
            const bf16x8 ka = ld8(Kt + (16 * kf + i16) * KS + (32 * ks + 8 * q4) * 2);
#pragma unroll
            for (int q = 0; q < NQF; ++q) st[kf][q] = mfma16(ka, qf[q][ks], st[kf][q]);
            if (DH > 64 && kf == 3) __builtin_amdgcn_sched_barrier(0);
        }
    if (maskmode) {
        int zb; asm volatile("v_mov_b32 %0, 0" : "=v"(zb));
        const int base = (maskmode == 1 ? 4 * q4 - i16 - qoff : i16 + qoff - 4 * q4) + zb;
#pragma unroll
        for (int kf = 0; kf < 4; ++kf)
#pragma unroll
            for (int q = 0; q < NQF; ++q)
#pragma unroll
                for (int r = 0; r < 4; ++r) { const int off = 16 * (kf - q) + r; const bool bad = (maskmode == 1 ? base + off : base - off) < 0; if (bad) st[kf][q][r] = -INFINITY; }
    }
#pragma unroll
    for (int q = 0; q < NQF; ++q) {
        float mx = st[0][q][0];
#pragma unroll
        for (int kf = 0; kf < 4; ++kf)
#pragma unroll
            for (int r = 0; r < 4; ++r) mx = fmaxf(mx, st[kf][q][r]);
        if (first || __builtin_amdgcn_ballot_w64(mx > 8.f) != 0ull) {
            mx = fmaxf(mx, __shfl_xor(mx, 16)); mx = fmaxf(mx, __shfl_xor(mx, 32));
            const float delta = (first || mx > 8.f) ? mx : 0.f; m[q] += delta;
            if (!first) {
                const float alpha = ex2(-delta);
                lp[q] = lp[q] * alpha;
#pragma unroll
                for (int d = 0; d < DH / 16; ++d) o[d][q] = o[d][q] * alpha;
            }
#pragma unroll
            for (int kf = 0; kf < 4; ++kf) st[kf][q] = st[kf][q] - delta;
        }
        float ps = 0.f;
#pragma unroll
        for (int kf = 0; kf < 4; ++kf)
#pragma unroll
            for (int r = 0; r < 4; ++r) { const float p = ex2(st[kf][q][r]); st[kf][q][r] = p; ps += p; }
        lp[q] += ps;
    }
#pragma unroll
    for (int kp = 0; kp < 2; ++kp) {
        bf16x8 pk[NQF];
#pragma unroll
        for (int q = 0; q < NQF; ++q) pk[q] = packfrag(st[2 * kp][q], st[2 * kp + 1][q]);
#pragma unroll
        for (int d = 0; d < DH / 16; ++d) {
            ldsp va = Vt + (32 * kp + 4 * q4 + (i16 >> 2)) * VS + (16 * d + 4 * (i16 & 3)) * 2;
            const bf16x8 vf = cat8(vtr(va), vtr(va + 16 * VS));
#pragma unroll
            for (int q = 0; q < NQF; ++q) o[d][q] = mfma16(vf, pk[q], o[d][q]);
            if (DH > 64 && (d & 3) == 3) __builtin_amdgcn_sched_barrier(0);
        }
    }
}

__device__ __forceinline__ void ring_stage_block(const Ctx& F, const bf16_t* kvbase, int keyblock) {
    constexpr int KS = 144, VS = 160; const ldsp Kb = F.lds + (keyblock & 511) * KS, Vb = F.lds + 512 * KS + (keyblock & 511) * VS;
    const bf16_t* src0 = kvbase + (size_t)keyblock * PW;
    for (int wi = F.wave; wi < 18; wi += 8) {
        const int slot = wi * 64 + F.lane, row = slot / 9, ch = slot - row * 9;
        __builtin_amdgcn_global_load_lds((const unsigned*)(src0 + (size_t)row * PW + C_K + 8 * (ch > 7 ? 7 : ch)), (LAS unsigned*)(Kb + wi * 1024), 16, 0, 0);
    }
    for (int wi = F.wave; wi < 20; wi += 8) {
        const int slot = wi * 64 + F.lane, row = slot / 10, ch = slot - row * 10;
        __builtin_amdgcn_global_load_lds((const unsigned*)(src0 + (size_t)row * PW + C_V + 8 * (ch > 7 ? 7 : ch)), (LAS unsigned*)(Vb + wi * 1024), 16, 0, 0);
    }
}
__device__ __forceinline__ void attn_window_seq(const Ctx& F, int sq) {
    constexpr int KS = 144, VS = 160; const ldsp Ki = F.lds, Vi = F.lds + 512 * KS;
    const int sidx = sq >> 2, b = sidx >> 2, kvh = sidx & 3, i0 = 8 * (sq & 3);
    const int w = F.wave, lane = F.lane, i16 = lane & 15, q4 = lane >> 4, hq = 4 * kvh + (w >> 1);
    const bf16_t* kvbase = F.proj() + (size_t)b * SEQ * PW + 64 * kvh;
    __syncthreads();
    for (int t = 0; t < 3; ++t) { const int kb = 128 * (i0 - 1 + t); if (kb >= 0 && kb < SEQ) ring_stage_block(F, kvbase, kb); }
    const float sink = F.attn_sink[hq] * LOG2E;
#pragma unroll 1
    for (int k = 0; k < 8; ++k) {
        const int i = i0 + k, q0 = 128 * i + 64 * (w & 1);
        __syncthreads();
        { const int nkey0 = 128 * i + 256; if (k < 7 && nkey0 < SEQ) ring_stage_block(F, kvbase, nkey0); }
#pragma unroll 1
        for (int half = 0; half < 2; ++half) {
            const int qh = q0 + 32 * half;
            bf16x8 qf[2][2];
#pragma unroll
            for (int q = 0; q < 2; ++q)
#pragma unroll
                for (int ks = 0; ks < 2; ++ks) qf[q][ks] = *(const bf16x8*)(F.proj() + (size_t)(b * SEQ + qh + 16 * q + i16) * PW + C_Q + hq * 64 + 32 * ks + 8 * q4);
            u32x2 graw[2][4];
#pragma unroll
            for (int q = 0; q < 2; ++q)
#pragma unroll
                for (int d = 0; d < 4; ++d) graw[q][d] = *(const u32x2*)(F.proj() + (size_t)(b * SEQ + qh + 16 * q + i16) * PW + C_G + hq * 64 + 16 * d + 4 * q4);
            f32x4 o[4][2]; float m[2], lp[2];
#pragma unroll
            for (int q = 0; q < 2; ++q) { m[q] = sink; lp[q] = q4 == 0 ? 1.f : 0.f;
#pragma unroll
                for (int d = 0; d < 4; ++d) o[d][q] = (f32x4){0.f, 0.f, 0.f, 0.f}; }
#pragma unroll 1
            for (int j = 0; j < 5; ++j) {
                const int kstart = q0 - 128 + 64 * j; if (kstart < 0 || kstart >= SEQ) continue;
                const int ir = kstart & 511;
                attn_tile<64, 2>(Ki + ir * KS, KS, Vi + ir * VS, VS, qf, o, m, lp, j == 0 ? 1 : (j == 4 ? 2 : 0), lane, 32 * half);
            }
#pragma unroll
            for (int q = 0; q < 2; ++q) {
                float l = lp[q]; l += __shfl_xor(l, 16); l += __shfl_xor(l, 32); const float inv = 1.f / l;
                const size_t row = (size_t)(b * SEQ + qh + 16 * q + i16);
#pragma unroll
                for (int d = 0; d < 4; ++d) {
                    const int col = hq * 64 + 16 * d + 4 * q4;
                    const f32x4 g = unpack4(graw[q][d]);
                    *(u32x2*)(F.mix() + row * MIXP + col) = pack4(o[d][q] * inv * g);
                }
            }
        }
    }
}
__device__ __forceinline__ void attn_mem_item(const Ctx& F, int item, bool stage) {
    constexpr int KS = 272, VS = 288; const ldsp Ki = F.lds, Vi = F.lds + 256 * KS;
    const int qb = item & 15, hm = (item >> 4) & 3, b = item >> 6;
    if (stage) {
    __syncthreads();
#pragma unroll
    for (int c = F.tid; c < 4096; c += 512) {
        const int r = c >> 4, ch = c & 15;
        const bf16_t* src = F.mkv() + (size_t)(b * 256 + r) * 1024 + hm * 128 + 8 * ch;
        *(LAS u32x4*)(Ki + r * KS + ch * 16) = *(const u32x4*)(src);
        *(LAS u32x4*)(Vi + r * VS + ch * 16) = *(const u32x4*)(src + 512);
    }
    __syncthreads();
    }
    const int w = F.wave, lane = F.lane, i16 = lane & 15, q4 = lane >> 4, q0 = 256 * qb + 32 * w;
    bf16x8 qf[2][4];
#pragma unroll
    for (int q = 0; q < 2; ++q)
#pragma unroll
        for (int ks = 0; ks < 4; ++ks) qf[q][ks] = *(const bf16x8*)(F.proj() + (size_t)(b * SEQ + q0 + 16 * q + i16) * PW + C_QM + hm * 128 + 32 * ks + 8 * q4);
    u32x2 graw[2][8];
#pragma unroll
    for (int q = 0; q < 2; ++q)
#pragma unroll
        for (int d = 0; d < 8; ++d) graw[q][d] = *(const u32x2*)(F.proj() + (size_t)(b * SEQ + q0 + 16 * q + i16) * PW + C_GM + hm * 128 + 16 * d + 4 * q4);
    f32x4 o[8][2]; float m[2], lp[2];
#pragma unroll
    for (int q = 0; q < 2; ++q) { m[q] = 0.f; lp[q] = 0.f;
#pragma unroll
        for (int d = 0; d < 8; ++d) o[d][q] = (f32x4){0.f, 0.f, 0.f, 0.f}; }
#pragma unroll 1
    for (int j = 0; j < 4; ++j) attn_tile<128, 2>(Ki + 64 * j * KS, KS, Vi + 64 * j * VS, VS, qf, o, m, lp, 0, lane, 0, j == 0);
#pragma unroll
    for (int q = 0; q < 2; ++q) {
        float l = lp[q]; l += __shfl_xor(l, 16); l += __shfl_xor(l, 32); const float inv = 1.f / l;
        const size_t row = (size_t)(b * SEQ + q0 + 16 * q + i16);
#pragma unroll
        for (int d = 0; d < 8; ++d) {
            const int col = hm * 128 + 16 * d + 4 * q4;
            const f32x4 g = unpack4(graw[q][d]);
            *(u32x2*)(F.mix() + row * MIXP + 1536 + col) = pack4(o[d][q] * inv * g);
        }
    }
}

constexpr int XS = 544, BS = 288, PS = 272;
constexpr int L_XI = 0, L_BI = 128 * XS, L_CI = L_BI + 128 * BS, L_F32 = L_CI + 128 * BS;
static_assert(L_F32 + 12288 <= LDS_XB, "lds");
__device__ __forceinline__ void ssd_dtprep(const Ctx& F, int b, int c, int g, bool write_dec) {
    LAS float* DTs = (LAS float*)(F.lds + L_F32); LAS float* ACs = DTs + 1024;
    const int w = F.wave, lane = F.lane, dir = w >> 2, r = w & 3, h = 4 * g + r, j = dir * 8 + h;
    const size_t row0 = (size_t)b * SEQ + c * 128;
    const float d0 = F.dt()[(row0 + 2 * lane) * 16 + j], d1 = F.dt()[(row0 + 2 * lane + 1) * 16 + j];
    const float a = -expf(F.a_log[j]);
    const float x0 = d0 * a, x1 = d1 * a, ps = x0 + x1; float inc = ps;
#pragma unroll
    for (int off = 1; off < 64; off <<= 1) { const float t = __shfl_up(inc, off); if (lane >= off) inc += t; }
    const float total = __shfl(inc, 63);
    float a0, a1;
    if (dir == 0) { a0 = inc - x1; a1 = inc; } else { a0 = total - (inc - ps); a1 = total - (inc - x1); }
    *(LAS f32x2*)(DTs + w * 128 + 2 * lane) = (f32x2){__logf(d0) - a0, __logf(d1) - a1};
    *(LAS f32x2*)(ACs + w * 128 + 2 * lane) = (f32x2){a0, a1};
    *(LAS f32x2*)(ACs + 1024 + w * 128 + 2 * lane) = (f32x2){d0 * expf(total - a0), d1 * expf(total - a1)};
    if (write_dec && lane == 0) F.dec()[(b * 32 + c) * 16 + j] = expf(total);
}
template <int NCOLS>
__device__ __forceinline__ void conv_img(const Ctx& F, int b, int c, int xcol, ldsp img, int stride) {
    constexpr int NCQ = NCOLS / 4, NRG = 512 / NCQ, R = 128 / NRG;
    const int cq = F.tid % NCQ, rg = F.tid / NCQ, col = xcol + 4 * cq;
    f32x4 w[5];
#pragma unroll
    for (int j = 0; j < 5; ++j) w[j] = *(const f32x4*)(F.conv_w + j * 1024 + col);
    const f32x4 bias = *(const f32x4*)(F.conv_b + col);
    const int t0 = c * 128 + rg * R - 2;
    const bf16_t* base = F.proj() + (size_t)b * SEQ * PW + C_X + col;
    f32x4 win[R + 4];
#pragma unroll
    for (int k = 0; k < R + 4; ++k) { const int t = t0 + k, tc = t < 0 ? 0 : (t >= SEQ ? SEQ - 1 : t); const u32x2 raw = *(const u32x2*)(base + (size_t)tc * PW); const bool ok = (t == tc);
        win[k] = unpack4((u32x2){ok ? raw.x : 0u, ok ? raw.y : 0u}); }
#pragma unroll
    for (int r = 0; r < R; ++r) {
        f32x4 y = bias;
#pragma unroll
        for (int j = 0; j < 5; ++j) y = y + w[j] * win[r + j];
        *(LAS u32x2*)(img + (rg * R + r) * stride + cq * 8) = pack4(silu4(y));
    }
}
__device__ __forceinline__ void ssd_pass1_item(const Ctx& F, int item) {
    const int g = item & 1, c = (item >> 1) & 31, b = item >> 6;
    const ldsp XI = F.lds + L_XI, BI = F.lds + L_BI, CI = F.lds + L_CI;
    LAS float* DTs = (LAS float*)(F.lds + L_F32); LAS float* ACs = DTs + 1024;
    __syncthreads();
    ssd_dtprep(F, b, c, g, true);
    conv_img<256>(F, b, c, 256 * g, XI, XS);
    conv_img<128>(F, b, c, 512 + 128 * g, BI, BS);
    conv_img<128>(F, b, c, 768 + 128 * g, CI, BS);
    __syncthreads();
    const int lane = F.lane, i16 = lane & 15, q4 = lane >> 4, w = F.wave, tl = 16 * w + i16;
    const size_t row = (size_t)b * SEQ + c * 128 + tl;
    f32x4 cbt[8];
    {
        bf16x8 cf[4];
#pragma unroll
        for (int ks = 0; ks < 4; ++ks) cf[ks] = ld8(CI + tl * BS + (32 * ks + 8 * q4) * 2);
#pragma unroll
        for (int ks = 0; ks < 4; ++ks) *(bf16x8*)(F.cfb() + ((size_t)(item * 8 + w) * 64 + lane) * 32 + 8 * ks) = cf[ks];
#pragma unroll
        for (int sf = 0; sf < 8; ++sf) {
            cbt[sf] = (f32x4){0.f, 0.f, 0.f, 0.f};
#pragma unroll
            for (int ks = 0; ks < 4; ++ks) cbt[sf] = mfma16(ld8(BI + (16 * sf + i16) * BS + (32 * ks + 8 * q4) * 2), cf[ks], cbt[sf]);
        }
    }
#pragma unroll 1
    for (int r = 0; r < 4; ++r) {
        {
            const int dir = w & 1, nq = w >> 1;
            LAS const float* Wr = ACs + 1024 + (dir * 4 + r) * 128;
            f32x4 acc[2][4];
#pragma unroll
            for (int nf = 0; nf < 2; ++nf)
#pragma unroll
                for (int pf = 0; pf < 4; ++pf) acc[nf][pf] = (f32x4){0.f, 0.f, 0.f, 0.f};
#pragma unroll
            for (int ks = 0; ks < 4; ++ks) {
                const int t0 = 32 * ks + 8 * q4, trow = t0 + (i16 >> 2);
                const f32x4 wlo = *(const LAS f32x4*)(Wr + t0), whi = *(const LAS f32x4*)(Wr + t0 + 4);
                bf16x8 af[2], bfr[4];
#pragma unroll
                for (int nf = 0; nf < 2; ++nf) {
                    ldsp p = BI + trow * BS + (32 * nq + 16 * nf + 4 * (i16 & 3)) * 2;
                    const u32x2 lo = __builtin_bit_cast(u32x2, vtr(p)), hi = __builtin_bit_cast(u32x2, vtr(p + 4 * BS));
                    af[nf] = packfrag(unpack4(lo) * wlo, unpack4(hi) * whi);
                }
#pragma unroll
                for (int pf = 0; pf < 4; ++pf) { ldsp p = XI + trow * XS + (64 * r + 16 * pf + 4 * (i16 & 3)) * 2; bfr[pf] = cat8(vtr(p), vtr(p + 4 * XS)); }
#pragma unroll
                for (int nf = 0; nf < 2; ++nf)
#pragma unroll
                    for (int pf = 0; pf < 4; ++pf) acc[nf][pf] = mfma16(af[nf], bfr[pf], acc[nf][pf]);
            }
            bf16_t* S = F.st() + ((((size_t)(b * 32 + c) * 2 + dir) * 8 + (4 * g + r)) << 13);
#pragma unroll
            for (int nf = 0; nf < 2; ++nf)
#pragma unroll
                for (int pf = 0; pf < 4; ++pf) *(u32x2*)(S + (16 * pf + i16) * 128 + 32 * nq + 16 * nf + 4 * q4) = pack4(acc[nf][pf]);
        }
        {
            const float acf = ACs[r * 128 + tl], acb = ACs[(4 + r) * 128 + tl];
            f32x4 yt[4];
#pragma unroll
            for (int pf = 0; pf < 4; ++pf) yt[pf] = (f32x4){0.f, 0.f, 0.f, 0.f};
#pragma unroll
            for (int kp = 0; kp < 4; ++kp) {
                f32x4 gt[2];
#pragma unroll
                for (int u = 0; u < 2; ++u) {
                    const int sf = 2 * kp + u, s0 = 16 * sf + 4 * q4;
                    if (sf < w) {
                        const f32x4 ldf = *(const LAS f32x4*)(DTs + r * 128 + s0);
#pragma unroll
                        for (int e = 0; e < 4; ++e) gt[u][e] = cbt[sf][e] * __expf(acf + ldf[e]);
                    } else if (sf > w) {
                        const f32x4 ldb = *(const LAS f32x4*)(DTs + (4 + r) * 128 + s0);
#pragma unroll
                        for (int e = 0; e < 4; ++e) gt[u][e] = cbt[sf][e] * __expf(acb + ldb[e]);
                    } else {
                        const f32x4 ldf = *(const LAS f32x4*)(DTs + r * 128 + s0), ldb = *(const LAS f32x4*)(DTs + (4 + r) * 128 + s0);
#pragma unroll
                        for (int e = 0; e < 4; ++e) {
                            const int sx = s0 + e;
                            const float mf = sx <= tl ? __expf(acf + ldf[e]) : 0.f;
                            const float mb = sx >= tl ? __expf(acb + ldb[e]) : 0.f;
                            gt[u][e] = cbt[sf][e] * (mf + mb);
                        }
                    }
                }
                const bf16x8 gk = packfrag(gt[0], gt[1]);
#pragma unroll
                for (int pf = 0; pf < 4; ++pf) {
                    ldsp xa = XI + (32 * kp + 4 * q4 + (i16 >> 2)) * XS + (64 * r + 16 * pf + 4 * (i16 & 3)) * 2;
                    yt[pf] = mfma16(cat8(vtr(xa), vtr(xa + 16 * XS)), gk, yt[pf]);
                }
            }
            const float dsk = F.d_skip[4 * g + r];
#pragma unroll
            for (int pf = 0; pf < 4; ++pf) {
                const int pc = 64 * r + 16 * pf + 4 * q4;
                const f32x4 xv = unpack4(*(const LAS u32x2*)(XI + tl * XS + pc * 2));
                *(u32x2*)(F.yp() + row * 512 + 256 * g + pc) = pack4(yt[pf] + xv * dsk);
            }
            if (q4 == 0) { F.efb()[row * 16 + 4 * g + r] = __expf(acf); F.efb()[row * 16 + 8 + 4 * g + r] = __expf(acb); }
        }
    }
}
__device__ __forceinline__ void ssd_scan(const Ctx& F, int vb, int vg) {
    for (int it = vb * 512 + F.tid; it < NBATCH * 2 * 8 * 1024; it += vg * 512) {
        const int e8 = it & 1023, h = (it >> 10) & 7, dir = (it >> 13) & 1, b = it >> 14;
        float run[8];
#pragma unroll
        for (int k = 0; k < 8; ++k) run[k] = 0.f;
        for (int s0 = 0; s0 < 32; s0 += 4) {
            u32x4 v[4]; float dc[4]; bf16_t* ad[4];
#pragma unroll
            for (int u = 0; u < 4; ++u) { const int s = s0 + u, c = dir ? 31 - s : s; ad[u] = F.st() + (((((size_t)(b * 32 + c) * 2 + dir) * 8 + h) << 13) + e8 * 8); v[u] = __builtin_nontemporal_load((const u32x4*)ad[u]); dc[u] = F.dec()[(b * 32 + c) * 16 + dir * 8 + h]; }
#pragma unroll
            for (int u = 0; u < 4; ++u) {
                __builtin_nontemporal_store((u32x4){cvt_pk(run[0], run[1]), cvt_pk(run[2], run[3]), cvt_pk(run[4], run[5]), cvt_pk(run[6], run[7])}, (u32x4*)ad[u]);
                run[0] = run[0] * dc[u] + bf_lo(v[u].x); run[1] = run[1] * dc[u] + bf_hi(v[u].x); run[2] = run[2] * dc[u] + bf_lo(v[u].y); run[3] = run[3] * dc[u] + bf_hi(v[u].y);
                run[4] = run[4] * dc[u] + bf_lo(v[u].z); run[5] = run[5] * dc[u] + bf_hi(v[u].z); run[6] = run[6] * dc[u] + bf_lo(v[u].w); run[7] = run[7] * dc[u] + bf_hi(v[u].w);
            }
        }
    }
}
__device__ __forceinline__ void ssd_pass2_item(const Ctx& F, int item) {
    const int g = item & 1, c = (item >> 1) & 31, b = item >> 6;
    const ldsp PV = F.lds;
    const int lane = F.lane, i16 = lane & 15, q4 = lane >> 4, w = F.wave, tl = 16 * w + i16;
    const size_t row = (size_t)b * SEQ + c * 128 + tl;
    bf16x8 cf[4];
#pragma unroll
    for (int ks = 0; ks < 4; ++ks) cf[ks] = *(const bf16x8*)(F.cfb() + ((size_t)(item * 8 + w) * 64 + lane) * 32 + 8 * ks);
    const int pdir = F.tid >> 8, pp = (F.tid >> 2) & 63, pqu = F.tid & 3;
    const bf16_t* psrc = F.st() + (((((size_t)(b * 32 + c) * 2 + pdir) * 8 + 4 * g) << 13) + pp * 128 + 32 * pqu);
    u32x4 pvn[4][4];
#pragma unroll
    for (int r = 0; r < 4; ++r)
#pragma unroll
        for (int k = 0; k < 4; ++k) pvn[r][k] = *(const u32x4*)(psrc + ((size_t)r << 13) + 8 * k);
    __syncthreads();
#pragma unroll
    for (int r = 0; r < 4; ++r)
#pragma unroll
        for (int k = 0; k < 4; ++k) *(LAS u32x4*)(PV + (2 * r + pdir) * (64 * PS) + pp * PS + (32 * pqu + 8 * k) * 2) = pvn[r][k];
    __syncthreads();
    f32x4 gy[4][4]; float ss = 0.f;
#pragma unroll
    for (int r = 0; r < 4; ++r) {
        u32x2 zraw[4], yraw[4];
#pragma unroll
        for (int pf = 0; pf < 4; ++pf) { const int pc = 256 * g + 64 * r + 16 * pf + 4 * q4; zraw[pf] = *(const u32x2*)(F.proj() + row * PW + C_Z + pc); yraw[pf] = *(const u32x2*)(F.yp() + row * 512 + pc); }
        const float ef = F.efb()[row * 16 + 4 * g + r], eb = F.efb()[row * 16 + 8 + 4 * g + r];
        const ldsp PVr = PV + 2 * r * (64 * PS);
        f32x4 yf[4], yb[4];
#pragma unroll
        for (int pf = 0; pf < 4; ++pf) { yf[pf] = (f32x4){0.f, 0.f, 0.f, 0.f}; yb[pf] = (f32x4){0.f, 0.f, 0.f, 0.f}; }
#pragma unroll
        for (int ks = 0; ks < 4; ++ks)
#pragma unroll
            for (int pf = 0; pf < 4; ++pf) {
                yf[pf] = mfma16(ld8(PVr + (16 * pf + i16) * PS + (32 * ks + 8 * q4) * 2), cf[ks], yf[pf]);
                yb[pf] = mfma16(ld8(PVr + 64 * PS + (16 * pf + i16) * PS + (32 * ks + 8 * q4) * 2), cf[ks], yb[pf]);
            }
#pragma unroll
        for (int pf = 0; pf < 4; ++pf) {
            const f32x4 y = (unpack4(yraw[pf]) + yf[pf] * ef + yb[pf] * eb) * unpack4(zraw[pf]);
            gy[r][pf] = y; ss += y.x * y.x + y.y * y.y + y.z * y.z + y.w * y.w;
        }
    }
    ss += __shfl_xor(ss, 16); ss += __shfl_xor(ss, 32);
    const float rinv = rsqrtf(ss * (1.f / 256.f) + EPS);
#pragma unroll
    for (int r = 0; r < 4; ++r)
#pragma unroll
        for (int pf = 0; pf < 4; ++pf) {
            const int pc = 256 * g + 64 * r + 16 * pf + 4 * q4;
            const f32x4 nw = *(const f32x4*)(F.ssd_norm_w + pc);
            *(u32x2*)(F.mix() + row * MIXP + 1024 + pc) = pack4(gy[r][pf] * rinv * nw);
        }
}

__device__ __forceinline__ void final_norm(const Ctx& F) {
    const int gw = F.bid * 8 + F.wave, NGW = F.G * 8, lane = F.lane;
    for (int m = gw; m < TOK; m += NGW) {
        const f32x4* rp = (const f32x4*)(F.rowss() + (size_t)m * 16); const f32x4 s4 = (rp[0] + rp[1]) + (rp[2] + rp[3]);
        const float r = rsqrtf(((s4.x + s4.y) + (s4.z + s4.w)) * (1.f / DM) + EPS);
        float* o = F.out + (size_t)m * DM;
#pragma unroll
        for (int j = 0; j < 4; ++j) { const f32x4 v = __builtin_nontemporal_load((const f32x4*)(o + 4 * lane + 256 * j)), ww = *(const f32x4*)(F.norm_out_w + 4 * lane + 256 * j); __builtin_nontemporal_store(v * r * ww, (f32x4*)(o + 4 * lane + 256 * j)); }
    }
}

#define XB_TMO      128
#define XB_XCNT(j)  (256  + 64 * (j))
#define XB_XSUB(j)  (1280 + 64 * (j))
#define XB_XGEN(j)  (2304 + 64 * (j))
#define XB_TOP      3328
#define XB_TOPGEN   3392
#define XCD_BAR_WORDS 3456
#define XB_SPIN_CAP (1u << 18)

__device__ __forceinline__ unsigned xb_ld(unsigned* p)              { return __hip_atomic_load(p, __ATOMIC_RELAXED, __HIP_MEMORY_SCOPE_AGENT); }
__device__ __forceinline__ unsigned xb_add(unsigned* p, unsigned v) { return __hip_atomic_fetch_add(p, v, __ATOMIC_RELAXED, __HIP_MEMORY_SCOPE_AGENT); }
__device__ __forceinline__ unsigned xb_xcc_id() { return (unsigned)__builtin_amdgcn_s_getreg((3 << 11) | 20) & 0xFu; }
#define XB_SPIN(cond, bar) do { unsigned _sp = 0; while (cond) { __builtin_amdgcn_s_sleep(1); \
    if ((++_sp & 255u) == 0u) { if (xb_ld(&(bar)[XB_TMO])) break; if (_sp > XB_SPIN_CAP) { atomicAdd(&(bar)[XB_TMO], 1u); break; } } } } while (0)

struct XcdBarrier {
    unsigned* bar; unsigned x;
    volatile LAS unsigned* st;
};

__device__ __forceinline__ XcdBarrier xcd_barrier_post(unsigned* bar, volatile LAS unsigned* st, int xb_tid) {
    XcdBarrier b; b.bar = bar; b.x = xb_xcc_id(); b.st = st;
    if (xb_tid == 0) (void)xb_add(&bar[XB_XCNT(b.x)], 1u);
    return b;
}
__device__ __forceinline__ void xcd_barrier_complete(unsigned* bar, unsigned x, unsigned& nloc, unsigned& nx) {
    const unsigned G = gridDim.x * gridDim.y * gridDim.z;
    unsigned sum, cnt, mine, sp = 0u;
    for (;;) {
        sum = 0u; cnt = 0u; mine = 0u;
#pragma unroll
        for (unsigned j = 0; j < 16; ++j) { const unsigned c = xb_ld(&bar[XB_XCNT(j)]); sum += c; cnt += (c > 0u) ? 1u : 0u; mine = (j == x) ? c : mine; }
        if (sum == G) break;
        __builtin_amdgcn_s_sleep(1);
        if ((++sp & 255u) == 0u) { if (xb_ld(&bar[XB_TMO])) break; if (sp > XB_SPIN_CAP) { atomicAdd(&bar[XB_TMO], 1u); break; } }
    }
    nloc = mine > 0u ? mine : 1u; nx = cnt > 0u ? cnt : 1u;
}

__device__ __forceinline__ void xcd_barrier(const XcdBarrier& b, int xb_tid) {
    asm volatile("s_waitcnt vmcnt(0)" ::: "memory");
    __syncthreads();
    if (xb_tid == 0) {
        unsigned* bar = b.bar;
        __builtin_amdgcn_s_waitcnt(0);
        unsigned nloc = b.st[0], nx = b.st[1];
        if (nloc == 0u) { xcd_barrier_complete(bar, b.x, nloc, nx); b.st[0] = nloc; b.st[1] = nx; }
        const unsigned old = xb_add(&bar[XB_XSUB(b.x)], 1u);
        const unsigned gen = old / nloc;
        if (old + 1u == (gen + 1u) * nloc) {
            __builtin_amdgcn_fence(__ATOMIC_RELEASE, "agent");
            asm volatile("s_waitcnt vmcnt(0)" ::: "memory");
            const unsigned og = xb_add(&bar[XB_TOP], 1u);
            const unsigned tg = og / nx;
            if (og + 1u == (tg + 1u) * nx) xb_add(&bar[XB_TOPGEN], 1u);
            else XB_SPIN(xb_ld(&bar[XB_TOPGEN]) == tg, bar);
            __builtin_amdgcn_fence(__ATOMIC_ACQUIRE, "agent");
            xb_add(&bar[XB_XGEN(b.x)], 1u);
            asm volatile("s_waitcnt vmcnt(0)" ::: "memory");
        } else {
            XB_SPIN(xb_ld(&bar[XB_XGEN(b.x)]) == gen, bar);
            __builtin_amdgcn_fence(__ATOMIC_ACQUIRE, "agent");
            asm volatile("s_waitcnt vmcnt(0)" ::: "memory");
        }
    }
    __syncthreads();
}

__global__ void __launch_bounds__(512, 2) hymba_fwd(Args args) {
    extern __shared__ __attribute__((aligned(16))) unsigned char lds_raw[];
    Ctx F;
    F.x = args.in[0]; F.mem = args.in[1]; F.norm_mem_w = args.in[2]; F.norm_in_w = args.in[3]; F.w_in = args.in[4]; F.attn_sink = args.in[5]; F.conv_w = args.in[6]; F.conv_b = args.in[7];
    F.dt_bias = args.in[8]; F.a_log = args.in[9]; F.d_skip = args.in[10]; F.ssd_norm_w = args.in[11]; F.w_mem_kv = args.in[12]; F.w_out = args.in[13]; F.norm_out_w = args.in[14];
    F.out = args.out; F.ws = args.ws;
    F.lds = (ldsp)lds_raw; F.tid = threadIdx.x; F.lane = F.tid & 63; F.wave = __builtin_amdgcn_readfirstlane(F.tid >> 6); F.G = gridDim.x; F.bid = blockIdx.x;
    const int lo = args.lo, hi = args.hi;
    cg::grid_group grid = cg::this_grid();
#define IN(k) (lo <= (k) && (k) < hi)
#define REFRESH() do { F.lane = lane_id_now(); F.tid = F.wave * 64 + F.lane; } while (0)
    if (F.tid == 0) { *(LAS u32x4*)(F.lds + LDS_XB) = (u32x4){0u, 0u, 0u, 0u}; }
    __syncthreads();
    XcdBarrier xbar; xbar.bar = (unsigned*)args.ws; xbar.x = 0; xbar.st = (volatile LAS unsigned*)(F.lds + LDS_XB);
    if (hi - lo > 1) xbar = xcd_barrier_post((unsigned*)args.ws, (volatile LAS unsigned*)(F.lds + LDS_XB), F.tid);
    if (lo < 0) grid.sync();
#define SEAM(k) do { if (IN(k) && IN((k) + 1)) xcd_barrier(xbar, F.tid); } while (0)
    if (IN(0)) { REFRESH(); phase0(F); }
    SEAM(0);
    if (IN(1)) {
        REFRESH();
        { pg8::Gemm g{F.hn(), F.win_t(), TOK, NPHYS, DM, HNP, HNP}; pg8::StaticOrder S; S.init(g.M, g.N, F.G, F.bid); EpiProj E{F.proj(), F.dt(), F.rope(), F.dt_bias}; pg8::gemm_phase(F.lds, g, S, E, F.wave); }
    }
    SEAM(1);
    if (IN(2)) {
        REFRESH();
        if (F.bid & 1) for (int sq = F.bid; sq < NBATCH * 4 * 4; sq += F.G) attn_window_seq(F, sq);
        for (int it = F.bid; it < NBATCH * 32 * 2; it += F.G) ssd_pass1_item(F, it);
        if (!(F.bid & 1)) for (int sq = F.bid; sq < NBATCH * 4 * 4; sq += F.G) attn_window_seq(F, sq);
    }
    SEAM(2);
    if (IN(3)) {
        REFRESH();
        if (F.G >= 128) {
            if (F.bid < 64) { pg8::Gemm g{F.memn(), F.wmem_t(), NBATCH * 256, 1024, 1024, HNP, HNP}; pg8::StaticOrder S; S.init(g.M, g.N, 64, F.bid); EpiMkv E{F.mkv()}; pg8::gemm_phase(F.lds, g, S, E, F.wave); }
            else ssd_scan(F, F.bid - 64, F.G - 64);
        } else {
            { pg8::Gemm g{F.memn(), F.wmem_t(), NBATCH * 256, 1024, 1024, HNP, HNP}; pg8::StaticOrder S; S.init(g.M, g.N, F.G, F.bid); EpiMkv E{F.mkv()}; pg8::gemm_phase(F.lds, g, S, E, F.wave); }
            ssd_scan(F, F.bid, F.G);
        }
    }
    SEAM(3);
    if (IN(4)) {
        REFRESH();
        if (F.bid & 1) for (int grp = F.bid; grp < NBATCH * 16; grp += F.G) for (int k = 0; k < 4; ++k) attn_mem_item(F, 4 * grp + k, k == 0);
        for (int it = F.bid; it < NBATCH * 32 * 2; it += F.G) ssd_pass2_item(F, it);
        if (!(F.bid & 1)) for (int grp = F.bid; grp < NBATCH * 16; grp += F.G) for (int k = 0; k < 4; ++k) attn_mem_item(F, 4 * grp + k, k == 0);
    }
    SEAM(4);
    if (IN(5)) { REFRESH(); __syncthreads(); pg8::Gemm g{F.mix(), F.wout_t(), TOK, DM, MIXW, MIXP, MIXP}; pg8::StaticOrder S; S.init(g.M, g.N, F.G, F.bid); EpiOut E{F.x, F.out, F.rowss()}; pg8::gemm_phase(F.lds, g, S, E, F.wave); }
    SEAM(5);
    if (IN(6)) { REFRESH(); final_norm(F); }
#undef IN
#undef SEAM
}

extern "C" void kernel_launch(void* const* d_in, const int* in_sizes, int n_in, void* d_out, int out_size, void* d_ws, size_t ws_size, hipStream_t stream) {
    static int grid = 0;
    if (grid == 0) {
        if (n_in != 15 || out_size != TOK * DM || ws_size < WS_END) { fprintf(stderr, "kernel_launch: unexpected shapes (n_in %d out %d ws %zu)\n", n_in, out_size, ws_size); grid = -1; return; }
        int dev = 0, cus = 0, per_cu = 0;
        (void)hipGetDevice(&dev); (void)hipDeviceGetAttribute(&cus, hipDeviceAttributeMultiprocessorCount, dev);
        if (hipFuncSetAttribute((const void*)hymba_fwd, hipFuncAttributeMaxDynamicSharedMemorySize, LDS_BYTES) != hipSuccess) { fprintf(stderr, "kernel_launch: hipFuncSetAttribute failed\n"); grid = -1; return; }
        if (hipOccupancyMaxActiveBlocksPerMultiprocessor(&per_cu, (const void*)hymba_fwd, 512, LDS_BYTES) != hipSuccess || per_cu < 1) { fprintf(stderr, "kernel_launch: occupancy query says %d\n", per_cu); per_cu = 1; }
        (void)hipGetLastError();
        grid = cus > 0 ? cus : 256;
    }
    if (grid < 0) return;
    Args a{};
    for (int i = 0; i < 15; ++i) a.in[i] = (const float*)d_in[i];
    a.out = (float*)d_out; a.ws = (unsigned char*)d_ws;
    (void)hipMemsetAsync(d_ws, 0, 16384, stream);
#if MK_ONE_LAUNCH
    a.lo = 0; a.hi = NPHASE;
    void* kargs[] = {&a};
    hipError_t e = hipLaunchCooperativeKernel((const void*)hymba_fwd, dim3(grid), dim3(512), kargs, LDS_BYTES, stream);
    if (e != hipSuccess) fprintf(stderr, "kernel_launch: cooperative launch failed: %s (grid %d)\n", hipGetErrorString(e), grid);
#else
    for (int k = 0; k < NPHASE; ++k) { a.lo = k; a.hi = k + 1; hipLaunchKernelGGL(hymba_fwd, dim3(grid), dim3(512), LDS_BYTES, stream, a); }
#endif
}
```
